# Optimizing an MI355X kernel written in HIP

```python
import jax, jax.numpy as jnp
from jax import lax
import numpy as np

D_MODEL = 1024
BATCH = 16
SEQ = 4096
DEPTH = 1

CHUNK = 64

D_POOL = D_MODEL // 2
POOL_WINDOWS = (2, 4, 8, 16)
POOL_GROUPS = len(POOL_WINDOWS)
POOL_GROUP_DIM = D_POOL // POOL_GROUPS

D_CONV = D_MODEL // 2
CONV_WIDTH = 3

D_IN = D_POOL + 3 * D_CONV + 2 * D_MODEL

N_KEYS = 128
N_EXPERTS = N_KEYS * N_KEYS
PEER_HEADS = 8
PEER_QUERY_DIM = 256
PEER_HALF = PEER_QUERY_DIM // 2
PEER_TOPK = 16
PEER_TOKEN_BLOCK = 128

RMS_EPS = 1e-6

kernel_name = "hybrid_pool_shortconv_peer_block"


def rmsnorm(x, g):
    xf = x.astype(jnp.float32)
    y = xf * lax.rsqrt(jnp.mean(xf * xf, axis=-1, keepdims=True) + RMS_EPS)
    return (y * g.astype(jnp.float32)).astype(x.dtype)


def pool_mixer(u, group_w, scale):
    S_ = u.shape[1]
    uf = u.astype(jnp.float32)
    csum = jnp.cumsum(uf, axis=1)
    pos = jnp.arange(S_)
    outs = []
    for g, w in enumerate(POOL_WINDOWS):
        sl = slice(g * POOL_GROUP_DIM, (g + 1) * POOL_GROUP_DIM)
        c = csum[:, :, sl]
        c_shift = jnp.pad(c[:, :S_ - w, :], ((0, 0), (w, 0), (0, 0)))
        cnt = jnp.minimum(pos + 1, w).astype(jnp.float32)[None, :, None]
        outs.append((c - c_shift) / cnt - uf[:, :, sl])
    p = jnp.stack(outs, axis=2).astype(u.dtype)
    p = jnp.einsum('bsgc,gcd->bsgd', p, group_w)
    return p.reshape(u.shape) * scale


def short_conv_mixer(c_gate, b_gate, v, conv_w):
    S_ = v.shape[1]
    u = c_gate * v
    up = jnp.pad(u, ((0, 0), (CONV_WIDTH - 1, 0), (0, 0)))
    y = up[:, 0:S_, :] * conv_w[0]
    for k in range(1, CONV_WIDTH):
        y = y + up[:, k:k + S_, :] * conv_w[k]
    return b_gate * y


def peer_ffn(h, w_q, sub_keys, expert_u, expert_v):
    B_, S_, D_ = h.shape
    hb_all = h.reshape(B_ * S_ // PEER_TOKEN_BLOCK, PEER_TOKEN_BLOCK, D_)

    def block(hb):
        q = (hb @ w_q).reshape(PEER_TOKEN_BLOCK, PEER_HEADS, 2, PEER_HALF)
        s = jnp.einsum('thpc,hpkc->thpk', q, sub_keys).astype(jnp.float32)
        top_s, top_i = lax.top_k(s, PEER_TOPK)
        cand_s = top_s[:, :, 0, :, None] + top_s[:, :, 1, None, :]
        cand_i = top_i[:, :, 0, :, None] * N_KEYS + top_i[:, :, 1, None, :]
        cand_s = cand_s.reshape(PEER_TOKEN_BLOCK, PEER_HEADS, PEER_TOPK * PEER_TOPK)
        cand_i = cand_i.reshape(PEER_TOKEN_BLOCK, PEER_HEADS, PEER_TOPK * PEER_TOPK)
        fin_s, fin_pos = lax.top_k(cand_s, PEER_TOPK)
        idx = jnp.take_along_axis(cand_i, fin_pos, axis=-1)
        gates = jax.nn.softmax(fin_s, axis=-1)
        u = expert_u[idx]
        act = jax.nn.gelu(jnp.einsum('thkd,td->thk', u, hb).astype(jnp.float32), approximate=False)
        wts = (gates * act).astype(hb.dtype)
        return jnp.einsum('thk,thkd->td', wts, expert_v[idx])

    out = lax.map(block, hb_all)
    return out.reshape(B_, S_, D_)


def setup_inputs(seed: int = 0) -> dict:
    key = jax.random.key(seed)
    ks = jax.random.split(key, 16)
    f32 = jnp.float32
    nrm = lambda k, shape, s: jax.random.normal(k, shape, f32) * s
    L = DEPTH
    return {
        "x": nrm(ks[0], (BATCH, SEQ, D_MODEL), 1.0),
        "g_mix": 1.0 + nrm(ks[1], (L, D_MODEL), 0.02),
        "w_in": nrm(ks[2], (L, D_MODEL, D_IN), D_MODEL ** -0.5),
        "pool_group_w": nrm(ks[3], (L, POOL_GROUPS, POOL_GROUP_DIM, POOL_GROUP_DIM), POOL_GROUP_DIM ** -0.5),
        "pool_scale": 1.0 + nrm(ks[4], (L, D_POOL), 0.02),
        "conv_w": nrm(ks[5], (L, CONV_WIDTH, D_CONV), CONV_WIDTH ** -0.5),
        "w_branch_pool": nrm(ks[6], (L, D_POOL, D_MODEL), D_POOL ** -0.5),
        "w_branch_conv": nrm(ks[7], (L, D_CONV, D_MODEL), D_CONV ** -0.5),
        "w_out": nrm(ks[8], (L, D_MODEL, D_MODEL), D_MODEL ** -0.5),
        "g_ffn": 1.0 + nrm(ks[9], (L, D_MODEL), 0.02),
        "w_q": nrm(ks[10], (L, D_MODEL, PEER_HEADS * PEER_QUERY_DIM), D_MODEL ** -0.5),
        "sub_keys": nrm(ks[11], (L, PEER_HEADS, 2, N_KEYS, PEER_HALF), PEER_HALF ** -0.5),
        "expert_u": nrm(ks[12], (L, N_EXPERTS, D_MODEL), D_MODEL ** -0.5),
        "expert_v": nrm(ks[13], (L, N_EXPERTS, D_MODEL), PEER_HEADS ** -0.5),
        "g_final": 1.0 + nrm(ks[14], (D_MODEL,), 0.02),
    }


def reference(x, g_mix, w_in, pool_group_w, pool_scale, conv_w, w_branch_pool, w_branch_conv,
              w_out, g_ffn, w_q, sub_keys, expert_u, expert_v, g_final):
    for l in range(DEPTH):
        h = rmsnorm(x, g_mix[l])
        z = h @ w_in[l]
        o1 = D_POOL
        o2 = o1 + D_CONV
        o3 = o2 + D_CONV
        o4 = o3 + D_CONV
        o5 = o4 + D_MODEL
        z_pool, z_c, z_b, z_v = z[..., :o1], z[..., o1:o2], z[..., o2:o3], z[..., o3:o4]
        gate_a, gate_b = z[..., o4:o5], z[..., o5:]
        a = pool_mixer(z_pool, pool_group_w[l], pool_scale[l]) @ w_branch_pool[l]
        b = short_conv_mixer(z_c, z_b, z_v, conv_w[l]) @ w_branch_conv[l]
        m = jax.nn.sigmoid(gate_a) * a + jax.nn.sigmoid(gate_b) * b
        x = x + m @ w_out[l]
        h2 = rmsnorm(x, g_ffn[l])
        x = x + peer_ffn(h2, w_q[l], sub_keys[l], expert_u[l], expert_v[l])
    return rmsnorm(x, g_final)
```

```cpp
#include <hip/hip_runtime.h>
#include <cstdio>
#include <cstdint>

#ifndef MK_N_LAUNCHES
#define MK_N_LAUNCHES 8
#endif

namespace pg8 {
#define PG8_LAS __attribute__((address_space(3)))
typedef unsigned short bf16_t;
typedef short bf16x8 __attribute__((ext_vector_type(8)));
typedef float f32x4 __attribute__((ext_vector_type(4)));
typedef unsigned u32x4 __attribute__((ext_vector_type(4)));
constexpr int BM = 256, BK = 64, HALF = 128, HTB = HALF * BK * 2  , STAGE_BYTES = 8 * HTB, NXCD = 8, WGM = 8;

__host__ __device__ __forceinline__ int lds_byte(int r, int c) { const int st = (r >> 4) * 2 + (c >> 5), rr = r & 15, cc = c & 31, ob = rr * 64 + cc * 2; return st * 1024 + (ob ^ (((ob >> 9) & 1) << 5)); }
__host__ __device__ __forceinline__ void stage_rc(int b, int& R, int& C) { const int st = b / 1024, sb = b % 1024, swz = sb ^ (((sb >> 9) & 1) << 5); R = (st >> 1) * 16 + swz / 64; C = (st & 1) * 32 + (swz % 64) / 2; }
__host__ __device__ __forceinline__ int perm32(int rho) { const int n = rho >> 4, i = rho & 15; return 8 * (i >> 2) + 4 * n + (i & 3); }

struct Unit { int pm, pn, seg; };
struct Gemm { const bf16_t* A; const bf16_t* Bt; const bf16_t* A2; const bf16_t* Bt2; int M, N, K; };

struct StaticOrder {
    int nM, nN, nwg, G, c, segs;
    __host__ __device__ void init(int M, int N, int G_, int c_, int segs_) { nM = M / BM; nN = N / BM; nwg = nM * nN; G = G_; c = c_; segs = segs_; }
    __host__ __device__ bool next(int i, Unit& u) const {
        const int ti = (segs == 2) ? (i >> 1) : i; u.seg = (segs == 2) ? (i & 1) : 0;
        const long L = (long)ti * G + c; if (L >= nwg) return false;
        int wgid = (int)L; { const int q = nwg / NXCD, r = nwg % NXCD, xcd = wgid % NXCD, off = wgid / NXCD; wgid = (xcd < r ? xcd * (q + 1) : r * (q + 1) + (xcd - r) * q) + off; }
        const int nig = WGM * nN, gid = wgid / nig, fm = gid * WGM, gsz = (nM - fm) < WGM ? (nM - fm) : WGM;
        u.pm = fm + ((wgid % nig) % gsz); u.pn = (wgid % nig) / gsz; return true;
    }
    __device__ __forceinline__ void a_ready(const Unit&) const {}
    __device__ __forceinline__ void done(const Unit&) const {}
};

__device__ __forceinline__ unsigned cvt_pk_bf16(float lo, float hi) { unsigned r; asm volatile("v_cvt_pk_bf16_f32 %0, %1, %2" : "=v"(r) : "v"(lo), "v"(hi)); return r; }

template <class Epi, class Sched, bool ALIGN_EPI = false, bool SP2 = false>
__device__ __forceinline__ void gemm_phase(PG8_LAS unsigned char* lds, const Gemm g, const Sched& S, const Epi& E) {
    const int tid = threadIdx.x, wid = __builtin_amdgcn_readfirstlane(tid >> 6), lane = tid & 63, wr = wid >> 2, wc = wid & 3, fr = lane & 15, fq = lane >> 4;
    const int K = g.K, nt = K / BK;
    unsigned voffA[2], voffB[2];
#pragma unroll
    for (int i = 0; i < 2; ++i) { int R, C; stage_rc(tid * 16 + i * 8192, R, C); const int Rb = Epi::PERM ? ((R & ~31) + perm32(R & 31)) : R;
        voffA[i] = (unsigned)(R * K + C) * 2u; voffB[i] = (unsigned)(Rb * K + C) * 2u; }
    const size_t kstep = (size_t)(BK * 2);
    const size_t hstep = (size_t)HALF * K * 2;
    const size_t tstep = 2 * hstep;
    const unsigned ldsw = (unsigned)wid * 1024u;
    const int aoff = lds_byte(wr * 64 + fr, fq * 8), boff = lds_byte(wc * 32 + fr, fq * 8);
#define PG8_SA(b, h) (((b) * 2 + (h)) * HTB)
#define PG8_SB(b, h) ((4 + (b) * 2 + (h)) * HTB)
#define PG8_STAGE(bufoff, gbase, voff) do { _Pragma("unroll") for (int _i = 0; _i < 2; ++_i) \
        __builtin_amdgcn_global_load_lds((const unsigned*)((const char*)(gbase) + (voff)[_i]), (PG8_LAS unsigned*)(lds + (bufoff) + ldsw + _i * 8192), 16, 0, 0); } while (0)
#define PG8_LDA(dst, b, h) do { _Pragma("unroll") for (int m = 0; m < 4; ++m) _Pragma("unroll") for (int k = 0; k < 2; ++k) dst[m][k] = *(const PG8_LAS bf16x8*)(lds + PG8_SA(b, h) + aoff + m * 2048 + k * 1024); } while (0)
#define PG8_LDB(dst, b, h) do { _Pragma("unroll") for (int n = 0; n < 2; ++n) _Pragma("unroll") for (int k = 0; k < 2; ++k) dst[n][k] = *(const PG8_LAS bf16x8*)(lds + PG8_SB(b, h) + boff + n * 2048 + k * 1024); } while (0)
#define PG8_MMA(ai, bj, At, Bt) do { __builtin_amdgcn_s_setprio(1); _Pragma("unroll") for (int m = 0; m < 4; ++m) _Pragma("unroll") for (int n = 0; n < 2; ++n) _Pragma("unroll") for (int k = 0; k < 2; ++k) \
        acc[ai][bj][m][n] = __builtin_amdgcn_mfma_f32_16x16x32_bf16(Bt[n][k], At[m][k], acc[ai][bj][m][n], 0, 0, 0); __builtin_amdgcn_s_setprio(0); } while (0)
#define PG8_WAIT_V(n) asm volatile("s_waitcnt vmcnt(" #n ")" ::: "memory")
#define PG8_WAIT_L(n) asm volatile("s_waitcnt lgkmcnt(" #n ")" ::: "memory")
#define PG8_BAR __builtin_amdgcn_s_barrier()
#define PG8_SCHED __builtin_amdgcn_sched_barrier(0)
    Unit cur, nxt; int ui = 0;
    if (!S.next(0, cur)) return;
    f32x4 acc[2][2][4][2];
#pragma unroll
    for (int a = 0; a < 2; ++a)
#pragma unroll
        for (int b = 0; b < 2; ++b)
#pragma unroll
            for (int m = 0; m < 4; ++m)
#pragma unroll
                for (int n = 0; n < 2; ++n) acc[a][b][m][n] = (f32x4){0.f, 0.f, 0.f, 0.f};
    bf16x8 At[4][2], B0[2][2], B1[2][2];
    const char* cA = (const char*)(cur.seg ? g.A2 : g.A) + (size_t)cur.pm * tstep; const char* cB = (const char*)(cur.seg ? g.Bt2 : g.Bt) + (size_t)cur.pn * tstep;
    S.a_ready(cur);
    if constexpr (SP2) {
        PG8_STAGE(PG8_SB(0, 0), cB, voffB); PG8_STAGE(PG8_SB(0, 1), cB + hstep, voffB); PG8_STAGE(PG8_SA(0, 0), cA, voffA); PG8_STAGE(PG8_SA(0, 1), cA + hstep, voffA);
        if (wr == 1) PG8_BAR;
        PG8_WAIT_V(2); PG8_BAR;
        PG8_STAGE(PG8_SB(1, 0), cB + kstep, voffB); PG8_STAGE(PG8_SA(1, 0), cA + kstep, voffA); PG8_STAGE(PG8_SB(1, 1), cB + hstep + kstep, voffB);
        PG8_WAIT_V(6); PG8_BAR;
    } else {
        PG8_STAGE(PG8_SB(0, 0), cB, voffB); PG8_STAGE(PG8_SA(0, 0), cA, voffA); PG8_STAGE(PG8_SB(0, 1), cB + hstep, voffB); PG8_STAGE(PG8_SA(0, 1), cA + hstep, voffA);
        if (wr == 1) PG8_BAR;
        PG8_WAIT_V(4); PG8_BAR;
        PG8_STAGE(PG8_SB(1, 0), cB + kstep, voffB); PG8_STAGE(PG8_SA(1, 0), cA + kstep, voffA); PG8_STAGE(PG8_SB(1, 1), cB + hstep + kstep, voffB);
        PG8_WAIT_V(6); PG8_BAR;
    }
    for (;;) {
        const bool has_next = S.next(ui + 1, nxt);
        const char* nA = has_next ? (const char*)(nxt.seg ? g.A2 : g.A) + (size_t)nxt.pm * tstep : cA; const char* nB = has_next ? (const char*)(nxt.seg ? g.Bt2 : g.Bt) + (size_t)nxt.pn * tstep : cB;
        for (int t = 0; t < nt; t += 2) {
            const bool last = (t == nt - 2);
            const char* a1 = cA + (size_t)(t + 1) * kstep;
            const char* a2 = last ? nA : cA + (size_t)(t + 2) * kstep; const char* b2 = last ? nB : cB + (size_t)(t + 2) * kstep;
            const char* a3 = a2 + kstep; const char* b3 = b2 + kstep;
            if (last && has_next) S.a_ready(nxt);
            if constexpr (SP2) {
            PG8_LDB(B0, 0, 0); PG8_LDB(B1, 0, 1); PG8_SCHED; PG8_LDA(At, 0, 0); PG8_STAGE(PG8_SA(1, 1), a1 + hstep, voffA);
            PG8_WAIT_V(8); PG8_WAIT_L(0); PG8_BAR; PG8_MMA(0, 0, At, B0); PG8_MMA(0, 1, At, B1); PG8_BAR; PG8_SCHED;
            PG8_LDA(At, 0, 1); PG8_STAGE(PG8_SB(0, 0), b2, voffB); PG8_STAGE(PG8_SB(0, 1), b2 + hstep, voffB); PG8_STAGE(PG8_SA(0, 0), a2, voffA);
            PG8_WAIT_V(8); PG8_WAIT_L(0); PG8_BAR; PG8_MMA(1, 0, At, B0); PG8_MMA(1, 1, At, B1); PG8_BAR; PG8_SCHED;
            PG8_LDB(B0, 1, 0); PG8_LDB(B1, 1, 1); PG8_SCHED; PG8_LDA(At, 1, 0); PG8_STAGE(PG8_SA(0, 1), a2 + hstep, voffA);
            PG8_WAIT_V(8); PG8_WAIT_L(0); PG8_BAR; PG8_MMA(0, 0, At, B0); PG8_MMA(0, 1, At, B1); PG8_BAR; PG8_SCHED;
            PG8_LDA(At, 1, 1); PG8_STAGE(PG8_SB(1, 0), b3, voffB); PG8_STAGE(PG8_SB(1, 1), b3 + hstep, voffB); PG8_STAGE(PG8_SA(1, 0), a3, voffA);
            PG8_WAIT_V(8); PG8_WAIT_L(0); PG8_BAR; PG8_MMA(1, 0, At, B0); PG8_MMA(1, 1, At, B1); PG8_BAR; PG8_SCHED;
            } else {
            PG8_LDB(B0, 0, 0); PG8_SCHED; PG8_LDA(At, 0, 0); PG8_STAGE(PG8_SA(1, 1), a1 + hstep, voffA);
            PG8_WAIT_L(8); PG8_BAR; PG8_WAIT_L(0); PG8_MMA(0, 0, At, B0); PG8_BAR; PG8_SCHED;
            PG8_LDB(B1, 0, 1); PG8_STAGE(PG8_SB(0, 0), b2, voffB);
            PG8_BAR; PG8_WAIT_L(0); PG8_MMA(0, 1, At, B1); PG8_BAR;
            PG8_LDA(At, 0, 1); PG8_STAGE(PG8_SA(0, 0), a2, voffA);
            PG8_BAR; PG8_WAIT_L(0); PG8_MMA(1, 0, At, B0); PG8_BAR; PG8_SCHED;
            PG8_STAGE(PG8_SB(0, 1), b2 + hstep, voffB);
            PG8_WAIT_V(6); PG8_BAR; PG8_MMA(1, 1, At, B1); PG8_BAR;
            PG8_LDB(B0, 1, 0); PG8_SCHED; PG8_LDA(At, 1, 0); PG8_STAGE(PG8_SA(0, 1), a2 + hstep, voffA);
            PG8_WAIT_L(8); PG8_BAR; PG8_WAIT_L(0); PG8_MMA(0, 0, At, B0); PG8_BAR; PG8_SCHED;
            PG8_LDB(B1, 1, 1); PG8_STAGE(PG8_SB(1, 0), b3, voffB);
            PG8_BAR; PG8_WAIT_L(0); PG8_MMA(0, 1, At, B1); PG8_BAR;
            PG8_LDA(At, 1, 1); PG8_STAGE(PG8_SA(1, 0), a3, voffA);
            PG8_BAR; PG8_WAIT_L(0); PG8_MMA(1, 0, At, B0); PG8_BAR; PG8_SCHED;
            PG8_STAGE(PG8_SB(1, 1), b3 + hstep, voffB);
            PG8_WAIT_V(6); PG8_BAR; PG8_MMA(1, 1, At, B1); PG8_BAR;
            }
        }
        if constexpr (ALIGN_EPI) { if (wr == 0) PG8_BAR; }
        const bool keep = E(acc, cur, wr, wc, fr, fq); S.done(cur);
        if (!has_next) break;
        if (!keep) {
#pragma unroll
        for (int a = 0; a < 2; ++a)
#pragma unroll
            for (int b = 0; b < 2; ++b)
#pragma unroll
                for (int m = 0; m < 4; ++m)
#pragma unroll
                    for (int n = 0; n < 2; ++n) acc[a][b][m][n] = (f32x4){0.f, 0.f, 0.f, 0.f};
        }
        cur = nxt; cA = nA; cB = nB; ++ui;
        if constexpr (ALIGN_EPI) { if (wr == 1) PG8_BAR; }
    }
    PG8_WAIT_V(0);
    if constexpr (!ALIGN_EPI) { if (wr == 0) PG8_BAR; }
    PG8_BAR;
#undef PG8_SA
#undef PG8_SB
#undef PG8_STAGE
#undef PG8_LDA
#undef PG8_LDB
#undef PG8_MMA
#undef PG8_WAIT_V
#undef PG8_WAIT_L
#undef PG8_BAR
#undef PG8_SCHED
}
}

constexpr int NWAVES = 8;
constexpr int M = 65536, D = 1024, SEQ = 4096, DIN = 4096, DP = 512, NSC = 2048, NE = 16384, NH = 8, TOPK = 16;
constexpr float RMS_EPS = 1e-6f;
constexpr int N_LAUNCHES = MK_N_LAUNCHES;
constexpr int PER_PHASE = 8;

constexpr size_t MiB = 1u << 20;
constexpr size_t WS_CTL = 0, CTL_ZERO_BYTES = 1 * MiB;
constexpr size_t WS_WIN = 1 * MiB;
constexpr size_t WS_WC = 9 * MiB;
constexpr size_t WS_WBC = 10 * MiB;
constexpr size_t WS_WOUT = 11 * MiB;
constexpr size_t WS_WPP = 13 * MiB;
constexpr size_t WS_SU = 17 * MiB;
constexpr size_t WS_SV = 17 * MiB + 65536;
constexpr size_t WS_SSQ = 18 * MiB;
constexpr size_t WS_U8 = 22 * MiB;
constexpr size_t WS_V8 = 38 * MiB;
constexpr size_t WS_INV = 54 * MiB;
constexpr size_t WS_B = 64 * MiB;
constexpr size_t WS_C = 192 * MiB;
constexpr size_t WS_A = 320 * MiB;
constexpr size_t WS_END = 832 * MiB;
constexpr int CW_BAR = 4096;

constexpr int RING_BYTES = 131072;
constexpr int LDSCTL_OFF = RING_BYTES, MISC_OFF = LDSCTL_OFF + 320;
constexpr int LDS_BYTES = 147456;

#define GAS __attribute__((address_space(1)))
#define LAS __attribute__((address_space(3)))
typedef unsigned short bf16;
typedef unsigned v4u __attribute__((ext_vector_type(4)));
typedef unsigned v2u __attribute__((ext_vector_type(2)));
typedef float f32x4 __attribute__((ext_vector_type(4)));
typedef GAS unsigned gu32;
#define RLX_AGENT __ATOMIC_RELAXED, __HIP_MEMORY_SCOPE_AGENT
#define LDS_WAIT() asm volatile("s_waitcnt lgkmcnt(0)" ::: "memory")
#define VM_WAIT() asm volatile("s_waitcnt vmcnt(0)" ::: "memory")
__device__ __forceinline__ unsigned f2bf(float f) { unsigned u = __builtin_bit_cast(unsigned, f); return (u + 0x7fffu + ((u >> 16) & 1u)) >> 16; }
__device__ __forceinline__ unsigned pk2(float lo, float hi) { return f2bf(lo) | (f2bf(hi) << 16); }
__device__ __forceinline__ float bflo(unsigned w) { return __builtin_bit_cast(float, w << 16); }
__device__ __forceinline__ float bfhi(unsigned w) { return __builtin_bit_cast(float, w & 0xffff0000u); }
__device__ __forceinline__ float wave_sum(float v) {
#pragma unroll
    for (int o = 1; o < 64; o <<= 1) v += __shfl_xor(v, o);
    return v;
}
__device__ __forceinline__ float wave_max(float v) {
#pragma unroll
    for (int o = 1; o < 64; o <<= 1) v = fmaxf(v, __shfl_xor(v, o));
    return v;
}

#define XB_TMO      128
#define XB_XCNT(j)  (256  + 64 * (j))
#define XB_XSUB(j)  (1280 + 64 * (j))
#define XB_XGEN(j)  (2304 + 64 * (j))
#define XB_TOP      3328
#define XB_TOPGEN   3392
#define XCD_BAR_WORDS 3456
#define XB_SPIN_CAP (1u << 18)
__device__ __forceinline__ unsigned xb_ld(unsigned* p)              { return __hip_atomic_load(p, __ATOMIC_RELAXED, __HIP_MEMORY_SCOPE_AGENT); }
__device__ __forceinline__ unsigned xb_add(unsigned* p, unsigned v) { return __hip_atomic_fetch_add(p, v, __ATOMIC_RELAXED, __HIP_MEMORY_SCOPE_AGENT); }
__device__ __forceinline__ unsigned xb_xcc_id() { return (unsigned)__builtin_amdgcn_s_getreg((3 << 11) | 20) & 0xFu; }
#define XB_SPIN(cond, bar) do { unsigned _sp = 0; while (cond) { __builtin_amdgcn_s_sleep(1); \
    if ((++_sp & 255u) == 0u) { if (xb_ld(&(bar)[XB_TMO])) break; if (_sp > XB_SPIN_CAP) { atomicAdd(&(bar)[XB_TMO], 1u); break; } } } } while (0)
struct XcdBarrier { unsigned* bar; unsigned x; volatile LAS unsigned* st; };
__device__ __forceinline__ XcdBarrier xcd_barrier_post(unsigned* bar, volatile LAS unsigned* st) {
    XcdBarrier b; b.bar = bar; b.x = xb_xcc_id(); b.st = st;
    if (threadIdx.x == 0) (void)xb_add(&bar[XB_XCNT(b.x)], 1u);
    return b;
}
__device__ __forceinline__ void xcd_barrier_complete(unsigned* bar, unsigned x, unsigned& nloc, unsigned& nx) {
    const unsigned G = gridDim.x * gridDim.y * gridDim.z;
    unsigned sum, cnt, mine, sp = 0u;
    for (;;) {
        sum = 0u; cnt = 0u; mine = 0u;
#pragma unroll
        for (unsigned j = 0; j < 16; ++j) { const unsigned c = xb_ld(&bar[XB_XCNT(j)]); sum += c; cnt += (c > 0u) ? 1u : 0u; mine = (j == x) ? c : mine; }
        if (sum == G) break;
        __builtin_amdgcn_s_sleep(1);
        if ((++sp & 255u) == 0u) { if (xb_ld(&bar[XB_TMO])) break; if (sp > XB_SPIN_CAP) { atomicAdd(&bar[XB_TMO], 1u); break; } }
    }
    nloc = mine > 0u ? mine : 1u; nx = cnt > 0u ? cnt : 1u;
}
__device__ __forceinline__ void xcd_barrier(const XcdBarrier& b) {
    asm volatile("s_waitcnt vmcnt(0)" ::: "memory");
    __syncthreads();
    if (threadIdx.x == 0) {
        unsigned* bar = b.bar;
        __builtin_amdgcn_s_waitcnt(0);
        unsigned nloc = b.st[0], nx = b.st[1];
        if (nloc == 0u) { xcd_barrier_complete(bar, b.x, nloc, nx); b.st[0] = nloc; b.st[1] = nx; }
        const unsigned old = xb_add(&bar[XB_XSUB(b.x)], 1u);
        const unsigned gen = old / nloc;
        if (old + 1u == (gen + 1u) * nloc) {
            __builtin_amdgcn_fence(__ATOMIC_RELEASE, "agent");
            asm volatile("s_waitcnt vmcnt(0)" ::: "memory");
            const unsigned og = xb_add(&bar[XB_TOP], 1u);
            const unsigned tg = og / nx;
            if (og + 1u == (tg + 1u) * nx) xb_add(&bar[XB_TOPGEN], 1u);
            else XB_SPIN(xb_ld(&bar[XB_TOPGEN]) == tg, bar);
            __builtin_amdgcn_fence(__ATOMIC_ACQUIRE, "agent");
            xb_add(&bar[XB_XGEN(b.x)], 1u);
            asm volatile("s_waitcnt vmcnt(0)" ::: "memory");
        } else {
            XB_SPIN(xb_ld(&bar[XB_XGEN(b.x)]) == gen, bar);
            __builtin_amdgcn_fence(__ATOMIC_ACQUIRE, "agent");
            asm volatile("s_waitcnt vmcnt(0)" ::: "memory");
        }
    }
    __syncthreads();
}

__device__ __forceinline__ void p0_transpose_item(const float* W, int K, int N, bf16* WT, LAS float* scr, int item, int lane) {
    const int nblk = N / 32, kb = item / nblk, nb = item % nblk, k0 = 64 * kb, n0 = 32 * nb;
#pragma unroll 8
    for (int i = 0; i < 32; ++i) { const int kk = 2 * i + (lane >> 5); scr[kk * 33 + (lane & 31)] = W[(size_t)(k0 + kk) * N + n0 + (lane & 31)]; }
    LDS_WAIT(); asm volatile("" ::: "memory");
    const int c = lane & 7;
#pragma unroll
    for (int j = 0; j < 4; ++j) { const int n = (lane >> 3) + 8 * j; const LAS float* s = scr + (8 * c) * 33 + n;
        v4u o; o.x = pk2(s[0 * 33], s[1 * 33]); o.y = pk2(s[2 * 33], s[3 * 33]); o.z = pk2(s[4 * 33], s[5 * 33]); o.w = pk2(s[6 * 33], s[7 * 33]);
        *(v4u*)(WT + (size_t)(n0 + n) * K + k0 + 8 * c) = o; }
    LDS_WAIT(); asm volatile("" ::: "memory");
}
__device__ __forceinline__ void p0_wc_item(const float* gwt, const float* scale, const float* wbp, bf16* WcT, int item, int lane) {
    const int nb = item & 15, cb = (item >> 4) & 7, g = item >> 7;
    const int n = nb * 64 + lane;
    float acc[16];
#pragma unroll
    for (int c = 0; c < 16; ++c) acc[c] = 0.f;
    for (int d = 0; d < 128; ++d) {
        const float b = wbp[(size_t)(g * 128 + d) * 1024 + n] * scale[g * 128 + d];
#pragma unroll
        for (int c = 0; c < 16; ++c) acc[c] += gwt[(size_t)((g * 128 + cb * 16 + c) * 128) + d] * b;
    }
    v4u o0, o1;
    o0.x = pk2(acc[0], acc[1]); o0.y = pk2(acc[2], acc[3]); o0.z = pk2(acc[4], acc[5]); o0.w = pk2(acc[6], acc[7]);
    o1.x = pk2(acc[8], acc[9]); o1.y = pk2(acc[10], acc[11]); o1.z = pk2(acc[12], acc[13]); o1.w = pk2(acc[14], acc[15]);
    bf16* dst = WcT + (size_t)n * 512 + g * 128 + cb * 16;
    *(v4u*)dst = o0; *(v4u*)(dst + 8) = o1;
}
__device__ __forceinline__ void p0_wpp_item(const float* wq, const float* keys, const float* gffn, bf16* WppT, int item, int lane) {
    const int kb = item & 3, db = (item >> 2) & 15, hp = item >> 6;
    const int d = db * 64 + lane;
    float acc[32];
#pragma unroll
    for (int k = 0; k < 32; ++k) acc[k] = 0.f;
    const float* arow = wq + (size_t)d * 2048 + hp * 128;
    const float* kbase = keys + (size_t)(hp * 128 + kb * 32) * 128;
    for (int c4 = 0; c4 < 32; ++c4) {
        const f32x4 a = *(const f32x4*)(arow + 4 * c4);
#pragma unroll
        for (int k = 0; k < 32; ++k) { const float* kr = kbase + k * 128 + 4 * c4; acc[k] += a.x * kr[0] + a.y * kr[1] + a.z * kr[2] + a.w * kr[3]; }
    }
    const float gs = gffn[d];
#pragma unroll
    for (int k = 0; k < 32; ++k) WppT[(size_t)(hp * 128 + kb * 32 + k) * 1024 + d] = (bf16)f2bf(acc[k] * gs);
}
__device__ __forceinline__ void p0_h_row(const float* xrow, const float* g, bf16* orow, int lane) {
    const f32x4* xr = (const f32x4*)xrow + lane; const f32x4* gr = (const f32x4*)g + lane;
    f32x4 v[4]; float s = 0.f;
#pragma unroll
    for (int j = 0; j < 4; ++j) { v[j] = xr[64 * j]; s += (v[j].x * v[j].x + v[j].y * v[j].y) + (v[j].z * v[j].z + v[j].w * v[j].w); }
    const float rstd = rsqrtf(wave_sum(s) * (1.f / D) + RMS_EPS);
    v2u* o8 = (v2u*)orow + lane;
#pragma unroll
    for (int j = 0; j < 4; ++j) { const f32x4 gg = gr[64 * j]; v2u o; o.x = pk2(v[j].x * rstd * gg.x, v[j].y * rstd * gg.y); o.y = pk2(v[j].z * rstd * gg.z, v[j].w * rstd * gg.w); o8[64 * j] = o; }
}
__device__ __forceinline__ void p0_quant_row(const float* src, const float* gmul, unsigned char* dst, float* scale_out, int e, int lane, bool uns) {
    const f32x4* p = (const f32x4*)(src + (size_t)e * 1024 + 16 * lane);
    f32x4 v[4];
#pragma unroll
    for (int j = 0; j < 4; ++j) v[j] = p[j];
    if (gmul) { const f32x4* gp = (const f32x4*)(gmul + 16 * lane);
#pragma unroll
        for (int j = 0; j < 4; ++j) v[j] = v[j] * gp[j]; }
    float mx = 0.f;
#pragma unroll
    for (int j = 0; j < 4; ++j) mx = fmaxf(mx, fmaxf(fmaxf(fabsf(v[j].x), fabsf(v[j].y)), fmaxf(fabsf(v[j].z), fabsf(v[j].w))));
    mx = wave_max(mx);
    const float sc = mx > 0.f ? mx * (1.f / 127.f) : 1.f, inv = 1.f / sc;
    const int bias = uns ? 128 : 0;
    v4u w;
#pragma unroll
    for (int j = 0; j < 4; ++j) {
        unsigned acc = 0;
#pragma unroll
        for (int c = 0; c < 4; ++c) { int q = (int)rintf(v[j][c] * inv); q = q > 127 ? 127 : (q < -127 ? -127 : q); acc |= ((unsigned)(q + bias) & 0xffu) << (8 * c); }
        w[j] = acc;
    }
    *(v4u*)(dst + (size_t)e * 1024 + 16 * lane) = w;
    if (lane == 0) scale_out[e] = sc;
}

typedef pg8::f32x4 (&AccRef)[2][2][4][2];
struct EpiZ {
    static constexpr bool PERM = true;
    bf16* O; int ldc;
    __device__ __forceinline__ bool operator()(AccRef acc, const pg8::Unit& u, int wr, int wc, int fr, int fq) const {
        const int row0 = u.pm * 256 + wr * 64 + fr, col0 = u.pn * 256 + wc * 32 + 8 * fq;
#pragma unroll
        for (int ai = 0; ai < 2; ++ai)
#pragma unroll
            for (int m = 0; m < 4; ++m) { bf16* rowp = O + (size_t)(row0 + ai * 128 + m * 16) * ldc + col0;
#pragma unroll
                for (int bj = 0; bj < 2; ++bj) { const pg8::f32x4 v0 = acc[ai][bj][m][0], v1 = acc[ai][bj][m][1]; v4u w;
                    w.x = pg8::cvt_pk_bf16(v0[0], v0[1]); w.y = pg8::cvt_pk_bf16(v0[2], v0[3]); w.z = pg8::cvt_pk_bf16(v1[0], v1[1]); w.w = pg8::cvt_pk_bf16(v1[2], v1[3]);
                    *(v4u*)(rowp + bj * 128) = w; } }
        return false;
    }
};
__device__ __forceinline__ float sigm_ratio(float ga, float gb) { return (1.f + __expf(-gb)) / (1.f + __expf(-ga)); }
struct EpiGate {
    static constexpr bool PERM = true;
    const bf16* Z; bf16* Mo;
    __device__ __forceinline__ bool operator()(AccRef acc, const pg8::Unit& u, int wr, int wc, int fr, int fq) const {
        const int row0 = u.pm * 256 + wr * 64 + fr, col0 = u.pn * 256 + wc * 32 + 8 * fq;
        if (u.seg == 0) {
#pragma unroll
            for (int ai = 0; ai < 2; ++ai)
#pragma unroll
                for (int m = 0; m < 4; ++m) { const bf16* zr = Z + (size_t)(row0 + ai * 128 + m * 16) * DIN + col0;
#pragma unroll
                    for (int bj = 0; bj < 2; ++bj) { const v4u a = *(const v4u*)(zr + 2048 + bj * 128), b = *(const v4u*)(zr + 3072 + bj * 128);
                        pg8::f32x4& v0 = acc[ai][bj][m][0]; pg8::f32x4& v1 = acc[ai][bj][m][1];
                        v0[0] *= sigm_ratio(bflo(a.x), bflo(b.x)); v0[1] *= sigm_ratio(bfhi(a.x), bfhi(b.x)); v0[2] *= sigm_ratio(bflo(a.y), bflo(b.y)); v0[3] *= sigm_ratio(bfhi(a.y), bfhi(b.y));
                        v1[0] *= sigm_ratio(bflo(a.z), bflo(b.z)); v1[1] *= sigm_ratio(bfhi(a.z), bfhi(b.z)); v1[2] *= sigm_ratio(bflo(a.w), bflo(b.w)); v1[3] *= sigm_ratio(bfhi(a.w), bfhi(b.w)); } }
            return true;
        }
#pragma unroll
        for (int ai = 0; ai < 2; ++ai)
#pragma unroll
            for (int m = 0; m < 4; ++m) { const size_t r = (size_t)(row0 + ai * 128 + m * 16); const bf16* zr = Z + r * DIN + col0; bf16* mo = Mo + r * D + col0;
#pragma unroll
                for (int bj = 0; bj < 2; ++bj) { const v4u b = *(const v4u*)(zr + 3072 + bj * 128);
                    const pg8::f32x4 v0 = acc[ai][bj][m][0], v1 = acc[ai][bj][m][1]; v4u w;
#define SG(x) (1.f / (1.f + __expf(-(x))))
                    w.x = pg8::cvt_pk_bf16(v0[0] * SG(bflo(b.x)), v0[1] * SG(bfhi(b.x))); w.y = pg8::cvt_pk_bf16(v0[2] * SG(bflo(b.y)), v0[3] * SG(bfhi(b.y)));
                    w.z = pg8::cvt_pk_bf16(v1[0] * SG(bflo(b.z)), v1[1] * SG(bfhi(b.z))); w.w = pg8::cvt_pk_bf16(v1[2] * SG(bflo(b.w)), v1[3] * SG(bfhi(b.w)));
#undef SG
                    *(v4u*)(mo + bj * 128) = w; } }
        return false;
    }
};
struct EpiRes {
    static constexpr bool PERM = true;
    const float* X; bf16* X1; float* SSQ;
    __device__ __forceinline__ bool operator()(AccRef acc, const pg8::Unit& u, int wr, int wc, int fr, int fq) const {
        const int row0 = u.pm * 256 + wr * 64 + fr, col0 = u.pn * 256 + wc * 32 + 8 * fq;
#pragma unroll
        for (int ai = 0; ai < 2; ++ai)
#pragma unroll
            for (int m = 0; m < 4; ++m) { const size_t r = (size_t)(row0 + ai * 128 + m * 16); const float* xr = X + r * D + col0; bf16* o = X1 + r * D + col0; float ss = 0.f;
#pragma unroll
                for (int bj = 0; bj < 2; ++bj) { const pg8::f32x4 x0 = *(const pg8::f32x4*)(xr + bj * 128), x1v = *(const pg8::f32x4*)(xr + bj * 128 + 4);
                    const pg8::f32x4 v0 = acc[ai][bj][m][0] + x0, v1 = acc[ai][bj][m][1] + x1v;
                    ss += (v0[0] * v0[0] + v0[1] * v0[1]) + (v0[2] * v0[2] + v0[3] * v0[3]) + (v1[0] * v1[0] + v1[1] * v1[1]) + (v1[2] * v1[2] + v1[3] * v1[3]);
                    v4u w; w.x = pg8::cvt_pk_bf16(v0[0], v0[1]); w.y = pg8::cvt_pk_bf16(v0[2], v0[3]); w.z = pg8::cvt_pk_bf16(v1[0], v1[1]); w.w = pg8::cvt_pk_bf16(v1[2], v1[3]);
                    *(v4u*)(o + bj * 128) = w; }
                ss += __shfl_xor(ss, 16); ss += __shfl_xor(ss, 32);
                if (fq == 0) SSQ[r * 16 + u.pn * 4 + wc] = ss; }
        return false;
    }
};
struct EpiScore {
    static constexpr bool PERM = true;
    const float* SSQ; _Float16* S;
    __device__ __forceinline__ bool operator()(AccRef acc, const pg8::Unit& u, int wr, int wc, int fr, int fq) const {
        const int row0 = u.pm * 256 + wr * 64 + fr, col0 = u.pn * 256 + wc * 32 + 8 * fq;
#pragma unroll
        for (int ai = 0; ai < 2; ++ai)
#pragma unroll
            for (int m = 0; m < 4; ++m) { const size_t r = (size_t)(row0 + ai * 128 + m * 16);
                const pg8::f32x4* sp = (const pg8::f32x4*)(SSQ + r * 16); const pg8::f32x4 s0 = sp[0], s1 = sp[1], s2 = sp[2], s3 = sp[3];
                const float tot = ((s0[0] + s0[1]) + (s0[2] + s0[3])) + ((s1[0] + s1[1]) + (s1[2] + s1[3])) + ((s2[0] + s2[1]) + (s2[2] + s2[3])) + ((s3[0] + s3[1]) + (s3[2] + s3[3]));
                const float rstd = rsqrtf(tot * (1.f / D) + RMS_EPS);
                _Float16* o = S + r * NSC + col0;
#pragma unroll
                for (int bj = 0; bj < 2; ++bj) { const pg8::f32x4 v0 = acc[ai][bj][m][0] * rstd, v1 = acc[ai][bj][m][1] * rstd;
                    typedef _Float16 h2 __attribute__((ext_vector_type(2)));
                    h2 p0 = {(_Float16)v0[0], (_Float16)v0[1]}, p1 = {(_Float16)v0[2], (_Float16)v0[3]}, p2 = {(_Float16)v1[0], (_Float16)v1[1]}, p3 = {(_Float16)v1[2], (_Float16)v1[3]};
                    v4u w; w.x = __builtin_bit_cast(unsigned, p0); w.y = __builtin_bit_cast(unsigned, p1); w.z = __builtin_bit_cast(unsigned, p2); w.w = __builtin_bit_cast(unsigned, p3);
                    *(v4u*)(o + bj * 128) = w; } }
        return false;
    }
};

__device__ __forceinline__ void unpack8(const v4u w, float (&f)[8]) { f[0] = bflo(w.x); f[1] = bfhi(w.x); f[2] = bflo(w.y); f[3] = bfhi(w.y); f[4] = bflo(w.z); f[5] = bfhi(w.z); f[6] = bflo(w.w); f[7] = bfhi(w.w); }
__device__ __forceinline__ v4u pack8(const float (&f)[8]) { v4u w; w.x = pk2(f[0], f[1]); w.y = pk2(f[2], f[3]); w.z = pk2(f[4], f[5]); w.w = pk2(f[6], f[7]); return w; }
__device__ __forceinline__ void p2_timemix(const bf16* Z, const float* convw, bf16* PA, bf16* CA, int gw, int NGW, int lane) {
    const int w = 2 << (lane >> 4);
    const int ch = 8 * lane;
    float cw0[8], cw1[8], cw2[8];
#pragma unroll
    for (int i = 0; i < 8; ++i) { cw0[i] = convw[ch + i]; cw1[i] = convw[512 + ch + i]; cw2[i] = convw[1024 + ch + i]; }
    for (int chunk = gw; chunk < M / 32; chunk += NGW) {
        const int t0 = chunk * 32, s0 = t0 & (SEQ - 1);
        float sum[8], up1[8], up2[8];
#pragma unroll
        for (int i = 0; i < 8; ++i) { sum[i] = 0.f; up1[i] = 0.f; up2[i] = 0.f; }
        if (s0 > 0) {
            for (int j = 1; j < 16; ++j) {
                if (j < w) { float f[8]; unpack8(*(const v4u*)(Z + (size_t)(t0 - j) * DIN + ch), f);
#pragma unroll
                    for (int i = 0; i < 8; ++i) sum[i] += f[i]; }
            }
            float c[8], v[8];
            unpack8(*(const v4u*)(Z + (size_t)(t0 - 2) * DIN + 512 + ch), c); unpack8(*(const v4u*)(Z + (size_t)(t0 - 2) * DIN + 1536 + ch), v);
#pragma unroll
            for (int i = 0; i < 8; ++i) up2[i] = c[i] * v[i];
            unpack8(*(const v4u*)(Z + (size_t)(t0 - 1) * DIN + 512 + ch), c); unpack8(*(const v4u*)(Z + (size_t)(t0 - 1) * DIN + 1536 + ch), v);
#pragma unroll
            for (int i = 0; i < 8; ++i) up1[i] = c[i] * v[i];
        }
        for (int i2 = 0; i2 < 32; ++i2) {
            const int t = t0 + i2, s = s0 + i2;
            const bf16* zr = Z + (size_t)t * DIN;
            float zt[8], c[8], b[8], v[8], o[8];
            unpack8(*(const v4u*)(zr + ch), zt); unpack8(*(const v4u*)(zr + 512 + ch), c); unpack8(*(const v4u*)(zr + 1024 + ch), b); unpack8(*(const v4u*)(zr + 1536 + ch), v);
            const int cnt = (s + 1) < w ? (s + 1) : w; const float rc = 1.f / (float)cnt;
#pragma unroll
            for (int i = 0; i < 8; ++i) { sum[i] += zt[i]; o[i] = sum[i] * rc - zt[i]; }
            *(v4u*)(PA + (size_t)t * DP + ch) = pack8(o);
            if (s + 1 - w >= 0) { float f[8]; unpack8(*(const v4u*)(Z + (size_t)(t + 1 - w) * DIN + ch), f);
#pragma unroll
                for (int i = 0; i < 8; ++i) sum[i] -= f[i]; }
#pragma unroll
            for (int i = 0; i < 8; ++i) { const float uu = c[i] * v[i]; o[i] = b[i] * (cw0[i] * up2[i] + cw1[i] * up1[i] + cw2[i] * uu); up2[i] = up1[i]; up1[i] = uu; }
            *(v4u*)(CA + (size_t)t * DP + ch) = pack8(o);
        }
    }
}

__device__ __forceinline__ void p6_topk(const _Float16* S, unsigned short* IDX, float* EV, float* INV, LAS unsigned char* lds, int gw, int NGW, int wave, int lane) {
    LAS unsigned char* my = lds + wave * 9216;
    const float NEG = -3.0e38f;
    for (int grp = gw; grp < M * NH / 64; grp += NGW) {
        const char* base = (const char*)S + (size_t)grp * 64 * 512;
        float A[16], B[16];
#pragma unroll
        for (int half = 0; half < 2; ++half) {
            float L[16];
#pragma unroll
            for (int i = 0; i < 16; ++i) L[i] = NEG;
#pragma unroll 1
            for (int step = 0; step < 2; ++step) {
                const int j = half * 2 + step;
#pragma unroll
                for (int q = 0; q < 8; ++q) { const int row = 8 * q + (lane >> 3), chn = lane & 7;
                    const v4u dd = *(const v4u*)(base + (size_t)row * 512 + 128 * j + 16 * chn); *(LAS v4u*)(my + row * 144 + 16 * chn) = dd; }
                asm volatile("s_waitcnt lgkmcnt(0)" ::: "memory");
#pragma unroll 1
                for (int c = 0; c < 8; ++c) {
                    const v4u dd = *(const LAS v4u*)(my + lane * 144 + 16 * c);
                    const unsigned ww[4] = {dd.x, dd.y, dd.z, dd.w};
#pragma unroll
                    for (int e = 0; e < 8; ++e) {
                        const unsigned hb = (e & 1) ? (ww[e >> 1] >> 16) : (ww[e >> 1] & 0xffffu);
                        const float val = (float)__builtin_bit_cast(_Float16, (unsigned short)hb);
                        const int key = step * 64 + c * 8 + e;
                        float tv = __builtin_bit_cast(float, __builtin_bit_cast(unsigned, val) | (unsigned)(127 - key));
#pragma unroll
                        for (int i = 0; i < 16; ++i) { const float hi = fmaxf(L[i], tv); tv = fminf(L[i], tv); L[i] = hi; }
                    }
                }
                asm volatile("s_waitcnt lgkmcnt(0)" ::: "memory");
            }
#pragma unroll
            for (int i = 0; i < 16; ++i) { if (half == 0) A[i] = L[i]; else B[i] = L[i]; }
        }
        float FV[16]; int FI[16];
#pragma unroll
        for (int i = 0; i < 16; ++i) { FV[i] = NEG; FI[i] = 0; }
#pragma unroll
        for (int i = 0; i < 16; ++i) {
            const unsigned ab = __builtin_bit_cast(unsigned, A[i]); const float av = __builtin_bit_cast(float, ab & ~0x7fu); const int ak = 127 - (int)(ab & 0x7fu);
#pragma unroll
            for (int j = 0; j < 16; ++j) {
                if ((i + 1) * (j + 1) <= 16) {
                    const unsigned bb = __builtin_bit_cast(unsigned, B[j]); const float bv = __builtin_bit_cast(float, bb & ~0x7fu); const int bk = 127 - (int)(bb & 0x7fu);
                    float x = av + bv; int xi = ak * 128 + bk;
#pragma unroll
                    for (int s = (i + 1) * (j + 1) - 1; s < 16; ++s) { const bool c = x > FV[s]; const float nv = c ? x : FV[s], ox = c ? FV[s] : x; const int ni = c ? xi : FI[s], oi = c ? FI[s] : xi; FV[s] = nv; FI[s] = ni; x = ox; xi = oi; }
                }
            }
        }
        const size_t r = (size_t)grp * 64 + lane;
        float ev[16]; float sum = 0.f;
#pragma unroll
        for (int i = 0; i < 16; ++i) { ev[i] = __expf(FV[i] - FV[0]); sum += ev[i]; }
        v4u i0, i1;
        i0.x = (unsigned)FI[0] | ((unsigned)FI[1] << 16); i0.y = (unsigned)FI[2] | ((unsigned)FI[3] << 16); i0.z = (unsigned)FI[4] | ((unsigned)FI[5] << 16); i0.w = (unsigned)FI[6] | ((unsigned)FI[7] << 16);
        i1.x = (unsigned)FI[8] | ((unsigned)FI[9] << 16); i1.y = (unsigned)FI[10] | ((unsigned)FI[11] << 16); i1.z = (unsigned)FI[12] | ((unsigned)FI[13] << 16); i1.w = (unsigned)FI[14] | ((unsigned)FI[15] << 16);
        *(v4u*)(IDX + r * 16) = i0; *(v4u*)(IDX + r * 16 + 8) = i1;
#pragma unroll
        for (int q = 0; q < 4; ++q) *(f32x4*)(EV + r * 16 + 4 * q) = (f32x4){ev[4 * q], ev[4 * q + 1], ev[4 * q + 2], ev[4 * q + 3]};
        INV[r] = 1.f / sum;
    }
}

__device__ __forceinline__ float ubf(unsigned w, int b) { return (float)((w >> (8 * b)) & 0xffu); }
__device__ __forceinline__ void p7_peer(const bf16* X1, const float* SSQ, const unsigned short* IDX, const float* EV, const float* INV, const unsigned char* U8, const unsigned char* V8,
                                        const float* SU, const float* SV, const float* gfin, float* out, int gw, int NGW, int lane) {
    const int k = (lane >> 2) & 15;
    f32x4 gf[4];
#pragma unroll
    for (int q = 0; q < 4; ++q) gf[q] = *(const f32x4*)(gfin + 16 * lane + 4 * q);
    for (int t = gw; t < M; t += NGW) {
        const v4u xa = *(const v4u*)(X1 + (size_t)t * D + 16 * lane), xb = *(const v4u*)(X1 + (size_t)t * D + 16 * lane + 8);
        float xv[16];
        { float f[8]; unpack8(xa, f);
#pragma unroll
          for (int i = 0; i < 8; ++i) xv[i] = f[i];
          unpack8(xb, f);
#pragma unroll
          for (int i = 0; i < 8; ++i) xv[8 + i] = f[i]; }
        float mx = 0.f;
#pragma unroll
        for (int i = 0; i < 16; ++i) mx = fmaxf(mx, fabsf(xv[i]));
        mx = wave_max(mx);
        const float sx = mx > 0.f ? mx * (1.f / 127.f) : 1.f, isx = 1.f / sx;
        int xq[4];
#pragma unroll
        for (int j = 0; j < 4; ++j) { unsigned a = 0;
#pragma unroll
            for (int c = 0; c < 4; ++c) { int q = (int)rintf(xv[4 * j + c] * isx); q = q > 127 ? 127 : (q < -127 ? -127 : q); a |= ((unsigned)q & 0xffu) << (8 * c); }
            xq[j] = (int)a; }
        const float ssp = lane < 16 ? SSQ[(size_t)t * 16 + lane] : 0.f;
        const float rstd = rsqrtf(wave_sum(ssp) * (1.f / D) + RMS_EPS);
        float acc[16];
#pragma unroll
        for (int i = 0; i < 16; ++i) acc[i] = 0.f;
        float wtot = 0.f;
#pragma unroll 1
        for (int h = 0; h < NH; ++h) {
            const size_t r = (size_t)t * NH + h;
            const int idv = (int)IDX[r * 16 + k]; const float ev = EV[r * 16 + k]; const float iv = INV[r];
            const float suk = SU[idv], svk = SV[idv];
            v4u ur[16], vr[16];
#pragma unroll
            for (int kk = 0; kk < 16; ++kk) { const int e = __builtin_amdgcn_readlane(idv, 4 * kk);
                ur[kk] = *(const v4u*)(U8 + (size_t)e * 1024 + 16 * lane); vr[kk] = *(const v4u*)(V8 + (size_t)e * 1024 + 16 * lane); }
            int p[16];
#pragma unroll
            for (int kk = 0; kk < 16; ++kk) { int s = __builtin_amdgcn_sdot4((int)ur[kk].x, xq[0], 0, false); s = __builtin_amdgcn_sdot4((int)ur[kk].y, xq[1], s, false);
                s = __builtin_amdgcn_sdot4((int)ur[kk].z, xq[2], s, false); s = __builtin_amdgcn_sdot4((int)ur[kk].w, xq[3], s, false); p[kk] = s; }
            int q8[8], q4[4], q2[2], q1;
            const bool b5 = lane & 32, b4 = lane & 16, b3 = lane & 8, b2 = lane & 4;
#pragma unroll
            for (int i = 0; i < 8; ++i) { const int snd = b5 ? p[i] : p[i + 8], kp = b5 ? p[i + 8] : p[i]; q8[i] = kp + __shfl_xor(snd, 32); }
#pragma unroll
            for (int i = 0; i < 4; ++i) { const int snd = b4 ? q8[i] : q8[i + 4], kp = b4 ? q8[i + 4] : q8[i]; q4[i] = kp + __shfl_xor(snd, 16); }
#pragma unroll
            for (int i = 0; i < 2; ++i) { const int snd = b3 ? q4[i] : q4[i + 2], kp = b3 ? q4[i + 2] : q4[i]; q2[i] = kp + __shfl_xor(snd, 8); }
            { const int snd = b2 ? q2[0] : q2[1], kp = b2 ? q2[1] : q2[0]; q1 = kp + __shfl_xor(snd, 4); }
            q1 += __shfl_xor(q1, 2); q1 += __shfl_xor(q1, 1);
            const float act = (float)q1 * sx * suk * rstd;
            const float gl = 0.5f * act * (1.f + erff(act * 0.70710678118654752f));
            const float wv = ev * iv * gl * svk;
#pragma unroll
            for (int kk = 0; kk < 16; ++kk) { const float wk = __builtin_bit_cast(float, __builtin_amdgcn_readlane(__builtin_bit_cast(int, wv), 4 * kk)); wtot += wk;
#pragma unroll
                for (int j = 0; j < 4; ++j) { const unsigned w = vr[kk][j];
#pragma unroll
                    for (int b = 0; b < 4; ++b) acc[4 * j + b] += wk * ubf(w, b); } }
        }
        float ss = 0.f;
#pragma unroll
        for (int i = 0; i < 16; ++i) { xv[i] = xv[i] + acc[i] - 128.f * wtot; ss += xv[i] * xv[i]; }
        const float r2 = rsqrtf(wave_sum(ss) * (1.f / D) + RMS_EPS);
        float* o = out + (size_t)t * D + 16 * lane;
#pragma unroll
        for (int q = 0; q < 4; ++q) *(f32x4*)(o + 4 * q) = (f32x4){xv[4 * q] * r2 * gf[q].x, xv[4 * q + 1] * r2 * gf[q].y, xv[4 * q + 2] * r2 * gf[q].z, xv[4 * q + 3] * r2 * gf[q].w};
    }
}

struct Args { const float* in[15]; float* out; unsigned char* ws; int ph_lo, ph_hi, li, pad; };
__global__ void __launch_bounds__(NWAVES * 64, 2) fwd_kernel(Args args) {
    extern __shared__ __attribute__((aligned(16))) unsigned char lds_raw[];
    LAS unsigned char* lds = (LAS unsigned char*)lds_raw;
    volatile LAS unsigned* MISC = (volatile LAS unsigned*)(lds + MISC_OFF);
    const int tid = threadIdx.x, lane = tid & 63, wave = __builtin_amdgcn_readfirstlane(tid >> 6);
    const int G = gridDim.x; const int bx = blockIdx.x; const int vcu = (G % 8 == 0) ? (bx % 8) * (G / 8) + bx / 8 : bx;
    const int gw = vcu * NWAVES + wave, NGW = G * NWAVES;
    unsigned char* ws = args.ws;
    gu32* ctl = (gu32*)(ws + WS_CTL);
    const float* x = args.in[0]; const float* g_mix = args.in[1]; const float* w_in = args.in[2]; const float* pool_gw = args.in[3]; const float* pool_scale = args.in[4];
    const float* conv_w = args.in[5]; const float* w_bp = args.in[6]; const float* w_bc = args.in[7]; const float* w_out = args.in[8]; const float* g_ffn = args.in[9];
    const float* w_q = args.in[10]; const float* sub_keys = args.in[11]; const float* expert_u = args.in[12]; const float* expert_v = args.in[13]; const float* g_final = args.in[14];
    bf16* Win_t = (bf16*)(ws + WS_WIN); bf16* Wc_t = (bf16*)(ws + WS_WC); bf16* Wbc_t = (bf16*)(ws + WS_WBC); bf16* Wout_t = (bf16*)(ws + WS_WOUT); bf16* Wpp_t = (bf16*)(ws + WS_WPP);
    float* SU = (float*)(ws + WS_SU); float* SV = (float*)(ws + WS_SV); float* SSQ = (float*)(ws + WS_SSQ);
    unsigned char* U8 = ws + WS_U8; unsigned char* V8 = ws + WS_V8; float* INV = (float*)(ws + WS_INV);
    bf16* Hb = (bf16*)(ws + WS_B); bf16* PA = (bf16*)(ws + WS_B); bf16* CA = (bf16*)(ws + WS_B + 64 * MiB); bf16* X1 = (bf16*)(ws + WS_B);
    bf16* Mb = (bf16*)(ws + WS_C); unsigned short* IDX = (unsigned short*)(ws + WS_C); float* EV = (float*)(ws + WS_C + 16 * MiB);
    bf16* Zb = (bf16*)(ws + WS_A); _Float16* SC = (_Float16*)(ws + WS_A);

    for (int u = tid; u < (LDS_BYTES - LDSCTL_OFF) / 4; u += NWAVES * 64) ((LAS unsigned*)(lds + LDSCTL_OFF))[u] = 0u;
    __syncthreads();
    XcdBarrier bar; bar.bar = (unsigned*)(ctl + CW_BAR); bar.x = 0; bar.st = nullptr;
    if (N_LAUNCHES != PER_PHASE) bar = xcd_barrier_post((unsigned*)(ctl + CW_BAR), MISC + 8);
#define GRID_BAR() do { if (N_LAUNCHES != PER_PHASE) xcd_barrier(bar); } while (0)
    const int lo = args.ph_lo, hi = args.ph_hi;
#define IN(k) (lo <= (k) && (k) < hi)
#define BOTH(k) (IN(k) && IN((k) + 1))

    if (IN(0)) {
        LAS float* scr = (LAS float*)(lds + wave * 16384);
        constexpr int I_WPP = 1024, I_WIN = (1024 / 64) * (4096 / 32), I_WOUT = (1024 / 64) * (1024 / 32), I_WBC = (512 / 64) * (1024 / 32), I_WC = 512;
        constexpr int NITEMS = I_WPP + I_WIN + I_WOUT + I_WBC + I_WC;
        for (int it = gw; it < NITEMS; it += NGW) {
            int r = it;
            if (r < I_WPP) { p0_wpp_item(w_q, sub_keys, g_ffn, Wpp_t, r, lane); continue; } r -= I_WPP;
            if (r < I_WIN) { p0_transpose_item(w_in, 1024, 4096, Win_t, scr, r, lane); continue; } r -= I_WIN;
            if (r < I_WOUT) { p0_transpose_item(w_out, 1024, 1024, Wout_t, scr, r, lane); continue; } r -= I_WOUT;
            if (r < I_WBC) { p0_transpose_item(w_bc, 512, 1024, Wbc_t, scr, r, lane); continue; } r -= I_WBC;
            p0_wc_item(pool_gw, pool_scale, w_bp, Wc_t, r, lane);
        }
        for (int e = gw; e < 2 * NE; e += NGW) {
            if (e < NE) p0_quant_row(expert_u, g_ffn, U8, SU, e, lane, false);
            else p0_quant_row(expert_v, nullptr, V8, SV, e - NE, lane, true);
        }
        for (int m = gw; m < M; m += NGW) p0_h_row(x + (size_t)m * D, g_mix, Hb + (size_t)m * D, lane);
        if (BOTH(0)) GRID_BAR();
    }
    if (IN(1)) {
        pg8::Gemm g{Hb, Win_t, Hb, Win_t, M, DIN, D}; pg8::StaticOrder S; S.init(M, DIN, G, bx, 1);
        EpiZ E{Zb, DIN};
        pg8::gemm_phase<EpiZ, pg8::StaticOrder, true, true>(lds, g, S, E);
        if (BOTH(1)) GRID_BAR();
    }
    if (IN(2)) {
        p2_timemix(Zb, conv_w, PA, CA, gw, NGW, lane);
        if (BOTH(2)) GRID_BAR();
    }
    if (IN(3)) {
        pg8::Gemm g{PA, Wc_t, CA, Wbc_t, M, D, DP}; pg8::StaticOrder S; S.init(M, D, G, bx, 2);
        EpiGate E{Zb, Mb};
        pg8::gemm_phase<EpiGate, pg8::StaticOrder, true, true>(lds, g, S, E);
        if (BOTH(3)) GRID_BAR();
    }
    if (IN(4)) {
        pg8::Gemm g{Mb, Wout_t, Mb, Wout_t, M, D, D}; pg8::StaticOrder S; S.init(M, D, G, bx, 1);
        EpiRes E{x, X1, SSQ};
        pg8::gemm_phase<EpiRes, pg8::StaticOrder, true, true>(lds, g, S, E);
        if (BOTH(4)) GRID_BAR();
    }
    if (IN(5)) {
        pg8::Gemm g{X1, Wpp_t, X1, Wpp_t, M, NSC, D}; pg8::StaticOrder S; S.init(M, NSC, G, bx, 1);
        EpiScore E{SSQ, SC};
        pg8::gemm_phase<EpiScore, pg8::StaticOrder, true, true>(lds, g, S, E);
        if (BOTH(5)) GRID_BAR();
    }
    if (IN(6)) {
        p6_topk(SC, IDX, EV, INV, lds, gw, NGW, wave, lane);
        if (BOTH(6)) GRID_BAR();
    }
    if (IN(7)) {
        p7_peer(X1, SSQ, IDX, EV, INV, U8, V8, SU, SV, g_final, args.out, gw, NGW, lane);
    }
#undef IN
#undef BOTH
#undef GRID_BAR
}

extern "C" void kernel_launch(void* const* d_in, const int* in_sizes, int n_in, void* d_out, int out_size, void* d_ws, size_t ws_size, hipStream_t stream) {
    static int grid = 0;
    if (grid == 0) {
        if (n_in != 15 || in_sizes[0] != M * D || out_size != M * D || ws_size < WS_END) { fprintf(stderr, "kernel_launch: unexpected shapes (n_in %d, in0 %d, out %d, ws %zu); nothing launched\n", n_in, n_in > 0 ? in_sizes[0] : -1, out_size, ws_size); grid = -1; return; }
        int dev = 0, cus = 0, per_cu = 0;
        if (hipGetDevice(&dev) != hipSuccess || hipDeviceGetAttribute(&cus, hipDeviceAttributeMultiprocessorCount, dev) != hipSuccess) { grid = -1; return; }
        if (hipFuncSetAttribute((const void*)fwd_kernel, hipFuncAttributeMaxDynamicSharedMemorySize, LDS_BYTES) != hipSuccess) { fprintf(stderr, "kernel_launch: hipFuncSetAttribute failed\n"); grid = -1; return; }
        if (hipOccupancyMaxActiveBlocksPerMultiprocessor(&per_cu, (const void*)fwd_kernel, NWAVES * 64, LDS_BYTES) != hipSuccess || per_cu < 1)
            fprintf(stderr, "kernel_launch: note: occupancy query reports %d workgroups per CU\n", per_cu);
        (void)hipGetLastError();
        grid = cus;
    }
    if (grid < 0) return;
    if (hipMemsetAsync((char*)d_ws + WS_CTL, 0, CTL_ZERO_BYTES, stream) != hipSuccess) { fprintf(stderr, "kernel_launch: hipMemsetAsync failed\n"); return; }
    Args a{};
    for (int i = 0; i < 15; ++i) a.in[i] = (const float*)d_in[i];
    a.out = (float*)d_out; a.ws = (unsigned char*)d_ws;
    for (int li = 0; li < N_LAUNCHES; ++li) {
        a.ph_lo = (N_LAUNCHES == PER_PHASE) ? li : 0; a.ph_hi = (N_LAUNCHES == PER_PHASE) ? li + 1 : PER_PHASE; a.li = li;
        hipLaunchKernelGGL(fwd_kernel, dim3(grid), dim3(NWAVES * 64), LDS_BYTES, stream, a);
        const hipError_t le = hipPeekAtLastError();
        if (le != hipSuccess) { fprintf(stderr, "kernel_launch: launch %d failed: %s\n", li, hipGetErrorName(le)); break; }
    }
}
```

```cpp
#include <hip/hip_runtime.h>
#include <cstdio>
#include <cstdint>

#ifndef MK_N_LAUNCHES
#define MK_N_LAUNCHES 1
#endif

namespace pg8 {
#define PG8_LAS __attribute__((address_space(3)))
typedef unsigned short bf16_t;
typedef short bf16x8 __attribute__((ext_vector_type(8)));
typedef float f32x4 __attribute__((ext_vector_type(4)));
typedef unsigned u32x4 __attribute__((ext_vector_type(4)));
constexpr int BM = 256, BK = 64, HALF = 128, HTB = HALF * BK * 2  , STAGE_BYTES = 8 * HTB, NXCD = 8, WGM = 8;

__host__ __device__ __forceinline__ int lds_byte(int r, int c) { const int st = (r >> 4) * 2 + (c >> 5), rr = r & 15, cc = c & 31, ob = rr * 64 + cc * 2; return st * 1024 + (ob ^ (((ob >> 9) & 1) << 5)); }
__host__ __device__ __forceinline__ void stage_rc(int b, int& R, int& C) { const int st = b / 1024, sb = b % 1024, swz = sb ^ (((sb >> 9) & 1) << 5); R = (st >> 1) * 16 + swz / 64; C = (st & 1) * 32 + (swz % 64) / 2; }
__host__ __device__ __forceinline__ int perm32(int rho) { const int n = rho >> 4, i = rho & 15; return 8 * (i >> 2) + 4 * n + (i & 3); }

struct Unit { int pm, pn, seg; };
struct Gemm { const bf16_t* A; const bf16_t* Bt; const bf16_t* A2; const bf16_t* Bt2; int M, N, K; };

struct StaticOrder {
    int nM, nN, nwg, G, c, segs;
    __host__ __device__ void init(int M, int N, int G_, int c_, int segs_) { nM = M / BM; nN = N / BM; nwg = nM * nN; G = G_; c = c_; segs = segs_; }
    __host__ __device__ bool next(int i, Unit& u) const {
        const int ti = (segs == 2) ? (i >> 1) : i; u.seg = (segs == 2) ? (i & 1) : 0;
        const long L = (long)ti * G + c; if (L >= nwg) return false;
        int wgid = (int)L; { const int q = nwg / NXCD, r = nwg % NXCD, xcd = wgid % NXCD, off = wgid / NXCD; wgid = (xcd < r ? xcd * (q + 1) : r * (q + 1) + (xcd - r) * q) + off; }
        const int nig = WGM * nN, gid = wgid / nig, fm = gid * WGM, gsz = (nM - fm) < WGM ? (nM - fm) : WGM;
        u.pm = fm + ((wgid % nig) % gsz); u.pn = (wgid % nig) / gsz; return true;
    }
    __device__ __forceinline__ void a_ready(const Unit&) const {}
    __device__ __forceinline__ void done(const Unit&) const {}
};

__device__ __forceinline__ unsigned cvt_pk_bf16(float lo, float hi) { unsigned r; asm volatile("v_cvt_pk_bf16_f32 %0, %1, %2" : "=v"(r) : "v"(lo), "v"(hi)); return r; }

template <class Epi, class Sched, bool ALIGN_EPI = false, bool SP2 = false>
__device__ __forceinline__ void gemm_phase(PG8_LAS unsigned char* lds, const Gemm g, const Sched& S, const Epi& E) {
    const int tid = threadIdx.x, wid = __builtin_amdgcn_readfirstlane(tid >> 6), lane = tid & 63, wr = wid >> 2, wc = wid & 3, fr = lane & 15, fq = lane >> 4;
    const int K = g.K, nt = K / BK;
    unsigned voffA[2], voffB[2];
#pragma unroll
    for (int i = 0; i < 2; ++i) { int R, C; stage_rc(tid * 16 + i * 8192, R, C); const int Rb = Epi::PERM ? ((R & ~31) + perm32(R & 31)) : R;
        voffA[i] = (unsigned)(R * K + C) * 2u; voffB[i] = (unsigned)(Rb * K + C) * 2u; }
    const size_t kstep = (size_t)(BK * 2);
    const size_t hstep = (size_t)HALF * K * 2;
    const size_t tstep = 2 * hstep;
    const unsigned ldsw = (unsigned)wid * 1024u;
    const int aoff = lds_byte(wr * 64 + fr, fq * 8), boff = lds_byte(wc * 32 + fr, fq * 8);
#define PG8_SA(b, h) (((b) * 2 + (h)) * HTB)
#define PG8_SB(b, h) ((4 + (b) * 2 + (h)) * HTB)
#define PG8_STAGE(bufoff, gbase, voff) do { _Pragma("unroll") for (int _i = 0; _i < 2; ++_i) \
        __builtin_amdgcn_global_load_lds((const unsigned*)((const char*)(gbase) + (voff)[_i]), (PG8_LAS unsigned*)(lds + (bufoff) + ldsw + _i * 8192), 16, 0, 0); } while (0)
#define PG8_LDA(dst, b, h) do { _Pragma("unroll") for (int m = 0; m < 4; ++m) _Pragma("unroll") for (int k = 0; k < 2; ++k) dst[m][k] = *(const PG8_LAS bf16x8*)(lds + PG8_SA(b, h) + aoff + m * 2048 + k * 1024); } while (0)
#define PG8_LDB(dst, b, h) do { _Pragma("unroll") for (int n = 0; n < 2; ++n) _Pragma("unroll") for (int k = 0; k < 2; ++k) dst[n][k] = *(const PG8_LAS bf16x8*)(lds + PG8_SB(b, h) + boff + n * 2048 + k * 1024); } while (0)
#define PG8_MMA(ai, bj, At, Bt) do { __builtin_amdgcn_s_setprio(1); _Pragma("unroll") for (int m = 0; m < 4; ++m) _Pragma("unroll") for (int n = 0; n < 2; ++n) _Pragma("unroll") for (int k = 0; k < 2; ++k) \
        acc[ai][bj][m][n] = __builtin_amdgcn_mfma_f32_16x16x32_bf16(Bt[n][k], At[m][k], acc[ai][bj][m][n], 0, 0, 0); __builtin_amdgcn_s_setprio(0); } while (0)
#define PG8_WAIT_V(n) asm volatile("s_waitcnt vmcnt(" #n ")" ::: "memory")
#define PG8_WAIT_L(n) asm volatile("s_waitcnt lgkmcnt(" #n ")" ::: "memory")
#define PG8_BAR __builtin_amdgcn_s_barrier()
#define PG8_SCHED __builtin_amdgcn_sched_barrier(0)
    Unit cur, nxt; int ui = 0;
    if (!S.next(0, cur)) return;
    f32x4 acc[2][2][4][2];
#pragma unroll
    for (int a = 0; a < 2; ++a)
#pragma unroll
        for (int b = 0; b < 2; ++b)
#pragma unroll
            for (int m = 0; m < 4; ++m)
#pragma unroll
                for (int n = 0; n < 2; ++n) acc[a][b][m][n] = (f32x4){0.f, 0.f, 0.f, 0.f};
    bf16x8 At[4][2], B0[2][2], B1[2][2];
    const char* cA = (const char*)(cur.seg ? g.A2 : g.A) + (size_t)cur.pm * tstep; const char* cB = (const char*)(cur.seg ? g.Bt2 : g.Bt) + (size_t)cur.pn * tstep;
    S.a_ready(cur);
    if constexpr (SP2) {
        PG8_STAGE(PG8_SB(0, 0), cB, voffB); PG8_STAGE(PG8_SB(0, 1), cB + hstep, voffB); PG8_STAGE(PG8_SA(0, 0), cA, voffA); PG8_STAGE(PG8_SA(0, 1), cA + hstep, voffA);
        if (wr == 1) PG8_BAR;
        PG8_WAIT_V(2); PG8_BAR;
        PG8_STAGE(PG8_SB(1, 0), cB + kstep, voffB); PG8_STAGE(PG8_SA(1, 0), cA + kstep, voffA); PG8_STAGE(PG8_SB(1, 1), cB + hstep + kstep, voffB);
        PG8_WAIT_V(6); PG8_BAR;
    } else {
        PG8_STAGE(PG8_SB(0, 0), cB, voffB); PG8_STAGE(PG8_SA(0, 0), cA, voffA); PG8_STAGE(PG8_SB(0, 1), cB + hstep, voffB); PG8_STAGE(PG8_SA(0, 1), cA + hstep, voffA);
        if (wr == 1) PG8_BAR;
        PG8_WAIT_V(4); PG8_BAR;
        PG8_STAGE(PG8_SB(1, 0), cB + kstep, voffB); PG8_STAGE(PG8_SA(1, 0), cA + kstep, voffA); PG8_STAGE(PG8_SB(1, 1), cB + hstep + kstep, voffB);
        PG8_WAIT_V(6); PG8_BAR;
    }
    for (;;) {
        const bool has_next = S.next(ui + 1, nxt);
        const char* nA = has_next ? (const char*)(nxt.seg ? g.A2 : g.A) + (size_t)nxt.pm * tstep : cA; const char* nB = has_next ? (const char*)(nxt.seg ? g.Bt2 : g.Bt) + (size_t)nxt.pn * tstep : cB;
        for (int t = 0; t < nt; t += 2) {
            const bool last = (t == nt - 2);
            const char* a1 = cA + (size_t)(t + 1) * kstep;
            const char* a2 = last ? nA : cA + (size_t)(t + 2) * kstep; const char* b2 = last ? nB : cB + (size_t)(t + 2) * kstep;
            const char* a3 = a2 + kstep; const char* b3 = b2 + kstep;
            if (last && has_next) S.a_ready(nxt);
            if constexpr (SP2) {
            PG8_LDB(B0, 0, 0); PG8_LDB(B1, 0, 1); PG8_SCHED; PG8_LDA(At, 0, 0); PG8_STAGE(PG8_SA(1, 1), a1 + hstep, voffA);
            PG8_WAIT_V(8); PG8_WAIT_L(0); PG8_BAR; PG8_MMA(0, 0, At, B0); PG8_MMA(0, 1, At, B1); PG8_BAR; PG8_SCHED;
            PG8_LDA(At, 0, 1); PG8_STAGE(PG8_SB(0, 0), b2, voffB); PG8_STAGE(PG8_SB(0, 1), b2 + hstep, voffB); PG8_STAGE(PG8_SA(0, 0), a2, voffA);
            PG8_WAIT_V(8); PG8_WAIT_L(0); PG8_BAR; PG8_MMA(1, 0, At, B0); PG8_MMA(1, 1, At, B1); PG8_BAR; PG8_SCHED;
            PG8_LDB(B0, 1, 0); PG8_LDB(B1, 1, 1); PG8_SCHED; PG8_LDA(At, 1, 0); PG8_STAGE(PG8_SA(0, 1), a2 + hstep, voffA);
            PG8_WAIT_V(8); PG8_WAIT_L(0); PG8_BAR; PG8_MMA(0, 0, At, B0); PG8_MMA(0, 1, At, B1); PG8_BAR; PG8_SCHED;
            PG8_LDA(At, 1, 1); PG8_STAGE(PG8_SB(1, 0), b3, voffB); PG8_STAGE(PG8_SB(1, 1), b3 + hstep, voffB); PG8_STAGE(PG8_SA(1, 0), a3, voffA);
            PG8_WAIT_V(8); PG8_WAIT_L(0); PG8_BAR; PG8_MMA(1, 0, At, B0); PG8_MMA(1, 1, At, B1); PG8_BAR; PG8_SCHED;
            } else {
            PG8_LDB(B0, 0, 0); PG8_SCHED; PG8_LDA(At, 0, 0); PG8_STAGE(PG8_SA(1, 1), a1 + hstep, voffA);
            PG8_WAIT_L(8); PG8_BAR; PG8_WAIT_L(0); PG8_MMA(0, 0, At, B0); PG8_BAR; PG8_SCHED;
            PG8_LDB(B1, 0, 1); PG8_STAGE(PG8_SB(0, 0), b2, voffB);
            PG8_BAR; PG8_WAIT_L(0); PG8_MMA(0, 1, At, B1); PG8_BAR;
            PG8_LDA(At, 0, 1); PG8_STAGE(PG8_SA(0, 0), a2, voffA);
            PG8_BAR; PG8_WAIT_L(0); PG8_MMA(1, 0, At, B0); PG8_BAR; PG8_SCHED;
            PG8_STAGE(PG8_SB(0, 1), b2 + hstep, voffB);
            PG8_WAIT_V(6); PG8_BAR; PG8_MMA(1, 1, At, B1); PG8_BAR;
            PG8_LDB(B0, 1, 0); PG8_SCHED; PG8_LDA(At, 1, 0); PG8_STAGE(PG8_SA(0, 1), a2 + hstep, voffA);
            PG8_WAIT_L(8); PG8_BAR; PG8_WAIT_L(0); PG8_MMA(0, 0, At, B0); PG8_BAR; PG8_SCHED;
            PG8_LDB(B1, 1, 1); PG8_STAGE(PG8_SB(1, 0), b3, voffB);
            PG8_BAR; PG8_WAIT_L(0); PG8_MMA(0, 1, At, B1); PG8_BAR;
            PG8_LDA(At, 1, 1); PG8_STAGE(PG8_SA(1, 0), a3, voffA);
            PG8_BAR; PG8_WAIT_L(0); PG8_MMA(1, 0, At, B0); PG8_BAR; PG8_SCHED;
            PG8_STAGE(PG8_SB(1, 1), b3 + hstep, voffB);
            PG8_WAIT_V(6); PG8_BAR; PG8_MMA(1, 1, At, B1); PG8_BAR;
            }
        }
        if constexpr (ALIGN_EPI) { if (wr == 0) PG8_BAR; }
        const bool keep = E(acc, cur, wr, wc, fr, fq); S.done(cur);
        if (!has_next) break;
        if (!keep) {
#pragma unroll
        for (int a = 0; a < 2; ++a)
#pragma unroll
            for (int b = 0; b < 2; ++b)
#pragma unroll
                for (int m = 0; m < 4; ++m)
#pragma unroll
                    for (int n = 0; n < 2; ++n) acc[a][b][m][n] = (f32x4){0.f, 0.f, 0.f, 0.f};
        }
        cur = nxt; cA = nA; cB = nB; ++ui;
        if constexpr (ALIGN_EPI) { if (wr == 1) PG8_BAR; }
    }
    PG8_WAIT_V(0);
    if constexpr (!ALIGN_EPI) { if (wr == 0) PG8_BAR; }
    PG8_BAR;
#undef PG8_SA
#undef PG8_SB
#undef PG8_STAGE
#undef PG8_LDA
#undef PG8_LDB
#undef PG8_MMA
#undef PG8_WAIT_V
#undef PG8_WAIT_L
#undef PG8_BAR
#undef PG8_SCHED
}
}

constexpr int NWAVES = 8;
constexpr int M = 65536, D = 1024, SEQ = 4096, DIN = 4096, DP = 512, NSC = 2048, NE = 16384, NH = 8, TOPK = 16;
constexpr float RMS_EPS = 1e-6f;
constexpr int N_LAUNCHES = MK_N_LAUNCHES;
constexpr int PER_PHASE = 8;

constexpr size_t MiB = 1u << 20;
constexpr size_t WS_CTL = 0, CTL_ZERO_BYTES = 1 * MiB;
constexpr size_t WS_WIN = 1 * MiB;
constexpr size_t WS_WC = 9 * MiB;
constexpr size_t WS_WBC = 10 * MiB;
constexpr size_t WS_WOUT = 11 * MiB;
constexpr size_t WS_WPP = 13 * MiB;
constexpr size_t WS_SU = 17 * MiB;
constexpr size_t WS_SV = 17 * MiB + 65536;
constexpr size_t WS_SSQ = 18 * MiB;
constexpr size_t WS_U8 = 22 * MiB;
constexpr size_t WS_V8 = 38 * MiB;
constexpr size_t WS_INV = 54 * MiB;
constexpr size_t WS_B = 64 * MiB;
constexpr size_t WS_C = 192 * MiB;
constexpr size_t WS_A = 320 * MiB;
constexpr size_t WS_END = 832 * MiB;
constexpr int CW_BAR = 4096;

constexpr int RING_BYTES = 131072;
constexpr int LDSCTL_OFF = RING_BYTES, MISC_OFF = LDSCTL_OFF + 320;
constexpr int LDS_BYTES = 147456;

#define GAS __attribute__((address_space(1)))
#define LAS __attribute__((address_space(3)))
typedef unsigned short bf16;
typedef unsigned v4u __attribute__((ext_vector_type(4)));
typedef unsigned v2u __attribute__((ext_vector_type(2)));
typedef float f32x4 __attribute__((ext_vector_type(4)));
typedef GAS unsigned gu32;
#define RLX_AGENT __ATOMIC_RELAXED, __HIP_MEMORY_SCOPE_AGENT
#define LDS_WAIT() asm volatile("s_waitcnt lgkmcnt(0)" ::: "memory")
#define VM_WAIT() asm volatile("s_waitcnt vmcnt(0)" ::: "memory")
__device__ __forceinline__ unsigned f2bf(float f) { unsigned u = __builtin_bit_cast(unsigned, f); return (u + 0x7fffu + ((u >> 16) & 1u)) >> 16; }
__device__ __forceinline__ unsigned pk2(float lo, float hi) { return f2bf(lo) | (f2bf(hi) << 16); }
__device__ __forceinline__ float bflo(unsigned w) { return __builtin_bit_cast(float, w << 16); }
__device__ __forceinline__ float bfhi(unsigned w) { return __builtin_bit_cast(float, w & 0xffff0000u); }
__device__ __forceinline__ float wave_sum(float v) {
#pragma unroll
    for (int o = 1; o < 64; o <<= 1) v += __shfl_xor(v, o);
    return v;
}
__device__ __forceinline__ float wave_max(float v) {
#pragma unroll
    for (int o = 1; o < 64; o <<= 1) v = fmaxf(v, __shfl_xor(v, o));
    return v;
}

#define XB_TMO      128
#define XB_XCNT(j)  (256  + 64 * (j))
#define XB_XSUB(j)  (1280 + 64 * (j))
#define XB_XGEN(j)  (2304 + 64 * (j))
#define XB_TOP      3328
#define XB_TOPGEN   3392
#define XCD_BAR_WORDS 3456
#define XB_SPIN_CAP (1u << 18)
__device__ __forceinline__ unsigned xb_ld(unsigned* p)              { return __hip_atomic_load(p, __ATOMIC_RELAXED, __HIP_MEMORY_SCOPE_AGENT); }
__device__ __forceinline__ unsigned xb_add(unsigned* p, unsigned v) { return __hip_atomic_fetch_add(p, v, __ATOMIC_RELAXED, __HIP_MEMORY_SCOPE_AGENT); }
__device__ __forceinline__ unsigned xb_xcc_id() { return (unsigned)__builtin_amdgcn_s_getreg((3 << 11) | 20) & 0xFu; }
#define XB_SPIN(cond, bar) do { unsigned _sp = 0; while (cond) { __builtin_amdgcn_s_sleep(1); \
    if ((++_sp & 255u) == 0u) { if (xb_ld(&(bar)[XB_TMO])) break; if (_sp > XB_SPIN_CAP) { atomicAdd(&(bar)[XB_TMO], 1u); break; } } } } while (0)
struct XcdBarrier { unsigned* bar; unsigned x; volatile LAS unsigned* st; };
__device__ __forceinline__ XcdBarrier xcd_barrier_post(unsigned* bar, volatile LAS unsigned* st) {
    XcdBarrier b; b.bar = bar; b.x = xb_xcc_id(); b.st = st;
    if (threadIdx.x == 0) (void)xb_add(&bar[XB_XCNT(b.x)], 1u);
    return b;
}
__device__ __forceinline__ void xcd_barrier_complete(unsigned* bar, unsigned x, unsigned& nloc, unsigned& nx) {
    const unsigned G = gridDim.x * gridDim.y * gridDim.z;
    unsigned sum, cnt, mine, sp = 0u;
    for (;;) {
        sum = 0u; cnt = 0u; mine = 0u;
#pragma unroll
        for (unsigned j = 0; j < 16; ++j) { const unsigned c = xb_ld(&bar[XB_XCNT(j)]); sum += c; cnt += (c > 0u) ? 1u : 0u; mine = (j == x) ? c : mine; }
        if (sum == G) break;
        __builtin_amdgcn_s_sleep(1);
        if ((++sp & 255u) == 0u) { if (xb_ld(&bar[XB_TMO])) break; if (sp > XB_SPIN_CAP) { atomicAdd(&bar[XB_TMO], 1u); break; } }
    }
    nloc = mine > 0u ? mine : 1u; nx = cnt > 0u ? cnt : 1u;
}
__device__ __forceinline__ void xcd_barrier(const XcdBarrier& b) {
    asm volatile("s_waitcnt vmcnt(0)" ::: "memory");
    __syncthreads();
    if (threadIdx.x == 0) {
        unsigned* bar = b.bar;
        __builtin_amdgcn_s_waitcnt(0);
        unsigned nloc = b.st[0], nx = b.st[1];
        if (nloc == 0u) { xcd_barrier_complete(bar, b.x, nloc, nx); b.st[0] = nloc; b.st[1] = nx; }
        const unsigned old = xb_add(&bar[XB_XSUB(b.x)], 1u);
        const unsigned gen = old / nloc;
        if (old + 1u == (gen + 1u) * nloc) {
            __builtin_amdgcn_fence(__ATOMIC_RELEASE, "agent");
            asm volatile("s_waitcnt vmcnt(0)" ::: "memory");
            const unsigned og = xb_add(&bar[XB_TOP], 1u);
            const unsigned tg = og / nx;
            if (og + 1u == (tg + 1u) * nx) xb_add(&bar[XB_TOPGEN], 1u);
            else XB_SPIN(xb_ld(&bar[XB_TOPGEN]) == tg, bar);
            __builtin_amdgcn_fence(__ATOMIC_ACQUIRE, "agent");
            xb_add(&bar[XB_XGEN(b.x)], 1u);
            asm volatile("s_waitcnt vmcnt(0)" ::: "memory");
        } else {
            XB_SPIN(xb_ld(&bar[XB_XGEN(b.x)]) == gen, bar);
            __builtin_amdgcn_fence(__ATOMIC_ACQUIRE, "agent");
            asm volatile("s_waitcnt vmcnt(0)" ::: "memory");
        }
    }
    __syncthreads();
}

__device__ __forceinline__ void p0_transpose_item(const float* W, int K, int N, bf16* WT, LAS float* scr, int item, int lane) {
    const int nblk = N / 32, kb = item / nblk, nb = item % nblk, k0 = 64 * kb, n0 = 32 * nb;
#pragma unroll 8
    for (int i = 0; i < 32; ++i) { const int kk = 2 * i + (lane >> 5); scr[kk * 33 + (lane & 31)] = W[(size_t)(k0 + kk) * N + n0 + (lane & 31)]; }
    LDS_WAIT(); asm volatile("" ::: "memory");
    const int c = lane & 7;
#pragma unroll
    for (int j = 0; j < 4; ++j) { const int n = (lane >> 3) + 8 * j; const LAS float* s = scr + (8 * c) * 33 + n;
        v4u o; o.x = pk2(s[0 * 33], s[1 * 33]); o.y = pk2(s[2 * 33], s[3 * 33]); o.z = pk2(s[4 * 33], s[5 * 33]); o.w = pk2(s[6 * 33], s[7 * 33]);
        *(v4u*)(WT + (size_t)(n0 + n) * K + k0 + 8 * c) = o; }
    LDS_WAIT(); asm volatile("" ::: "memory");
}
__device__ __forceinline__ void p0_wc_item(const float* gwt, const float* scale, const float* wbp, bf16* WcT, int item, int lane) {
    const int nb = item & 15, cb = (item >> 4) & 7, g = item >> 7;
    const int n = nb * 64 + lane;
    float acc[16];
#pragma unroll
    for (int c = 0; c < 16; ++c) acc[c] = 0.f;
    for (int d = 0; d < 128; ++d) {
        const float b = wbp[(size_t)(g * 128 + d) * 1024 + n] * scale[g * 128 + d];
#pragma unroll
        for (int c = 0; c < 16; ++c) acc[c] += gwt[(size_t)((g * 128 + cb * 16 + c) * 128) + d] * b;
    }
    v4u o0, o1;
    o0.x = pk2(acc[0], acc[1]); o0.y = pk2(acc[2], acc[3]); o0.z = pk2(acc[4], acc[5]); o0.w = pk2(acc[6], acc[7]);
    o1.x = pk2(acc[8], acc[9]); o1.y = pk2(acc[10], acc[11]); o1.z = pk2(acc[12], acc[13]); o1.w = pk2(acc[14], acc[15]);
    bf16* dst = WcT + (size_t)n * 512 + g * 128 + cb * 16;
    *(v4u*)dst = o0; *(v4u*)(dst + 8) = o1;
}
__device__ __forceinline__ void p0_wpp_item(const float* wq, const float* keys, const float* gffn, bf16* WppT, int item, int lane) {
    const int kb = item & 3, db = (item >> 2) & 15, hp = item >> 6;
    const int d = db * 64 + lane;
    float acc[32];
#pragma unroll
    for (int k = 0; k < 32; ++k) acc[k] = 0.f;
    const float* arow = wq + (size_t)d * 2048 + hp * 128;
    const float* kbase = keys + (size_t)(hp * 128 + kb * 32) * 128;
    for (int c4 = 0; c4 < 32; ++c4) {
        const f32x4 a = *(const f32x4*)(arow + 4 * c4);
#pragma unroll
        for (int k = 0; k < 32; ++k) { const float* kr = kbase + k * 128 + 4 * c4; acc[k] += a.x * kr[0] + a.y * kr[1] + a.z * kr[2] + a.w * kr[3]; }
    }
    const float gs = gffn[d];
#pragma unroll
    for (int k = 0; k < 32; ++k) WppT[(size_t)(hp * 128 + kb * 32 + k) * 1024 + d] = (bf16)f2bf(acc[k] * gs);
}
__device__ __forceinline__ void p0_h_row(const float* xrow, const float* g, bf16* orow, int lane) {
    const f32x4* xr = (const f32x4*)xrow + lane; const f32x4* gr = (const f32x4*)g + lane;
    f32x4 v[4]; float s = 0.f;
#pragma unroll
    for (int j = 0; j < 4; ++j) { v[j] = xr[64 * j]; s += (v[j].x * v[j].x + v[j].y * v[j].y) + (v[j].z * v[j].z + v[j].w * v[j].w); }
    const float rstd = rsqrtf(wave_sum(s) * (1.f / D) + RMS_EPS);
    v2u* o8 = (v2u*)orow + lane;
#pragma unroll
    for (int j = 0; j < 4; ++j) { const f32x4 gg = gr[64 * j]; v2u o; o.x = pk2(v[j].x * rstd * gg.x, v[j].y * rstd * gg.y); o.y = pk2(v[j].z * rstd * gg.z, v[j].w * rstd * gg.w); o8[64 * j] = o; }
}
__device__ __forceinline__ void p0_quant_row(const float* src, const float* gmul, unsigned char* dst, float* scale_out, int e, int lane, bool uns) {
    const f32x4* p = (const f32x4*)(src + (size_t)e * 1024 + 16 * lane);
    f32x4 v[4];
#pragma unroll
    for (int j = 0; j < 4; ++j) v[j] = p[j];
    if (gmul) { const f32x4* gp = (const f32x4*)(gmul + 16 * lane);
#pragma unroll
        for (int j = 0; j < 4; ++j) v[j] = v[j] * gp[j]; }
    float mx = 0.f;
#pragma unroll
    for (int j = 0; j < 4; ++j) mx = fmaxf(mx, fmaxf(fmaxf(fabsf(v[j].x), fabsf(v[j].y)), fmaxf(fabsf(v[j].z), fabsf(v[j].w))));
    mx = wave_max(mx);
    const float sc = mx > 0.f ? mx * (1.f / 127.f) : 1.f, inv = 1.f / sc;
    const int bias = uns ? 128 : 0;
    v4u w;
#pragma unroll
    for (int j = 0; j < 4; ++j) {
        unsigned acc = 0;
#pragma unroll
        for (int c = 0; c < 4; ++c) { int q = (int)rintf(v[j][c] * inv); q = q > 127 ? 127 : (q < -127 ? -127 : q); acc |= ((unsigned)(q + bias) & 0xffu) << (8 * c); }
        w[j] = acc;
    }
    *(v4u*)(dst + (size_t)e * 1024 + 16 * lane) = w;
    if (lane == 0) scale_out[e] = sc;
}

typedef pg8::f32x4 (&AccRef)[2][2][4][2];
struct EpiZ {
    static constexpr bool PERM = true;
    bf16* O; int ldc;
    __device__ __forceinline__ bool operator()(AccRef acc, const pg8::Unit& u, int wr, int wc, int fr, int fq) const {
        const int row0 = u.pm * 256 + wr * 64 + fr, col0 = u.pn * 256 + wc * 32 + 8 * fq;
#pragma unroll
        for (int ai = 0; ai < 2; ++ai)
#pragma unroll
            for (int m = 0; m < 4; ++m) { bf16* rowp = O + (size_t)(row0 + ai * 128 + m * 16) * ldc + col0;
#pragma unroll
                for (int bj = 0; bj < 2; ++bj) { const pg8::f32x4 v0 = acc[ai][bj][m][0], v1 = acc[ai][bj][m][1]; v4u w;
                    w.x = pg8::cvt_pk_bf16(v0[0], v0[1]); w.y = pg8::cvt_pk_bf16(v0[2], v0[3]); w.z = pg8::cvt_pk_bf16(v1[0], v1[1]); w.w = pg8::cvt_pk_bf16(v1[2], v1[3]);
                    *(v4u*)(rowp + bj * 128) = w; } }
        return false;
    }
};
__device__ __forceinline__ float sigm_ratio(float ga, float gb) { return (1.f + __expf(-gb)) / (1.f + __expf(-ga)); }
struct EpiGate {
    static constexpr bool PERM = true;
    const bf16* Z; bf16* Mo;
    __device__ __forceinline__ bool operator()(AccRef acc, const pg8::Unit& u, int wr, int wc, int fr, int fq) const {
        const int row0 = u.pm * 256 + wr * 64 + fr, col0 = u.pn * 256 + wc * 32 + 8 * fq;
        if (u.seg == 0) {
#pragma unroll
            for (int ai = 0; ai < 2; ++ai)
#pragma unroll
                for (int m = 0; m < 4; ++m) { const bf16* zr = Z + (size_t)(row0 + ai * 128 + m * 16) * DIN + col0;
#pragma unroll
                    for (int bj = 0; bj < 2; ++bj) { const v4u a = *(const v4u*)(zr + 2048 + bj * 128), b = *(const v4u*)(zr + 3072 + bj * 128);
                        pg8::f32x4& v0 = acc[ai][bj][m][0]; pg8::f32x4& v1 = acc[ai][bj][m][1];
                        v0[0] *= sigm_ratio(bflo(a.x), bflo(b.x)); v0[1] *= sigm_ratio(bfhi(a.x), bfhi(b.x)); v0[2] *= sigm_ratio(bflo(a.y), bflo(b.y)); v0[3] *= sigm_ratio(bfhi(a.y), bfhi(b.y));
                        v1[0] *= sigm_ratio(bflo(a.z), bflo(b.z)); v1[1] *= sigm_ratio(bfhi(a.z), bfhi(b.z)); v1[2] *= sigm_ratio(bflo(a.w), bflo(b.w)); v1[3] *= sigm_ratio(bfhi(a.w), bfhi(b.w)); } }
            return true;
        }
#pragma unroll
        for (int ai = 0; ai < 2; ++ai)
#pragma unroll
            for (int m = 0; m < 4; ++m) { const size_t r = (size_t)(row0 + ai * 128 + m * 16); const bf16* zr = Z + r * DIN + col0; bf16* mo = Mo + r * D + col0;
#pragma unroll
                for (int bj = 0; bj < 2; ++bj) { const v4u b = *(const v4u*)(zr + 3072 + bj * 128);
                    const pg8::f32x4 v0 = acc[ai][bj][m][0], v1 = acc[ai][bj][m][1]; v4u w;
#define SG(x) (1.f / (1.f + __expf(-(x))))
                    w.x = pg8::cvt_pk_bf16(v0[0] * SG(bflo(b.x)), v0[1] * SG(bfhi(b.x))); w.y = pg8::cvt_pk_bf16(v0[2] * SG(bflo(b.y)), v0[3] * SG(bfhi(b.y)));
                    w.z = pg8::cvt_pk_bf16(v1[0] * SG(bflo(b.z)), v1[1] * SG(bfhi(b.z))); w.w = pg8::cvt_pk_bf16(v1[2] * SG(bflo(b.w)), v1[3] * SG(bfhi(b.w)));
#undef SG
                    *(v4u*)(mo + bj * 128) = w; } }
        return false;
    }
};
struct EpiRes {
    static constexpr bool PERM = true;
    const float* X; bf16* X1; float* SSQ;
    __device__ __forceinline__ bool operator()(AccRef acc, const pg8::Unit& u, int wr, int wc, int fr, int fq) const {
        const int row0 = u.pm * 256 + wr * 64 + fr, col0 = u.pn * 256 + wc * 32 + 8 * fq;
#pragma unroll
        for (int ai = 0; ai < 2; ++ai)
#pragma unroll
            for (int m = 0; m < 4; ++m) { const size_t r = (size_t)(row0 + ai * 128 + m * 16); const float* xr = X + r * D + col0; bf16* o = X1 + r * D + col0; float ss = 0.f;
#pragma unroll
                for (int bj = 0; bj < 2; ++bj) { const pg8::f32x4 x0 = *(const pg8::f32x4*)(xr + bj * 128), x1v = *(const pg8::f32x4*)(xr + bj * 128 + 4);
                    const pg8::f32x4 v0 = acc[ai][bj][m][0] + x0, v1 = acc[ai][bj][m][1] + x1v;
                    ss += (v0[0] * v0[0] + v0[1] * v0[1]) + (v0[2] * v0[2] + v0[3] * v0[3]) + (v1[0] * v1[0] + v1[1] * v1[1]) + (v1[2] * v1[2] + v1[3] * v1[3]);
                    v4u w; w.x = pg8::cvt_pk_bf16(v0[0], v0[1]); w.y = pg8::cvt_pk_bf16(v0[2], v0[3]); w.z = pg8::cvt_pk_bf16(v1[0], v1[1]); w.w = pg8::cvt_pk_bf16(v1[2], v1[3]);
                    *(v4u*)(o + bj * 128) = w; }
                ss += __shfl_xor(ss, 16); ss += __shfl_xor(ss, 32);
                if (fq == 0) SSQ[r * 16 + u.pn * 4 + wc] = ss; }
        return false;
    }
};
struct EpiScore {
    static constexpr bool PERM = true;
    const float* SSQ; _Float16* S;
    __device__ __forceinline__ bool operator()(AccRef acc, const pg8::Unit& u, int wr, int wc, int fr, int fq) const {
        const int row0 = u.pm * 256 + wr * 64 + fr, col0 = u.pn * 256 + wc * 32 + 8 * fq;
#pragma unroll
        for (int ai = 0; ai < 2; ++ai)
#pragma unroll
            for (int m = 0; m < 4; ++m) { const size_t r = (size_t)(row0 + ai * 128 + m * 16);
                const pg8::f32x4* sp = (const pg8::f32x4*)(SSQ + r * 16); const pg8::f32x4 s0 = sp[0], s1 = sp[1], s2 = sp[2], s3 = sp[3];
                const float tot = ((s0[0] + s0[1]) + (s0[2] + s0[3])) + ((s1[0] + s1[1]) + (s1[2] + s1[3])) + ((s2[0] + s2[1]) + (s2[2] + s2[3])) + ((s3[0] + s3[1]) + (s3[2] + s3[3]));
                const float rstd = rsqrtf(tot * (1.f / D) + RMS_EPS);
                _Float16* o = S + r * NSC + col0;
#pragma unroll
                for (int bj = 0; bj < 2; ++bj) { const pg8::f32x4 v0 = acc[ai][bj][m][0] * rstd, v1 = acc[ai][bj][m][1] * rstd;
                    typedef _Float16 h2 __attribute__((ext_vector_type(2)));
                    h2 p0 = {(_Float16)v0[0], (_Float16)v0[1]}, p1 = {(_Float16)v0[2], (_Float16)v0[3]}, p2 = {(_Float16)v1[0], (_Float16)v1[1]}, p3 = {(_Float16)v1[2], (_Float16)v1[3]};
                    v4u w; w.x = __builtin_bit_cast(unsigned, p0); w.y = __builtin_bit_cast(unsigned, p1); w.z = __builtin_bit_cast(unsigned, p2); w.w = __builtin_bit_cast(unsigned, p3);
                    *(v4u*)(o + bj * 128) = w; } }
        return false;
    }
};

__device__ __forceinline__ void unpack8(const v4u w, float (&f)[8]) { f[0] = bflo(w.x); f[1] = bfhi(w.x); f[2] = bflo(w.y); f[3] = bfhi(w.y); f[4] = bflo(w.z); f[5] = bfhi(w.z); f[6] = bflo(w.w); f[7] = bfhi(w.w); }
__device__ __forceinline__ v4u pack8(const float (&f)[8]) { v4u w; w.x = pk2(f[0], f[1]); w.y = pk2(f[2], f[3]); w.z = pk2(f[4], f[5]); w.w = pk2(f[6], f[7]); return w; }
__device__ __forceinline__ void p2_timemix(const bf16* Z, const float* convw, bf16* PA, bf16* CA, int gw, int NGW, int lane) {
    const int w = 2 << (lane >> 4);
    const int ch = 8 * lane;
    float cw0[8], cw1[8], cw2[8];
#pragma unroll
    for (int i = 0; i < 8; ++i) { cw0[i] = convw[ch + i]; cw1[i] = convw[512 + ch + i]; cw2[i] = convw[1024 + ch + i]; }
    for (int chunk = gw; chunk < M / 32; chunk += NGW) {
        const int t0 = chunk * 32, s0 = t0 & (SEQ - 1);
        float sum[8], up1[8], up2[8];
#pragma unroll
        for (int i = 0; i < 8; ++i) { sum[i] = 0.f; up1[i] = 0.f; up2[i] = 0.f; }
        if (s0 > 0) {
            for (int j = 1; j < 16; ++j) {
                if (j < w) { float f[8]; unpack8(*(const v4u*)(Z + (size_t)(t0 - j) * DIN + ch), f);
#pragma unroll
                    for (int i = 0; i < 8; ++i) sum[i] += f[i]; }
            }
            float c[8], v[8];
            unpack8(*(const v4u*)(Z + (size_t)(t0 - 2) * DIN + 512 + ch), c); unpack8(*(const v4u*)(Z + (size_t)(t0 - 2) * DIN + 1536 + ch), v);
#pragma unroll
            for (int i = 0; i < 8; ++i) up2[i] = c[i] * v[i];
            unpack8(*(const v4u*)(Z + (size_t)(t0 - 1) * DIN + 512 + ch), c); unpack8(*(const v4u*)(Z + (size_t)(t0 - 1) * DIN + 1536 + ch), v);
#pragma unroll
            for (int i = 0; i < 8; ++i) up1[i] = c[i] * v[i];
        }
        for (int i2 = 0; i2 < 32; ++i2) {
            const int t = t0 + i2, s = s0 + i2;
            const bf16* zr = Z + (size_t)t * DIN;
            float zt[8], c[8], b[8], v[8], o[8];
            unpack8(*(const v4u*)(zr + ch), zt); unpack8(*(const v4u*)(zr + 512 + ch), c); unpack8(*(const v4u*)(zr + 1024 + ch), b); unpack8(*(const v4u*)(zr + 1536 + ch), v);
            const int cnt = (s + 1) < w ? (s + 1) : w; const float rc = 1.f / (float)cnt;
#pragma unroll
            for (int i = 0; i < 8; ++i) { sum[i] += zt[i]; o[i] = sum[i] * rc - zt[i]; }
            *(v4u*)(PA + (size_t)t * DP + ch) = pack8(o);
            if (s + 1 - w >= 0) { float f[8]; unpack8(*(const v4u*)(Z + (size_t)(t + 1 - w) * DIN + ch), f);
#pragma unroll
                for (int i = 0; i < 8; ++i) sum[i] -= f[i]; }
#pragma unroll
            for (int i = 0; i < 8; ++i) { const float uu = c[i] * v[i]; o[i] = b[i] * (cw0[i] * up2[i] + cw1[i] * up1[i] + cw2[i] * uu); up2[i] = up1[i]; up1[i] = uu; }
            *(v4u*)(CA + (size_t)t * DP + ch) = pack8(o);
        }
    }
}

__device__ __forceinline__ void p6_topk(const _Float16* S, unsigned short* IDX, float* EV, float* INV, LAS unsigned char* lds, int gw, int NGW, int wave, int lane) {
    LAS unsigned char* my = lds + wave * 9216;
    const float NEG = -3.0e38f;
    for (int grp = gw; grp < M * NH / 64; grp += NGW) {
        const char* base = (const char*)S + (size_t)grp * 64 * 512;
        float A[16], B[16];
#pragma unroll
        for (int half = 0; half < 2; ++half) {
            float L[16];
#pragma unroll
            for (int i = 0; i < 16; ++i) L[i] = NEG;
#pragma unroll 1
            for (int step = 0; step < 2; ++step) {
                const int j = half * 2 + step;
#pragma unroll
                for (int q = 0; q < 8; ++q) { const int row = 8 * q + (lane >> 3), chn = lane & 7;
                    const v4u dd = *(const v4u*)(base + (size_t)row * 512 + 128 * j + 16 * chn); *(LAS v4u*)(my + row * 144 + 16 * chn) = dd; }
                asm volatile("s_waitcnt lgkmcnt(0)" ::: "memory");
#pragma unroll 1
                for (int c = 0; c < 8; ++c) {
                    const v4u dd = *(const LAS v4u*)(my + lane * 144 + 16 * c);
                    const unsigned ww[4] = {dd.x, dd.y, dd.z, dd.w};
#pragma unroll
                    for (int e = 0; e < 8; ++e) {
                        const unsigned hb = (e & 1) ? (ww[e >> 1] >> 16) : (ww[e >> 1] & 0xffffu);
                        const float val = (float)__builtin_bit_cast(_Float16, (unsigned short)hb);
                        const int key = step * 64 + c * 8 + e;
                        float tv = __builtin_bit_cast(float, __builtin_bit_cast(unsigned, val) | (unsigned)(127 - key));
#pragma unroll
                        for (int i = 0; i < 16; ++i) { const float hi = fmaxf(L[i], tv); tv = fminf(L[i], tv); L[i] = hi; }
                    }
                }
                asm volatile("s_waitcnt lgkmcnt(0)" ::: "memory");
            }
#pragma unroll
            for (int i = 0; i < 16; ++i) { if (half == 0) A[i] = L[i]; else B[i] = L[i]; }
        }
        float FV[16]; int FI[16];
#pragma unroll
        for (int i = 0; i < 16; ++i) { FV[i] = NEG; FI[i] = 0; }
#pragma unroll
        for (int i = 0; i < 16; ++i) {
            const unsigned ab = __builtin_bit_cast(unsigned, A[i]); const float av = __builtin_bit_cast(float, ab & ~0x7fu); const int ak = 127 - (int)(ab & 0x7fu);
#pragma unroll
            for (int j = 0; j < 16; ++j) {
                if ((i + 1) * (j + 1) <= 16) {
                    const unsigned bb = __builtin_bit_cast(unsigned, B[j]); const float bv = __builtin_bit_cast(float, bb & ~0x7fu); const int bk = 127 - (int)(bb & 0x7fu);
                    float x = av + bv; int xi = ak * 128 + bk;
#pragma unroll
                    for (int s = (i + 1) * (j + 1) - 1; s < 16; ++s) { const bool c = x > FV[s]; const float nv = c ? x : FV[s], ox = c ? FV[s] : x; const int ni = c ? xi : FI[s], oi = c ? FI[s] : xi; FV[s] = nv; FI[s] = ni; x = ox; xi = oi; }
                }
            }
        }
        const size_t r = (size_t)grp * 64 + lane;
        float ev[16]; float sum = 0.f;
#pragma unroll
        for (int i = 0; i < 16; ++i) { ev[i] = __expf(FV[i] - FV[0]); sum += ev[i]; }
        v4u i0, i1;
        i0.x = (unsigned)FI[0] | ((unsigned)FI[1] << 16); i0.y = (unsigned)FI[2] | ((unsigned)FI[3] << 16); i0.z = (unsigned)FI[4] | ((unsigned)FI[5] << 16); i0.w = (unsigned)FI[6] | ((unsigned)FI[7] << 16);
        i1.x = (unsigned)FI[8] | ((unsigned)FI[9] << 16); i1.y = (unsigned)FI[10] | ((unsigned)FI[11] << 16); i1.z = (unsigned)FI[12] | ((unsigned)FI[13] << 16); i1.w = (unsigned)FI[14] | ((unsigned)FI[15] << 16);
        *(v4u*)(IDX + r * 16) = i0; *(v4u*)(IDX + r * 16 + 8) = i1;
#pragma unroll
        for (int q = 0; q < 4; ++q) *(f32x4*)(EV + r * 16 + 4 * q) = (f32x4){ev[4 * q], ev[4 * q + 1], ev[4 * q + 2], ev[4 * q + 3]};
        INV[r] = 1.f / sum;
    }
}

__device__ __forceinline__ float ubf(unsigned w, int b) { return (float)((w >> (8 * b)) & 0xffu); }
__device__ __forceinline__ void p7_peer(const bf16* X1, const float* SSQ, const unsigned short* IDX, const float* EV, const float* INV, const unsigned char* U8, const unsigned char* V8,
                                        const float* SU, const float* SV, const float* gfin, float* out, int gw, int NGW, int lane) {
    const int k = (lane >> 2) & 15;
    f32x4 gf[4];
#pragma unroll
    for (int q = 0; q < 4; ++q) gf[q] = *(const f32x4*)(gfin + 16 * lane + 4 * q);
    for (int t = gw; t < M; t += NGW) {
        const v4u xa = *(const v4u*)(X1 + (size_t)t * D + 16 * lane), xb = *(const v4u*)(X1 + (size_t)t * D + 16 * lane + 8);
        float xv[16];
        { float f[8]; unpack8(xa, f);
#pragma unroll
          for (int i = 0; i < 8; ++i) xv[i] = f[i];
          unpack8(xb, f);
#pragma unroll
          for (int i = 0; i < 8; ++i) xv[8 + i] = f[i]; }
        float mx = 0.f;
#pragma unroll
        for (int i = 0; i < 16; ++i) mx = fmaxf(mx, fabsf(xv[i]));
        mx = wave_max(mx);
        const float sx = mx > 0.f ? mx * (1.f / 127.f) : 1.f, isx = 1.f / sx;
        int xq[4];
#pragma unroll
        for (int j = 0; j < 4; ++j) { unsigned a = 0;
#pragma unroll
            for (int c = 0; c < 4; ++c) { int q = (int)rintf(xv[4 * j + c] * isx); q = q > 127 ? 127 : (q < -127 ? -127 : q); a |= ((unsigned)q & 0xffu) << (8 * c); }
            xq[j] = (int)a; }
        const float ssp = lane < 16 ? SSQ[(size_t)t * 16 + lane] : 0.f;
        const float rstd = rsqrtf(wave_sum(ssp) * (1.f / D) + RMS_EPS);
        float acc[16];
#pragma unroll
        for (int i = 0; i < 16; ++i) acc[i] = 0.f;
        float wtot = 0.f;
#pragma unroll 1
        for (int h = 0; h < NH; ++h) {
            const size_t r = (size_t)t * NH + h;
            const int idv = (int)IDX[r * 16 + k]; const float ev = EV[r * 16 + k]; const float iv = INV[r];
            const float suk = SU[idv], svk = SV[idv];
            v4u ur[16], vr[16];
#pragma unroll
            for (int kk = 0; kk < 16; ++kk) { const int e = __builtin_amdgcn_readlane(idv, 4 * kk);
                ur[kk] = *(const v4u*)(U8 + (size_t)e * 1024 + 16 * lane); vr[kk] = *(const v4u*)(V8 + (size_t)e * 1024 + 16 * lane); }
            int p[16];
#pragma unroll
            for (int kk = 0; kk < 16; ++kk) { int s = __builtin_amdgcn_sdot4((int)ur[kk].x, xq[0], 0, false); s = __builtin_amdgcn_sdot4((int)ur[kk].y, xq[1], s, false);
                s = __builtin_amdgcn_sdot4((int)ur[kk].z, xq[2], s, false); s = __builtin_amdgcn_sdot4((int)ur[kk].w, xq[3], s, false); p[kk] = s; }
            int q8[8], q4[4], q2[2], q1;
            const bool b5 = lane & 32, b4 = lane & 16, b3 = lane & 8, b2 = lane & 4;
#pragma unroll
            for (int i = 0; i < 8; ++i) { const int snd = b5 ? p[i] : p[i + 8], kp = b5 ? p[i + 8] : p[i]; q8[i] = kp + __shfl_xor(snd, 32); }
#pragma unroll
            for (int i = 0; i < 4; ++i) { const int snd = b4 ? q8[i] : q8[i + 4], kp = b4 ? q8[i + 4] : q8[i]; q4[i] = kp + __shfl_xor(snd, 16); }
#pragma unroll
            for (int i = 0; i < 2; ++i) { const int snd = b3 ? q4[i] : q4[i + 2], kp = b3 ? q4[i + 2] : q4[i]; q2[i] = kp + __shfl_xor(snd, 8); }
            { const int snd = b2 ? q2[0] : q2[1], kp = b2 ? q2[1] : q2[0]; q1 = kp + __shfl_xor(snd, 4); }
            q1 += __shfl_xor(q1, 2); q1 += __shfl_xor(q1, 1);
            const float act = (float)q1 * sx * suk * rstd;
            const float gl = 0.5f * act * (1.f + erff(act * 0.70710678118654752f));
            const float wv = ev * iv * gl * svk;
#pragma unroll
            for (int kk = 0; kk < 16; ++kk) { const float wk = __builtin_bit_cast(float, __builtin_amdgcn_readlane(__builtin_bit_cast(int, wv), 4 * kk)); wtot += wk;
#pragma unroll
                for (int j = 0; j < 4; ++j) { const unsigned w = vr[kk][j];
#pragma unroll
                    for (int b = 0; b < 4; ++b) acc[4 * j + b] += wk * ubf(w, b); } }
        }
        float ss = 0.f;
#pragma unroll
        for (int i = 0; i < 16; ++i) { xv[i] = xv[i] + acc[i] - 128.f * wtot; ss += xv[i] * xv[i]; }
        const float r2 = rsqrtf(wave_sum(ss) * (1.f / D) + RMS_EPS);
        float* o = out + (size_t)t * D + 16 * lane;
#pragma unroll
        for (int q = 0; q < 4; ++q) *(f32x4*)(o + 4 * q) = (f32x4){xv[4 * q] * r2 * gf[q].x, xv[4 * q + 1] * r2 * gf[q].y, xv[4 * q + 2] * r2 * gf[q].z, xv[4 * q + 3] * r2 * gf[q].w};
    }
}

struct Args { const float* in[15]; float* out; unsigned char* ws; int ph_lo, ph_hi, li, pad; };
__global__ void __launch_bounds__(NWAVES * 64, 2) fwd_kernel(Args args) {
    extern __shared__ __attribute__((aligned(16))) unsigned char lds_raw[];
    LAS unsigned char* lds = (LAS unsigned char*)lds_raw;
    volatile LAS unsigned* MISC = (volatile LAS unsigned*)(lds + MISC_OFF);
    const int tid = threadIdx.x, lane = tid & 63, wave = __builtin_amdgcn_readfirstlane(tid >> 6);
    const int G = gridDim.x; const int bx = blockIdx.x; const int vcu = (G % 8 == 0) ? (bx % 8) * (G / 8) + bx / 8 : bx;
    const int gw = vcu * NWAVES + wave, NGW = G * NWAVES;
    unsigned char* ws = args.ws;
    gu32* ctl = (gu32*)(ws + WS_CTL);
    const float* x = args.in[0]; const float* g_mix = args.in[1]; const float* w_in = args.in[2]; const float* pool_gw = args.in[3]; const float* pool_scale = args.in[4];
    const float* conv_w = args.in[5]; const float* w_bp = args.in[6]; const float* w_bc = args.in[7]; const float* w_out = args.in[8]; const float* g_ffn = args.in[9];
    const float* w_q = args.in[10]; const float* sub_keys = args.in[11]; const float* expert_u = args.in[12]; const float* expert_v = args.in[13]; const float* g_final = args.in[14];
    bf16* Win_t = (bf16*)(ws + WS_WIN); bf16* Wc_t = (bf16*)(ws + WS_WC); bf16* Wbc_t = (bf16*)(ws + WS_WBC); bf16* Wout_t = (bf16*)(ws + WS_WOUT); bf16* Wpp_t = (bf16*)(ws + WS_WPP);
    float* SU = (float*)(ws + WS_SU); float* SV = (float*)(ws + WS_SV); float* SSQ = (float*)(ws + WS_SSQ);
    unsigned char* U8 = ws + WS_U8; unsigned char* V8 = ws + WS_V8; float* INV = (float*)(ws + WS_INV);
    bf16* Hb = (bf16*)(ws + WS_B); bf16* PA = (bf16*)(ws + WS_B); bf16* CA = (bf16*)(ws + WS_B + 64 * MiB); bf16* X1 = (bf16*)(ws + WS_B);
    bf16* Mb = (bf16*)(ws + WS_C); unsigned short* IDX = (unsigned short*)(ws + WS_C); float* EV = (float*)(ws + WS_C + 16 * MiB);
    bf16* Zb = (bf16*)(ws + WS_A); _Float16* SC = (_Float16*)(ws + WS_A);

    for (int u = tid; u < (LDS_BYTES - LDSCTL_OFF) / 4; u += NWAVES * 64) ((LAS unsigned*)(lds + LDSCTL_OFF))[u] = 0u;
    __syncthreads();
    XcdBarrier bar; bar.bar = (unsigned*)(ctl + CW_BAR); bar.x = 0; bar.st = nullptr;
    if (N_LAUNCHES != PER_PHASE) bar = xcd_barrier_post((unsigned*)(ctl + CW_BAR), MISC + 8);
#define GRID_BAR() do { if (N_LAUNCHES != PER_PHASE) xcd_barrier(bar); } while (0)
    const int lo = args.ph_lo, hi = args.ph_hi;
#define IN(k) (lo <= (k) && (k) < hi)
#define BOTH(k) (IN(k) && IN((k) + 1))

    if (IN(0)) {
        LAS float* scr = (LAS float*)(lds + wave * 16384);
        constexpr int I_WPP = 1024, I_WIN = (1024 / 64) * (4096 / 32), I_WOUT = (1024 / 64) * (1024 / 32), I_WBC = (512 / 64) * (1024 / 32), I_WC = 512;
        constexpr int NITEMS = I_WPP + I_WIN + I_WOUT + I_WBC + I_WC;
        for (int it = gw; it < NITEMS; it += NGW) {
            int r = it;
            if (r < I_WPP) { p0_wpp_item(w_q, sub_keys, g_ffn, Wpp_t, r, lane); continue; } r -= I_WPP;
            if (r < I_WIN) { p0_transpose_item(w_in, 1024, 4096, Win_t, scr, r, lane); continue; } r -= I_WIN;
            if (r < I_WOUT) { p0_transpose_item(w_out, 1024, 1024, Wout_t, scr, r, lane); continue; } r -= I_WOUT;
            if (r < I_WBC) { p0_transpose_item(w_bc, 512, 1024, Wbc_t, scr, r, lane); continue; } r -= I_WBC;
            p0_wc_item(pool_gw, pool_scale, w_bp, Wc_t, r, lane);
        }
        for (int e = gw; e < 2 * NE; e += NGW) {
            if (e < NE) p0_quant_row(expert_u, g_ffn, U8, SU, e, lane, false);
            else p0_quant_row(expert_v, nullptr, V8, SV, e - NE, lane, true);
        }
        for (int m = gw; m < M; m += NGW) p0_h_row(x + (size_t)m * D, g_mix, Hb + (size_t)m * D, lane);
        if (BOTH(0)) GRID_BAR();
    }
    if (IN(1)) {
        pg8::Gemm g{Hb, Win_t, Hb, Win_t, M, DIN, D}; pg8::StaticOrder S; S.init(M, DIN, G, bx, 1);
        EpiZ E{Zb, DIN};
        pg8::gemm_phase<EpiZ, pg8::StaticOrder, true, true>(lds, g, S, E);
        if (BOTH(1)) GRID_BAR();
    }
    if (IN(2)) {
        p2_timemix(Zb, conv_w, PA, CA, gw, NGW, lane);
        if (BOTH(2)) GRID_BAR();
    }
    if (IN(3)) {
        pg8::Gemm g{PA, Wc_t, CA, Wbc_t, M, D, DP}; pg8::StaticOrder S; S.init(M, D, G, bx, 2);
        EpiGate E{Zb, Mb};
        pg8::gemm_phase<EpiGate, pg8::StaticOrder, true, true>(lds, g, S, E);
        if (BOTH(3)) GRID_BAR();
    }
    if (IN(4)) {
        pg8::Gemm g{Mb, Wout_t, Mb, Wout_t, M, D, D}; pg8::StaticOrder S; S.init(M, D, G, bx, 1);
        EpiRes E{x, X1, SSQ};
        pg8::gemm_phase<EpiRes, pg8::StaticOrder, true, true>(lds, g, S, E);
        if (BOTH(4)) GRID_BAR();
    }
    if (IN(5)) {
        pg8::Gemm g{X1, Wpp_t, X1, Wpp_t, M, NSC, D}; pg8::StaticOrder S; S.init(M, NSC, G, bx, 1);
        EpiScore E{SSQ, SC};
        pg8::gemm_phase<EpiScore, pg8::StaticOrder, true, true>(lds, g, S, E);
        if (BOTH(5)) GRID_BAR();
    }
    if (IN(6)) {
        p6_topk(SC, IDX, EV, INV, lds, gw, NGW, wave, lane);
        if (BOTH(6)) GRID_BAR();
    }
    if (IN(7)) {
        p7_peer(X1, SSQ, IDX, EV, INV, U8, V8, SU, SV, g_final, args.out, gw, NGW, lane);
    }
#undef IN
#undef BOTH
#undef GRID_BAR
}

extern "C" void kernel_launch(void* const* d_in, const int* in_sizes, int n_in, void* d_out, int out_size, void* d_ws, size_t ws_size, hipStream_t stream) {
    static int grid = 0;
    if (grid == 0) {
        if (n_in != 15 || in_sizes[0] != M * D || out_size != M * D || ws_size < WS_END) { fprintf(stderr, "kernel_launch: unexpected shapes (n_in %d, in0 %d, out %d, ws %zu); nothing launched\n", n_in, n_in > 0 ? in_sizes[0] : -1, out_size, ws_size); grid = -1; return; }
        int dev = 0, cus = 0, per_cu = 0;
        if (hipGetDevice(&dev) != hipSuccess || hipDeviceGetAttribute(&cus, hipDeviceAttributeMultiprocessorCount, dev) != hipSuccess) { grid = -1; return; }
        if (hipFuncSetAttribute((const void*)fwd_kernel, hipFuncAttributeMaxDynamicSharedMemorySize, LDS_BYTES) != hipSuccess) { fprintf(stderr, "kernel_launch: hipFuncSetAttribute failed\n"); grid = -1; return; }
        if (hipOccupancyMaxActiveBlocksPerMultiprocessor(&per_cu, (const void*)fwd_kernel, NWAVES * 64, LDS_BYTES) != hipSuccess || per_cu < 1)
            fprintf(stderr, "kernel_launch: note: occupancy query reports %d workgroups per CU\n", per_cu);
        (void)hipGetLastError();
        grid = cus;
    }
    if (grid < 0) return;
    if (hipMemsetAsync((char*)d_ws + WS_CTL, 0, CTL_ZERO_BYTES, stream) != hipSuccess) { fprintf(stderr, "kernel_launch: hipMemsetAsync failed\n"); return; }
    Args a{};
    for (int i = 0; i < 15; ++i) a.in[i] = (const float*)d_in[i];
    a.out = (float*)d_out; a.ws = (unsigned char*)d_ws;
    for (int li = 0; li < N_LAUNCHES; ++li) {
        a.ph_lo = (N_LAUNCHES == PER_PHASE) ? li : 0; a.ph_hi = (N_LAUNCHES == PER_PHASE) ? li + 1 : PER_PHASE; a.li = li;
        hipLaunchKernelGGL(fwd_kernel, dim3(grid), dim3(NWAVES * 64), LDS_BYTES, stream, a);
        const hipError_t le = hipPeekAtLastError();
        if (le != hipSuccess) { fprintf(stderr, "kernel_launch: launch %d failed: %s\n", li, hipGetErrorName(le)); break; }
    }
}
```

```cpp
#include <hip/hip_runtime.h>
#include <cstdio>
#include <cstdint>

#ifndef PROBE_REPEAT
#define PROBE_REPEAT 0
#endif
#ifndef MK_N_LAUNCHES
#define MK_N_LAUNCHES 1
#endif

namespace pg8 {
#define PG8_LAS __attribute__((address_space(3)))
typedef unsigned short bf16_t;
typedef short bf16x8 __attribute__((ext_vector_type(8)));
typedef float f32x4 __attribute__((ext_vector_type(4)));
typedef unsigned u32x4 __attribute__((ext_vector_type(4)));
constexpr int BM = 256, BK = 64, HALF = 128, HTB = HALF * BK * 2  , STAGE_BYTES = 8 * HTB, NXCD = 8, WGM = 8;

__host__ __device__ __forceinline__ int lds_byte(int r, int c) { const int st = (r >> 4) * 2 + (c >> 5), rr = r & 15, cc = c & 31, ob = rr * 64 + cc * 2; return st * 1024 + (ob ^ (((ob >> 9) & 1) << 5)); }
__host__ __device__ __forceinline__ void stage_rc(int b, int& R, int& C) { const int st = b / 1024, sb = b % 1024, swz = sb ^ (((sb >> 9) & 1) << 5); R = (st >> 1) * 16 + swz / 64; C = (st & 1) * 32 + (swz % 64) / 2; }
__host__ __device__ __forceinline__ int perm32(int rho) { const int n = rho >> 4, i = rho & 15; return 8 * (i >> 2) + 4 * n + (i & 3); }

struct Unit { int pm, pn, seg; };
struct Gemm { const bf16_t* A; const bf16_t* Bt; const bf16_t* A2; const bf16_t* Bt2; int M, N, K; };

struct StaticOrder {
    int nM, nN, nwg, G, c, segs;
    __host__ __device__ void init(int M, int N, int G_, int c_, int segs_) { nM = M / BM; nN = N / BM; nwg = nM * nN; G = G_; c = c_; segs = segs_; }
    __host__ __device__ bool next(int i, Unit& u) const {
        const int ti = (segs == 2) ? (i >> 1) : i; u.seg = (segs == 2) ? (i & 1) : 0;
        const long L = (long)ti * G + c; if (L >= nwg) return false;
        int wgid = (int)L; { const int q = nwg / NXCD, r = nwg % NXCD, xcd = wgid % NXCD, off = wgid / NXCD; wgid = (xcd < r ? xcd * (q + 1) : r * (q + 1) + (xcd - r) * q) + off; }
        const int nig = WGM * nN, gid = wgid / nig, fm = gid * WGM, gsz = (nM - fm) < WGM ? (nM - fm) : WGM;
        u.pm = fm + ((wgid % nig) % gsz); u.pn = (wgid % nig) / gsz; return true;
    }
    __device__ __forceinline__ void a_ready(const Unit&) const {}
    __device__ __forceinline__ void done(const Unit&) const {}
};

__device__ __forceinline__ unsigned cvt_pk_bf16(float lo, float hi) { unsigned r; asm volatile("v_cvt_pk_bf16_f32 %0, %1, %2" : "=v"(r) : "v"(lo), "v"(hi)); return r; }

template <class Epi, class Sched, bool ALIGN_EPI = false, bool SP2 = false>
__device__ __forceinline__ void gemm_phase(PG8_LAS unsigned char* lds, const Gemm g, const Sched& S, const Epi& E) {
    const int tid = threadIdx.x, wid = __builtin_amdgcn_readfirstlane(tid >> 6), lane = tid & 63, wr = wid >> 2, wc = wid & 3, fr = lane & 15, fq = lane >> 4;
    const int K = g.K, nt = K / BK;
    unsigned voffA[2], voffB[2];
#pragma unroll
    for (int i = 0; i < 2; ++i) { int R, C; stage_rc(tid * 16 + i * 8192, R, C); const int Rb = Epi::PERM ? ((R & ~31) + perm32(R & 31)) : R;
        voffA[i] = (unsigned)(R * K + C) * 2u; voffB[i] = (unsigned)(Rb * K + C) * 2u; }
    const size_t kstep = (size_t)(BK * 2);
    const size_t hstep = (size_t)HALF * K * 2;
    const size_t tstep = 2 * hstep;
    const unsigned ldsw = (unsigned)wid * 1024u;
    const int aoff = lds_byte(wr * 64 + fr, fq * 8), boff = lds_byte(wc * 32 + fr, fq * 8);
#define PG8_SA(b, h) (((b) * 2 + (h)) * HTB)
#define PG8_SB(b, h) ((4 + (b) * 2 + (h)) * HTB)
#define PG8_STAGE(bufoff, gbase, voff) do { _Pragma("unroll") for (int _i = 0; _i < 2; ++_i) \
        __builtin_amdgcn_global_load_lds((const unsigned*)((const char*)(gbase) + (voff)[_i]), (PG8_LAS unsigned*)(lds + (bufoff) + ldsw + _i * 8192), 16, 0, 0); } while (0)
#define PG8_LDA(dst, b, h) do { _Pragma("unroll") for (int m = 0; m < 4; ++m) _Pragma("unroll") for (int k = 0; k < 2; ++k) dst[m][k] = *(const PG8_LAS bf16x8*)(lds + PG8_SA(b, h) + aoff + m * 2048 + k * 1024); } while (0)
#define PG8_LDB(dst, b, h) do { _Pragma("unroll") for (int n = 0; n < 2; ++n) _Pragma("unroll") for (int k = 0; k < 2; ++k) dst[n][k] = *(const PG8_LAS bf16x8*)(lds + PG8_SB(b, h) + boff + n * 2048 + k * 1024); } while (0)
#define PG8_MMA(ai, bj, At, Bt) do { __builtin_amdgcn_s_setprio(1); _Pragma("unroll") for (int m = 0; m < 4; ++m) _Pragma("unroll") for (int n = 0; n < 2; ++n) _Pragma("unroll") for (int k = 0; k < 2; ++k) \
        acc[ai][bj][m][n] = __builtin_amdgcn_mfma_f32_16x16x32_bf16(Bt[n][k], At[m][k], acc[ai][bj][m][n], 0, 0, 0); __builtin_amdgcn_s_setprio(0); } while (0)
#define PG8_WAIT_V(n) asm volatile("s_waitcnt vmcnt(" #n ")" ::: "memory")
#define PG8_WAIT_L(n) asm volatile("s_waitcnt lgkmcnt(" #n ")" ::: "memory")
#define PG8_BAR __builtin_amdgcn_s_barrier()
#define PG8_SCHED __builtin_amdgcn_sched_barrier(0)
    Unit cur, nxt; int ui = 0;
    if (!S.next(0, cur)) return;
    f32x4 acc[2][2][4][2];
#pragma unroll
    for (int a = 0; a < 2; ++a)
#pragma unroll
        for (int b = 0; b < 2; ++b)
#pragma unroll
            for (int m = 0; m < 4; ++m)
#pragma unroll
                for (int n = 0; n < 2; ++n) acc[a][b][m][n] = (f32x4){0.f, 0.f, 0.f, 0.f};
    bf16x8 At[4][2], B0[2][2], B1[2][2];
    const char* cA = (const char*)(cur.seg ? g.A2 : g.A) + (size_t)cur.pm * tstep; const char* cB = (const char*)(cur.seg ? g.Bt2 : g.Bt) + (size_t)cur.pn * tstep;
    S.a_ready(cur);
    if constexpr (SP2) {
        PG8_STAGE(PG8_SB(0, 0), cB, voffB); PG8_STAGE(PG8_SB(0, 1), cB + hstep, voffB); PG8_STAGE(PG8_SA(0, 0), cA, voffA); PG8_STAGE(PG8_SA(0, 1), cA + hstep, voffA);
        if (wr == 1) PG8_BAR;
        PG8_WAIT_V(2); PG8_BAR;
        PG8_STAGE(PG8_SB(1, 0), cB + kstep, voffB); PG8_STAGE(PG8_SA(1, 0), cA + kstep, voffA); PG8_STAGE(PG8_SB(1, 1), cB + hstep + kstep, voffB);
        PG8_WAIT_V(6); PG8_BAR;
    } else {
        PG8_STAGE(PG8_SB(0, 0), cB, voffB); PG8_STAGE(PG8_SA(0, 0), cA, voffA); PG8_STAGE(PG8_SB(0, 1), cB + hstep, voffB); PG8_STAGE(PG8_SA(0, 1), cA + hstep, voffA);
        if (wr == 1) PG8_BAR;
        PG8_WAIT_V(4); PG8_BAR;
        PG8_STAGE(PG8_SB(1, 0), cB + kstep, voffB); PG8_STAGE(PG8_SA(1, 0), cA + kstep, voffA); PG8_STAGE(PG8_SB(1, 1), cB + hstep + kstep, voffB);
        PG8_WAIT_V(6); PG8_BAR;
    }
    for (;;) {
        const bool has_next = S.next(ui + 1, nxt);
        const char* nA = has_next ? (const char*)(nxt.seg ? g.A2 : g.A) + (size_t)nxt.pm * tstep : cA; const char* nB = has_next ? (const char*)(nxt.seg ? g.Bt2 : g.Bt) + (size_t)nxt.pn * tstep : cB;
        for (int t = 0; t < nt; t += 2) {
            const bool last = (t == nt - 2);
            const char* a1 = cA + (size_t)(t + 1) * kstep;
            const char* a2 = last ? nA : cA + (size_t)(t + 2) * kstep; const char* b2 = last ? nB : cB + (size_t)(t + 2) * kstep;
            const char* a3 = a2 + kstep; const char* b3 = b2 + kstep;
            if (last && has_next) S.a_ready(nxt);
            if constexpr (SP2) {
            PG8_LDB(B0, 0, 0); PG8_LDB(B1, 0, 1); PG8_SCHED; PG8_LDA(At, 0, 0); PG8_STAGE(PG8_SA(1, 1), a1 + hstep, voffA);
            PG8_WAIT_V(8); PG8_WAIT_L(0); PG8_BAR; PG8_MMA(0, 0, At, B0); PG8_MMA(0, 1, At, B1); PG8_BAR; PG8_SCHED;
            PG8_LDA(At, 0, 1); PG8_STAGE(PG8_SB(0, 0), b2, voffB); PG8_STAGE(PG8_SB(0, 1), b2 + hstep, voffB); PG8_STAGE(PG8_SA(0, 0), a2, voffA);
            PG8_WAIT_V(8); PG8_WAIT_L(0); PG8_BAR; PG8_MMA(1, 0, At, B0); PG8_MMA(1, 1, At, B1); PG8_BAR; PG8_SCHED;
            PG8_LDB(B0, 1, 0); PG8_LDB(B1, 1, 1); PG8_SCHED; PG8_LDA(At, 1, 0); PG8_STAGE(PG8_SA(0, 1), a2 + hstep, voffA);
            PG8_WAIT_V(8); PG8_WAIT_L(0); PG8_BAR; PG8_MMA(0, 0, At, B0); PG8_MMA(0, 1, At, B1); PG8_BAR; PG8_SCHED;
            PG8_LDA(At, 1, 1); PG8_STAGE(PG8_SB(1, 0), b3, voffB); PG8_STAGE(PG8_SB(1, 1), b3 + hstep, voffB); PG8_STAGE(PG8_SA(1, 0), a3, voffA);
            PG8_WAIT_V(8); PG8_WAIT_L(0); PG8_BAR; PG8_MMA(1, 0, At, B0); PG8_MMA(1, 1, At, B1); PG8_BAR; PG8_SCHED;
            } else {
            PG8_LDB(B0, 0, 0); PG8_SCHED; PG8_LDA(At, 0, 0); PG8_STAGE(PG8_SA(1, 1), a1 + hstep, voffA);
            PG8_WAIT_L(8); PG8_BAR; PG8_WAIT_L(0); PG8_MMA(0, 0, At, B0); PG8_BAR; PG8_SCHED;
            PG8_LDB(B1, 0, 1); PG8_STAGE(PG8_SB(0, 0), b2, voffB);
            PG8_BAR; PG8_WAIT_L(0); PG8_MMA(0, 1, At, B1); PG8_BAR;
            PG8_LDA(At, 0, 1); PG8_STAGE(PG8_SA(0, 0), a2, voffA);
            PG8_BAR; PG8_WAIT_L(0); PG8_MMA(1, 0, At, B0); PG8_BAR; PG8_SCHED;
            PG8_STAGE(PG8_SB(0, 1), b2 + hstep, voffB);
            PG8_WAIT_V(6); PG8_BAR; PG8_MMA(1, 1, At, B1); PG8_BAR;
            PG8_LDB(B0, 1, 0); PG8_SCHED; PG8_LDA(At, 1, 0); PG8_STAGE(PG8_SA(0, 1), a2 + hstep, voffA);
            PG8_WAIT_L(8); PG8_BAR; PG8_WAIT_L(0); PG8_MMA(0, 0, At, B0); PG8_BAR; PG8_SCHED;
            PG8_LDB(B1, 1, 1); PG8_STAGE(PG8_SB(1, 0), b3, voffB);
            PG8_BAR; PG8_WAIT_L(0); PG8_MMA(0, 1, At, B1); PG8_BAR;
            PG8_LDA(At, 1, 1); PG8_STAGE(PG8_SA(1, 0), a3, voffA);
            PG8_BAR; PG8_WAIT_L(0); PG8_MMA(1, 0, At, B0); PG8_BAR; PG8_SCHED;
            PG8_STAGE(PG8_SB(1, 1), b3 + hstep, voffB);
            PG8_WAIT_V(6); PG8_BAR; PG8_MMA(1, 1, At, B1); PG8_BAR;
            }
        }
        if constexpr (ALIGN_EPI) { if (wr == 0) PG8_BAR; }
        const bool keep = E(acc, cur, wr, wc, fr, fq); S.done(cur);
        if (!has_next) break;
        if (!keep) {
#pragma unroll
        for (int a = 0; a < 2; ++a)
#pragma unroll
            for (int b = 0; b < 2; ++b)
#pragma unroll
                for (int m = 0; m < 4; ++m)
#pragma unroll
                    for (int n = 0; n < 2; ++n) acc[a][b][m][n] = (f32x4){0.f, 0.f, 0.f, 0.f};
        }
        cur = nxt; cA = nA; cB = nB; ++ui;
        if constexpr (ALIGN_EPI) { if (wr == 1) PG8_BAR; }
    }
    PG8_WAIT_V(0);
    if constexpr (!ALIGN_EPI) { if (wr == 0) PG8_BAR; }
    PG8_BAR;
#undef PG8_SA
#undef PG8_SB
#undef PG8_STAGE
#undef PG8_LDA
#undef PG8_LDB
#undef PG8_MMA
#undef PG8_WAIT_V
#undef PG8_WAIT_L
#undef PG8_BAR
#undef PG8_SCHED
}
}

constexpr int NWAVES = 8;
constexpr int M = 65536, D = 1024, SEQ = 4096, DIN = 4096, DP = 512, NSC = 2048, NE = 16384, NH = 8, TOPK = 16;
constexpr float RMS_EPS = 1e-6f;
constexpr int N_LAUNCHES = MK_N_LAUNCHES;
constexpr int PER_PHASE = 11;
constexpr int TPI = 32;

constexpr size_t MiB = 1u << 20;
constexpr size_t WS_CTL = 0, CTL_ZERO_BYTES = 1 * MiB;
constexpr size_t WS_WIN = 1 * MiB;
constexpr size_t WS_WC = 9 * MiB;
constexpr size_t WS_WBC = 10 * MiB;
constexpr size_t WS_WOUT = 11 * MiB;
constexpr size_t WS_WPP = 13 * MiB;
constexpr size_t WS_SU = 17 * MiB;
constexpr size_t WS_SV = 17 * MiB + 65536;
constexpr size_t WS_SSQ = 18 * MiB;
constexpr size_t WS_U8 = 22 * MiB;
constexpr size_t WS_V8 = 38 * MiB;
constexpr size_t WS_INV = 54 * MiB;
constexpr size_t WS_SSQ2 = 56 * MiB;
constexpr size_t WS_RSTD = 58 * MiB;
constexpr size_t WS_WT = 58 * MiB + 512 * 1024;
constexpr size_t WS_WV = 192 * MiB + 48 * MiB;
constexpr size_t WS_PART = 576 * MiB;
constexpr size_t WS_B = 64 * MiB;
constexpr size_t WS_C = 192 * MiB;
constexpr size_t WS_A = 320 * MiB;
constexpr size_t WS_END = 832 * MiB;
constexpr int CW_BAR = 4096;
constexpr int CW_QU = 16384, CW_QV = 16384 + 1024;

constexpr int RING_BYTES = 131072;
constexpr int LDSCTL_OFF = RING_BYTES, MISC_OFF = LDSCTL_OFF + 320;
constexpr int LDS_BYTES = 147456;

#define GAS __attribute__((address_space(1)))
#define LAS __attribute__((address_space(3)))
typedef unsigned short bf16;
typedef unsigned v4u __attribute__((ext_vector_type(4)));
typedef unsigned v2u __attribute__((ext_vector_type(2)));
typedef float f32x4 __attribute__((ext_vector_type(4)));
typedef GAS unsigned gu32;
#define RLX_AGENT __ATOMIC_RELAXED, __HIP_MEMORY_SCOPE_AGENT
#define LDS_WAIT() asm volatile("s_waitcnt lgkmcnt(0)" ::: "memory")
#define VM_WAIT() asm volatile("s_waitcnt vmcnt(0)" ::: "memory")
__device__ __forceinline__ unsigned f2bf(float f) { unsigned u = __builtin_bit_cast(unsigned, f); return (u + 0x7fffu + ((u >> 16) & 1u)) >> 16; }
__device__ __forceinline__ unsigned pk2(float lo, float hi) { return f2bf(lo) | (f2bf(hi) << 16); }
__device__ __forceinline__ float bflo(unsigned w) { return __builtin_bit_cast(float, w << 16); }
__device__ __forceinline__ float bfhi(unsigned w) { return __builtin_bit_cast(float, w & 0xffff0000u); }
__device__ __forceinline__ float wave_sum(float v) {
#pragma unroll
    for (int o = 1; o < 64; o <<= 1) v += __shfl_xor(v, o);
    return v;
}
__device__ __forceinline__ float wave_max(float v) {
#pragma unroll
    for (int o = 1; o < 64; o <<= 1) v = fmaxf(v, __shfl_xor(v, o));
    return v;
}

#define XB_TMO      128
#define XB_XCNT(j)  (256  + 64 * (j))
#define XB_XSUB(j)  (1280 + 64 * (j))
#define XB_XGEN(j)  (2304 + 64 * (j))
#define XB_TOP      3328
#define XB_TOPGEN   3392
#define XCD_BAR_WORDS 3456
#define XB_SPIN_CAP (1u << 18)
__device__ __forceinline__ unsigned xb_ld(unsigned* p)              { return __hip_atomic_load(p, __ATOMIC_RELAXED, __HIP_MEMORY_SCOPE_AGENT); }
__device__ __forceinline__ unsigned xb_add(unsigned* p, unsigned v) { return __hip_atomic_fetch_add(p, v, __ATOMIC_RELAXED, __HIP_MEMORY_SCOPE_AGENT); }
__device__ __forceinline__ unsigned xb_xcc_id() { return (unsigned)__builtin_amdgcn_s_getreg((3 << 11) | 20) & 0xFu; }
#define XB_SPIN(cond, bar) do { unsigned _sp = 0; while (cond) { __builtin_amdgcn_s_sleep(1); \
    if ((++_sp & 255u) == 0u) { if (xb_ld(&(bar)[XB_TMO])) break; if (_sp > XB_SPIN_CAP) { atomicAdd(&(bar)[XB_TMO], 1u); break; } } } } while (0)
struct XcdBarrier { unsigned* bar; unsigned x; volatile LAS unsigned* st; };
__device__ __forceinline__ XcdBarrier xcd_barrier_post(unsigned* bar, volatile LAS unsigned* st) {
    XcdBarrier b; b.bar = bar; b.x = xb_xcc_id(); b.st = st;
    if (threadIdx.x == 0) (void)xb_add(&bar[XB_XCNT(b.x)], 1u);
    return b;
}
__device__ __forceinline__ void xcd_barrier_complete(unsigned* bar, unsigned x, unsigned& nloc, unsigned& nx) {
    const unsigned G = gridDim.x * gridDim.y * gridDim.z;
    unsigned sum, cnt, mine, sp = 0u;
    for (;;) {
        sum = 0u; cnt = 0u; mine = 0u;
#pragma unroll
        for (unsigned j = 0; j < 16; ++j) { const unsigned c = xb_ld(&bar[XB_XCNT(j)]); sum += c; cnt += (c > 0u) ? 1u : 0u; mine = (j == x) ? c : mine; }
        if (sum == G) break;
        __builtin_amdgcn_s_sleep(1);
        if ((++sp & 255u) == 0u) { if (xb_ld(&bar[XB_TMO])) break; if (sp > XB_SPIN_CAP) { atomicAdd(&bar[XB_TMO], 1u); break; } }
    }
    nloc = mine > 0u ? mine : 1u; nx = cnt > 0u ? cnt : 1u;
}
__device__ __forceinline__ void xcd_barrier(const XcdBarrier& b) {
    asm volatile("s_waitcnt vmcnt(0)" ::: "memory");
    __syncthreads();
    if (threadIdx.x == 0) {
        unsigned* bar = b.bar;
        __builtin_amdgcn_s_waitcnt(0);
        unsigned nloc = b.st[0], nx = b.st[1];
        if (nloc == 0u) { xcd_barrier_complete(bar, b.x, nloc, nx); b.st[0] = nloc; b.st[1] = nx; }
        const unsigned old = xb_add(&bar[XB_XSUB(b.x)], 1u);
        const unsigned gen = old / nloc;
        if (old + 1u == (gen + 1u) * nloc) {
            __builtin_amdgcn_fence(__ATOMIC_RELEASE, "agent");
            asm volatile("s_waitcnt vmcnt(0)" ::: "memory");
            const unsigned og = xb_add(&bar[XB_TOP], 1u);
            const unsigned tg = og / nx;
            if (og + 1u == (tg + 1u) * nx) xb_add(&bar[XB_TOPGEN], 1u);
            else XB_SPIN(xb_ld(&bar[XB_TOPGEN]) == tg, bar);
            __builtin_amdgcn_fence(__ATOMIC_ACQUIRE, "agent");
            xb_add(&bar[XB_XGEN(b.x)], 1u);
            asm volatile("s_waitcnt vmcnt(0)" ::: "memory");
        } else {
            XB_SPIN(xb_ld(&bar[XB_XGEN(b.x)]) == gen, bar);
            __builtin_amdgcn_fence(__ATOMIC_ACQUIRE, "agent");
            asm volatile("s_waitcnt vmcnt(0)" ::: "memory");
        }
    }
    __syncthreads();
}

__device__ __forceinline__ void p0_transpose_item(const float* W, int K, int N, bf16* WT, LAS float* scr, int item, int lane) {
    const int nblk = N / 32, kb = item / nblk, nb = item % nblk, k0 = 64 * kb, n0 = 32 * nb;
#pragma unroll 8
    for (int i = 0; i < 32; ++i) { const int kk = 2 * i + (lane >> 5); scr[kk * 33 + (lane & 31)] = W[(size_t)(k0 + kk) * N + n0 + (lane & 31)]; }
    LDS_WAIT(); asm volatile("" ::: "memory");
    const int c = lane & 7;
#pragma unroll
    for (int j = 0; j < 4; ++j) { const int n = (lane >> 3) + 8 * j; const LAS float* s = scr + (8 * c) * 33 + n;
        v4u o; o.x = pk2(s[0 * 33], s[1 * 33]); o.y = pk2(s[2 * 33], s[3 * 33]); o.z = pk2(s[4 * 33], s[5 * 33]); o.w = pk2(s[6 * 33], s[7 * 33]);
        *(v4u*)(WT + (size_t)(n0 + n) * K + k0 + 8 * c) = o; }
    LDS_WAIT(); asm volatile("" ::: "memory");
}
__device__ __forceinline__ void p0_wc_item(const float* gwt, const float* scale, const float* wbp, bf16* WcT, int item, int lane) {
    const int nb = item & 15, cb = (item >> 4) & 7, g = item >> 7;
    const int n = nb * 64 + lane;
    float acc[16];
#pragma unroll
    for (int c = 0; c < 16; ++c) acc[c] = 0.f;
    for (int d = 0; d < 128; ++d) {
        const float b = wbp[(size_t)(g * 128 + d) * 1024 + n] * scale[g * 128 + d];
#pragma unroll
        for (int c = 0; c < 16; ++c) acc[c] += gwt[(size_t)((g * 128 + cb * 16 + c) * 128) + d] * b;
    }
    v4u o0, o1;
    o0.x = pk2(acc[0], acc[1]); o0.y = pk2(acc[2], acc[3]); o0.z = pk2(acc[4], acc[5]); o0.w = pk2(acc[6], acc[7]);
    o1.x = pk2(acc[8], acc[9]); o1.y = pk2(acc[10], acc[11]); o1.z = pk2(acc[12], acc[13]); o1.w = pk2(acc[14], acc[15]);
    bf16* dst = WcT + (size_t)n * 512 + g * 128 + cb * 16;
    *(v4u*)dst = o0; *(v4u*)(dst + 8) = o1;
}
__device__ __forceinline__ void p0_wpp_item(const float* wq, const float* keys, const float* gffn, bf16* WppT, int item, int lane) {
    const int kb = item & 3, db = (item >> 2) & 15, hp = item >> 6;
    const int d = db * 64 + lane;
    float acc[32];
#pragma unroll
    for (int k = 0; k < 32; ++k) acc[k] = 0.f;
    const float* arow = wq + (size_t)d * 2048 + hp * 128;
    const float* kbase = keys + (size_t)(hp * 128 + kb * 32) * 128;
    for (int c4 = 0; c4 < 32; ++c4) {
        const f32x4 a = *(const f32x4*)(arow + 4 * c4);
#pragma unroll
        for (int k = 0; k < 32; ++k) { const float* kr = kbase + k * 128 + 4 * c4; acc[k] += a.x * kr[0] + a.y * kr[1] + a.z * kr[2] + a.w * kr[3]; }
    }
    const float gs = gffn[d];
#pragma unroll
    for (int k = 0; k < 32; ++k) WppT[(size_t)(hp * 128 + kb * 32 + k) * 1024 + d] = (bf16)f2bf(acc[k] * gs);
}
__device__ __forceinline__ void p0_h_row(const float* xrow, const float* g, bf16* orow, int lane) {
    const f32x4* xr = (const f32x4*)xrow + lane; const f32x4* gr = (const f32x4*)g + lane;
    f32x4 v[4]; float s = 0.f;
#pragma unroll
    for (int j = 0; j < 4; ++j) { v[j] = xr[64 * j]; s += (v[j].x * v[j].x + v[j].y * v[j].y) + (v[j].z * v[j].z + v[j].w * v[j].w); }
    const float rstd = rsqrtf(wave_sum(s) * (1.f / D) + RMS_EPS);
    v2u* o8 = (v2u*)orow + lane;
#pragma unroll
    for (int j = 0; j < 4; ++j) { const f32x4 gg = gr[64 * j]; v2u o; o.x = pk2(v[j].x * rstd * gg.x, v[j].y * rstd * gg.y); o.y = pk2(v[j].z * rstd * gg.z, v[j].w * rstd * gg.w); o8[64 * j] = o; }
}
__device__ __forceinline__ void p0_quant_row(const float* src, const float* gmul, unsigned char* dst, float* scale_out, int e, int lane, bool uns) {
    const f32x4* p = (const f32x4*)(src + (size_t)e * 1024 + 16 * lane);
    f32x4 v[4];
#pragma unroll
    for (int j = 0; j < 4; ++j) v[j] = p[j];
    if (gmul) { const f32x4* gp = (const f32x4*)(gmul + 16 * lane);
#pragma unroll
        for (int j = 0; j < 4; ++j) v[j] = v[j] * gp[j]; }
    float mx = 0.f;
#pragma unroll
    for (int j = 0; j < 4; ++j) mx = fmaxf(mx, fmaxf(fmaxf(fabsf(v[j].x), fabsf(v[j].y)), fmaxf(fabsf(v[j].z), fabsf(v[j].w))));
    mx = wave_max(mx);
    const float sc = mx > 0.f ? mx * (1.f / 127.f) : 1.f, inv = 1.f / sc;
    const int bias = uns ? 128 : 0;
    v4u w;
#pragma unroll
    for (int j = 0; j < 4; ++j) {
        unsigned acc = 0;
#pragma unroll
        for (int c = 0; c < 4; ++c) { int q = (int)rintf(v[j][c] * inv); q = q > 127 ? 127 : (q < -127 ? -127 : q); acc |= ((unsigned)(q + bias) & 0xffu) << (8 * c); }
        w[j] = acc;
    }
    *(v4u*)(dst + ((size_t)(lane >> 3) * NE + e) * 128 + 16 * (lane & 7)) = w;
    if (lane == 0) scale_out[e] = sc;
}

typedef pg8::f32x4 (&AccRef)[2][2][4][2];
struct EpiZ {
    static constexpr bool PERM = true;
    bf16* O; int ldc;
    __device__ __forceinline__ bool operator()(AccRef acc, const pg8::Unit& u, int wr, int wc, int fr, int fq) const {
        const int row0 = u.pm * 256 + wr * 64 + fr, col0 = u.pn * 256 + wc * 32 + 8 * fq;
#pragma unroll
        for (int ai = 0; ai < 2; ++ai)
#pragma unroll
            for (int m = 0; m < 4; ++m) { bf16* rowp = O + (size_t)(row0 + ai * 128 + m * 16) * ldc + col0;
#pragma unroll
                for (int bj = 0; bj < 2; ++bj) { const pg8::f32x4 v0 = acc[ai][bj][m][0], v1 = acc[ai][bj][m][1]; v4u w;
                    w.x = pg8::cvt_pk_bf16(v0[0], v0[1]); w.y = pg8::cvt_pk_bf16(v0[2], v0[3]); w.z = pg8::cvt_pk_bf16(v1[0], v1[1]); w.w = pg8::cvt_pk_bf16(v1[2], v1[3]);
                    *(v4u*)(rowp + bj * 128) = w; } }
        return false;
    }
};
__device__ __forceinline__ float sigm_ratio(float ga, float gb) { return (1.f + __expf(-gb)) / (1.f + __expf(-ga)); }
struct EpiGate {
    static constexpr bool PERM = true;
    const bf16* Z; bf16* Mo;
    __device__ __forceinline__ bool operator()(AccRef acc, const pg8::Unit& u, int wr, int wc, int fr, int fq) const {
        const int row0 = u.pm * 256 + wr * 64 + fr, col0 = u.pn * 256 + wc * 32 + 8 * fq;
        if (u.seg == 0) {
#pragma unroll
            for (int ai = 0; ai < 2; ++ai)
#pragma unroll
                for (int m = 0; m < 4; ++m) { const bf16* zr = Z + (size_t)(row0 + ai * 128 + m * 16) * DIN + col0;
#pragma unroll
                    for (int bj = 0; bj < 2; ++bj) { const v4u a = *(const v4u*)(zr + 2048 + bj * 128), b = *(const v4u*)(zr + 3072 + bj * 128);
                        pg8::f32x4& v0 = acc[ai][bj][m][0]; pg8::f32x4& v1 = acc[ai][bj][m][1];
                        v0[0] *= sigm_ratio(bflo(a.x), bflo(b.x)); v0[1] *= sigm_ratio(bfhi(a.x), bfhi(b.x)); v0[2] *= sigm_ratio(bflo(a.y), bflo(b.y)); v0[3] *= sigm_ratio(bfhi(a.y), bfhi(b.y));
                        v1[0] *= sigm_ratio(bflo(a.z), bflo(b.z)); v1[1] *= sigm_ratio(bfhi(a.z), bfhi(b.z)); v1[2] *= sigm_ratio(bflo(a.w), bflo(b.w)); v1[3] *= sigm_ratio(bfhi(a.w), bfhi(b.w)); } }
            return true;
        }
#pragma unroll
        for (int ai = 0; ai < 2; ++ai)
#pragma unroll
            for (int m = 0; m < 4; ++m) { const size_t r = (size_t)(row0 + ai * 128 + m * 16); const bf16* zr = Z + r * DIN + col0; bf16* mo = Mo + r * D + col0;
#pragma unroll
                for (int bj = 0; bj < 2; ++bj) { const v4u b = *(const v4u*)(zr + 3072 + bj * 128);
                    const pg8::f32x4 v0 = acc[ai][bj][m][0], v1 = acc[ai][bj][m][1]; v4u w;
#define SG(x) (1.f / (1.f + __expf(-(x))))
                    w.x = pg8::cvt_pk_bf16(v0[0] * SG(bflo(b.x)), v0[1] * SG(bfhi(b.x))); w.y = pg8::cvt_pk_bf16(v0[2] * SG(bflo(b.y)), v0[3] * SG(bfhi(b.y)));
                    w.z = pg8::cvt_pk_bf16(v1[0] * SG(bflo(b.z)), v1[1] * SG(bfhi(b.z))); w.w = pg8::cvt_pk_bf16(v1[2] * SG(bflo(b.w)), v1[3] * SG(bfhi(b.w)));
#undef SG
                    *(v4u*)(mo + bj * 128) = w; } }
        return false;
    }
};
struct EpiRes {
    static constexpr bool PERM = true;
    const float* X; bf16* X1; float* SSQ;
    __device__ __forceinline__ bool operator()(AccRef acc, const pg8::Unit& u, int wr, int wc, int fr, int fq) const {
        const int row0 = u.pm * 256 + wr * 64 + fr, col0 = u.pn * 256 + wc * 32 + 8 * fq;
#pragma unroll
        for (int ai = 0; ai < 2; ++ai)
#pragma unroll
            for (int m = 0; m < 4; ++m) { const size_t r = (size_t)(row0 + ai * 128 + m * 16); const float* xr = X + r * D + col0; bf16* o = X1 + r * D + col0; float ss = 0.f;
#pragma unroll
                for (int bj = 0; bj < 2; ++bj) { const pg8::f32x4 x0 = *(const pg8::f32x4*)(xr + bj * 128), x1v = *(const pg8::f32x4*)(xr + bj * 128 + 4);
                    const pg8::f32x4 v0 = acc[ai][bj][m][0] + x0, v1 = acc[ai][bj][m][1] + x1v;
                    ss += (v0[0] * v0[0] + v0[1] * v0[1]) + (v0[2] * v0[2] + v0[3] * v0[3]) + (v1[0] * v1[0] + v1[1] * v1[1]) + (v1[2] * v1[2] + v1[3] * v1[3]);
                    v4u w; w.x = pg8::cvt_pk_bf16(v0[0], v0[1]); w.y = pg8::cvt_pk_bf16(v0[2], v0[3]); w.z = pg8::cvt_pk_bf16(v1[0], v1[1]); w.w = pg8::cvt_pk_bf16(v1[2], v1[3]);
                    *(v4u*)(o + bj * 128) = w; }
                ss += __shfl_xor(ss, 16); ss += __shfl_xor(ss, 32);
                if (fq == 0) SSQ[r * 16 + u.pn * 4 + wc] = ss; }
        return false;
    }
};
struct EpiScore {
    static constexpr bool PERM = true;
    const float* SSQ; _Float16* S; float* RSTD;
    __device__ __forceinline__ bool operator()(AccRef acc, const pg8::Unit& u, int wr, int wc, int fr, int fq) const {
        const int row0 = u.pm * 256 + wr * 64 + fr, col0 = u.pn * 256 + wc * 32 + 8 * fq;
#pragma unroll
        for (int ai = 0; ai < 2; ++ai)
#pragma unroll
            for (int m = 0; m < 4; ++m) { const size_t r = (size_t)(row0 + ai * 128 + m * 16);
                const pg8::f32x4* sp = (const pg8::f32x4*)(SSQ + r * 16); const pg8::f32x4 s0 = sp[0], s1 = sp[1], s2 = sp[2], s3 = sp[3];
                const float tot = ((s0[0] + s0[1]) + (s0[2] + s0[3])) + ((s1[0] + s1[1]) + (s1[2] + s1[3])) + ((s2[0] + s2[1]) + (s2[2] + s2[3])) + ((s3[0] + s3[1]) + (s3[2] + s3[3]));
                const float rstd = rsqrtf(tot * (1.f / D) + RMS_EPS);
                if (u.pn == 0 && wc == 0 && fq == 0) RSTD[r] = rstd;
                _Float16* o = S + r * NSC + col0;
#pragma unroll
                for (int bj = 0; bj < 2; ++bj) { const pg8::f32x4 v0 = acc[ai][bj][m][0] * rstd, v1 = acc[ai][bj][m][1] * rstd;
                    typedef _Float16 h2 __attribute__((ext_vector_type(2)));
                    h2 p0 = {(_Float16)v0[0], (_Float16)v0[1]}, p1 = {(_Float16)v0[2], (_Float16)v0[3]}, p2 = {(_Float16)v1[0], (_Float16)v1[1]}, p3 = {(_Float16)v1[2], (_Float16)v1[3]};
                    v4u w; w.x = __builtin_bit_cast(unsigned, p0); w.y = __builtin_bit_cast(unsigned, p1); w.z = __builtin_bit_cast(unsigned, p2); w.w = __builtin_bit_cast(unsigned, p3);
                    *(v4u*)(o + bj * 128) = w; } }
        return false;
    }
};

__device__ __forceinline__ void unpack8(const v4u w, float (&f)[8]) { f[0] = bflo(w.x); f[1] = bfhi(w.x); f[2] = bflo(w.y); f[3] = bfhi(w.y); f[4] = bflo(w.z); f[5] = bfhi(w.z); f[6] = bflo(w.w); f[7] = bfhi(w.w); }
__device__ __forceinline__ v4u pack8(const float (&f)[8]) { v4u w; w.x = pk2(f[0], f[1]); w.y = pk2(f[2], f[3]); w.z = pk2(f[4], f[5]); w.w = pk2(f[6], f[7]); return w; }
__device__ __forceinline__ void p2_timemix(const bf16* Z, const float* convw, bf16* PA, bf16* CA, int gw, int NGW, int lane) {
    const int w = 2 << (lane >> 4);
    const int ch = 8 * lane;
    float cw0[8], cw1[8], cw2[8];
#pragma unroll
    for (int i = 0; i < 8; ++i) { cw0[i] = convw[ch + i]; cw1[i] = convw[512 + ch + i]; cw2[i] = convw[1024 + ch + i]; }
    for (int chunk = gw; chunk < M / 32; chunk += NGW) {
        const int t0 = chunk * 32, s0 = t0 & (SEQ - 1);
        float sum[8], up1[8], up2[8];
#pragma unroll
        for (int i = 0; i < 8; ++i) { sum[i] = 0.f; up1[i] = 0.f; up2[i] = 0.f; }
        if (s0 > 0) {
            for (int j = 1; j < 16; ++j) {
                if (j < w) { float f[8]; unpack8(*(const v4u*)(Z + (size_t)(t0 - j) * DIN + ch), f);
#pragma unroll
                    for (int i = 0; i < 8; ++i) sum[i] += f[i]; }
            }
            float c[8], v[8];
            unpack8(*(const v4u*)(Z + (size_t)(t0 - 2) * DIN + 512 + ch), c); unpack8(*(const v4u*)(Z + (size_t)(t0 - 2) * DIN + 1536 + ch), v);
#pragma unroll
            for (int i = 0; i < 8; ++i) up2[i] = c[i] * v[i];
            unpack8(*(const v4u*)(Z + (size_t)(t0 - 1) * DIN + 512 + ch), c); unpack8(*(const v4u*)(Z + (size_t)(t0 - 1) * DIN + 1536 + ch), v);
#pragma unroll
            for (int i = 0; i < 8; ++i) up1[i] = c[i] * v[i];
        }
        for (int i2 = 0; i2 < 32; ++i2) {
            const int t = t0 + i2, s = s0 + i2;
            const bf16* zr = Z + (size_t)t * DIN;
            float zt[8], c[8], b[8], v[8], o[8];
            unpack8(*(const v4u*)(zr + ch), zt); unpack8(*(const v4u*)(zr + 512 + ch), c); unpack8(*(const v4u*)(zr + 1024 + ch), b); unpack8(*(const v4u*)(zr + 1536 + ch), v);
            const int cnt = (s + 1) < w ? (s + 1) : w; const float rc = 1.f / (float)cnt;
#pragma unroll
            for (int i = 0; i < 8; ++i) { sum[i] += zt[i]; o[i] = sum[i] * rc - zt[i]; }
            *(v4u*)(PA + (size_t)t * DP + ch) = pack8(o);
            if (s + 1 - w >= 0) { float f[8]; unpack8(*(const v4u*)(Z + (size_t)(t + 1 - w) * DIN + ch), f);
#pragma unroll
                for (int i = 0; i < 8; ++i) sum[i] -= f[i]; }
#pragma unroll
            for (int i = 0; i < 8; ++i) { const float uu = c[i] * v[i]; o[i] = b[i] * (cw0[i] * up2[i] + cw1[i] * up1[i] + cw2[i] * uu); up2[i] = up1[i]; up1[i] = uu; }
            *(v4u*)(CA + (size_t)t * DP + ch) = pack8(o);
        }
    }
}

__device__ __forceinline__ void p6_topk(const _Float16* S, unsigned short* IDX, float* EV, float* INV, LAS unsigned char* lds, int gw, int NGW, int wave, int lane) {
    LAS unsigned char* my = lds + wave * 9216;
    const float NEG = -3.0e38f;
    for (int grp = gw; grp < M * NH / 64; grp += NGW) {
        const char* base = (const char*)S + (size_t)grp * 64 * 512;
        float A[16], B[16];
#pragma unroll
        for (int half = 0; half < 2; ++half) {
            float L[16];
#pragma unroll
            for (int i = 0; i < 16; ++i) L[i] = NEG;
#pragma unroll 1
            for (int step = 0; step < 2; ++step) {
                const int j = half * 2 + step;
#pragma unroll
                for (int q = 0; q < 8; ++q) { const int row = 8 * q + (lane >> 3), chn = lane & 7;
                    const v4u dd = *(const v4u*)(base + (size_t)row * 512 + 128 * j + 16 * chn); *(LAS v4u*)(my + row * 144 + 16 * chn) = dd; }
                asm volatile("s_waitcnt lgkmcnt(0)" ::: "memory");
#pragma unroll 1
                for (int c = 0; c < 8; ++c) {
                    const v4u dd = *(const LAS v4u*)(my + lane * 144 + 16 * c);
                    const unsigned ww[4] = {dd.x, dd.y, dd.z, dd.w};
#pragma unroll
                    for (int e = 0; e < 8; ++e) {
                        const unsigned hb = (e & 1) ? (ww[e >> 1] >> 16) : (ww[e >> 1] & 0xffffu);
                        const float val = (float)__builtin_bit_cast(_Float16, (unsigned short)hb);
                        const int key = step * 64 + c * 8 + e;
                        float tv = __builtin_bit_cast(float, __builtin_bit_cast(unsigned, val) | (unsigned)(127 - key));
#pragma unroll
                        for (int i = 0; i < 16; ++i) { const float hi = fmaxf(L[i], tv); tv = fminf(L[i], tv); L[i] = hi; }
                    }
                }
                asm volatile("s_waitcnt lgkmcnt(0)" ::: "memory");
            }
#pragma unroll
            for (int i = 0; i < 16; ++i) { if (half == 0) A[i] = L[i]; else B[i] = L[i]; }
        }
        float FV[16]; int FI[16];
#pragma unroll
        for (int i = 0; i < 16; ++i) { FV[i] = NEG; FI[i] = 0; }
#pragma unroll
        for (int i = 0; i < 16; ++i) {
            const unsigned ab = __builtin_bit_cast(unsigned, A[i]); const float av = __builtin_bit_cast(float, ab & ~0x7fu); const int ak = 127 - (int)(ab & 0x7fu);
#pragma unroll
            for (int j = 0; j < 16; ++j) {
                if ((i + 1) * (j + 1) <= 16) {
                    const unsigned bb = __builtin_bit_cast(unsigned, B[j]); const float bv = __builtin_bit_cast(float, bb & ~0x7fu); const int bk = 127 - (int)(bb & 0x7fu);
                    float x = av + bv; int xi = ak * 128 + bk;
#pragma unroll
                    for (int s = (i + 1) * (j + 1) - 1; s < 16; ++s) { const bool c = x > FV[s]; const float nv = c ? x : FV[s], ox = c ? FV[s] : x; const int ni = c ? xi : FI[s], oi = c ? FI[s] : xi; FV[s] = nv; FI[s] = ni; x = ox; xi = oi; }
                }
            }
        }
        const size_t r = (size_t)grp * 64 + lane;
        float ev[16]; float sum = 0.f;
#pragma unroll
        for (int i = 0; i < 16; ++i) { ev[i] = __expf(FV[i] - FV[0]); sum += ev[i]; }
        v4u i0, i1;
        i0.x = (unsigned)FI[0] | ((unsigned)FI[1] << 16); i0.y = (unsigned)FI[2] | ((unsigned)FI[3] << 16); i0.z = (unsigned)FI[4] | ((unsigned)FI[5] << 16); i0.w = (unsigned)FI[6] | ((unsigned)FI[7] << 16);
        i1.x = (unsigned)FI[8] | ((unsigned)FI[9] << 16); i1.y = (unsigned)FI[10] | ((unsigned)FI[11] << 16); i1.z = (unsigned)FI[12] | ((unsigned)FI[13] << 16); i1.w = (unsigned)FI[14] | ((unsigned)FI[15] << 16);
        *(v4u*)(IDX + r * 16) = i0; *(v4u*)(IDX + r * 16 + 8) = i1;
#pragma unroll
        for (int q = 0; q < 4; ++q) *(f32x4*)(EV + r * 16 + 4 * q) = (f32x4){ev[4 * q], ev[4 * q + 1], ev[4 * q + 2], ev[4 * q + 3]};
        INV[r] = 1.f / sum;
    }
}

__device__ __forceinline__ float ubf(unsigned w, int b) { return (float)((w >> (8 * b)) & 0xffu); }
typedef float v2f __attribute__((ext_vector_type(2)));
__device__ __forceinline__ int q_pull(unsigned* heads, int s, int lane) { int it = 0; if (lane == 0) it = (int)__hip_atomic_fetch_add(heads + 64 * s, 1u, __ATOMIC_RELAXED, __HIP_MEMORY_SCOPE_AGENT); return __builtin_amdgcn_readfirstlane(it); }

struct UIdx { v4u ia, ib; };
struct UBuf { v4u ur[16]; v4u xa, xb; };
__device__ __forceinline__ void u_idx(UIdx& p, int t, const unsigned short* IDX, int lane) { const unsigned short* ip = IDX + (size_t)t * 128 + (lane >> 3) * 16; p.ia = *(const v4u*)ip; p.ib = *(const v4u*)(ip + 8); }
__device__ __forceinline__ void u_gather(UBuf& b, const UIdx& p, int s, int t, const bf16* X1, const unsigned char* U8, int lane) {
    const int c = lane & 7;
    const unsigned iw[8] = {p.ia.x, p.ia.y, p.ia.z, p.ia.w, p.ib.x, p.ib.y, p.ib.z, p.ib.w};
    const unsigned char* ub = U8 + (size_t)s * NE * 128 + 16 * c;
#pragma unroll
    for (int i = 0; i < 16; ++i) { const unsigned e = (i & 1) ? (iw[i >> 1] >> 16) : (iw[i >> 1] & 0xffffu); b.ur[i] = *(const v4u*)(ub + (size_t)e * 128); }
    const bf16* xp = X1 + (size_t)t * D + 128 * s + 16 * c;
    b.xa = *(const v4u*)xp; b.xb = *(const v4u*)(xp + 8);
}
__device__ __forceinline__ void u_compute(const UBuf& bf, int s, int t, float* PART, int lane) {
    float xv[16];
    { float f[8]; unpack8(bf.xa, f);
#pragma unroll
      for (int i = 0; i < 8; ++i) xv[i] = f[i];
      unpack8(bf.xb, f);
#pragma unroll
      for (int i = 0; i < 8; ++i) xv[8 + i] = f[i]; }
    float mx = 0.f;
#pragma unroll
    for (int i = 0; i < 16; ++i) mx = fmaxf(mx, fabsf(xv[i]));
    mx = fmaxf(mx, __shfl_xor(mx, 1)); mx = fmaxf(mx, __shfl_xor(mx, 2)); mx = fmaxf(mx, __shfl_xor(mx, 4));
    const float sx = mx > 0.f ? mx * (1.f / 127.f) : 1.f, isx = 1.f / sx;
    int xq[4];
#pragma unroll
    for (int j = 0; j < 4; ++j) { unsigned a = 0;
#pragma unroll
        for (int b = 0; b < 4; ++b) { int q = (int)rintf(xv[4 * j + b] * isx); q = q > 127 ? 127 : (q < -127 ? -127 : q); a |= ((unsigned)q & 0xffu) << (8 * b); }
        xq[j] = (int)a; }
    int p[16];
#pragma unroll
    for (int i = 0; i < 16; ++i) { int a = __builtin_amdgcn_sdot4((int)bf.ur[i].x, xq[0], 0, false); a = __builtin_amdgcn_sdot4((int)bf.ur[i].y, xq[1], a, false);
        a = __builtin_amdgcn_sdot4((int)bf.ur[i].z, xq[2], a, false); a = __builtin_amdgcn_sdot4((int)bf.ur[i].w, xq[3], a, false); p[i] = a; }
    int r8[8], r4[4], r2[2];
    const bool b2 = lane & 4, b1 = lane & 2, b0 = lane & 1;
#pragma unroll
    for (int i = 0; i < 8; ++i) { const int snd = b2 ? p[i] : p[i + 8], kp = b2 ? p[i + 8] : p[i]; r8[i] = kp + __shfl_xor(snd, 4); }
#pragma unroll
    for (int i = 0; i < 4; ++i) { const int snd = b1 ? r8[i] : r8[i + 4], kp = b1 ? r8[i + 4] : r8[i]; r4[i] = kp + __shfl_xor(snd, 2); }
#pragma unroll
    for (int i = 0; i < 2; ++i) { const int snd = b0 ? r4[i] : r4[i + 2], kp = b0 ? r4[i + 2] : r4[i]; r2[i] = kp + __shfl_xor(snd, 1); }
    *(v2f*)(PART + ((size_t)s * M + t) * 128 + 2 * lane) = (v2f){(float)r2[0] * sx, (float)r2[1] * sx};
}
__device__ __forceinline__ void p7_u_phase(unsigned* heads, unsigned xcc, const bf16* X1, const unsigned short* IDX, const unsigned char* U8, float* PART, int lane) {
    int s = (int)(xcc & 7u), tried = 0;
    for (;;) {
        const int item = q_pull(heads, s, lane);
        if (item >= M / TPI) { if (++tried == 8) break; s = (s + 1) & 7; continue; }
        const int t0 = item * TPI, tl = t0 + TPI - 1;
        UIdx ia, ib, in; UBuf ga, gb;
        u_idx(ia, t0, IDX, lane); u_idx(ib, t0 + 1, IDX, lane);
        u_gather(ga, ia, s, t0, X1, U8, lane);
#pragma unroll 1
        for (int i = 0; i < TPI; i += 2) {
            const int t = t0 + i, t2 = (t + 2) < tl ? (t + 2) : tl, t3 = (t + 3) < tl ? (t + 3) : tl;
            u_gather(gb, ib, s, t + 1, X1, U8, lane);
            u_idx(in, t2, IDX, lane);
            u_compute(ga, s, t, PART, lane);
            ia = in;
            u_gather(ga, ia, s, t2, X1, U8, lane);
            u_idx(in, t3, IDX, lane);
            u_compute(gb, s, t + 1, PART, lane);
            ib = in;
        }
    }
}
__device__ __forceinline__ void p8_w_phase(const float* PART, const float* RSTD, const unsigned short* IDX, const float* EV, const float* INV, const float* SU, const float* SV, float* WV, float* WT, int gw, int NGW, int lane) {
    for (int t = gw; t < M; t += NGW) {
        float a0 = 0.f, a1 = 0.f;
#pragma unroll
        for (int x = 0; x < 8; ++x) { const v2f pp = *(const v2f*)(PART + ((size_t)x * M + t) * 128 + 2 * lane); a0 += pp.x; a1 += pp.y; }
        const unsigned ip = *(const unsigned*)(IDX + (size_t)t * 128 + 2 * lane); const int e0 = (int)(ip & 0xffffu), e1 = (int)(ip >> 16);
        const v2f evp = *(const v2f*)(EV + (size_t)t * 128 + 2 * lane); const float iv = INV[(size_t)t * NH + (lane >> 3)];
        const float rstd = RSTD[t];
        const float act0 = a0 * SU[e0] * rstd, act1 = a1 * SU[e1] * rstd;
        const float w0 = evp.x * iv * (0.5f * act0 * (1.f + erff(act0 * 0.70710678118654752f))) * SV[e0];
        const float w1 = evp.y * iv * (0.5f * act1 * (1.f + erff(act1 * 0.70710678118654752f))) * SV[e1];
        *(v2f*)(WV + (size_t)t * 128 + 2 * lane) = (v2f){w0, w1};
        const float wtot = wave_sum(w0 + w1);
        if (lane == 0) WT[t] = wtot;
    }
}
struct VBuf { v4u vr[16]; v2f w2; unsigned xw; float wtot; };
__device__ __forceinline__ void v_gather(VBuf& b, const UIdx& p, int s, int t, const bf16* X1, const float* WV, const float* WT, const unsigned char* V8, int lane) {
    const int c = lane & 7, g = lane >> 3;
    const unsigned iw[8] = {p.ia.x, p.ia.y, p.ia.z, p.ia.w, p.ib.x, p.ib.y, p.ib.z, p.ib.w};
    const unsigned char* vb = V8 + (size_t)s * NE * 128 + 16 * c;
#pragma unroll
    for (int i = 0; i < 16; ++i) { const unsigned e = (i & 1) ? (iw[i >> 1] >> 16) : (iw[i >> 1] & 0xffffu); b.vr[i] = *(const v4u*)(vb + (size_t)e * 128); }
    b.w2 = *(const v2f*)(WV + (size_t)t * 128 + 2 * lane);
    b.xw = *(const unsigned*)(X1 + (size_t)t * D + 128 * s + 16 * c + 2 * g);
    b.wtot = WT[t];
}
__device__ __forceinline__ void v_compute(const VBuf& bf, int s, int t, float* out, float* SSQ2, int lane) {
    const int c = lane & 7, g = lane >> 3;
    float acc[16];
#pragma unroll
    for (int j = 0; j < 16; ++j) acc[j] = 0.f;
#pragma unroll
    for (int i = 0; i < 16; ++i) { const float wi = __shfl((i & 1) ? bf.w2.y : bf.w2.x, (lane & ~7) | (i >> 1));
#pragma unroll
        for (int j = 0; j < 4; ++j) { const unsigned w = bf.vr[i][j];
#pragma unroll
            for (int b = 0; b < 4; ++b) acc[4 * j + b] += wi * ubf(w, b); } }
    float r8[8], r4[4], r2[2];
    const bool b5 = lane & 32, b4 = lane & 16, b3 = lane & 8;
#pragma unroll
    for (int i = 0; i < 8; ++i) { const float snd = b5 ? acc[i] : acc[i + 8], kp = b5 ? acc[i + 8] : acc[i]; r8[i] = kp + __shfl_xor(snd, 32); }
#pragma unroll
    for (int i = 0; i < 4; ++i) { const float snd = b4 ? r8[i] : r8[i + 4], kp = b4 ? r8[i + 4] : r8[i]; r4[i] = kp + __shfl_xor(snd, 16); }
#pragma unroll
    for (int i = 0; i < 2; ++i) { const float snd = b3 ? r4[i] : r4[i + 2], kp = b3 ? r4[i + 2] : r4[i]; r2[i] = kp + __shfl_xor(snd, 8); }
    const size_t col = (size_t)t * D + 128 * s + 16 * c + 2 * g;
    const float y0 = bflo(bf.xw) + r2[0] - 128.f * bf.wtot, y1 = bfhi(bf.xw) + r2[1] - 128.f * bf.wtot;
    const float ss = wave_sum(y0 * y0 + y1 * y1);
    *(v2f*)(out + col) = (v2f){y0, y1};
    if (lane == 0) SSQ2[(size_t)t * 8 + s] = ss;
}
__device__ __forceinline__ void p9_v_phase(unsigned* heads, unsigned xcc, const bf16* X1, const unsigned short* IDX, const float* WV, const float* WT, const unsigned char* V8, float* out, float* SSQ2, int lane) {
    int s = (int)(xcc & 7u), tried = 0;
    for (;;) {
        const int item = q_pull(heads, s, lane);
        if (item >= M / TPI) { if (++tried == 8) break; s = (s + 1) & 7; continue; }
        const int t0 = item * TPI, tl = t0 + TPI - 1;
        UIdx ia, ib, in; VBuf ga, gb;
        u_idx(ia, t0, IDX, lane); u_idx(ib, t0 + 1, IDX, lane);
        v_gather(ga, ia, s, t0, X1, WV, WT, V8, lane);
#pragma unroll 1
        for (int i = 0; i < TPI; i += 2) {
            const int t = t0 + i, t2 = (t + 2) < tl ? (t + 2) : tl, t3 = (t + 3) < tl ? (t + 3) : tl;
            v_gather(gb, ib, s, t + 1, X1, WV, WT, V8, lane);
            u_idx(in, t2, IDX, lane);
            v_compute(ga, s, t, out, SSQ2, lane);
            ia = in;
            v_gather(ga, ia, s, t2, X1, WV, WT, V8, lane);
            u_idx(in, t3, IDX, lane);
            v_compute(gb, s, t + 1, out, SSQ2, lane);
            ib = in;
        }
    }
}
__device__ __forceinline__ void p10_final(float* out, const float* SSQ2, const float* gfin, int gw, int NGW, int lane) {
    f32x4 gf[4];
#pragma unroll
    for (int j = 0; j < 4; ++j) gf[j] = ((const f32x4*)gfin)[lane + 64 * j];
    for (int t = gw; t < M; t += NGW) {
        const float ssp = lane < 8 ? SSQ2[(size_t)t * 8 + lane] : 0.f;
        const float r2 = rsqrtf(wave_sum(ssp) * (1.f / D) + RMS_EPS);
        f32x4* o = (f32x4*)(out + (size_t)t * D) + lane;
#pragma unroll
        for (int j = 0; j < 4; ++j) { const f32x4 v = o[64 * j]; o[64 * j] = (f32x4){v.x * r2 * gf[j].x, v.y * r2 * gf[j].y, v.z * r2 * gf[j].z, v.w * r2 * gf[j].w}; }
    }
}

struct Args { const float* in[15]; float* out; unsigned char* ws; int ph_lo, ph_hi, li, pad; };
__global__ void __launch_bounds__(NWAVES * 64, 2) fwd_kernel(Args args) {
    extern __shared__ __attribute__((aligned(16))) unsigned char lds_raw[];
    LAS unsigned char* lds = (LAS unsigned char*)lds_raw;
    volatile LAS unsigned* MISC = (volatile LAS unsigned*)(lds + MISC_OFF);
    const int tid = threadIdx.x, lane = tid & 63, wave = __builtin_amdgcn_readfirstlane(tid >> 6);
    const int G = gridDim.x; const int bx = blockIdx.x; const int vcu = (G % 8 == 0) ? (bx % 8) * (G / 8) + bx / 8 : bx;
    const int gw = vcu * NWAVES + wave, NGW = G * NWAVES;
    unsigned char* ws = args.ws;
    gu32* ctl = (gu32*)(ws + WS_CTL);
    const float* x = args.in[0]; const float* g_mix = args.in[1]; const float* w_in = args.in[2]; const float* pool_gw = args.in[3]; const float* pool_scale = args.in[4];
    const float* conv_w = args.in[5]; const float* w_bp = args.in[6]; const float* w_bc = args.in[7]; const float* w_out = args.in[8]; const float* g_ffn = args.in[9];
    const float* w_q = args.in[10]; const float* sub_keys = args.in[11]; const float* expert_u = args.in[12]; const float* expert_v = args.in[13]; const float* g_final = args.in[14];
    bf16* Win_t = (bf16*)(ws + WS_WIN); bf16* Wc_t = (bf16*)(ws + WS_WC); bf16* Wbc_t = (bf16*)(ws + WS_WBC); bf16* Wout_t = (bf16*)(ws + WS_WOUT); bf16* Wpp_t = (bf16*)(ws + WS_WPP);
    float* SU = (float*)(ws + WS_SU); float* SV = (float*)(ws + WS_SV); float* SSQ = (float*)(ws + WS_SSQ);
    unsigned char* U8 = ws + WS_U8; unsigned char* V8 = ws + WS_V8; float* INV = (float*)(ws + WS_INV); float* SSQ2 = (float*)(ws + WS_SSQ2); float* PART = (float*)(ws + WS_PART); float* RSTD = (float*)(ws + WS_RSTD); float* WT = (float*)(ws + WS_WT); float* WV = (float*)(ws + WS_WV);
    bf16* Hb = (bf16*)(ws + WS_B); bf16* PA = (bf16*)(ws + WS_B); bf16* CA = (bf16*)(ws + WS_B + 64 * MiB); bf16* X1 = (bf16*)(ws + WS_B);
    bf16* Mb = (bf16*)(ws + WS_C); unsigned short* IDX = (unsigned short*)(ws + WS_C); float* EV = (float*)(ws + WS_C + 16 * MiB);
    bf16* Zb = (bf16*)(ws + WS_A); _Float16* SC = (_Float16*)(ws + WS_A);

    for (int u = tid; u < (LDS_BYTES - LDSCTL_OFF) / 4; u += NWAVES * 64) ((LAS unsigned*)(lds + LDSCTL_OFF))[u] = 0u;
    __syncthreads();
    XcdBarrier bar; bar.bar = (unsigned*)(ctl + CW_BAR); bar.x = 0; bar.st = nullptr;
    if (N_LAUNCHES != PER_PHASE) bar = xcd_barrier_post((unsigned*)(ctl + CW_BAR), MISC + 8);
#define GRID_BAR() do { if (N_LAUNCHES != PER_PHASE) xcd_barrier(bar); } while (0)
    const int lo = args.ph_lo, hi = args.ph_hi;
#define IN(k) (lo <= (k) && (k) < hi)
#define BOTH(k) (IN(k) && IN((k) + 1))

    if (IN(0)) for (int rep_ = 0; rep_ < ((PROBE_REPEAT >> 0) & 1) + 1; ++rep_) {
        LAS float* scr = (LAS float*)(lds + wave * 16384);
        constexpr int I_WPP = 1024, I_WIN = (1024 / 64) * (4096 / 32), I_WOUT = (1024 / 64) * (1024 / 32), I_WBC = (512 / 64) * (1024 / 32), I_WC = 512;
        constexpr int NITEMS = I_WPP + I_WIN + I_WOUT + I_WBC + I_WC;
        for (int it = gw; it < NITEMS; it += NGW) {
            int r = it;
            if (r < I_WPP) { p0_wpp_item(w_q, sub_keys, g_ffn, Wpp_t, r, lane); continue; } r -= I_WPP;
            if (r < I_WIN) { p0_transpose_item(w_in, 1024, 4096, Win_t, scr, r, lane); continue; } r -= I_WIN;
            if (r < I_WOUT) { p0_transpose_item(w_out, 1024, 1024, Wout_t, scr, r, lane); continue; } r -= I_WOUT;
            if (r < I_WBC) { p0_transpose_item(w_bc, 512, 1024, Wbc_t, scr, r, lane); continue; } r -= I_WBC;
            p0_wc_item(pool_gw, pool_scale, w_bp, Wc_t, r, lane);
        }
        for (int e = gw; e < 2 * NE; e += NGW) {
            if (e < NE) p0_quant_row(expert_u, g_ffn, U8, SU, e, lane, false);
            else p0_quant_row(expert_v, nullptr, V8, SV, e - NE, lane, true);
        }
        for (int m = gw; m < M; m += NGW) p0_h_row(x + (size_t)m * D, g_mix, Hb + (size_t)m * D, lane);
        if (BOTH(0)) GRID_BAR();
    }
    if (IN(1)) for (int rep_ = 0; rep_ < ((PROBE_REPEAT >> 1) & 1) + 1; ++rep_) {
        pg8::Gemm g{Hb, Win_t, Hb, Win_t, M, DIN, D}; pg8::StaticOrder S; S.init(M, DIN, G, bx, 1);
        EpiZ E{Zb, DIN};
        pg8::gemm_phase<EpiZ, pg8::StaticOrder, true, true>(lds, g, S, E);
        if (BOTH(1)) GRID_BAR();
    }
    if (IN(2)) for (int rep_ = 0; rep_ < ((PROBE_REPEAT >> 2) & 1) + 1; ++rep_) {
        p2_timemix(Zb, conv_w, PA, CA, gw, NGW, lane);
        if (BOTH(2)) GRID_BAR();
    }
    if (IN(3)) for (int rep_ = 0; rep_ < ((PROBE_REPEAT >> 3) & 1) + 1; ++rep_) {
        pg8::Gemm g{PA, Wc_t, CA, Wbc_t, M, D, DP}; pg8::StaticOrder S; S.init(M, D, G, bx, 2);
        EpiGate E{Zb, Mb};
        pg8::gemm_phase<EpiGate, pg8::StaticOrder, true, true>(lds, g, S, E);
        if (BOTH(3)) GRID_BAR();
    }
    if (IN(4)) for (int rep_ = 0; rep_ < ((PROBE_REPEAT >> 4) & 1) + 1; ++rep_) {
        pg8::Gemm g{Mb, Wout_t, Mb, Wout_t, M, D, D}; pg8::StaticOrder S; S.init(M, D, G, bx, 1);
        EpiRes E{x, X1, SSQ};
        pg8::gemm_phase<EpiRes, pg8::StaticOrder, true, true>(lds, g, S, E);
        if (BOTH(4)) GRID_BAR();
    }
    if (IN(5)) for (int rep_ = 0; rep_ < ((PROBE_REPEAT >> 5) & 1) + 1; ++rep_) {
        pg8::Gemm g{X1, Wpp_t, X1, Wpp_t, M, NSC, D}; pg8::StaticOrder S; S.init(M, NSC, G, bx, 1);
        EpiScore E{SSQ, SC, RSTD};
        pg8::gemm_phase<EpiScore, pg8::StaticOrder, true, true>(lds, g, S, E);
        if (BOTH(5)) GRID_BAR();
    }
    if (IN(6)) for (int rep_ = 0; rep_ < ((PROBE_REPEAT >> 6) & 1) + 1; ++rep_) {
        p6_topk(SC, IDX, EV, INV, lds, gw, NGW, wave, lane);
        if (BOTH(6)) GRID_BAR();
    }
    const unsigned xcc = xb_xcc_id();
    if (IN(7)) for (int rep_ = 0; rep_ < ((PROBE_REPEAT >> 7) & 1) + 1; ++rep_) {
        p7_u_phase((unsigned*)(ctl + CW_QU + 2048 * rep_), xcc, X1, IDX, U8, PART, lane);
        if (BOTH(7)) GRID_BAR();
    }
    if (IN(8)) for (int rep_ = 0; rep_ < ((PROBE_REPEAT >> 8) & 1) + 1; ++rep_) {
        p8_w_phase(PART, RSTD, IDX, EV, INV, SU, SV, WV, WT, gw, NGW, lane);
        if (BOTH(8)) GRID_BAR();
    }
    if (IN(9)) for (int rep_ = 0; rep_ < ((PROBE_REPEAT >> 9) & 1) + 1; ++rep_) {
        p9_v_phase((unsigned*)(ctl + CW_QV + 2048 * rep_), xcc, X1, IDX, WV, WT, V8, args.out, SSQ2, lane);
        if (BOTH(9)) GRID_BAR();
    }
    if (IN(10)) {
        p10_final(args.out, SSQ2, g_final, gw, NGW, lane);
    }
#undef IN
#undef BOTH
#undef GRID_BAR
}

extern "C" void kernel_launch(void* const* d_in, const int* in_sizes, int n_in, void* d_out, int out_size, void* d_ws, size_t ws_size, hipStream_t stream) {
    static int grid = 0;
    if (grid == 0) {
        if (n_in != 15 || in_sizes[0] != M * D || out_size != M * D || ws_size < WS_END) { fprintf(stderr, "kernel_launch: unexpected shapes (n_in %d, in0 %d, out %d, ws %zu); nothing launched\n", n_in, n_in > 0 ? in_sizes[0] : -1, out_size, ws_size); grid = -1; return; }
        int dev = 0, cus = 0, per_cu = 0;
        if (hipGetDevice(&dev) != hipSuccess || hipDeviceGetAttribute(&cus, hipDeviceAttributeMultiprocessorCount, dev) != hipSuccess) { grid = -1; return; }
        if (hipFuncSetAttribute((const void*)fwd_kernel, hipFuncAttributeMaxDynamicSharedMemorySize, LDS_BYTES) != hipSuccess) { fprintf(stderr, "kernel_launch: hipFuncSetAttribute failed\n"); grid = -1; return; }
        if (hipOccupancyMaxActiveBlocksPerMultiprocessor(&per_cu, (const void*)fwd_kernel, NWAVES * 64, LDS_BYTES) != hipSuccess || per_cu < 1)
            fprintf(stderr, "kernel_launch: note: occupancy query reports %d workgroups per CU\n", per_cu);
        (void)hipGetLastError();
        grid = cus;
    }
    if (grid < 0) return;
    if (hipMemsetAsync((char*)d_ws + WS_CTL, 0, CTL_ZERO_BYTES, stream) != hipSuccess) { fprintf(stderr, "kernel_launch: hipMemsetAsync failed\n"); return; }
    Args a{};
    for (int i = 0; i < 15; ++i) a.in[i] = (const float*)d_in[i];
    a.out = (float*)d_out; a.ws = (unsigned char*)d_ws;
    for (int li = 0; li < N_LAUNCHES; ++li) {
        a.ph_lo = (N_LAUNCHES == PER_PHASE) ? li : 0; a.ph_hi = (N_LAUNCHES == PER_PHASE) ? li + 1 : PER_PHASE; a.li = li;
        hipLaunchKernelGGL(fwd_kernel, dim3(grid), dim3(NWAVES * 64), LDS_BYTES, stream, a);
        const hipError_t le = hipPeekAtLastError();
        if (le != hipSuccess) { fprintf(stderr, "kernel_launch: launch %d failed: %s\n", li, hipGetErrorName(le)); break; }
    }
}
```

```cpp
#include <hip/hip_runtime.h>
#include <cstdio>
#include <cstdint>

#ifndef PROBE_REPEAT
#define PROBE_REPEAT 0
#endif
#ifndef MK_N_LAUNCHES
#define MK_N_LAUNCHES 1
#endif

namespace pg8 {
#define PG8_LAS __attribute__((address_space(3)))
typedef unsigned short bf16_t;
typedef short bf16x8 __attribute__((ext_vector_type(8)));
typedef float f32x4 __attribute__((ext_vector_type(4)));
typedef unsigned u32x4 __attribute__((ext_vector_type(4)));
constexpr int BM = 256, BK = 64, HALF = 128, HTB = HALF * BK * 2  , STAGE_BYTES = 8 * HTB, NXCD = 8, WGM = 8;

__host__ __device__ __forceinline__ int lds_byte(int r, int c) { const int st = (r >> 4) * 2 + (c >> 5), rr = r & 15, cc = c & 31, ob = rr * 64 + cc * 2; return st * 1024 + (ob ^ (((ob >> 9) & 1) << 5)); }
__host__ __device__ __forceinline__ void stage_rc(int b, int& R, int& C) { const int st = b / 1024, sb = b % 1024, swz = sb ^ (((sb >> 9) & 1) << 5); R = (st >> 1) * 16 + swz / 64; C = (st & 1) * 32 + (swz % 64) / 2; }
__host__ __device__ __forceinline__ int perm32(int rho) { const int n = rho >> 4, i = rho & 15; return 8 * (i >> 2) + 4 * n + (i & 3); }

struct Unit { int pm, pn, seg; };
struct Gemm { const bf16_t* A; const bf16_t* Bt; const bf16_t* A2; const bf16_t* Bt2; int M, N, K; };

struct StaticOrder {
    int nM, nN, nwg, G, c, segs;
    __host__ __device__ void init(int M, int N, int G_, int c_, int segs_) { nM = M / BM; nN = N / BM; nwg = nM * nN; G = G_; c = c_; segs = segs_; }
    __host__ __device__ bool next(int i, Unit& u) const {
        const int ti = (segs == 2) ? (i >> 1) : i; u.seg = (segs == 2) ? (i & 1) : 0;
        const long L = (long)ti * G + c; if (L >= nwg) return false;
        int wgid = (int)L; { const int q = nwg / NXCD, r = nwg % NXCD, xcd = wgid % NXCD, off = wgid / NXCD; wgid = (xcd < r ? xcd * (q + 1) : r * (q + 1) + (xcd - r) * q) + off; }
        const int nig = WGM * nN, gid = wgid / nig, fm = gid * WGM, gsz = (nM - fm) < WGM ? (nM - fm) : WGM;
        u.pm = fm + ((wgid % nig) % gsz); u.pn = (wgid % nig) / gsz; return true;
    }
    __device__ __forceinline__ void a_ready(const Unit&) const {}
    __device__ __forceinline__ void done(const Unit&) const {}
};

__device__ __forceinline__ unsigned cvt_pk_bf16(float lo, float hi) { unsigned r; asm volatile("v_cvt_pk_bf16_f32 %0, %1, %2" : "=v"(r) : "v"(lo), "v"(hi)); return r; }

typedef int i32x4 __attribute__((ext_vector_type(4)));
template <class Epi, class Sched, bool ALIGN_EPI = false, bool SP2 = false, bool I8 = false>
__device__ __forceinline__ void gemm_phase(PG8_LAS unsigned char* lds, const Gemm g, const Sched& S, const Epi& E) {
    const int tid = threadIdx.x, wid = __builtin_amdgcn_readfirstlane(tid >> 6), lane = tid & 63, wr = wid >> 2, wc = wid & 3, fr = lane & 15, fq = lane >> 4;
    const int K = g.K, nt = K / BK;
    unsigned voffA[2], voffB[2];
#pragma unroll
    for (int i = 0; i < 2; ++i) { int R, C; stage_rc(tid * 16 + i * 8192, R, C); const int Rb = Epi::PERM ? ((R & ~31) + perm32(R & 31)) : R;
        voffA[i] = (unsigned)(R * K + C) * 2u; voffB[i] = (unsigned)(Rb * K + C) * 2u; }
    const size_t kstep = (size_t)(BK * 2);
    const size_t hstep = (size_t)HALF * K * 2;
    const size_t tstep = 2 * hstep;
    const unsigned ldsw = (unsigned)wid * 1024u;
    const int aoff = lds_byte(wr * 64 + fr, fq * 8), boff = lds_byte(wc * 32 + fr, fq * 8);
#define PG8_SA(b, h) (((b) * 2 + (h)) * HTB)
#define PG8_SB(b, h) ((4 + (b) * 2 + (h)) * HTB)
#define PG8_STAGE(bufoff, gbase, voff) do { _Pragma("unroll") for (int _i = 0; _i < 2; ++_i) \
        __builtin_amdgcn_global_load_lds((const unsigned*)((const char*)(gbase) + (voff)[_i]), (PG8_LAS unsigned*)(lds + (bufoff) + ldsw + _i * 8192), 16, 0, 0); } while (0)
#define PG8_LDA(dst, b, h) do { _Pragma("unroll") for (int m = 0; m < 4; ++m) _Pragma("unroll") for (int k = 0; k < 2; ++k) dst[m][k] = *(const PG8_LAS bf16x8*)(lds + PG8_SA(b, h) + aoff + m * 2048 + k * 1024); } while (0)
#define PG8_LDB(dst, b, h) do { _Pragma("unroll") for (int n = 0; n < 2; ++n) _Pragma("unroll") for (int k = 0; k < 2; ++k) dst[n][k] = *(const PG8_LAS bf16x8*)(lds + PG8_SB(b, h) + boff + n * 2048 + k * 1024); } while (0)
#define PG8_MMA(ai, bj, At, Bt) do { __builtin_amdgcn_s_setprio(1); _Pragma("unroll") for (int m = 0; m < 4; ++m) _Pragma("unroll") for (int n = 0; n < 2; ++n) _Pragma("unroll") for (int k = 0; k < 2; ++k) { \
        if constexpr (I8) acc[ai][bj][m][n] = __builtin_bit_cast(f32x4, __builtin_amdgcn_mfma_i32_16x16x64_i8(__builtin_bit_cast(i32x4, Bt[n][k]), __builtin_bit_cast(i32x4, At[m][k]), __builtin_bit_cast(i32x4, acc[ai][bj][m][n]), 0, 0, 0)); \
        else acc[ai][bj][m][n] = __builtin_amdgcn_mfma_f32_16x16x32_bf16(Bt[n][k], At[m][k], acc[ai][bj][m][n], 0, 0, 0); } __builtin_amdgcn_s_setprio(0); } while (0)
#define PG8_WAIT_V(n) asm volatile("s_waitcnt vmcnt(" #n ")" ::: "memory")
#define PG8_WAIT_L(n) asm volatile("s_waitcnt lgkmcnt(" #n ")" ::: "memory")
#define PG8_BAR __builtin_amdgcn_s_barrier()
#define PG8_SCHED __builtin_amdgcn_sched_barrier(0)
    Unit cur, nxt; int ui = 0;
    if (!S.next(0, cur)) return;
    f32x4 acc[2][2][4][2];
#pragma unroll
    for (int a = 0; a < 2; ++a)
#pragma unroll
        for (int b = 0; b < 2; ++b)
#pragma unroll
            for (int m = 0; m < 4; ++m)
#pragma unroll
                for (int n = 0; n < 2; ++n) acc[a][b][m][n] = (f32x4){0.f, 0.f, 0.f, 0.f};
    bf16x8 At[4][2], B0[2][2], B1[2][2];
    const char* cA = (const char*)(cur.seg ? g.A2 : g.A) + (size_t)cur.pm * tstep; const char* cB = (const char*)(cur.seg ? g.Bt2 : g.Bt) + (size_t)cur.pn * tstep;
    S.a_ready(cur);
    if constexpr (SP2) {
        PG8_STAGE(PG8_SB(0, 0), cB, voffB); PG8_STAGE(PG8_SB(0, 1), cB + hstep, voffB); PG8_STAGE(PG8_SA(0, 0), cA, voffA); PG8_STAGE(PG8_SA(0, 1), cA + hstep, voffA);
        if (wr == 1) PG8_BAR;
        PG8_WAIT_V(2); PG8_BAR;
        PG8_STAGE(PG8_SB(1, 0), cB + kstep, voffB); PG8_STAGE(PG8_SA(1, 0), cA + kstep, voffA); PG8_STAGE(PG8_SB(1, 1), cB + hstep + kstep, voffB);
        PG8_WAIT_V(6); PG8_BAR;
    } else {
        PG8_STAGE(PG8_SB(0, 0), cB, voffB); PG8_STAGE(PG8_SA(0, 0), cA, voffA); PG8_STAGE(PG8_SB(0, 1), cB + hstep, voffB); PG8_STAGE(PG8_SA(0, 1), cA + hstep, voffA);
        if (wr == 1) PG8_BAR;
        PG8_WAIT_V(4); PG8_BAR;
        PG8_STAGE(PG8_SB(1, 0), cB + kstep, voffB); PG8_STAGE(PG8_SA(1, 0), cA + kstep, voffA); PG8_STAGE(PG8_SB(1, 1), cB + hstep + kstep, voffB);
        PG8_WAIT_V(6); PG8_BAR;
    }
    for (;;) {
        const bool has_next = S.next(ui + 1, nxt);
        const char* nA = has_next ? (const char*)(nxt.seg ? g.A2 : g.A) + (size_t)nxt.pm * tstep : cA; const char* nB = has_next ? (const char*)(nxt.seg ? g.Bt2 : g.Bt) + (size_t)nxt.pn * tstep : cB;
        for (int t = 0; t < nt; t += 2) {
            const bool last = (t == nt - 2);
            const char* a1 = cA + (size_t)(t + 1) * kstep;
            const char* a2 = last ? nA : cA + (size_t)(t + 2) * kstep; const char* b2 = last ? nB : cB + (size_t)(t + 2) * kstep;
            const char* a3 = a2 + kstep; const char* b3 = b2 + kstep;
            if (last && has_next) S.a_ready(nxt);
            if constexpr (SP2) {
            PG8_LDB(B0, 0, 0); PG8_LDB(B1, 0, 1); PG8_SCHED; PG8_LDA(At, 0, 0); PG8_STAGE(PG8_SA(1, 1), a1 + hstep, voffA);
            PG8_WAIT_V(8); PG8_WAIT_L(0); PG8_BAR; PG8_MMA(0, 0, At, B0); PG8_MMA(0, 1, At, B1); PG8_BAR; PG8_SCHED;
            PG8_LDA(At, 0, 1); PG8_STAGE(PG8_SB(0, 0), b2, voffB); PG8_STAGE(PG8_SB(0, 1), b2 + hstep, voffB); PG8_STAGE(PG8_SA(0, 0), a2, voffA);
            PG8_WAIT_V(8); PG8_WAIT_L(0); PG8_BAR; PG8_MMA(1, 0, At, B0); PG8_MMA(1, 1, At, B1); PG8_BAR; PG8_SCHED;
            PG8_LDB(B0, 1, 0); PG8_LDB(B1, 1, 1); PG8_SCHED; PG8_LDA(At, 1, 0); PG8_STAGE(PG8_SA(0, 1), a2 + hstep, voffA);
            PG8_WAIT_V(8); PG8_WAIT_L(0); PG8_BAR; PG8_MMA(0, 0, At, B0); PG8_MMA(0, 1, At, B1); PG8_BAR; PG8_SCHED;
            PG8_LDA(At, 1, 1); PG8_STAGE(PG8_SB(1, 0), b3, voffB); PG8_STAGE(PG8_SB(1, 1), b3 + hstep, voffB); PG8_STAGE(PG8_SA(1, 0), a3, voffA);
            PG8_WAIT_V(8); PG8_WAIT_L(0); PG8_BAR; PG8_MMA(1, 0, At, B0); PG8_MMA(1, 1, At, B1); PG8_BAR; PG8_SCHED;
            } else {
            PG8_LDB(B0, 0, 0); PG8_SCHED; PG8_LDA(At, 0, 0); PG8_STAGE(PG8_SA(1, 1), a1 + hstep, voffA);
            PG8_WAIT_L(8); PG8_BAR; PG8_WAIT_L(0); PG8_MMA(0, 0, At, B0); PG8_BAR; PG8_SCHED;
            PG8_LDB(B1, 0, 1); PG8_STAGE(PG8_SB(0, 0), b2, voffB);
            PG8_BAR; PG8_WAIT_L(0); PG8_MMA(0, 1, At, B1); PG8_BAR;
            PG8_LDA(At, 0, 1); PG8_STAGE(PG8_SA(0, 0), a2, voffA);
            PG8_BAR; PG8_WAIT_L(0); PG8_MMA(1, 0, At, B0); PG8_BAR; PG8_SCHED;
            PG8_STAGE(PG8_SB(0, 1), b2 + hstep, voffB);
            PG8_WAIT_V(6); PG8_BAR; PG8_MMA(1, 1, At, B1); PG8_BAR;
            PG8_LDB(B0, 1, 0); PG8_SCHED; PG8_LDA(At, 1, 0); PG8_STAGE(PG8_SA(0, 1), a2 + hstep, voffA);
            PG8_WAIT_L(8); PG8_BAR; PG8_WAIT_L(0); PG8_MMA(0, 0, At, B0); PG8_BAR; PG8_SCHED;
            PG8_LDB(B1, 1, 1); PG8_STAGE(PG8_SB(1, 0), b3, voffB);
            PG8_BAR; PG8_WAIT_L(0); PG8_MMA(0, 1, At, B1); PG8_BAR;
            PG8_LDA(At, 1, 1); PG8_STAGE(PG8_SA(1, 0), a3, voffA);
            PG8_BAR; PG8_WAIT_L(0); PG8_MMA(1, 0, At, B0); PG8_BAR; PG8_SCHED;
            PG8_STAGE(PG8_SB(1, 1), b3 + hstep, voffB);
            PG8_WAIT_V(6); PG8_BAR; PG8_MMA(1, 1, At, B1); PG8_BAR;
            }
        }
        if constexpr (ALIGN_EPI) { if (wr == 0) PG8_BAR; }
        const bool keep = E(acc, cur, wr, wc, fr, fq); S.done(cur);
        if (!has_next) break;
        if (!keep) {
#pragma unroll
        for (int a = 0; a < 2; ++a)
#pragma unroll
            for (int b = 0; b < 2; ++b)
#pragma unroll
                for (int m = 0; m < 4; ++m)
#pragma unroll
                    for (int n = 0; n < 2; ++n) acc[a][b][m][n] = (f32x4){0.f, 0.f, 0.f, 0.f};
        }
        cur = nxt; cA = nA; cB = nB; ++ui;
        if constexpr (ALIGN_EPI) { if (wr == 1) PG8_BAR; }
    }
    PG8_WAIT_V(0);
    if constexpr (!ALIGN_EPI) { if (wr == 0) PG8_BAR; }
    PG8_BAR;
#undef PG8_SA
#undef PG8_SB
#undef PG8_STAGE
#undef PG8_LDA
#undef PG8_LDB
#undef PG8_MMA
#undef PG8_WAIT_V
#undef PG8_WAIT_L
#undef PG8_BAR
#undef PG8_SCHED
}
}

constexpr int NWAVES = 8;
constexpr int M = 65536, D = 1024, SEQ = 4096, DIN = 4096, DP = 512, NSC = 2048, NE = 16384, NH = 8, TOPK = 16;
constexpr float RMS_EPS = 1e-6f;
constexpr int N_LAUNCHES = MK_N_LAUNCHES;
constexpr int PER_PHASE = 11;
constexpr int TPI = 32;

constexpr size_t MiB = 1u << 20;
constexpr size_t WS_CTL = 0, CTL_ZERO_BYTES = 1 * MiB;
constexpr size_t WS_WIN = 1 * MiB;
constexpr size_t WS_WC = 9 * MiB;
constexpr size_t WS_WBC = 10 * MiB;
constexpr size_t WS_WOUT = 11 * MiB;
constexpr size_t WS_WPP = 13 * MiB;
constexpr size_t WS_SU = 17 * MiB;
constexpr size_t WS_SV = 17 * MiB + 65536;
constexpr size_t WS_SSQ = 18 * MiB;
constexpr size_t WS_U8 = 22 * MiB;
constexpr size_t WS_V8 = 38 * MiB;
constexpr size_t WS_INV = 54 * MiB;
constexpr size_t WS_SSQ2 = 56 * MiB;
constexpr size_t WS_RSTD = 58 * MiB;
constexpr size_t WS_WT = 58 * MiB + 512 * 1024;
constexpr size_t WS_SA = 59 * MiB;
constexpr size_t WS_SB = 59 * MiB + 512 * 1024;
constexpr int CW_CMAX = 32768;
constexpr size_t WS_WV = 192 * MiB + 48 * MiB;
constexpr size_t WS_PART = 576 * MiB;
constexpr size_t WS_B = 64 * MiB;
constexpr size_t WS_C = 192 * MiB;
constexpr size_t WS_A = 320 * MiB;
constexpr size_t WS_END = 832 * MiB;
constexpr int CW_BAR = 4096;
constexpr int CW_QU = 16384, CW_QV = 16384 + 1024;

constexpr int RING_BYTES = 131072;
constexpr int LDSCTL_OFF = RING_BYTES, MISC_OFF = LDSCTL_OFF + 320;
constexpr int LDS_BYTES = 147456;

#define GAS __attribute__((address_space(1)))
#define LAS __attribute__((address_space(3)))
typedef unsigned short bf16;
typedef unsigned v4u __attribute__((ext_vector_type(4)));
typedef unsigned v2u __attribute__((ext_vector_type(2)));
typedef float f32x4 __attribute__((ext_vector_type(4)));
typedef GAS unsigned gu32;
#define RLX_AGENT __ATOMIC_RELAXED, __HIP_MEMORY_SCOPE_AGENT
#define LDS_WAIT() asm volatile("s_waitcnt lgkmcnt(0)" ::: "memory")
#define VM_WAIT() asm volatile("s_waitcnt vmcnt(0)" ::: "memory")
__device__ __forceinline__ unsigned f2bf(float f) { unsigned u = __builtin_bit_cast(unsigned, f); return (u + 0x7fffu + ((u >> 16) & 1u)) >> 16; }
__device__ __forceinline__ unsigned pk2(float lo, float hi) { return f2bf(lo) | (f2bf(hi) << 16); }
__device__ __forceinline__ float bflo(unsigned w) { return __builtin_bit_cast(float, w << 16); }
__device__ __forceinline__ float bfhi(unsigned w) { return __builtin_bit_cast(float, w & 0xffff0000u); }
__device__ __forceinline__ float wave_sum(float v) {
#pragma unroll
    for (int o = 1; o < 64; o <<= 1) v += __shfl_xor(v, o);
    return v;
}
__device__ __forceinline__ float wave_max(float v) {
#pragma unroll
    for (int o = 1; o < 64; o <<= 1) v = fmaxf(v, __shfl_xor(v, o));
    return v;
}

#define XB_TMO      128
#define XB_XCNT(j)  (256  + 64 * (j))
#define XB_XSUB(j)  (1280 + 64 * (j))
#define XB_XGEN(j)  (2304 + 64 * (j))
#define XB_TOP      3328
#define XB_TOPGEN   3392
#define XCD_BAR_WORDS 3456
#define XB_SPIN_CAP (1u << 18)
__device__ __forceinline__ unsigned xb_ld(unsigned* p)              { return __hip_atomic_load(p, __ATOMIC_RELAXED, __HIP_MEMORY_SCOPE_AGENT); }
__device__ __forceinline__ unsigned xb_add(unsigned* p, unsigned v) { return __hip_atomic_fetch_add(p, v, __ATOMIC_RELAXED, __HIP_MEMORY_SCOPE_AGENT); }
__device__ __forceinline__ unsigned xb_xcc_id() { return (unsigned)__builtin_amdgcn_s_getreg((3 << 11) | 20) & 0xFu; }
#define XB_SPIN(cond, bar) do { unsigned _sp = 0; while (cond) { __builtin_amdgcn_s_sleep(1); \
    if ((++_sp & 255u) == 0u) { if (xb_ld(&(bar)[XB_TMO])) break; if (_sp > XB_SPIN_CAP) { atomicAdd(&(bar)[XB_TMO], 1u); break; } } } } while (0)
struct XcdBarrier { unsigned* bar; unsigned x; volatile LAS unsigned* st; };
__device__ __forceinline__ XcdBarrier xcd_barrier_post(unsigned* bar, volatile LAS unsigned* st) {
    XcdBarrier b; b.bar = bar; b.x = xb_xcc_id(); b.st = st;
    if (threadIdx.x == 0) (void)xb_add(&bar[XB_XCNT(b.x)], 1u);
    return b;
}
__device__ __forceinline__ void xcd_barrier_complete(unsigned* bar, unsigned x, unsigned& nloc, unsigned& nx) {
    const unsigned G = gridDim.x * gridDim.y * gridDim.z;
    unsigned sum, cnt, mine, sp = 0u;
    for (;;) {
        sum = 0u; cnt = 0u; mine = 0u;
#pragma unroll
        for (unsigned j = 0; j < 16; ++j) { const unsigned c = xb_ld(&bar[XB_XCNT(j)]); sum += c; cnt += (c > 0u) ? 1u : 0u; mine = (j == x) ? c : mine; }
        if (sum == G) break;
        __builtin_amdgcn_s_sleep(1);
        if ((++sp & 255u) == 0u) { if (xb_ld(&bar[XB_TMO])) break; if (sp > XB_SPIN_CAP) { atomicAdd(&bar[XB_TMO], 1u); break; } }
    }
    nloc = mine > 0u ? mine : 1u; nx = cnt > 0u ? cnt : 1u;
}
__device__ __forceinline__ void xcd_barrier(const XcdBarrier& b) {
    asm volatile("s_waitcnt vmcnt(0)" ::: "memory");
    __syncthreads();
    if (threadIdx.x == 0) {
        unsigned* bar = b.bar;
        __builtin_amdgcn_s_waitcnt(0);
        unsigned nloc = b.st[0], nx = b.st[1];
        if (nloc == 0u) { xcd_barrier_complete(bar, b.x, nloc, nx); b.st[0] = nloc; b.st[1] = nx; }
        const unsigned old = xb_add(&bar[XB_XSUB(b.x)], 1u);
        const unsigned gen = old / nloc;
        if (old + 1u == (gen + 1u) * nloc) {
            __builtin_amdgcn_fence(__ATOMIC_RELEASE, "agent");
            asm volatile("s_waitcnt vmcnt(0)" ::: "memory");
            const unsigned og = xb_add(&bar[XB_TOP], 1u);
            const unsigned tg = og / nx;
            if (og + 1u == (tg + 1u) * nx) xb_add(&bar[XB_TOPGEN], 1u);
            else XB_SPIN(xb_ld(&bar[XB_TOPGEN]) == tg, bar);
            __builtin_amdgcn_fence(__ATOMIC_ACQUIRE, "agent");
            xb_add(&bar[XB_XGEN(b.x)], 1u);
            asm volatile("s_waitcnt vmcnt(0)" ::: "memory");
        } else {
            XB_SPIN(xb_ld(&bar[XB_XGEN(b.x)]) == gen, bar);
            __builtin_amdgcn_fence(__ATOMIC_ACQUIRE, "agent");
            asm volatile("s_waitcnt vmcnt(0)" ::: "memory");
        }
    }
    __syncthreads();
}

__device__ __forceinline__ void p0_transpose_item(const float* W, int K, int N, bf16* WT, LAS float* scr, int item, int lane) {
    const int nblk = N / 32, kb = item / nblk, nb = item % nblk, k0 = 64 * kb, n0 = 32 * nb;
#pragma unroll 8
    for (int i = 0; i < 32; ++i) { const int kk = 2 * i + (lane >> 5); scr[kk * 33 + (lane & 31)] = W[(size_t)(k0 + kk) * N + n0 + (lane & 31)]; }
    LDS_WAIT(); asm volatile("" ::: "memory");
    const int c = lane & 7;
#pragma unroll
    for (int j = 0; j < 4; ++j) { const int n = (lane >> 3) + 8 * j; const LAS float* s = scr + (8 * c) * 33 + n;
        v4u o; o.x = pk2(s[0 * 33], s[1 * 33]); o.y = pk2(s[2 * 33], s[3 * 33]); o.z = pk2(s[4 * 33], s[5 * 33]); o.w = pk2(s[6 * 33], s[7 * 33]);
        *(v4u*)(WT + (size_t)(n0 + n) * K + k0 + 8 * c) = o; }
    LDS_WAIT(); asm volatile("" ::: "memory");
}
__device__ __forceinline__ void p0_wc_item(const float* gwt, const float* scale, const float* wbp, bf16* WcT, int item, int lane) {
    const int nb = item & 15, cb = (item >> 4) & 7, g = item >> 7;
    const int n = nb * 64 + lane;
    float acc[16];
#pragma unroll
    for (int c = 0; c < 16; ++c) acc[c] = 0.f;
    for (int d = 0; d < 128; ++d) {
        const float b = wbp[(size_t)(g * 128 + d) * 1024 + n] * scale[g * 128 + d];
#pragma unroll
        for (int c = 0; c < 16; ++c) acc[c] += gwt[(size_t)((g * 128 + cb * 16 + c) * 128) + d] * b;
    }
    v4u o0, o1;
    o0.x = pk2(acc[0], acc[1]); o0.y = pk2(acc[2], acc[3]); o0.z = pk2(acc[4], acc[5]); o0.w = pk2(acc[6], acc[7]);
    o1.x = pk2(acc[8], acc[9]); o1.y = pk2(acc[10], acc[11]); o1.z = pk2(acc[12], acc[13]); o1.w = pk2(acc[14], acc[15]);
    bf16* dst = WcT + (size_t)n * 512 + g * 128 + cb * 16;
    *(v4u*)dst = o0; *(v4u*)(dst + 8) = o1;
}
__device__ __forceinline__ void p0_wpp_item(const float* wq, const float* keys, const float* gffn, bf16* WppT, int item, int lane) {
    const int kb = item & 3, db = (item >> 2) & 15, hp = item >> 6;
    const int d = db * 64 + lane;
    float acc[32];
#pragma unroll
    for (int k = 0; k < 32; ++k) acc[k] = 0.f;
    const float* arow = wq + (size_t)d * 2048 + hp * 128;
    const float* kbase = keys + (size_t)(hp * 128 + kb * 32) * 128;
#pragma unroll 4
    for (int c4 = 0; c4 < 32; ++c4) {
        const f32x4 a = *(const f32x4*)(arow + 4 * c4);
#pragma unroll
        for (int k = 0; k < 32; ++k) { const float* kr = kbase + k * 128 + 4 * c4; acc[k] += a.x * kr[0] + a.y * kr[1] + a.z * kr[2] + a.w * kr[3]; }
    }
    const float gs = gffn[d];
#pragma unroll
    for (int k = 0; k < 32; ++k) WppT[(size_t)(hp * 128 + kb * 32 + k) * 1024 + d] = (bf16)f2bf(acc[k] * gs);
}
__device__ __forceinline__ void p0_h_row(const float* xrow, const float* g, bf16* orow, int lane) {
    const f32x4* xr = (const f32x4*)xrow + lane; const f32x4* gr = (const f32x4*)g + lane;
    f32x4 v[4]; float s = 0.f;
#pragma unroll
    for (int j = 0; j < 4; ++j) { v[j] = xr[64 * j]; s += (v[j].x * v[j].x + v[j].y * v[j].y) + (v[j].z * v[j].z + v[j].w * v[j].w); }
    const float rstd = rsqrtf(wave_sum(s) * (1.f / D) + RMS_EPS);
    v2u* o8 = (v2u*)orow + lane;
#pragma unroll
    for (int j = 0; j < 4; ++j) { const f32x4 gg = gr[64 * j]; v2u o; o.x = pk2(v[j].x * rstd * gg.x, v[j].y * rstd * gg.y); o.y = pk2(v[j].z * rstd * gg.z, v[j].w * rstd * gg.w); o8[64 * j] = o; }
}
__device__ __forceinline__ void p0_h_rows2(const float* x, const float* g, unsigned char* Hq, float* SA, int m0, int m1, int lane) {
    const f32x4* xr0 = (const f32x4*)(x + (size_t)m0 * D) + lane; const f32x4* xr1 = (const f32x4*)(x + (size_t)m1 * D) + lane; const f32x4* gr = (const f32x4*)g + lane;
    f32x4 v0[4], v1[4]; float s0 = 0.f, s1 = 0.f;
#pragma unroll
    for (int j = 0; j < 4; ++j) { v0[j] = xr0[64 * j]; v1[j] = xr1[64 * j]; }
#pragma unroll
    for (int j = 0; j < 4; ++j) { s0 += (v0[j].x * v0[j].x + v0[j].y * v0[j].y) + (v0[j].z * v0[j].z + v0[j].w * v0[j].w); s1 += (v1[j].x * v1[j].x + v1[j].y * v1[j].y) + (v1[j].z * v1[j].z + v1[j].w * v1[j].w); }
    const float r0 = rsqrtf(wave_sum(s0) * (1.f / D) + RMS_EPS), r1 = rsqrtf(wave_sum(s1) * (1.f / D) + RMS_EPS);
    float mx0 = 0.f, mx1 = 0.f;
#pragma unroll
    for (int j = 0; j < 4; ++j) { const f32x4 gg = gr[64 * j]; v0[j] = v0[j] * gg * r0; v1[j] = v1[j] * gg * r1;
        mx0 = fmaxf(mx0, fmaxf(fmaxf(fabsf(v0[j].x), fabsf(v0[j].y)), fmaxf(fabsf(v0[j].z), fabsf(v0[j].w))));
        mx1 = fmaxf(mx1, fmaxf(fmaxf(fabsf(v1[j].x), fabsf(v1[j].y)), fmaxf(fabsf(v1[j].z), fabsf(v1[j].w)))); }
    mx0 = wave_max(mx0); mx1 = wave_max(mx1);
    const float sc0 = mx0 > 0.f ? mx0 * (1.f / 127.f) : 1.f, sc1 = mx1 > 0.f ? mx1 * (1.f / 127.f) : 1.f, i0 = 1.f / sc0, i1 = 1.f / sc1;
    unsigned* o0 = (unsigned*)(Hq + (size_t)m0 * D) + lane; unsigned* o1 = (unsigned*)(Hq + (size_t)m1 * D) + lane;
#pragma unroll
    for (int j = 0; j < 4; ++j) { unsigned a = 0, b = 0;
#pragma unroll
        for (int c = 0; c < 4; ++c) { int q = (int)rintf(v0[j][c] * i0); q = q > 127 ? 127 : (q < -127 ? -127 : q); a |= ((unsigned)q & 0xffu) << (8 * c);
            int q1 = (int)rintf(v1[j][c] * i1); q1 = q1 > 127 ? 127 : (q1 < -127 ? -127 : q1); b |= ((unsigned)q1 & 0xffu) << (8 * c); }
        o0[64 * j] = a; o1[64 * j] = b; }
    if (lane == 0) { SA[m0] = sc0; SA[m1] = sc1; }
}
__device__ __forceinline__ void p0_colmax_item(const float* W, int N, unsigned* cmax, int item, int lane) {
    const int nblk = N / 256, kb = item / nblk, nb = item % nblk;
    const float* p = W + (size_t)(kb * 64) * N + nb * 256 + 4 * lane;
    f32x4 mx = {0.f, 0.f, 0.f, 0.f};
#pragma unroll 8
    for (int k = 0; k < 64; ++k) { const f32x4 v = *(const f32x4*)(p + (size_t)k * N); mx.x = fmaxf(mx.x, fabsf(v.x)); mx.y = fmaxf(mx.y, fabsf(v.y)); mx.z = fmaxf(mx.z, fabsf(v.z)); mx.w = fmaxf(mx.w, fabsf(v.w)); }
    unsigned* c = cmax + nb * 256 + 4 * lane;
    atomicMax(c + 0, __builtin_bit_cast(unsigned, mx.x)); atomicMax(c + 1, __builtin_bit_cast(unsigned, mx.y)); atomicMax(c + 2, __builtin_bit_cast(unsigned, mx.z)); atomicMax(c + 3, __builtin_bit_cast(unsigned, mx.w));
}
__device__ __forceinline__ void p0_transpose_i8_item(const float* W, int K, int N, unsigned char* WT, const unsigned* cmax, float* SB, LAS float* scr, int item, int lane) {
    const int nblk = N / 32, kb = item / nblk, nb = item % nblk, k0 = 64 * kb, n0 = 32 * nb;
#pragma unroll 8
    for (int i = 0; i < 32; ++i) { const int kk = 2 * i + (lane >> 5); scr[kk * 33 + (lane & 31)] = W[(size_t)(k0 + kk) * N + n0 + (lane & 31)]; }
    LDS_WAIT(); asm volatile("" ::: "memory");
    const int c = lane & 3;
#pragma unroll
    for (int j = 0; j < 2; ++j) { const int n = (lane >> 2) + 16 * j; const LAS float* s = scr + (16 * c) * 33 + n;
        const float mxv = __builtin_bit_cast(float, cmax[n0 + n]); const float sc = mxv > 0.f ? mxv * (1.f / 127.f) : 1.f, inv = 1.f / sc;
        if (kb == 0 && c == 0) SB[n0 + n] = sc;
        v4u o;
#pragma unroll
        for (int q4 = 0; q4 < 4; ++q4) { unsigned a = 0;
#pragma unroll
            for (int b = 0; b < 4; ++b) { int q = (int)rintf(s[(4 * q4 + b) * 33] * inv); q = q > 127 ? 127 : (q < -127 ? -127 : q); a |= ((unsigned)q & 0xffu) << (8 * b); }
            o[q4] = a; }
        *(v4u*)(WT + (size_t)(n0 + n) * K + k0 + 16 * c) = o; }
    LDS_WAIT(); asm volatile("" ::: "memory");
}
__device__ __forceinline__ void p0_quant_row(const float* src, const float* gmul, unsigned char* dst, float* scale_out, int e, int lane, bool uns) {
    const f32x4* p = (const f32x4*)(src + (size_t)e * 1024 + 16 * lane);
    f32x4 v[4];
#pragma unroll
    for (int j = 0; j < 4; ++j) v[j] = p[j];
    if (gmul) { const f32x4* gp = (const f32x4*)(gmul + 16 * lane);
#pragma unroll
        for (int j = 0; j < 4; ++j) v[j] = v[j] * gp[j]; }
    float mx = 0.f;
#pragma unroll
    for (int j = 0; j < 4; ++j) mx = fmaxf(mx, fmaxf(fmaxf(fabsf(v[j].x), fabsf(v[j].y)), fmaxf(fabsf(v[j].z), fabsf(v[j].w))));
    mx = wave_max(mx);
    const float sc = mx > 0.f ? mx * (1.f / 127.f) : 1.f, inv = 1.f / sc;
    const int bias = uns ? 128 : 0;
    v4u w;
#pragma unroll
    for (int j = 0; j < 4; ++j) {
        unsigned acc = 0;
#pragma unroll
        for (int c = 0; c < 4; ++c) { int q = (int)rintf(v[j][c] * inv); q = q > 127 ? 127 : (q < -127 ? -127 : q); acc |= ((unsigned)(q + bias) & 0xffu) << (8 * c); }
        w[j] = acc;
    }
    *(v4u*)(dst + ((size_t)(lane >> 3) * NE + e) * 128 + 16 * (lane & 7)) = w;
    if (lane == 0) scale_out[e] = sc;
}

typedef pg8::f32x4 (&AccRef)[2][2][4][2];
struct EpiZ {
    static constexpr bool PERM = true;
    bf16* O; int ldc; const float* SA; const float* SB;
    __device__ __forceinline__ bool operator()(AccRef acc, const pg8::Unit& u, int wr, int wc, int fr, int fq) const {
        const int row0 = u.pm * 256 + wr * 64 + fr, col0 = u.pn * 256 + wc * 32 + 8 * fq;
        pg8::f32x4 sb[2][2];
#pragma unroll
        for (int bj = 0; bj < 2; ++bj) { sb[bj][0] = *(const pg8::f32x4*)(SB + col0 + bj * 128); sb[bj][1] = *(const pg8::f32x4*)(SB + col0 + bj * 128 + 4); }
#pragma unroll
        for (int ai = 0; ai < 2; ++ai)
#pragma unroll
            for (int m = 0; m < 4; ++m) { const int r = row0 + ai * 128 + m * 16; bf16* rowp = O + (size_t)r * ldc + col0; const float sa = SA[r];
#pragma unroll
                for (int bj = 0; bj < 2; ++bj) { const pg8::i32x4 i0 = __builtin_bit_cast(pg8::i32x4, acc[ai][bj][m][0]), i1 = __builtin_bit_cast(pg8::i32x4, acc[ai][bj][m][1]);
                    pg8::f32x4 v0 = {(float)i0[0], (float)i0[1], (float)i0[2], (float)i0[3]}, v1 = {(float)i1[0], (float)i1[1], (float)i1[2], (float)i1[3]};
                    v0 = v0 * sb[bj][0] * sa; v1 = v1 * sb[bj][1] * sa; v4u w;
                    w.x = pg8::cvt_pk_bf16(v0[0], v0[1]); w.y = pg8::cvt_pk_bf16(v0[2], v0[3]); w.z = pg8::cvt_pk_bf16(v1[0], v1[1]); w.w = pg8::cvt_pk_bf16(v1[2], v1[3]);
                    *(v4u*)(rowp + bj * 128) = w; } }
        return false;
    }
};
__device__ __forceinline__ float sigm_ratio(float ga, float gb) { return (1.f + __expf(-gb)) / (1.f + __expf(-ga)); }
struct EpiGate {
    static constexpr bool PERM = true;
    const bf16* Z; bf16* Mo;
    __device__ __forceinline__ bool operator()(AccRef acc, const pg8::Unit& u, int wr, int wc, int fr, int fq) const {
        const int row0 = u.pm * 256 + wr * 64 + fr, col0 = u.pn * 256 + wc * 32 + 8 * fq;
        if (u.seg == 0) {
#pragma unroll
            for (int ai = 0; ai < 2; ++ai)
#pragma unroll
                for (int m = 0; m < 4; ++m) { const bf16* zr = Z + (size_t)(row0 + ai * 128 + m * 16) * DIN + col0;
#pragma unroll
                    for (int bj = 0; bj < 2; ++bj) { const v4u a = *(const v4u*)(zr + 2048 + bj * 128), b = *(const v4u*)(zr + 3072 + bj * 128);
                        pg8::f32x4& v0 = acc[ai][bj][m][0]; pg8::f32x4& v1 = acc[ai][bj][m][1];
                        v0[0] *= sigm_ratio(bflo(a.x), bflo(b.x)); v0[1] *= sigm_ratio(bfhi(a.x), bfhi(b.x)); v0[2] *= sigm_ratio(bflo(a.y), bflo(b.y)); v0[3] *= sigm_ratio(bfhi(a.y), bfhi(b.y));
                        v1[0] *= sigm_ratio(bflo(a.z), bflo(b.z)); v1[1] *= sigm_ratio(bfhi(a.z), bfhi(b.z)); v1[2] *= sigm_ratio(bflo(a.w), bflo(b.w)); v1[3] *= sigm_ratio(bfhi(a.w), bfhi(b.w)); } }
            return true;
        }
#pragma unroll
        for (int ai = 0; ai < 2; ++ai)
#pragma unroll
            for (int m = 0; m < 4; ++m) { const size_t r = (size_t)(row0 + ai * 128 + m * 16); const bf16* zr = Z + r * DIN + col0; bf16* mo = Mo + r * D + col0;
#pragma unroll
                for (int bj = 0; bj < 2; ++bj) { const v4u b = *(const v4u*)(zr + 3072 + bj * 128);
                    const pg8::f32x4 v0 = acc[ai][bj][m][0], v1 = acc[ai][bj][m][1]; v4u w;
#define SG(x) (1.f / (1.f + __expf(-(x))))
                    w.x = pg8::cvt_pk_bf16(v0[0] * SG(bflo(b.x)), v0[1] * SG(bfhi(b.x))); w.y = pg8::cvt_pk_bf16(v0[2] * SG(bflo(b.y)), v0[3] * SG(bfhi(b.y)));
                    w.z = pg8::cvt_pk_bf16(v1[0] * SG(bflo(b.z)), v1[1] * SG(bfhi(b.z))); w.w = pg8::cvt_pk_bf16(v1[2] * SG(bflo(b.w)), v1[3] * SG(bfhi(b.w)));
#undef SG
                    *(v4u*)(mo + bj * 128) = w; } }
        return false;
    }
};
struct EpiRes {
    static constexpr bool PERM = true;
    const float* X; bf16* X1; float* SSQ;
    __device__ __forceinline__ bool operator()(AccRef acc, const pg8::Unit& u, int wr, int wc, int fr, int fq) const {
        const int row0 = u.pm * 256 + wr * 64 + fr, col0 = u.pn * 256 + wc * 32 + 8 * fq;
#pragma unroll
        for (int ai = 0; ai < 2; ++ai)
#pragma unroll
            for (int m = 0; m < 4; ++m) { const size_t r = (size_t)(row0 + ai * 128 + m * 16); const float* xr = X + r * D + col0; bf16* o = X1 + r * D + col0; float ss = 0.f;
#pragma unroll
                for (int bj = 0; bj < 2; ++bj) { const pg8::f32x4 x0 = *(const pg8::f32x4*)(xr + bj * 128), x1v = *(const pg8::f32x4*)(xr + bj * 128 + 4);
                    const pg8::f32x4 v0 = acc[ai][bj][m][0] + x0, v1 = acc[ai][bj][m][1] + x1v;
                    ss += (v0[0] * v0[0] + v0[1] * v0[1]) + (v0[2] * v0[2] + v0[3] * v0[3]) + (v1[0] * v1[0] + v1[1] * v1[1]) + (v1[2] * v1[2] + v1[3] * v1[3]);
                    v4u w; w.x = pg8::cvt_pk_bf16(v0[0], v0[1]); w.y = pg8::cvt_pk_bf16(v0[2], v0[3]); w.z = pg8::cvt_pk_bf16(v1[0], v1[1]); w.w = pg8::cvt_pk_bf16(v1[2], v1[3]);
                    *(v4u*)(o + bj * 128) = w; }
                ss += __shfl_xor(ss, 16); ss += __shfl_xor(ss, 32);
                if (fq == 0) SSQ[r * 16 + u.pn * 4 + wc] = ss; }
        return false;
    }
};
struct EpiScore {
    static constexpr bool PERM = true;
    const float* SSQ; _Float16* S; float* RSTD;
    __device__ __forceinline__ bool operator()(AccRef acc, const pg8::Unit& u, int wr, int wc, int fr, int fq) const {
        const int row0 = u.pm * 256 + wr * 64 + fr, col0 = u.pn * 256 + wc * 32 + 8 * fq;
#pragma unroll
        for (int ai = 0; ai < 2; ++ai)
#pragma unroll
            for (int m = 0; m < 4; ++m) { const size_t r = (size_t)(row0 + ai * 128 + m * 16);
                const pg8::f32x4* sp = (const pg8::f32x4*)(SSQ + r * 16); const pg8::f32x4 s0 = sp[0], s1 = sp[1], s2 = sp[2], s3 = sp[3];
                const float tot = ((s0[0] + s0[1]) + (s0[2] + s0[3])) + ((s1[0] + s1[1]) + (s1[2] + s1[3])) + ((s2[0] + s2[1]) + (s2[2] + s2[3])) + ((s3[0] + s3[1]) + (s3[2] + s3[3]));
                const float rstd = rsqrtf(tot * (1.f / D) + RMS_EPS);
                if (u.pn == 0 && wc == 0 && fq == 0) RSTD[r] = rstd;
                _Float16* o = S + r * NSC + col0;
#pragma unroll
                for (int bj = 0; bj < 2; ++bj) { const pg8::f32x4 v0 = acc[ai][bj][m][0] * rstd, v1 = acc[ai][bj][m][1] * rstd;
                    typedef _Float16 h2 __attribute__((ext_vector_type(2)));
                    h2 p0 = {(_Float16)v0[0], (_Float16)v0[1]}, p1 = {(_Float16)v0[2], (_Float16)v0[3]}, p2 = {(_Float16)v1[0], (_Float16)v1[1]}, p3 = {(_Float16)v1[2], (_Float16)v1[3]};
                    v4u w; w.x = __builtin_bit_cast(unsigned, p0); w.y = __builtin_bit_cast(unsigned, p1); w.z = __builtin_bit_cast(unsigned, p2); w.w = __builtin_bit_cast(unsigned, p3);
                    *(v4u*)(o + bj * 128) = w; } }
        return false;
    }
};

__device__ __forceinline__ void unpack8(const v4u w, float (&f)[8]) { f[0] = bflo(w.x); f[1] = bfhi(w.x); f[2] = bflo(w.y); f[3] = bfhi(w.y); f[4] = bflo(w.z); f[5] = bfhi(w.z); f[6] = bflo(w.w); f[7] = bfhi(w.w); }
__device__ __forceinline__ v4u pack8(const float (&f)[8]) { v4u w; w.x = pk2(f[0], f[1]); w.y = pk2(f[2], f[3]); w.z = pk2(f[4], f[5]); w.w = pk2(f[6], f[7]); return w; }
__device__ __forceinline__ void p2_timemix(const bf16* Z, const float* convw, bf16* PA, bf16* CA, int gw, int NGW, int lane) {
    const int w = 2 << (lane >> 4);
    const int ch = 8 * lane;
    float cw0[8], cw1[8], cw2[8];
#pragma unroll
    for (int i = 0; i < 8; ++i) { cw0[i] = convw[ch + i]; cw1[i] = convw[512 + ch + i]; cw2[i] = convw[1024 + ch + i]; }
    for (int chunk = gw; chunk < M / 32; chunk += NGW) {
        const int t0 = chunk * 32, s0 = t0 & (SEQ - 1);
        float sum[8], up1[8], up2[8];
#pragma unroll
        for (int i = 0; i < 8; ++i) { sum[i] = 0.f; up1[i] = 0.f; up2[i] = 0.f; }
        if (s0 > 0) {
            for (int j = 1; j < 16; ++j) {
                if (j < w) { float f[8]; unpack8(*(const v4u*)(Z + (size_t)(t0 - j) * DIN + ch), f);
#pragma unroll
                    for (int i = 0; i < 8; ++i) sum[i] += f[i]; }
            }
            float c[8], v[8];
            unpack8(*(const v4u*)(Z + (size_t)(t0 - 2) * DIN + 512 + ch), c); unpack8(*(const v4u*)(Z + (size_t)(t0 - 2) * DIN + 1536 + ch), v);
#pragma unroll
            for (int i = 0; i < 8; ++i) up2[i] = c[i] * v[i];
            unpack8(*(const v4u*)(Z + (size_t)(t0 - 1) * DIN + 512 + ch), c); unpack8(*(const v4u*)(Z + (size_t)(t0 - 1) * DIN + 1536 + ch), v);
#pragma unroll
            for (int i = 0; i < 8; ++i) up1[i] = c[i] * v[i];
        }
        for (int i2 = 0; i2 < 32; ++i2) {
            const int t = t0 + i2, s = s0 + i2;
            const bf16* zr = Z + (size_t)t * DIN;
            float zt[8], c[8], b[8], v[8], o[8];
            unpack8(*(const v4u*)(zr + ch), zt); unpack8(*(const v4u*)(zr + 512 + ch), c); unpack8(*(const v4u*)(zr + 1024 + ch), b); unpack8(*(const v4u*)(zr + 1536 + ch), v);
            const int cnt = (s + 1) < w ? (s + 1) : w; const float rc = 1.f / (float)cnt;
#pragma unroll
            for (int i = 0; i < 8; ++i) { sum[i] += zt[i]; o[i] = sum[i] * rc - zt[i]; }
            *(v4u*)(PA + (size_t)t * DP + ch) = pack8(o);
            if (s + 1 - w >= 0) { float f[8]; unpack8(*(const v4u*)(Z + (size_t)(t + 1 - w) * DIN + ch), f);
#pragma unroll
                for (int i = 0; i < 8; ++i) sum[i] -= f[i]; }
#pragma unroll
            for (int i = 0; i < 8; ++i) { const float uu = c[i] * v[i]; o[i] = b[i] * (cw0[i] * up2[i] + cw1[i] * up1[i] + cw2[i] * uu); up2[i] = up1[i]; up1[i] = uu; }
            *(v4u*)(CA + (size_t)t * DP + ch) = pack8(o);
        }
    }
}

__device__ __forceinline__ void p6_topk(const _Float16* S, unsigned short* IDX, float* EV, float* INV, LAS unsigned char* lds, int gw, int NGW, int wave, int lane) {
    LAS unsigned char* my = lds + wave * 9216;
    const float NEG = -3.0e38f;
    for (int grp = gw; grp < M * NH / 64; grp += NGW) {
        const char* base = (const char*)S + (size_t)grp * 64 * 512;
        float A[16], B[16];
#pragma unroll
        for (int half = 0; half < 2; ++half) {
            float L[16];
#pragma unroll
            for (int i = 0; i < 16; ++i) L[i] = NEG;
#pragma unroll 1
            for (int step = 0; step < 2; ++step) {
                const int j = half * 2 + step;
#pragma unroll
                for (int q = 0; q < 8; ++q) { const int row = 8 * q + (lane >> 3), chn = lane & 7;
                    const v4u dd = *(const v4u*)(base + (size_t)row * 512 + 128 * j + 16 * chn); *(LAS v4u*)(my + row * 144 + 16 * chn) = dd; }
                asm volatile("s_waitcnt lgkmcnt(0)" ::: "memory");
#pragma unroll 1
                for (int c = 0; c < 8; ++c) {
                    const v4u dd = *(const LAS v4u*)(my + lane * 144 + 16 * c);
                    const unsigned ww[4] = {dd.x, dd.y, dd.z, dd.w};
#pragma unroll
                    for (int e = 0; e < 8; ++e) {
                        const unsigned hb = (e & 1) ? (ww[e >> 1] >> 16) : (ww[e >> 1] & 0xffffu);
                        const float val = (float)__builtin_bit_cast(_Float16, (unsigned short)hb);
                        const int key = step * 64 + c * 8 + e;
                        float tv = __builtin_bit_cast(float, __builtin_bit_cast(unsigned, val) | (unsigned)(127 - key));
#pragma unroll
                        for (int i = 0; i < 16; ++i) { const float hi = fmaxf(L[i], tv); tv = fminf(L[i], tv); L[i] = hi; }
                    }
                }
                asm volatile("s_waitcnt lgkmcnt(0)" ::: "memory");
            }
#pragma unroll
            for (int i = 0; i < 16; ++i) { if (half == 0) A[i] = L[i]; else B[i] = L[i]; }
        }
        float FV[16]; int FI[16];
#pragma unroll
        for (int i = 0; i < 16; ++i) { FV[i] = NEG; FI[i] = 0; }
#pragma unroll
        for (int i = 0; i < 16; ++i) {
            const unsigned ab = __builtin_bit_cast(unsigned, A[i]); const float av = __builtin_bit_cast(float, ab & ~0x7fu); const int ak = 127 - (int)(ab & 0x7fu);
#pragma unroll
            for (int j = 0; j < 16; ++j) {
                if ((i + 1) * (j + 1) <= 16) {
                    const unsigned bb = __builtin_bit_cast(unsigned, B[j]); const float bv = __builtin_bit_cast(float, bb & ~0x7fu); const int bk = 127 - (int)(bb & 0x7fu);
                    float x = av + bv; int xi = ak * 128 + bk;
#pragma unroll
                    for (int s = (i + 1) * (j + 1) - 1; s < 16; ++s) { const bool c = x > FV[s]; const float nv = c ? x : FV[s], ox = c ? FV[s] : x; const int ni = c ? xi : FI[s], oi = c ? FI[s] : xi; FV[s] = nv; FI[s] = ni; x = ox; xi = oi; }
                }
            }
        }
        const size_t r = (size_t)grp * 64 + lane;
        float ev[16]; float sum = 0.f;
#pragma unroll
        for (int i = 0; i < 16; ++i) { ev[i] = __expf(FV[i] - FV[0]); sum += ev[i]; }
        v4u i0, i1;
        i0.x = (unsigned)FI[0] | ((unsigned)FI[1] << 16); i0.y = (unsigned)FI[2] | ((unsigned)FI[3] << 16); i0.z = (unsigned)FI[4] | ((unsigned)FI[5] << 16); i0.w = (unsigned)FI[6] | ((unsigned)FI[7] << 16);
        i1.x = (unsigned)FI[8] | ((unsigned)FI[9] << 16); i1.y = (unsigned)FI[10] | ((unsigned)FI[11] << 16); i1.z = (unsigned)FI[12] | ((unsigned)FI[13] << 16); i1.w = (unsigned)FI[14] | ((unsigned)FI[15] << 16);
        *(v4u*)(IDX + r * 16) = i0; *(v4u*)(IDX + r * 16 + 8) = i1;
#pragma unroll
        for (int q = 0; q < 4; ++q) *(f32x4*)(EV + r * 16 + 4 * q) = (f32x4){ev[4 * q], ev[4 * q + 1], ev[4 * q + 2], ev[4 * q + 3]};
        INV[r] = 1.f / sum;
    }
}

__device__ __forceinline__ float ubf(unsigned w, int b) { return (float)((w >> (8 * b)) & 0xffu); }
typedef float v2f __attribute__((ext_vector_type(2)));
__device__ __forceinline__ int q_pull(unsigned* heads, int s, int lane) { int it = 0; if (lane == 0) it = (int)__hip_atomic_fetch_add(heads + 64 * s, 1u, __ATOMIC_RELAXED, __HIP_MEMORY_SCOPE_AGENT); return __builtin_amdgcn_readfirstlane(it); }

struct UIdx { v4u ia, ib; };
struct UBuf { v4u ur[16]; v4u xa, xb; };
__device__ __forceinline__ void u_idx(UIdx& p, int t, const unsigned short* IDX, int lane) { const unsigned short* ip = IDX + (size_t)t * 128 + (lane >> 3) * 16; p.ia = *(const v4u*)ip; p.ib = *(const v4u*)(ip + 8); }
__device__ __forceinline__ void u_gather(UBuf& b, const UIdx& p, int s, int t, const bf16* X1, const unsigned char* U8, int lane) {
    const int c = lane & 7;
    const unsigned iw[8] = {p.ia.x, p.ia.y, p.ia.z, p.ia.w, p.ib.x, p.ib.y, p.ib.z, p.ib.w};
    const unsigned char* ub = U8 + (size_t)s * NE * 128 + 16 * c;
#pragma unroll
    for (int i = 0; i < 16; ++i) { const unsigned e = (i & 1) ? (iw[i >> 1] >> 16) : (iw[i >> 1] & 0xffffu); b.ur[i] = *(const v4u*)(ub + (size_t)e * 128); }
    const bf16* xp = X1 + (size_t)t * D + 128 * s + 16 * c;
    b.xa = *(const v4u*)xp; b.xb = *(const v4u*)(xp + 8);
}
__device__ __forceinline__ void u_compute(const UBuf& bf, int s, int t, float* PART, int lane) {
    float xv[16];
    { float f[8]; unpack8(bf.xa, f);
#pragma unroll
      for (int i = 0; i < 8; ++i) xv[i] = f[i];
      unpack8(bf.xb, f);
#pragma unroll
      for (int i = 0; i < 8; ++i) xv[8 + i] = f[i]; }
    float mx = 0.f;
#pragma unroll
    for (int i = 0; i < 16; ++i) mx = fmaxf(mx, fabsf(xv[i]));
    mx = fmaxf(mx, __shfl_xor(mx, 1)); mx = fmaxf(mx, __shfl_xor(mx, 2)); mx = fmaxf(mx, __shfl_xor(mx, 4));
    const float sx = mx > 0.f ? mx * (1.f / 127.f) : 1.f, isx = 1.f / sx;
    int xq[4];
#pragma unroll
    for (int j = 0; j < 4; ++j) { unsigned a = 0;
#pragma unroll
        for (int b = 0; b < 4; ++b) { int q = (int)rintf(xv[4 * j + b] * isx); q = q > 127 ? 127 : (q < -127 ? -127 : q); a |= ((unsigned)q & 0xffu) << (8 * b); }
        xq[j] = (int)a; }
    int p[16];
#pragma unroll
    for (int i = 0; i < 16; ++i) { int a = __builtin_amdgcn_sdot4((int)bf.ur[i].x, xq[0], 0, false); a = __builtin_amdgcn_sdot4((int)bf.ur[i].y, xq[1], a, false);
        a = __builtin_amdgcn_sdot4((int)bf.ur[i].z, xq[2], a, false); a = __builtin_amdgcn_sdot4((int)bf.ur[i].w, xq[3], a, false); p[i] = a; }
    int r8[8], r4[4], r2[2];
    const bool b2 = lane & 4, b1 = lane & 2, b0 = lane & 1;
#pragma unroll
    for (int i = 0; i < 8; ++i) { const int snd = b2 ? p[i] : p[i + 8], kp = b2 ? p[i + 8] : p[i]; r8[i] = kp + __shfl_xor(snd, 4); }
#pragma unroll
    for (int i = 0; i < 4; ++i) { const int snd = b1 ? r8[i] : r8[i + 4], kp = b1 ? r8[i + 4] : r8[i]; r4[i] = kp + __shfl_xor(snd, 2); }
#pragma unroll
    for (int i = 0; i < 2; ++i) { const int snd = b0 ? r4[i] : r4[i + 2], kp = b0 ? r4[i + 2] : r4[i]; r2[i] = kp + __shfl_xor(snd, 1); }
    *(v2f*)(PART + ((size_t)s * M + t) * 128 + 2 * lane) = (v2f){(float)r2[0] * sx, (float)r2[1] * sx};
}
__device__ __forceinline__ void p7_u_phase(unsigned* heads, unsigned xcc, const bf16* X1, const unsigned short* IDX, const unsigned char* U8, float* PART, int lane) {
    int s = (int)(xcc & 7u), tried = 0;
    for (;;) {
        const int item = q_pull(heads, s, lane);
        if (item >= M / TPI) { if (++tried == 8) break; s = (s + 1) & 7; continue; }
        const int t0 = item * TPI, tl = t0 + TPI - 1;
        UIdx ia, ib, in; UBuf ga, gb;
        u_idx(ia, t0, IDX, lane); u_idx(ib, t0 + 1, IDX, lane);
        u_gather(ga, ia, s, t0, X1, U8, lane);
#pragma unroll 1
        for (int i = 0; i < TPI; i += 2) {
            const int t = t0 + i, t2 = (t + 2) < tl ? (t + 2) : tl, t3 = (t + 3) < tl ? (t + 3) : tl;
            u_gather(gb, ib, s, t + 1, X1, U8, lane);
            u_idx(in, t2, IDX, lane);
            u_compute(ga, s, t, PART, lane);
            ia = in;
            u_gather(ga, ia, s, t2, X1, U8, lane);
            u_idx(in, t3, IDX, lane);
            u_compute(gb, s, t + 1, PART, lane);
            ib = in;
        }
    }
}
__device__ __forceinline__ void p8_w_phase(const float* PART, const float* RSTD, const unsigned short* IDX, const float* EV, const float* INV, const float* SU, const float* SV, float* WV, float* WT, int gw, int NGW, int lane) {
    for (int t = gw; t < M; t += NGW) {
        float a0 = 0.f, a1 = 0.f;
#pragma unroll
        for (int x = 0; x < 8; ++x) { const v2f pp = *(const v2f*)(PART + ((size_t)x * M + t) * 128 + 2 * lane); a0 += pp.x; a1 += pp.y; }
        const unsigned ip = *(const unsigned*)(IDX + (size_t)t * 128 + 2 * lane); const int e0 = (int)(ip & 0xffffu), e1 = (int)(ip >> 16);
        const v2f evp = *(const v2f*)(EV + (size_t)t * 128 + 2 * lane); const float iv = INV[(size_t)t * NH + (lane >> 3)];
        const float rstd = RSTD[t];
        const float act0 = a0 * SU[e0] * rstd, act1 = a1 * SU[e1] * rstd;
        const float w0 = evp.x * iv * (0.5f * act0 * (1.f + erff(act0 * 0.70710678118654752f))) * SV[e0];
        const float w1 = evp.y * iv * (0.5f * act1 * (1.f + erff(act1 * 0.70710678118654752f))) * SV[e1];
        *(v2f*)(WV + (size_t)t * 128 + 2 * lane) = (v2f){w0, w1};
        const float wtot = wave_sum(w0 + w1);
        if (lane == 0) WT[t] = wtot;
    }
}
struct VBuf { v4u vr[16]; v2f w2; unsigned xw; float wtot; };
__device__ __forceinline__ void v_gather(VBuf& b, const UIdx& p, int s, int t, const bf16* X1, const float* WV, const float* WT, const unsigned char* V8, int lane) {
    const int c = lane & 7, g = lane >> 3;
    const unsigned iw[8] = {p.ia.x, p.ia.y, p.ia.z, p.ia.w, p.ib.x, p.ib.y, p.ib.z, p.ib.w};
    const unsigned char* vb = V8 + (size_t)s * NE * 128 + 16 * c;
#pragma unroll
    for (int i = 0; i < 16; ++i) { const unsigned e = (i & 1) ? (iw[i >> 1] >> 16) : (iw[i >> 1] & 0xffffu); b.vr[i] = *(const v4u*)(vb + (size_t)e * 128); }
    b.w2 = *(const v2f*)(WV + (size_t)t * 128 + 2 * lane);
    b.xw = *(const unsigned*)(X1 + (size_t)t * D + 128 * s + 16 * c + 2 * g);
    b.wtot = WT[t];
}
__device__ __forceinline__ void v_compute(const VBuf& bf, int s, int t, float* out, float* SSQ2, int lane) {
    const int c = lane & 7, g = lane >> 3;
    float acc[16];
#pragma unroll
    for (int j = 0; j < 16; ++j) acc[j] = 0.f;
#pragma unroll
    for (int i = 0; i < 16; ++i) { const float wi = __shfl((i & 1) ? bf.w2.y : bf.w2.x, (lane & ~7) | (i >> 1));
#pragma unroll
        for (int j = 0; j < 4; ++j) { const unsigned w = bf.vr[i][j];
#pragma unroll
            for (int b = 0; b < 4; ++b) acc[4 * j + b] += wi * ubf(w, b); } }
    float r8[8], r4[4], r2[2];
    const bool b5 = lane & 32, b4 = lane & 16, b3 = lane & 8;
#pragma unroll
    for (int i = 0; i < 8; ++i) { const float snd = b5 ? acc[i] : acc[i + 8], kp = b5 ? acc[i + 8] : acc[i]; r8[i] = kp + __shfl_xor(snd, 32); }
#pragma unroll
    for (int i = 0; i < 4; ++i) { const float snd = b4 ? r8[i] : r8[i + 4], kp = b4 ? r8[i + 4] : r8[i]; r4[i] = kp + __shfl_xor(snd, 16); }
#pragma unroll
    for (int i = 0; i < 2; ++i) { const float snd = b3 ? r4[i] : r4[i + 2], kp = b3 ? r4[i + 2] : r4[i]; r2[i] = kp + __shfl_xor(snd, 8); }
    const size_t col = (size_t)t * D + 128 * s + 16 * c + 2 * g;
    const float y0 = bflo(bf.xw) + r2[0] - 128.f * bf.wtot, y1 = bfhi(bf.xw) + r2[1] - 128.f * bf.wtot;
    const float ss = wave_sum(y0 * y0 + y1 * y1);
    *(v2f*)(out + col) = (v2f){y0, y1};
    if (lane == 0) SSQ2[(size_t)t * 8 + s] = ss;
}
__device__ __forceinline__ void p9_v_phase(unsigned* heads, unsigned xcc, const bf16* X1, const unsigned short* IDX, const float* WV, const float* WT, const unsigned char* V8, float* out, float* SSQ2, int lane) {
    int s = (int)(xcc & 7u), tried = 0;
    for (;;) {
        const int item = q_pull(heads, s, lane);
        if (item >= M / TPI) { if (++tried == 8) break; s = (s + 1) & 7; continue; }
        const int t0 = item * TPI, tl = t0 + TPI - 1;
        UIdx ia, ib, in; VBuf ga, gb;
        u_idx(ia, t0, IDX, lane); u_idx(ib, t0 + 1, IDX, lane);
        v_gather(ga, ia, s, t0, X1, WV, WT, V8, lane);
#pragma unroll 1
        for (int i = 0; i < TPI; i += 2) {
            const int t = t0 + i, t2 = (t + 2) < tl ? (t + 2) : tl, t3 = (t + 3) < tl ? (t + 3) : tl;
            v_gather(gb, ib, s, t + 1, X1, WV, WT, V8, lane);
            u_idx(in, t2, IDX, lane);
            v_compute(ga, s, t, out, SSQ2, lane);
            ia = in;
            v_gather(ga, ia, s, t2, X1, WV, WT, V8, lane);
            u_idx(in, t3, IDX, lane);
            v_compute(gb, s, t + 1, out, SSQ2, lane);
            ib = in;
        }
    }
}
__device__ __forceinline__ void p10_final(float* out, const float* SSQ2, const float* gfin, int gw, int NGW, int lane) {
    f32x4 gf[4];
#pragma unroll
    for (int j = 0; j < 4; ++j) gf[j] = ((const f32x4*)gfin)[lane + 64 * j];
    for (int t = gw; t < M; t += NGW) {
        const float ssp = lane < 8 ? SSQ2[(size_t)t * 8 + lane] : 0.f;
        const float r2 = rsqrtf(wave_sum(ssp) * (1.f / D) + RMS_EPS);
        f32x4* o = (f32x4*)(out + (size_t)t * D) + lane;
#pragma unroll
        for (int j = 0; j < 4; ++j) { const f32x4 v = o[64 * j]; o[64 * j] = (f32x4){v.x * r2 * gf[j].x, v.y * r2 * gf[j].y, v.z * r2 * gf[j].z, v.w * r2 * gf[j].w}; }
    }
}

struct Args { const float* in[15]; float* out; unsigned char* ws; int ph_lo, ph_hi, li, pad; };
__global__ void __launch_bounds__(NWAVES * 64, 2) fwd_kernel(Args args) {
    extern __shared__ __attribute__((aligned(16))) unsigned char lds_raw[];
    LAS unsigned char* lds = (LAS unsigned char*)lds_raw;
    volatile LAS unsigned* MISC = (volatile LAS unsigned*)(lds + MISC_OFF);
    const int tid = threadIdx.x, lane = tid & 63, wave = __builtin_amdgcn_readfirstlane(tid >> 6);
    const int G = gridDim.x; const int bx = blockIdx.x; const int vcu = (G % 8 == 0) ? (bx % 8) * (G / 8) + bx / 8 : bx;
    const int gw = vcu * NWAVES + wave, NGW = G * NWAVES;
    unsigned char* ws = args.ws;
    gu32* ctl = (gu32*)(ws + WS_CTL);
    const float* x = args.in[0]; const float* g_mix = args.in[1]; const float* w_in = args.in[2]; const float* pool_gw = args.in[3]; const float* pool_scale = args.in[4];
    const float* conv_w = args.in[5]; const float* w_bp = args.in[6]; const float* w_bc = args.in[7]; const float* w_out = args.in[8]; const float* g_ffn = args.in[9];
    const float* w_q = args.in[10]; const float* sub_keys = args.in[11]; const float* expert_u = args.in[12]; const float* expert_v = args.in[13]; const float* g_final = args.in[14];
    bf16* Wc_t = (bf16*)(ws + WS_WC); bf16* Wbc_t = (bf16*)(ws + WS_WBC); bf16* Wout_t = (bf16*)(ws + WS_WOUT); bf16* Wpp_t = (bf16*)(ws + WS_WPP);
    float* SU = (float*)(ws + WS_SU); float* SV = (float*)(ws + WS_SV); float* SSQ = (float*)(ws + WS_SSQ);
    unsigned char* U8 = ws + WS_U8; unsigned char* V8 = ws + WS_V8; float* INV = (float*)(ws + WS_INV); float* SSQ2 = (float*)(ws + WS_SSQ2); float* PART = (float*)(ws + WS_PART); float* RSTD = (float*)(ws + WS_RSTD); float* WT = (float*)(ws + WS_WT); float* WV = (float*)(ws + WS_WV);
    unsigned char* Hq = ws + WS_B; unsigned char* Winq = ws + WS_WIN; float* SA = (float*)(ws + WS_SA); float* SB = (float*)(ws + WS_SB); unsigned* CMAX = (unsigned*)(ctl + CW_CMAX); bf16* PA = (bf16*)(ws + WS_B); bf16* CA = (bf16*)(ws + WS_B + 64 * MiB); bf16* X1 = (bf16*)(ws + WS_B);
    bf16* Mb = (bf16*)(ws + WS_C); unsigned short* IDX = (unsigned short*)(ws + WS_C); float* EV = (float*)(ws + WS_C + 16 * MiB);
    bf16* Zb = (bf16*)(ws + WS_A); _Float16* SC = (_Float16*)(ws + WS_A);

    for (int u = tid; u < (LDS_BYTES - LDSCTL_OFF) / 4; u += NWAVES * 64) ((LAS unsigned*)(lds + LDSCTL_OFF))[u] = 0u;
    __syncthreads();
    XcdBarrier bar; bar.bar = (unsigned*)(ctl + CW_BAR); bar.x = 0; bar.st = nullptr;
    if (N_LAUNCHES != PER_PHASE) bar = xcd_barrier_post((unsigned*)(ctl + CW_BAR), MISC + 8);
#define GRID_BAR() do { if (N_LAUNCHES != PER_PHASE) xcd_barrier(bar); } while (0)
    const int lo = args.ph_lo, hi = args.ph_hi;
#define IN(k) (lo <= (k) && (k) < hi)
#define BOTH(k) (IN(k) && IN((k) + 1))

    if (IN(0)) for (int rep_ = 0; rep_ < ((PROBE_REPEAT >> 0) & 1) + 1; ++rep_) {
        LAS float* scr = (LAS float*)(lds + wave * 16384);
        constexpr int I_WPP = 1024, I_CMAX = 16 * 16, I_WOUT = (1024 / 64) * (1024 / 32), I_WBC = (512 / 64) * (1024 / 32), I_WC = 512;
        constexpr int NITEMS = I_WPP + I_CMAX + I_WOUT + I_WBC + I_WC;
        for (int it = gw; it < NITEMS; it += NGW) {
            int r = it;
            if (r < I_WPP) { p0_wpp_item(w_q, sub_keys, g_ffn, Wpp_t, r, lane); continue; } r -= I_WPP;
            if (r < I_CMAX) { p0_colmax_item(w_in, 4096, CMAX, r, lane); continue; } r -= I_CMAX;
            if (r < I_WOUT) { p0_transpose_item(w_out, 1024, 1024, Wout_t, scr, r, lane); continue; } r -= I_WOUT;
            if (r < I_WBC) { p0_transpose_item(w_bc, 512, 1024, Wbc_t, scr, r, lane); continue; } r -= I_WBC;
            p0_wc_item(pool_gw, pool_scale, w_bp, Wc_t, r, lane);
        }
        GRID_BAR();
        for (int it = gw; it < (1024 / 64) * (4096 / 32); it += NGW) p0_transpose_i8_item(w_in, 1024, 4096, Winq, CMAX, SB, scr, it, lane);
        for (int e = gw; e < 2 * NE; e += NGW) {
            if (e < NE) p0_quant_row(expert_u, g_ffn, U8, SU, e, lane, false);
            else p0_quant_row(expert_v, nullptr, V8, SV, e - NE, lane, true);
        }
        for (int m = gw; m < M; m += 2 * NGW) p0_h_rows2(x, g_mix, Hq, SA, m, m + NGW, lane);
        if (BOTH(0)) GRID_BAR();
    }
    if (IN(1)) for (int rep_ = 0; rep_ < ((PROBE_REPEAT >> 1) & 1) + 1; ++rep_) {
        pg8::Gemm g{(const bf16*)Hq, (const bf16*)Winq, (const bf16*)Hq, (const bf16*)Winq, M, DIN, D / 2}; pg8::StaticOrder S; S.init(M, DIN, G, bx, 1);
        EpiZ E{Zb, DIN, SA, SB};
        pg8::gemm_phase<EpiZ, pg8::StaticOrder, true, true, true>(lds, g, S, E);
        if (BOTH(1)) GRID_BAR();
    }
    if (IN(2)) for (int rep_ = 0; rep_ < ((PROBE_REPEAT >> 2) & 1) + 1; ++rep_) {
        p2_timemix(Zb, conv_w, PA, CA, gw, NGW, lane);
        if (BOTH(2)) GRID_BAR();
    }
    if (IN(3)) for (int rep_ = 0; rep_ < ((PROBE_REPEAT >> 3) & 1) + 1; ++rep_) {
        pg8::Gemm g{PA, Wc_t, CA, Wbc_t, M, D, DP}; pg8::StaticOrder S; S.init(M, D, G, bx, 2);
        EpiGate E{Zb, Mb};
        pg8::gemm_phase<EpiGate, pg8::StaticOrder, true, true>(lds, g, S, E);
        if (BOTH(3)) GRID_BAR();
    }
    if (IN(4)) for (int rep_ = 0; rep_ < ((PROBE_REPEAT >> 4) & 1) + 1; ++rep_) {
        pg8::Gemm g{Mb, Wout_t, Mb, Wout_t, M, D, D}; pg8::StaticOrder S; S.init(M, D, G, bx, 1);
        EpiRes E{x, X1, SSQ};
        pg8::gemm_phase<EpiRes, pg8::StaticOrder, true, true>(lds, g, S, E);
        if (BOTH(4)) GRID_BAR();
    }
    if (IN(5)) for (int rep_ = 0; rep_ < ((PROBE_REPEAT >> 5) & 1) + 1; ++rep_) {
        pg8::Gemm g{X1, Wpp_t, X1, Wpp_t, M, NSC, D}; pg8::StaticOrder S; S.init(M, NSC, G, bx, 1);
        EpiScore E{SSQ, SC, RSTD};
        pg8::gemm_phase<EpiScore, pg8::StaticOrder, true, true>(lds, g, S, E);
        if (BOTH(5)) GRID_BAR();
    }
    if (IN(6)) for (int rep_ = 0; rep_ < ((PROBE_REPEAT >> 6) & 1) + 1; ++rep_) {
        p6_topk(SC, IDX, EV, INV, lds, gw, NGW, wave, lane);
        if (BOTH(6)) GRID_BAR();
    }
    const unsigned xcc = xb_xcc_id();
    if (IN(7)) for (int rep_ = 0; rep_ < ((PROBE_REPEAT >> 7) & 1) + 1; ++rep_) {
        p7_u_phase((unsigned*)(ctl + CW_QU + 2048 * rep_), xcc, X1, IDX, U8, PART, lane);
        if (BOTH(7)) GRID_BAR();
    }
    if (IN(8)) for (int rep_ = 0; rep_ < ((PROBE_REPEAT >> 8) & 1) + 1; ++rep_) {
        p8_w_phase(PART, RSTD, IDX, EV, INV, SU, SV, WV, WT, gw, NGW, lane);
        if (BOTH(8)) GRID_BAR();
    }
    if (IN(9)) for (int rep_ = 0; rep_ < ((PROBE_REPEAT >> 9) & 1) + 1; ++rep_) {
        p9_v_phase((unsigned*)(ctl + CW_QV + 2048 * rep_), xcc, X1, IDX, WV, WT, V8, args.out, SSQ2, lane);
        if (BOTH(9)) GRID_BAR();
    }
    if (IN(10)) {
        p10_final(args.out, SSQ2, g_final, gw, NGW, lane);
    }
#undef IN
#undef BOTH
#undef GRID_BAR
}

extern "C" void kernel_launch(void* const* d_in, const int* in_sizes, int n_in, void* d_out, int out_size, void* d_ws, size_t ws_size, hipStream_t stream) {
    static int grid = 0;
    if (grid == 0) {
        if (n_in != 15 || in_sizes[0] != M * D || out_size != M * D || ws_size < WS_END) { fprintf(stderr, "kernel_launch: unexpected shapes (n_in %d, in0 %d, out %d, ws %zu); nothing launched\n", n_in, n_in > 0 ? in_sizes[0] : -1, out_size, ws_size); grid = -1; return; }
        int dev = 0, cus = 0, per_cu = 0;
        if (hipGetDevice(&dev) != hipSuccess || hipDeviceGetAttribute(&cus, hipDeviceAttributeMultiprocessorCount, dev) != hipSuccess) { grid = -1; return; }
        if (hipFuncSetAttribute((const void*)fwd_kernel, hipFuncAttributeMaxDynamicSharedMemorySize, LDS_BYTES) != hipSuccess) { fprintf(stderr, "kernel_launch: hipFuncSetAttribute failed\n"); grid = -1; return; }
        if (hipOccupancyMaxActiveBlocksPerMultiprocessor(&per_cu, (const void*)fwd_kernel, NWAVES * 64, LDS_BYTES) != hipSuccess || per_cu < 1)
            fprintf(stderr, "kernel_launch: note: occupancy query reports %d workgroups per CU\n", per_cu);
        (void)hipGetLastError();
        grid = cus;
    }
    if (grid < 0) return;
    if (hipMemsetAsync((char*)d_ws + WS_CTL, 0, CTL_ZERO_BYTES, stream) != hipSuccess) { fprintf(stderr, "kernel_launch: hipMemsetAsync failed\n"); return; }
    Args a{};
    for (int i = 0; i < 15; ++i) a.in[i] = (const float*)d_in[i];
    a.out = (float*)d_out; a.ws = (unsigned char*)d_ws;
    for (int li = 0; li < N_LAUNCHES; ++li) {
        a.ph_lo = (N_LAUNCHES == PER_PHASE) ? li : 0; a.ph_hi = (N_LAUNCHES == PER_PHASE) ? li + 1 : PER_PHASE; a.li = li;
        hipLaunchKernelGGL(fwd_kernel, dim3(grid), dim3(NWAVES * 64), LDS_BYTES, stream, a);
        const hipError_t le = hipPeekAtLastError();
        if (le != hipSuccess) { fprintf(stderr, "kernel_launch: launch %d failed: %s\n", li, hipGetErrorName(le)); break; }
    }
}
```

```cpp
#include <hip/hip_runtime.h>
#include <cstdio>
#include <cstdint>

#ifndef PROBE_REPEAT
#define PROBE_REPEAT 0
#endif
#ifndef PROBE_GEMM_REP
#define PROBE_GEMM_REP 0
#endif
#ifndef MK_N_LAUNCHES
#define MK_N_LAUNCHES 1
#endif

namespace pg8 {
#define PG8_LAS __attribute__((address_space(3)))
typedef unsigned short bf16_t;
typedef short bf16x8 __attribute__((ext_vector_type(8)));
typedef float f32x4 __attribute__((ext_vector_type(4)));
typedef unsigned u32x4 __attribute__((ext_vector_type(4)));
constexpr int BM = 256, BK = 64, HALF = 128, HTB = HALF * BK * 2  , STAGE_BYTES = 8 * HTB, NXCD = 8, WGM = 8;

__host__ __device__ __forceinline__ int lds_byte(int r, int c) { const int st = (r >> 4) * 2 + (c >> 5), rr = r & 15, cc = c & 31, ob = rr * 64 + cc * 2; return st * 1024 + (ob ^ (((ob >> 9) & 1) << 5)); }
__host__ __device__ __forceinline__ void stage_rc(int b, int& R, int& C) { const int st = b / 1024, sb = b % 1024, swz = sb ^ (((sb >> 9) & 1) << 5); R = (st >> 1) * 16 + swz / 64; C = (st & 1) * 32 + (swz % 64) / 2; }
__host__ __device__ __forceinline__ int perm32(int rho) { const int n = rho >> 4, i = rho & 15; return 8 * (i >> 2) + 4 * n + (i & 3); }

struct Unit { int pm, pn, seg; };
struct Gemm { const bf16_t* A; const bf16_t* Bt; const bf16_t* A2; const bf16_t* Bt2; int M, N, K; };

struct StaticOrder {
    int nM, nN, nwg, G, c, segs, rep;
    __host__ __device__ void init(int M, int N, int G_, int c_, int segs_, int rep_ = 1) { nM = M / BM; nN = N / BM; nwg = nM * nN; G = G_; c = c_; segs = segs_; rep = rep_; }
    __host__ __device__ bool next(int i, Unit& u) const {
        const int ti = (segs == 2) ? (i >> 1) : i; u.seg = (segs == 2) ? (i & 1) : 0;
        const long L = (long)ti * G + c; if (L >= (long)nwg * rep) return false;
        int wgid = (int)(L % nwg); { const int q = nwg / NXCD, r = nwg % NXCD, xcd = wgid % NXCD, off = wgid / NXCD; wgid = (xcd < r ? xcd * (q + 1) : r * (q + 1) + (xcd - r) * q) + off; }
        const int nig = WGM * nN, gid = wgid / nig, fm = gid * WGM, gsz = (nM - fm) < WGM ? (nM - fm) : WGM;
        u.pm = fm + ((wgid % nig) % gsz); u.pn = (wgid % nig) / gsz; return true;
    }
    __device__ __forceinline__ void a_ready(const Unit&) const {}
    __device__ __forceinline__ void done(const Unit&) const {}
};

__device__ __forceinline__ unsigned cvt_pk_bf16(float lo, float hi) { unsigned r; asm volatile("v_cvt_pk_bf16_f32 %0, %1, %2" : "=v"(r) : "v"(lo), "v"(hi)); return r; }

typedef int i32x4 __attribute__((ext_vector_type(4)));
template <class Epi, class Sched, bool ALIGN_EPI = false, bool SP2 = false, bool I8 = false>
__device__ __forceinline__ void gemm_phase(PG8_LAS unsigned char* lds, const Gemm g, const Sched& S, const Epi& E) {
    const int tid = threadIdx.x, wid = __builtin_amdgcn_readfirstlane(tid >> 6), lane = tid & 63, wr = wid >> 2, wc = wid & 3, fr = lane & 15, fq = lane >> 4;
    const int K = g.K, nt = K / BK;
    unsigned voffA[2], voffB[2];
#pragma unroll
    for (int i = 0; i < 2; ++i) { int R, C; stage_rc(tid * 16 + i * 8192, R, C); const int Rb = Epi::PERM ? ((R & ~31) + perm32(R & 31)) : R;
        voffA[i] = (unsigned)(R * K + C) * 2u; voffB[i] = (unsigned)(Rb * K + C) * 2u; }
    const size_t kstep = (size_t)(BK * 2);
    const size_t hstep = (size_t)HALF * K * 2;
    const size_t tstep = 2 * hstep;
    const unsigned ldsw = (unsigned)wid * 1024u;
    const int aoff = lds_byte(wr * 64 + fr, fq * 8), boff = lds_byte(wc * 32 + fr, fq * 8);
#define PG8_SA(b, h) (((b) * 2 + (h)) * HTB)
#define PG8_SB(b, h) ((4 + (b) * 2 + (h)) * HTB)
#define PG8_STAGE(bufoff, gbase, voff) do { _Pragma("unroll") for (int _i = 0; _i < 2; ++_i) \
        __builtin_amdgcn_global_load_lds((const unsigned*)((const char*)(gbase) + (voff)[_i]), (PG8_LAS unsigned*)(lds + (bufoff) + ldsw + _i * 8192), 16, 0, 0); } while (0)
#define PG8_LDA(dst, b, h) do { _Pragma("unroll") for (int m = 0; m < 4; ++m) _Pragma("unroll") for (int k = 0; k < 2; ++k) dst[m][k] = *(const PG8_LAS bf16x8*)(lds + PG8_SA(b, h) + aoff + m * 2048 + k * 1024); } while (0)
#define PG8_LDB(dst, b, h) do { _Pragma("unroll") for (int n = 0; n < 2; ++n) _Pragma("unroll") for (int k = 0; k < 2; ++k) dst[n][k] = *(const PG8_LAS bf16x8*)(lds + PG8_SB(b, h) + boff + n * 2048 + k * 1024); } while (0)
#define PG8_MMA(ai, bj, At, Bt) do { __builtin_amdgcn_s_setprio(1); _Pragma("unroll") for (int m = 0; m < 4; ++m) _Pragma("unroll") for (int n = 0; n < 2; ++n) _Pragma("unroll") for (int k = 0; k < 2; ++k) { \
        if constexpr (I8) acc[ai][bj][m][n] = __builtin_bit_cast(f32x4, __builtin_amdgcn_mfma_i32_16x16x64_i8(__builtin_bit_cast(i32x4, Bt[n][k]), __builtin_bit_cast(i32x4, At[m][k]), __builtin_bit_cast(i32x4, acc[ai][bj][m][n]), 0, 0, 0)); \
        else acc[ai][bj][m][n] = __builtin_amdgcn_mfma_f32_16x16x32_bf16(Bt[n][k], At[m][k], acc[ai][bj][m][n], 0, 0, 0); } __builtin_amdgcn_s_setprio(0); } while (0)
#define PG8_WAIT_V(n) asm volatile("s_waitcnt vmcnt(" #n ")" ::: "memory")
#define PG8_WAIT_L(n) asm volatile("s_waitcnt lgkmcnt(" #n ")" ::: "memory")
#define PG8_BAR __builtin_amdgcn_s_barrier()
#define PG8_SCHED __builtin_amdgcn_sched_barrier(0)
    Unit cur, nxt; int ui = 0;
    if (!S.next(0, cur)) return;
    f32x4 acc[2][2][4][2];
#pragma unroll
    for (int a = 0; a < 2; ++a)
#pragma unroll
        for (int b = 0; b < 2; ++b)
#pragma unroll
            for (int m = 0; m < 4; ++m)
#pragma unroll
                for (int n = 0; n < 2; ++n) acc[a][b][m][n] = (f32x4){0.f, 0.f, 0.f, 0.f};
    bf16x8 At[4][2], B0[2][2], B1[2][2];
    const char* cA = (const char*)(cur.seg ? g.A2 : g.A) + (size_t)cur.pm * tstep; const char* cB = (const char*)(cur.seg ? g.Bt2 : g.Bt) + (size_t)cur.pn * tstep;
    S.a_ready(cur);
    if constexpr (SP2) {
        PG8_STAGE(PG8_SB(0, 0), cB, voffB); PG8_STAGE(PG8_SB(0, 1), cB + hstep, voffB); PG8_STAGE(PG8_SA(0, 0), cA, voffA); PG8_STAGE(PG8_SA(0, 1), cA + hstep, voffA);
        if (wr == 1) PG8_BAR;
        PG8_WAIT_V(2); PG8_BAR;
        PG8_STAGE(PG8_SB(1, 0), cB + kstep, voffB); PG8_STAGE(PG8_SA(1, 0), cA + kstep, voffA); PG8_STAGE(PG8_SB(1, 1), cB + hstep + kstep, voffB);
        PG8_WAIT_V(6); PG8_BAR;
    } else {
        PG8_STAGE(PG8_SB(0, 0), cB, voffB); PG8_STAGE(PG8_SA(0, 0), cA, voffA); PG8_STAGE(PG8_SB(0, 1), cB + hstep, voffB); PG8_STAGE(PG8_SA(0, 1), cA + hstep, voffA);
        if (wr == 1) PG8_BAR;
        PG8_WAIT_V(4); PG8_BAR;
        PG8_STAGE(PG8_SB(1, 0), cB + kstep, voffB); PG8_STAGE(PG8_SA(1, 0), cA + kstep, voffA); PG8_STAGE(PG8_SB(1, 1), cB + hstep + kstep, voffB);
        PG8_WAIT_V(6); PG8_BAR;
    }
    for (;;) {
        const bool has_next = S.next(ui + 1, nxt);
        const char* nA = has_next ? (const char*)(nxt.seg ? g.A2 : g.A) + (size_t)nxt.pm * tstep : cA; const char* nB = has_next ? (const char*)(nxt.seg ? g.Bt2 : g.Bt) + (size_t)nxt.pn * tstep : cB;
        for (int t = 0; t < nt; t += 2) {
            const bool last = (t == nt - 2);
            const char* a1 = cA + (size_t)(t + 1) * kstep;
            const char* a2 = last ? nA : cA + (size_t)(t + 2) * kstep; const char* b2 = last ? nB : cB + (size_t)(t + 2) * kstep;
            const char* a3 = a2 + kstep; const char* b3 = b2 + kstep;
            if (last && has_next) S.a_ready(nxt);
            if constexpr (SP2) {
            PG8_LDB(B0, 0, 0); PG8_LDB(B1, 0, 1); PG8_SCHED; PG8_LDA(At, 0, 0); PG8_STAGE(PG8_SA(1, 1), a1 + hstep, voffA);
            PG8_WAIT_V(8); PG8_WAIT_L(0); PG8_BAR; PG8_MMA(0, 0, At, B0); PG8_MMA(0, 1, At, B1); PG8_BAR; PG8_SCHED;
            PG8_LDA(At, 0, 1); PG8_STAGE(PG8_SB(0, 0), b2, voffB); PG8_STAGE(PG8_SB(0, 1), b2 + hstep, voffB); PG8_STAGE(PG8_SA(0, 0), a2, voffA);
            PG8_WAIT_V(8); PG8_WAIT_L(0); PG8_BAR; PG8_MMA(1, 0, At, B0); PG8_MMA(1, 1, At, B1); PG8_BAR; PG8_SCHED;
            PG8_LDB(B0, 1, 0); PG8_LDB(B1, 1, 1); PG8_SCHED; PG8_LDA(At, 1, 0); PG8_STAGE(PG8_SA(0, 1), a2 + hstep, voffA);
            PG8_WAIT_V(8); PG8_WAIT_L(0); PG8_BAR; PG8_MMA(0, 0, At, B0); PG8_MMA(0, 1, At, B1); PG8_BAR; PG8_SCHED;
            PG8_LDA(At, 1, 1); PG8_STAGE(PG8_SB(1, 0), b3, voffB); PG8_STAGE(PG8_SB(1, 1), b3 + hstep, voffB); PG8_STAGE(PG8_SA(1, 0), a3, voffA);
            PG8_WAIT_V(8); PG8_WAIT_L(0); PG8_BAR; PG8_MMA(1, 0, At, B0); PG8_MMA(1, 1, At, B1); PG8_BAR; PG8_SCHED;
            } else {
            PG8_LDB(B0, 0, 0); PG8_SCHED; PG8_LDA(At, 0, 0); PG8_STAGE(PG8_SA(1, 1), a1 + hstep, voffA);
            PG8_WAIT_L(8); PG8_BAR; PG8_WAIT_L(0); PG8_MMA(0, 0, At, B0); PG8_BAR; PG8_SCHED;
            PG8_LDB(B1, 0, 1); PG8_STAGE(PG8_SB(0, 0), b2, voffB);
            PG8_BAR; PG8_WAIT_L(0); PG8_MMA(0, 1, At, B1); PG8_BAR;
            PG8_LDA(At, 0, 1); PG8_STAGE(PG8_SA(0, 0), a2, voffA);
            PG8_BAR; PG8_WAIT_L(0); PG8_MMA(1, 0, At, B0); PG8_BAR; PG8_SCHED;
            PG8_STAGE(PG8_SB(0, 1), b2 + hstep, voffB);
            PG8_WAIT_V(6); PG8_BAR; PG8_MMA(1, 1, At, B1); PG8_BAR;
            PG8_LDB(B0, 1, 0); PG8_SCHED; PG8_LDA(At, 1, 0); PG8_STAGE(PG8_SA(0, 1), a2 + hstep, voffA);
            PG8_WAIT_L(8); PG8_BAR; PG8_WAIT_L(0); PG8_MMA(0, 0, At, B0); PG8_BAR; PG8_SCHED;
            PG8_LDB(B1, 1, 1); PG8_STAGE(PG8_SB(1, 0), b3, voffB);
            PG8_BAR; PG8_WAIT_L(0); PG8_MMA(0, 1, At, B1); PG8_BAR;
            PG8_LDA(At, 1, 1); PG8_STAGE(PG8_SA(1, 0), a3, voffA);
            PG8_BAR; PG8_WAIT_L(0); PG8_MMA(1, 0, At, B0); PG8_BAR; PG8_SCHED;
            PG8_STAGE(PG8_SB(1, 1), b3 + hstep, voffB);
            PG8_WAIT_V(6); PG8_BAR; PG8_MMA(1, 1, At, B1); PG8_BAR;
            }
        }
        if constexpr (ALIGN_EPI) { if (wr == 0) PG8_BAR; }
        const bool keep = E(acc, cur, wr, wc, fr, fq); S.done(cur);
        if (!has_next) break;
        if (!keep) {
#pragma unroll
        for (int a = 0; a < 2; ++a)
#pragma unroll
            for (int b = 0; b < 2; ++b)
#pragma unroll
                for (int m = 0; m < 4; ++m)
#pragma unroll
                    for (int n = 0; n < 2; ++n) acc[a][b][m][n] = (f32x4){0.f, 0.f, 0.f, 0.f};
        }
        cur = nxt; cA = nA; cB = nB; ++ui;
        if constexpr (ALIGN_EPI) { if (wr == 1) PG8_BAR; }
    }
    PG8_WAIT_V(0);
    if constexpr (!ALIGN_EPI) { if (wr == 0) PG8_BAR; }
    PG8_BAR;
#undef PG8_SA
#undef PG8_SB
#undef PG8_STAGE
#undef PG8_LDA
#undef PG8_LDB
#undef PG8_MMA
#undef PG8_WAIT_V
#undef PG8_WAIT_L
#undef PG8_BAR
#undef PG8_SCHED
}
}

constexpr int NWAVES = 8;
constexpr int M = 65536, D = 1024, SEQ = 4096, DIN = 4096, DP = 512, NSC = 2048, NE = 16384, NH = 8, TOPK = 16;
constexpr float RMS_EPS = 1e-6f;
constexpr int N_LAUNCHES = MK_N_LAUNCHES;
constexpr int PER_PHASE = 11;
constexpr int TPI = 32;

constexpr size_t MiB = 1u << 20;
constexpr size_t WS_CTL = 0, CTL_ZERO_BYTES = 1 * MiB;
constexpr size_t WS_WIN = 1 * MiB;
constexpr size_t WS_WC = 9 * MiB;
constexpr size_t WS_WBC = 10 * MiB;
constexpr size_t WS_WOUT = 11 * MiB;
constexpr size_t WS_WPP = 13 * MiB;
constexpr size_t WS_SU = 17 * MiB;
constexpr size_t WS_SV = 17 * MiB + 65536;
constexpr size_t WS_SSQ = 18 * MiB;
constexpr size_t WS_U8 = 22 * MiB;
constexpr size_t WS_V8 = 38 * MiB;
constexpr size_t WS_INV = 54 * MiB;
constexpr size_t WS_SSQ2 = 56 * MiB;
constexpr size_t WS_RSTD = 58 * MiB;
constexpr size_t WS_WT = 58 * MiB + 512 * 1024;
constexpr size_t WS_SA = 59 * MiB;
constexpr size_t WS_SB = 59 * MiB + 512 * 1024;
constexpr int CW_CMAX = 32768;
constexpr size_t WS_WV = 192 * MiB + 48 * MiB;
constexpr size_t WS_PART = 576 * MiB;
constexpr size_t WS_B = 64 * MiB;
constexpr size_t WS_C = 192 * MiB;
constexpr size_t WS_A = 320 * MiB;
constexpr size_t WS_END = 832 * MiB;
constexpr int CW_BAR = 4096;
constexpr int CW_QU = 16384, CW_QV = 16384 + 1024;

constexpr int RING_BYTES = 131072;
constexpr int LDSCTL_OFF = RING_BYTES, MISC_OFF = LDSCTL_OFF + 320;
constexpr int LDS_BYTES = 147456;

#define GAS __attribute__((address_space(1)))
#define LAS __attribute__((address_space(3)))
typedef unsigned short bf16;
typedef unsigned v4u __attribute__((ext_vector_type(4)));
typedef unsigned v2u __attribute__((ext_vector_type(2)));
typedef float f32x4 __attribute__((ext_vector_type(4)));
typedef GAS unsigned gu32;
#define RLX_AGENT __ATOMIC_RELAXED, __HIP_MEMORY_SCOPE_AGENT
#define LDS_WAIT() asm volatile("s_waitcnt lgkmcnt(0)" ::: "memory")
#define VM_WAIT() asm volatile("s_waitcnt vmcnt(0)" ::: "memory")
__device__ __forceinline__ unsigned f2bf(float f) { unsigned u = __builtin_bit_cast(unsigned, f); return (u + 0x7fffu + ((u >> 16) & 1u)) >> 16; }
__device__ __forceinline__ unsigned pk2(float lo, float hi) { return f2bf(lo) | (f2bf(hi) << 16); }
__device__ __forceinline__ float bflo(unsigned w) { return __builtin_bit_cast(float, w << 16); }
__device__ __forceinline__ float bfhi(unsigned w) { return __builtin_bit_cast(float, w & 0xffff0000u); }
__device__ __forceinline__ float wave_sum(float v) {
#pragma unroll
    for (int o = 1; o < 64; o <<= 1) v += __shfl_xor(v, o);
    return v;
}
__device__ __forceinline__ float wave_max(float v) {
#pragma unroll
    for (int o = 1; o < 64; o <<= 1) v = fmaxf(v, __shfl_xor(v, o));
    return v;
}

#define XB_TMO      128
#define XB_XCNT(j)  (256  + 64 * (j))
#define XB_XSUB(j)  (1280 + 64 * (j))
#define XB_XGEN(j)  (2304 + 64 * (j))
#define XB_TOP      3328
#define XB_TOPGEN   3392
#define XCD_BAR_WORDS 3456
#define XB_SPIN_CAP (1u << 18)
__device__ __forceinline__ unsigned xb_ld(unsigned* p)              { return __hip_atomic_load(p, __ATOMIC_RELAXED, __HIP_MEMORY_SCOPE_AGENT); }
__device__ __forceinline__ unsigned xb_add(unsigned* p, unsigned v) { return __hip_atomic_fetch_add(p, v, __ATOMIC_RELAXED, __HIP_MEMORY_SCOPE_AGENT); }
__device__ __forceinline__ unsigned xb_xcc_id() { return (unsigned)__builtin_amdgcn_s_getreg((3 << 11) | 20) & 0xFu; }
#define XB_SPIN(cond, bar) do { unsigned _sp = 0; while (cond) { __builtin_amdgcn_s_sleep(1); \
    if ((++_sp & 255u) == 0u) { if (xb_ld(&(bar)[XB_TMO])) break; if (_sp > XB_SPIN_CAP) { atomicAdd(&(bar)[XB_TMO], 1u); break; } } } } while (0)
struct XcdBarrier { unsigned* bar; unsigned x; volatile LAS unsigned* st; };
__device__ __forceinline__ XcdBarrier xcd_barrier_post(unsigned* bar, volatile LAS unsigned* st) {
    XcdBarrier b; b.bar = bar; b.x = xb_xcc_id(); b.st = st;
    if (threadIdx.x == 0) (void)xb_add(&bar[XB_XCNT(b.x)], 1u);
    return b;
}
__device__ __forceinline__ void xcd_barrier_complete(unsigned* bar, unsigned x, unsigned& nloc, unsigned& nx) {
    const unsigned G = gridDim.x * gridDim.y * gridDim.z;
    unsigned sum, cnt, mine, sp = 0u;
    for (;;) {
        sum = 0u; cnt = 0u; mine = 0u;
#pragma unroll
        for (unsigned j = 0; j < 16; ++j) { const unsigned c = xb_ld(&bar[XB_XCNT(j)]); sum += c; cnt += (c > 0u) ? 1u : 0u; mine = (j == x) ? c : mine; }
        if (sum == G) break;
        __builtin_amdgcn_s_sleep(1);
        if ((++sp & 255u) == 0u) { if (xb_ld(&bar[XB_TMO])) break; if (sp > XB_SPIN_CAP) { atomicAdd(&bar[XB_TMO], 1u); break; } }
    }
    nloc = mine > 0u ? mine : 1u; nx = cnt > 0u ? cnt : 1u;
}
__device__ __forceinline__ void xcd_barrier(const XcdBarrier& b) {
    asm volatile("s_waitcnt vmcnt(0)" ::: "memory");
    __syncthreads();
    if (threadIdx.x == 0) {
        unsigned* bar = b.bar;
        __builtin_amdgcn_s_waitcnt(0);
        unsigned nloc = b.st[0], nx = b.st[1];
        if (nloc == 0u) { xcd_barrier_complete(bar, b.x, nloc, nx); b.st[0] = nloc; b.st[1] = nx; }
        const unsigned old = xb_add(&bar[XB_XSUB(b.x)], 1u);
        const unsigned gen = old / nloc;
        if (old + 1u == (gen + 1u) * nloc) {
            __builtin_amdgcn_fence(__ATOMIC_RELEASE, "agent");
            asm volatile("s_waitcnt vmcnt(0)" ::: "memory");
            const unsigned og = xb_add(&bar[XB_TOP], 1u);
            const unsigned tg = og / nx;
            if (og + 1u == (tg + 1u) * nx) xb_add(&bar[XB_TOPGEN], 1u);
            else XB_SPIN(xb_ld(&bar[XB_TOPGEN]) == tg, bar);
            __builtin_amdgcn_fence(__ATOMIC_ACQUIRE, "agent");
            xb_add(&bar[XB_XGEN(b.x)], 1u);
            asm volatile("s_waitcnt vmcnt(0)" ::: "memory");
        } else {
            XB_SPIN(xb_ld(&bar[XB_XGEN(b.x)]) == gen, bar);
            __builtin_amdgcn_fence(__ATOMIC_ACQUIRE, "agent");
            asm volatile("s_waitcnt vmcnt(0)" ::: "memory");
        }
    }
    __syncthreads();
}

__device__ __forceinline__ void p0_transpose_item(const float* W, int K, int N, bf16* WT, LAS float* scr, int item, int lane) {
    const int nblk = N / 32, kb = item / nblk, nb = item % nblk, k0 = 64 * kb, n0 = 32 * nb;
#pragma unroll 8
    for (int i = 0; i < 32; ++i) { const int kk = 2 * i + (lane >> 5); scr[kk * 33 + (lane & 31)] = W[(size_t)(k0 + kk) * N + n0 + (lane & 31)]; }
    LDS_WAIT(); asm volatile("" ::: "memory");
    const int c = lane & 7;
#pragma unroll
    for (int j = 0; j < 4; ++j) { const int n = (lane >> 3) + 8 * j; const LAS float* s = scr + (8 * c) * 33 + n;
        v4u o; o.x = pk2(s[0 * 33], s[1 * 33]); o.y = pk2(s[2 * 33], s[3 * 33]); o.z = pk2(s[4 * 33], s[5 * 33]); o.w = pk2(s[6 * 33], s[7 * 33]);
        *(v4u*)(WT + (size_t)(n0 + n) * K + k0 + 8 * c) = o; }
    LDS_WAIT(); asm volatile("" ::: "memory");
}
__device__ __forceinline__ void p0_wc_item(const float* gwt, const float* scale, const float* wbp, bf16* WcT, int item, int lane) {
    const int nb = item & 15, cb = (item >> 4) & 7, g = item >> 7;
    const int n = nb * 64 + lane;
    float acc[16];
#pragma unroll
    for (int c = 0; c < 16; ++c) acc[c] = 0.f;
    for (int d = 0; d < 128; ++d) {
        const float b = wbp[(size_t)(g * 128 + d) * 1024 + n] * scale[g * 128 + d];
#pragma unroll
        for (int c = 0; c < 16; ++c) acc[c] += gwt[(size_t)((g * 128 + cb * 16 + c) * 128) + d] * b;
    }
    v4u o0, o1;
    o0.x = pk2(acc[0], acc[1]); o0.y = pk2(acc[2], acc[3]); o0.z = pk2(acc[4], acc[5]); o0.w = pk2(acc[6], acc[7]);
    o1.x = pk2(acc[8], acc[9]); o1.y = pk2(acc[10], acc[11]); o1.z = pk2(acc[12], acc[13]); o1.w = pk2(acc[14], acc[15]);
    bf16* dst = WcT + (size_t)n * 512 + g * 128 + cb * 16;
    *(v4u*)dst = o0; *(v4u*)(dst + 8) = o1;
}
__device__ __forceinline__ void p0_wpp_item(const float* wq, const float* keys, const float* gffn, bf16* WppT, LAS float* scr, int item, int lane) {
    const int kb = item & 3, db = (item >> 2) & 15, hp = item >> 6;
    const int d = db * 64 + lane;
    const f32x4* kbase = (const f32x4*)(keys + (size_t)(hp * 128 + kb * 32) * 128);
    LAS f32x4* kt = (LAS f32x4*)scr;
#pragma unroll
    for (int i = 0; i < 16; ++i) kt[i * 64 + lane] = kbase[i * 64 + lane];
    float acc[32];
#pragma unroll
    for (int k = 0; k < 32; ++k) acc[k] = 0.f;
    const float* arow = wq + (size_t)d * 2048 + hp * 128;
    LDS_WAIT(); asm volatile("" ::: "memory");
#pragma unroll 4
    for (int c4 = 0; c4 < 32; ++c4) {
        const f32x4 a = *(const f32x4*)(arow + 4 * c4);
#pragma unroll
        for (int k = 0; k < 32; ++k) { const f32x4 kr = kt[k * 32 + c4]; acc[k] += (a.x * kr.x + a.y * kr.y) + (a.z * kr.z + a.w * kr.w); }
    }
    const float gs = gffn[d];
#pragma unroll
    for (int k = 0; k < 32; ++k) WppT[(size_t)(hp * 128 + kb * 32 + k) * 1024 + d] = (bf16)f2bf(acc[k] * gs);
    LDS_WAIT(); asm volatile("" ::: "memory");
}
__device__ __forceinline__ void p0_h_row(const float* xrow, const float* g, bf16* orow, int lane) {
    const f32x4* xr = (const f32x4*)xrow + lane; const f32x4* gr = (const f32x4*)g + lane;
    f32x4 v[4]; float s = 0.f;
#pragma unroll
    for (int j = 0; j < 4; ++j) { v[j] = xr[64 * j]; s += (v[j].x * v[j].x + v[j].y * v[j].y) + (v[j].z * v[j].z + v[j].w * v[j].w); }
    const float rstd = rsqrtf(wave_sum(s) * (1.f / D) + RMS_EPS);
    v2u* o8 = (v2u*)orow + lane;
#pragma unroll
    for (int j = 0; j < 4; ++j) { const f32x4 gg = gr[64 * j]; v2u o; o.x = pk2(v[j].x * rstd * gg.x, v[j].y * rstd * gg.y); o.y = pk2(v[j].z * rstd * gg.z, v[j].w * rstd * gg.w); o8[64 * j] = o; }
}
__device__ __forceinline__ void p0_h_rows2(const float* x, const float* g, unsigned char* Hq, float* SA, int m0, int m1, int lane) {
    const f32x4* xr0 = (const f32x4*)(x + (size_t)m0 * D) + lane; const f32x4* xr1 = (const f32x4*)(x + (size_t)m1 * D) + lane; const f32x4* gr = (const f32x4*)g + lane;
    f32x4 v0[4], v1[4]; float s0 = 0.f, s1 = 0.f;
#pragma unroll
    for (int j = 0; j < 4; ++j) { v0[j] = xr0[64 * j]; v1[j] = xr1[64 * j]; }
#pragma unroll
    for (int j = 0; j < 4; ++j) { s0 += (v0[j].x * v0[j].x + v0[j].y * v0[j].y) + (v0[j].z * v0[j].z + v0[j].w * v0[j].w); s1 += (v1[j].x * v1[j].x + v1[j].y * v1[j].y) + (v1[j].z * v1[j].z + v1[j].w * v1[j].w); }
    const float r0 = rsqrtf(wave_sum(s0) * (1.f / D) + RMS_EPS), r1 = rsqrtf(wave_sum(s1) * (1.f / D) + RMS_EPS);
    float mx0 = 0.f, mx1 = 0.f;
#pragma unroll
    for (int j = 0; j < 4; ++j) { const f32x4 gg = gr[64 * j]; v0[j] = v0[j] * gg * r0; v1[j] = v1[j] * gg * r1;
        mx0 = fmaxf(mx0, fmaxf(fmaxf(fabsf(v0[j].x), fabsf(v0[j].y)), fmaxf(fabsf(v0[j].z), fabsf(v0[j].w))));
        mx1 = fmaxf(mx1, fmaxf(fmaxf(fabsf(v1[j].x), fabsf(v1[j].y)), fmaxf(fabsf(v1[j].z), fabsf(v1[j].w)))); }
    mx0 = wave_max(mx0); mx1 = wave_max(mx1);
    const float sc0 = mx0 > 0.f ? mx0 * (1.f / 127.f) : 1.f, sc1 = mx1 > 0.f ? mx1 * (1.f / 127.f) : 1.f, i0 = 1.f / sc0, i1 = 1.f / sc1;
    unsigned* o0 = (unsigned*)(Hq + (size_t)m0 * D) + lane; unsigned* o1 = (unsigned*)(Hq + (size_t)m1 * D) + lane;
#pragma unroll
    for (int j = 0; j < 4; ++j) { unsigned a = 0, b = 0;
#pragma unroll
        for (int c = 0; c < 4; ++c) { int q = (int)rintf(v0[j][c] * i0); q = q > 127 ? 127 : (q < -127 ? -127 : q); a |= ((unsigned)q & 0xffu) << (8 * c);
            int q1 = (int)rintf(v1[j][c] * i1); q1 = q1 > 127 ? 127 : (q1 < -127 ? -127 : q1); b |= ((unsigned)q1 & 0xffu) << (8 * c); }
        o0[64 * j] = a; o1[64 * j] = b; }
    if (lane == 0) { SA[m0] = sc0; SA[m1] = sc1; }
}
__device__ __forceinline__ void p0_colmax_item(const float* W, int N, unsigned* cmax, int item, int lane) {
    const int nblk = N / 256, kb = item / nblk, nb = item % nblk;
    const float* p = W + (size_t)(kb * 64) * N + nb * 256 + 4 * lane;
    f32x4 mx = {0.f, 0.f, 0.f, 0.f};
#pragma unroll 8
    for (int k = 0; k < 64; ++k) { const f32x4 v = *(const f32x4*)(p + (size_t)k * N); mx.x = fmaxf(mx.x, fabsf(v.x)); mx.y = fmaxf(mx.y, fabsf(v.y)); mx.z = fmaxf(mx.z, fabsf(v.z)); mx.w = fmaxf(mx.w, fabsf(v.w)); }
    unsigned* c = cmax + nb * 256 + 4 * lane;
    atomicMax(c + 0, __builtin_bit_cast(unsigned, mx.x)); atomicMax(c + 1, __builtin_bit_cast(unsigned, mx.y)); atomicMax(c + 2, __builtin_bit_cast(unsigned, mx.z)); atomicMax(c + 3, __builtin_bit_cast(unsigned, mx.w));
}
__device__ __forceinline__ void p0_transpose_i8_item(const float* W, int K, int N, unsigned char* WT, const unsigned* cmax, float* SB, LAS float* scr, int item, int lane) {
    const int nblk = N / 32, kb = item / nblk, nb = item % nblk, k0 = 64 * kb, n0 = 32 * nb;
#pragma unroll 8
    for (int i = 0; i < 32; ++i) { const int kk = 2 * i + (lane >> 5); scr[kk * 33 + (lane & 31)] = W[(size_t)(k0 + kk) * N + n0 + (lane & 31)]; }
    LDS_WAIT(); asm volatile("" ::: "memory");
    const int c = lane & 3;
#pragma unroll
    for (int j = 0; j < 2; ++j) { const int n = (lane >> 2) + 16 * j; const LAS float* s = scr + (16 * c) * 33 + n;
        const float mxv = __builtin_bit_cast(float, cmax[n0 + n]); const float sc = mxv > 0.f ? mxv * (1.f / 127.f) : 1.f, inv = 1.f / sc;
        if (kb == 0 && c == 0) SB[n0 + n] = sc;
        v4u o;
#pragma unroll
        for (int q4 = 0; q4 < 4; ++q4) { unsigned a = 0;
#pragma unroll
            for (int b = 0; b < 4; ++b) { int q = (int)rintf(s[(4 * q4 + b) * 33] * inv); q = q > 127 ? 127 : (q < -127 ? -127 : q); a |= ((unsigned)q & 0xffu) << (8 * b); }
            o[q4] = a; }
        *(v4u*)(WT + (size_t)(n0 + n) * K + k0 + 16 * c) = o; }
    LDS_WAIT(); asm volatile("" ::: "memory");
}
template <bool FP8>
__device__ __forceinline__ void p0_quant_rows2(const float* src, const float* gmul, unsigned char* dst, float* scale_out, int e0, int e1, int lane) {
    const f32x4* p0 = (const f32x4*)(src + (size_t)e0 * 1024 + 16 * lane); const f32x4* p1 = (const f32x4*)(src + (size_t)e1 * 1024 + 16 * lane);
    f32x4 v[2][4];
#pragma unroll
    for (int j = 0; j < 4; ++j) { v[0][j] = p0[j]; v[1][j] = p1[j]; }
    if (gmul) { const f32x4* gp = (const f32x4*)(gmul + 16 * lane);
#pragma unroll
        for (int j = 0; j < 4; ++j) { const f32x4 gg = gp[j]; v[0][j] = v[0][j] * gg; v[1][j] = v[1][j] * gg; } }
#pragma unroll
    for (int r = 0; r < 2; ++r) {
        float mx = 0.f;
#pragma unroll
        for (int j = 0; j < 4; ++j) mx = fmaxf(mx, fmaxf(fmaxf(fabsf(v[r][j].x), fabsf(v[r][j].y)), fmaxf(fabsf(v[r][j].z), fabsf(v[r][j].w))));
        mx = wave_max(mx);
        const float sc = mx > 0.f ? mx * (FP8 ? (1.f / 448.f) : (1.f / 127.f)) : 1.f, inv = 1.f / sc;
        v4u w;
#pragma unroll
        for (int j = 0; j < 4; ++j) {
            if (FP8) { int pk = __builtin_amdgcn_cvt_pk_fp8_f32(v[r][j].x * inv, v[r][j].y * inv, 0, false); pk = __builtin_amdgcn_cvt_pk_fp8_f32(v[r][j].z * inv, v[r][j].w * inv, pk, true); w[j] = (unsigned)pk; }
            else { unsigned acc = 0;
#pragma unroll
                for (int c = 0; c < 4; ++c) { int q = (int)rintf(v[r][j][c] * inv); q = q > 127 ? 127 : (q < -127 ? -127 : q); acc |= ((unsigned)q & 0xffu) << (8 * c); }
                w[j] = acc; }
        }
        const int e = r ? e1 : e0;
        *(v4u*)(dst + ((size_t)(lane >> 3) * NE + e) * 128 + 16 * (lane & 7)) = w;
        if (lane == 0) scale_out[e] = sc;
    }
}

typedef pg8::f32x4 (&AccRef)[2][2][4][2];
struct EpiZ {
    static constexpr bool PERM = true;
    bf16* O; int ldc; const float* SA; const float* SB;
    __device__ __forceinline__ bool operator()(AccRef acc, const pg8::Unit& u, int wr, int wc, int fr, int fq) const {
        const int row0 = u.pm * 256 + wr * 64 + fr, col0 = u.pn * 256 + wc * 32 + 8 * fq;
        pg8::f32x4 sb[2][2];
#pragma unroll
        for (int bj = 0; bj < 2; ++bj) { sb[bj][0] = *(const pg8::f32x4*)(SB + col0 + bj * 128); sb[bj][1] = *(const pg8::f32x4*)(SB + col0 + bj * 128 + 4); }
#pragma unroll
        for (int ai = 0; ai < 2; ++ai)
#pragma unroll
            for (int m = 0; m < 4; ++m) { const int r = row0 + ai * 128 + m * 16; bf16* rowp = O + (size_t)r * ldc + col0; const float sa = SA[r];
#pragma unroll
                for (int bj = 0; bj < 2; ++bj) { const pg8::i32x4 i0 = __builtin_bit_cast(pg8::i32x4, acc[ai][bj][m][0]), i1 = __builtin_bit_cast(pg8::i32x4, acc[ai][bj][m][1]);
                    pg8::f32x4 v0 = {(float)i0[0], (float)i0[1], (float)i0[2], (float)i0[3]}, v1 = {(float)i1[0], (float)i1[1], (float)i1[2], (float)i1[3]};
                    v0 = v0 * sb[bj][0] * sa; v1 = v1 * sb[bj][1] * sa; v4u w;
                    w.x = pg8::cvt_pk_bf16(v0[0], v0[1]); w.y = pg8::cvt_pk_bf16(v0[2], v0[3]); w.z = pg8::cvt_pk_bf16(v1[0], v1[1]); w.w = pg8::cvt_pk_bf16(v1[2], v1[3]);
                    *(v4u*)(rowp + bj * 128) = w; } }
        return false;
    }
};
__device__ __forceinline__ float einv(float x) { return 1.f + __builtin_amdgcn_exp2f(x * -1.44269504089f); }
__device__ __forceinline__ float sigm_ratio(float ga, float gb) { return einv(gb) * __builtin_amdgcn_rcpf(einv(ga)); }
struct EpiGate {
    static constexpr bool PERM = true;
    const bf16* Z; bf16* Mo;
    __device__ __forceinline__ bool operator()(AccRef acc, const pg8::Unit& u, int wr, int wc, int fr, int fq) const {
        const int row0 = u.pm * 256 + wr * 64 + fr, col0 = u.pn * 256 + wc * 32 + 8 * fq;
        if (u.seg == 0) {
#pragma unroll
            for (int ai = 0; ai < 2; ++ai)
#pragma unroll
                for (int m = 0; m < 4; ++m) { const bf16* zr = Z + (size_t)(row0 + ai * 128 + m * 16) * DIN + col0;
#pragma unroll
                    for (int bj = 0; bj < 2; ++bj) { const v4u a = *(const v4u*)(zr + 2048 + bj * 128), b = *(const v4u*)(zr + 3072 + bj * 128);
                        pg8::f32x4& v0 = acc[ai][bj][m][0]; pg8::f32x4& v1 = acc[ai][bj][m][1];
                        v0[0] *= sigm_ratio(bflo(a.x), bflo(b.x)); v0[1] *= sigm_ratio(bfhi(a.x), bfhi(b.x)); v0[2] *= sigm_ratio(bflo(a.y), bflo(b.y)); v0[3] *= sigm_ratio(bfhi(a.y), bfhi(b.y));
                        v1[0] *= sigm_ratio(bflo(a.z), bflo(b.z)); v1[1] *= sigm_ratio(bfhi(a.z), bfhi(b.z)); v1[2] *= sigm_ratio(bflo(a.w), bflo(b.w)); v1[3] *= sigm_ratio(bfhi(a.w), bfhi(b.w)); } }
            return true;
        }
#pragma unroll
        for (int ai = 0; ai < 2; ++ai)
#pragma unroll
            for (int m = 0; m < 4; ++m) { const size_t r = (size_t)(row0 + ai * 128 + m * 16); const bf16* zr = Z + r * DIN + col0; bf16* mo = Mo + r * D + col0;
#pragma unroll
                for (int bj = 0; bj < 2; ++bj) { const v4u b = *(const v4u*)(zr + 3072 + bj * 128);
                    const pg8::f32x4 v0 = acc[ai][bj][m][0], v1 = acc[ai][bj][m][1]; v4u w;
#define SG(x) __builtin_amdgcn_rcpf(einv(x))
                    w.x = pg8::cvt_pk_bf16(v0[0] * SG(bflo(b.x)), v0[1] * SG(bfhi(b.x))); w.y = pg8::cvt_pk_bf16(v0[2] * SG(bflo(b.y)), v0[3] * SG(bfhi(b.y)));
                    w.z = pg8::cvt_pk_bf16(v1[0] * SG(bflo(b.z)), v1[1] * SG(bfhi(b.z))); w.w = pg8::cvt_pk_bf16(v1[2] * SG(bflo(b.w)), v1[3] * SG(bfhi(b.w)));
#undef SG
                    *(v4u*)(mo + bj * 128) = w; } }
        return false;
    }
};
struct EpiRes {
    static constexpr bool PERM = true;
    const float* X; bf16* X1; float* SSQ;
    __device__ __forceinline__ bool operator()(AccRef acc, const pg8::Unit& u, int wr, int wc, int fr, int fq) const {
        const int row0 = u.pm * 256 + wr * 64 + fr, col0 = u.pn * 256 + wc * 32 + 8 * fq;
#pragma unroll
        for (int ai = 0; ai < 2; ++ai)
#pragma unroll
            for (int m = 0; m < 4; ++m) { const size_t r = (size_t)(row0 + ai * 128 + m * 16); const float* xr = X + r * D + col0; bf16* o = X1 + r * D + col0; float ss = 0.f;
#pragma unroll
                for (int bj = 0; bj < 2; ++bj) { const pg8::f32x4 x0 = *(const pg8::f32x4*)(xr + bj * 128), x1v = *(const pg8::f32x4*)(xr + bj * 128 + 4);
                    const pg8::f32x4 v0 = acc[ai][bj][m][0] + x0, v1 = acc[ai][bj][m][1] + x1v;
                    ss += (v0[0] * v0[0] + v0[1] * v0[1]) + (v0[2] * v0[2] + v0[3] * v0[3]) + (v1[0] * v1[0] + v1[1] * v1[1]) + (v1[2] * v1[2] + v1[3] * v1[3]);
                    v4u w; w.x = pg8::cvt_pk_bf16(v0[0], v0[1]); w.y = pg8::cvt_pk_bf16(v0[2], v0[3]); w.z = pg8::cvt_pk_bf16(v1[0], v1[1]); w.w = pg8::cvt_pk_bf16(v1[2], v1[3]);
                    *(v4u*)(o + bj * 128) = w; }
                ss += __shfl_xor(ss, 16); ss += __shfl_xor(ss, 32);
                if (fq == 0) SSQ[r * 16 + u.pn * 4 + wc] = ss; }
        return false;
    }
};
struct EpiScore {
    static constexpr bool PERM = true;
    const float* SSQ; _Float16* S; float* RSTD;
    __device__ __forceinline__ bool operator()(AccRef acc, const pg8::Unit& u, int wr, int wc, int fr, int fq) const {
        const int row0 = u.pm * 256 + wr * 64 + fr, col0 = u.pn * 256 + wc * 32 + 8 * fq;
#pragma unroll
        for (int ai = 0; ai < 2; ++ai)
#pragma unroll
            for (int m = 0; m < 4; ++m) { const size_t r = (size_t)(row0 + ai * 128 + m * 16);
                const pg8::f32x4* sp = (const pg8::f32x4*)(SSQ + r * 16); const pg8::f32x4 s0 = sp[0], s1 = sp[1], s2 = sp[2], s3 = sp[3];
                const float tot = ((s0[0] + s0[1]) + (s0[2] + s0[3])) + ((s1[0] + s1[1]) + (s1[2] + s1[3])) + ((s2[0] + s2[1]) + (s2[2] + s2[3])) + ((s3[0] + s3[1]) + (s3[2] + s3[3]));
                const float rstd = rsqrtf(tot * (1.f / D) + RMS_EPS);
                if (u.pn == 0 && wc == 0 && fq == 0) RSTD[r] = rstd;
                _Float16* o = S + r * NSC + col0;
#pragma unroll
                for (int bj = 0; bj < 2; ++bj) { const pg8::f32x4 v0 = acc[ai][bj][m][0] * rstd, v1 = acc[ai][bj][m][1] * rstd;
                    typedef _Float16 h2 __attribute__((ext_vector_type(2)));
                    h2 p0 = {(_Float16)v0[0], (_Float16)v0[1]}, p1 = {(_Float16)v0[2], (_Float16)v0[3]}, p2 = {(_Float16)v1[0], (_Float16)v1[1]}, p3 = {(_Float16)v1[2], (_Float16)v1[3]};
                    v4u w; w.x = __builtin_bit_cast(unsigned, p0); w.y = __builtin_bit_cast(unsigned, p1); w.z = __builtin_bit_cast(unsigned, p2); w.w = __builtin_bit_cast(unsigned, p3);
                    *(v4u*)(o + bj * 128) = w; } }
        return false;
    }
};

__device__ __forceinline__ void unpack8(const v4u w, float (&f)[8]) { f[0] = bflo(w.x); f[1] = bfhi(w.x); f[2] = bflo(w.y); f[3] = bfhi(w.y); f[4] = bflo(w.z); f[5] = bfhi(w.z); f[6] = bflo(w.w); f[7] = bfhi(w.w); }
__device__ __forceinline__ v4u pack8(const float (&f)[8]) { v4u w; w.x = pk2(f[0], f[1]); w.y = pk2(f[2], f[3]); w.z = pk2(f[4], f[5]); w.w = pk2(f[6], f[7]); return w; }
__device__ __forceinline__ void p2_timemix(const bf16* Z, const float* convw, bf16* PA, bf16* CA, int gw, int NGW, int lane) {
    const int w = 2 << (lane >> 4);
    const int ch = 8 * lane;
    float cw0[8], cw1[8], cw2[8];
#pragma unroll
    for (int i = 0; i < 8; ++i) { cw0[i] = convw[ch + i]; cw1[i] = convw[512 + ch + i]; cw2[i] = convw[1024 + ch + i]; }
    for (int chunk = gw; chunk < M / 32; chunk += NGW) {
        const int t0 = chunk * 32, s0 = t0 & (SEQ - 1);
        float sum[8], up1[8], up2[8];
#pragma unroll
        for (int i = 0; i < 8; ++i) { sum[i] = 0.f; up1[i] = 0.f; up2[i] = 0.f; }
        if (s0 > 0) {
            for (int j = 1; j < 16; ++j) {
                if (j < w) { float f[8]; unpack8(*(const v4u*)(Z + (size_t)(t0 - j) * DIN + ch), f);
#pragma unroll
                    for (int i = 0; i < 8; ++i) sum[i] += f[i]; }
            }
            float c[8], v[8];
            unpack8(*(const v4u*)(Z + (size_t)(t0 - 2) * DIN + 512 + ch), c); unpack8(*(const v4u*)(Z + (size_t)(t0 - 2) * DIN + 1536 + ch), v);
#pragma unroll
            for (int i = 0; i < 8; ++i) up2[i] = c[i] * v[i];
            unpack8(*(const v4u*)(Z + (size_t)(t0 - 1) * DIN + 512 + ch), c); unpack8(*(const v4u*)(Z + (size_t)(t0 - 1) * DIN + 1536 + ch), v);
#pragma unroll
            for (int i = 0; i < 8; ++i) up1[i] = c[i] * v[i];
        }
        for (int i2 = 0; i2 < 32; ++i2) {
            const int t = t0 + i2, s = s0 + i2;
            const bf16* zr = Z + (size_t)t * DIN;
            float zt[8], c[8], b[8], v[8], o[8];
            unpack8(*(const v4u*)(zr + ch), zt); unpack8(*(const v4u*)(zr + 512 + ch), c); unpack8(*(const v4u*)(zr + 1024 + ch), b); unpack8(*(const v4u*)(zr + 1536 + ch), v);
            const int cnt = (s + 1) < w ? (s + 1) : w; const float rc = 1.f / (float)cnt;
#pragma unroll
            for (int i = 0; i < 8; ++i) { sum[i] += zt[i]; o[i] = sum[i] * rc - zt[i]; }
            *(v4u*)(PA + (size_t)t * DP + ch) = pack8(o);
            if (s + 1 - w >= 0) { float f[8]; unpack8(*(const v4u*)(Z + (size_t)(t + 1 - w) * DIN + ch), f);
#pragma unroll
                for (int i = 0; i < 8; ++i) sum[i] -= f[i]; }
#pragma unroll
            for (int i = 0; i < 8; ++i) { const float uu = c[i] * v[i]; o[i] = b[i] * (cw0[i] * up2[i] + cw1[i] * up1[i] + cw2[i] * uu); up2[i] = up1[i]; up1[i] = uu; }
            *(v4u*)(CA + (size_t)t * DP + ch) = pack8(o);
        }
    }
}

__device__ __forceinline__ void p6_topk(const _Float16* S, unsigned short* IDX, float* EV, float* INV, LAS unsigned char* lds, int gw, int NGW, int wave, int lane) {
    LAS unsigned char* my = lds + wave * 9216;
    const float NEG = -3.0e38f;
    for (int grp = gw; grp < M * NH / 64; grp += NGW) {
        const char* base = (const char*)S + (size_t)grp * 64 * 512;
        float A[16], B[16];
#pragma unroll
        for (int half = 0; half < 2; ++half) {
            float L[16];
#pragma unroll
            for (int i = 0; i < 16; ++i) L[i] = NEG;
#pragma unroll 1
            for (int step = 0; step < 2; ++step) {
                const int j = half * 2 + step;
#pragma unroll
                for (int q = 0; q < 8; ++q) { const int row = 8 * q + (lane >> 3), chn = lane & 7;
                    const v4u dd = *(const v4u*)(base + (size_t)row * 512 + 128 * j + 16 * chn); *(LAS v4u*)(my + row * 144 + 16 * chn) = dd; }
                asm volatile("s_waitcnt lgkmcnt(0)" ::: "memory");
#pragma unroll 1
                for (int c = 0; c < 8; ++c) {
                    const v4u dd = *(const LAS v4u*)(my + lane * 144 + 16 * c);
                    const unsigned ww[4] = {dd.x, dd.y, dd.z, dd.w};
#pragma unroll
                    for (int e = 0; e < 8; ++e) {
                        const unsigned hb = (e & 1) ? (ww[e >> 1] >> 16) : (ww[e >> 1] & 0xffffu);
                        const float val = (float)__builtin_bit_cast(_Float16, (unsigned short)hb);
                        const int key = step * 64 + c * 8 + e;
                        float tv = __builtin_bit_cast(float, __builtin_bit_cast(unsigned, val) | (unsigned)(127 - key));
#pragma unroll
                        for (int i = 0; i < 16; ++i) { const float hi = fmaxf(L[i], tv); tv = fminf(L[i], tv); L[i] = hi; }
                    }
                }
                asm volatile("s_waitcnt lgkmcnt(0)" ::: "memory");
            }
#pragma unroll
            for (int i = 0; i < 16; ++i) { if (half == 0) A[i] = L[i]; else B[i] = L[i]; }
        }
        float FV[16]; int FI[16];
#pragma unroll
        for (int i = 0; i < 16; ++i) { FV[i] = NEG; FI[i] = 0; }
#pragma unroll
        for (int i = 0; i < 16; ++i) {
            const unsigned ab = __builtin_bit_cast(unsigned, A[i]); const float av = __builtin_bit_cast(float, ab & ~0x7fu); const int ak = 127 - (int)(ab & 0x7fu);
#pragma unroll
            for (int j = 0; j < 16; ++j) {
                if ((i + 1) * (j + 1) <= 16) {
                    const unsigned bb = __builtin_bit_cast(unsigned, B[j]); const float bv = __builtin_bit_cast(float, bb & ~0x7fu); const int bk = 127 - (int)(bb & 0x7fu);
                    float x = av + bv; int xi = ak * 128 + bk;
#pragma unroll
                    for (int s = (i + 1) * (j + 1) - 1; s < 16; ++s) { const bool c = x > FV[s]; const float nv = c ? x : FV[s], ox = c ? FV[s] : x; const int ni = c ? xi : FI[s], oi = c ? FI[s] : xi; FV[s] = nv; FI[s] = ni; x = ox; xi = oi; }
                }
            }
        }
        const size_t r = (size_t)grp * 64 + lane;
        float ev[16]; float sum = 0.f;
#pragma unroll
        for (int i = 0; i < 16; ++i) { ev[i] = __expf(FV[i] - FV[0]); sum += ev[i]; }
        v4u i0, i1;
        i0.x = (unsigned)FI[0] | ((unsigned)FI[1] << 16); i0.y = (unsigned)FI[2] | ((unsigned)FI[3] << 16); i0.z = (unsigned)FI[4] | ((unsigned)FI[5] << 16); i0.w = (unsigned)FI[6] | ((unsigned)FI[7] << 16);
        i1.x = (unsigned)FI[8] | ((unsigned)FI[9] << 16); i1.y = (unsigned)FI[10] | ((unsigned)FI[11] << 16); i1.z = (unsigned)FI[12] | ((unsigned)FI[13] << 16); i1.w = (unsigned)FI[14] | ((unsigned)FI[15] << 16);
        *(v4u*)(IDX + r * 16) = i0; *(v4u*)(IDX + r * 16 + 8) = i1;
#pragma unroll
        for (int q = 0; q < 4; ++q) *(f32x4*)(EV + r * 16 + 4 * q) = (f32x4){ev[4 * q], ev[4 * q + 1], ev[4 * q + 2], ev[4 * q + 3]};
        INV[r] = 1.f / sum;
    }
}

__device__ __forceinline__ float ubf(unsigned w, int b) { return (float)((w >> (8 * b)) & 0xffu); }
typedef float v2f __attribute__((ext_vector_type(2)));
__device__ __forceinline__ int q_pull(unsigned* heads, int s, int lane) { int it = 0; if (lane == 0) it = (int)__hip_atomic_fetch_add(heads + 64 * s, 1u, __ATOMIC_RELAXED, __HIP_MEMORY_SCOPE_AGENT); return __builtin_amdgcn_readfirstlane(it); }

struct UIdx { v4u ia, ib; };
struct UBuf { v4u ur[16]; v4u xa, xb; };
__device__ __forceinline__ void u_idx(UIdx& p, int t, const unsigned short* IDX, int lane) { const unsigned short* ip = IDX + (size_t)t * 128 + (lane >> 3) * 16; p.ia = *(const v4u*)ip; p.ib = *(const v4u*)(ip + 8); }
__device__ __forceinline__ void u_gather(UBuf& b, const UIdx& p, int s, int t, const bf16* X1, const unsigned char* U8, int lane) {
    const int c = lane & 7;
    const unsigned iw[8] = {p.ia.x, p.ia.y, p.ia.z, p.ia.w, p.ib.x, p.ib.y, p.ib.z, p.ib.w};
    const unsigned char* ub = U8 + (size_t)s * NE * 128 + 16 * c;
#pragma unroll
    for (int i = 0; i < 16; ++i) { const unsigned e = (i & 1) ? (iw[i >> 1] >> 16) : (iw[i >> 1] & 0xffffu); b.ur[i] = *(const v4u*)(ub + (size_t)e * 128); }
    const bf16* xp = X1 + (size_t)t * D + 128 * s + 16 * c;
    b.xa = *(const v4u*)xp; b.xb = *(const v4u*)(xp + 8);
}
__device__ __forceinline__ void u_compute(const UBuf& bf, int s, int t, float* PART, int lane) {
    float xv[16];
    { float f[8]; unpack8(bf.xa, f);
#pragma unroll
      for (int i = 0; i < 8; ++i) xv[i] = f[i];
      unpack8(bf.xb, f);
#pragma unroll
      for (int i = 0; i < 8; ++i) xv[8 + i] = f[i]; }
    float mx = 0.f;
#pragma unroll
    for (int i = 0; i < 16; ++i) mx = fmaxf(mx, fabsf(xv[i]));
    mx = fmaxf(mx, __shfl_xor(mx, 1)); mx = fmaxf(mx, __shfl_xor(mx, 2)); mx = fmaxf(mx, __shfl_xor(mx, 4));
    const float sx = mx > 0.f ? mx * (1.f / 127.f) : 1.f, isx = 1.f / sx;
    int xq[4];
#pragma unroll
    for (int j = 0; j < 4; ++j) { unsigned a = 0;
#pragma unroll
        for (int b = 0; b < 4; ++b) { int q = (int)rintf(xv[4 * j + b] * isx); q = q > 127 ? 127 : (q < -127 ? -127 : q); a |= ((unsigned)q & 0xffu) << (8 * b); }
        xq[j] = (int)a; }
    int p[16];
#pragma unroll
    for (int i = 0; i < 16; ++i) { int a = __builtin_amdgcn_sdot4((int)bf.ur[i].x, xq[0], 0, false); a = __builtin_amdgcn_sdot4((int)bf.ur[i].y, xq[1], a, false);
        a = __builtin_amdgcn_sdot4((int)bf.ur[i].z, xq[2], a, false); a = __builtin_amdgcn_sdot4((int)bf.ur[i].w, xq[3], a, false); p[i] = a; }
    int r8[8], r4[4], r2[2];
    const bool b2 = lane & 4, b1 = lane & 2, b0 = lane & 1;
#pragma unroll
    for (int i = 0; i < 8; ++i) { const int snd = b2 ? p[i] : p[i + 8], kp = b2 ? p[i + 8] : p[i]; r8[i] = kp + __shfl_xor(snd, 4); }
#pragma unroll
    for (int i = 0; i < 4; ++i) { const int snd = b1 ? r8[i] : r8[i + 4], kp = b1 ? r8[i + 4] : r8[i]; r4[i] = kp + __shfl_xor(snd, 2); }
#pragma unroll
    for (int i = 0; i < 2; ++i) { const int snd = b0 ? r4[i] : r4[i + 2], kp = b0 ? r4[i + 2] : r4[i]; r2[i] = kp + __shfl_xor(snd, 1); }
    *(v2f*)(PART + ((size_t)s * M + t) * 128 + 2 * lane) = (v2f){(float)r2[0] * sx, (float)r2[1] * sx};
}
__device__ __forceinline__ void p7_u_phase(unsigned* heads, unsigned xcc, const bf16* X1, const unsigned short* IDX, const unsigned char* U8, float* PART, int lane) {
    int s = (int)(xcc & 7u), tried = 0;
    for (;;) {
        const int item = q_pull(heads, s, lane);
        if (item >= M / TPI) { if (++tried == 8) break; s = (s + 1) & 7; continue; }
        const int t0 = item * TPI, tl = t0 + TPI - 1;
        UIdx ia, ib, in; UBuf ga, gb;
        u_idx(ia, t0, IDX, lane); u_idx(ib, t0 + 1, IDX, lane);
        u_gather(ga, ia, s, t0, X1, U8, lane);
#pragma unroll 1
        for (int i = 0; i < TPI; i += 2) {
            const int t = t0 + i, t2 = (t + 2) < tl ? (t + 2) : tl, t3 = (t + 3) < tl ? (t + 3) : tl;
            u_gather(gb, ib, s, t + 1, X1, U8, lane);
            u_idx(in, t2, IDX, lane);
            u_compute(ga, s, t, PART, lane);
            ia = in;
            u_gather(ga, ia, s, t2, X1, U8, lane);
            u_idx(in, t3, IDX, lane);
            u_compute(gb, s, t + 1, PART, lane);
            ib = in;
        }
    }
}
__device__ __forceinline__ void p8_w_phase(const float* PART, const float* RSTD, const unsigned short* IDX, const float* EV, const float* INV, const float* SU, const float* SV, float* WV, int gw, int NGW, int lane) {
    for (int t = gw; t < M; t += NGW) {
        float a0 = 0.f, a1 = 0.f;
#pragma unroll
        for (int x = 0; x < 8; ++x) { const v2f pp = *(const v2f*)(PART + ((size_t)x * M + t) * 128 + 2 * lane); a0 += pp.x; a1 += pp.y; }
        const unsigned ip = *(const unsigned*)(IDX + (size_t)t * 128 + 2 * lane); const int e0 = (int)(ip & 0xffffu), e1 = (int)(ip >> 16);
        const v2f evp = *(const v2f*)(EV + (size_t)t * 128 + 2 * lane); const float iv = INV[(size_t)t * NH + (lane >> 3)];
        const float rstd = RSTD[t];
        const float act0 = a0 * SU[e0] * rstd, act1 = a1 * SU[e1] * rstd;
        const float w0 = evp.x * iv * (0.5f * act0 * (1.f + erff(act0 * 0.70710678118654752f))) * SV[e0];
        const float w1 = evp.y * iv * (0.5f * act1 * (1.f + erff(act1 * 0.70710678118654752f))) * SV[e1];
        *(v2f*)(WV + (size_t)t * 128 + 2 * lane) = (v2f){w0, w1};
    }
}
struct VBuf { v4u vr[16]; v2f w2; unsigned xw; };
__device__ __forceinline__ void v_gather(VBuf& b, const UIdx& p, int s, int t, const bf16* X1, const float* WV, const unsigned char* V8, int lane) {
    const int c = lane & 7, g = lane >> 3;
    const unsigned iw[8] = {p.ia.x, p.ia.y, p.ia.z, p.ia.w, p.ib.x, p.ib.y, p.ib.z, p.ib.w};
    const unsigned char* vb = V8 + (size_t)s * NE * 128 + 16 * c;
#pragma unroll
    for (int i = 0; i < 16; ++i) { const unsigned e = (i & 1) ? (iw[i >> 1] >> 16) : (iw[i >> 1] & 0xffffu); b.vr[i] = *(const v4u*)(vb + (size_t)e * 128); }
    b.w2 = *(const v2f*)(WV + (size_t)t * 128 + 2 * lane);
    b.xw = *(const unsigned*)(X1 + (size_t)t * D + 128 * s + 16 * c + 2 * g);
}
__device__ __forceinline__ void v_compute(const VBuf& bf, int s, int t, float* out, float* SSQ2, int lane) {
    const int c = lane & 7, g = lane >> 3;
    v2f ac[8];
#pragma unroll
    for (int j = 0; j < 8; ++j) ac[j] = (v2f){0.f, 0.f};
#pragma unroll
    for (int i = 0; i < 16; ++i) { const float wi = __shfl((i & 1) ? bf.w2.y : bf.w2.x, (lane & ~7) | (i >> 1)); const v2f ww = {wi, wi};
#pragma unroll
        for (int j = 0; j < 4; ++j) { const int w = (int)bf.vr[i][j];
            ac[2 * j] = __builtin_elementwise_fma(ww, __builtin_amdgcn_cvt_pk_f32_fp8(w, false), ac[2 * j]);
            ac[2 * j + 1] = __builtin_elementwise_fma(ww, __builtin_amdgcn_cvt_pk_f32_fp8(w, true), ac[2 * j + 1]); } }
    float acc[16];
#pragma unroll
    for (int j = 0; j < 8; ++j) { acc[2 * j] = ac[j].x; acc[2 * j + 1] = ac[j].y; }
    float r8[8], r4[4], r2[2];
    const bool b5 = lane & 32, b4 = lane & 16, b3 = lane & 8;
#pragma unroll
    for (int i = 0; i < 8; ++i) { const float snd = b5 ? acc[i] : acc[i + 8], kp = b5 ? acc[i + 8] : acc[i]; r8[i] = kp + __shfl_xor(snd, 32); }
#pragma unroll
    for (int i = 0; i < 4; ++i) { const float snd = b4 ? r8[i] : r8[i + 4], kp = b4 ? r8[i + 4] : r8[i]; r4[i] = kp + __shfl_xor(snd, 16); }
#pragma unroll
    for (int i = 0; i < 2; ++i) { const float snd = b3 ? r4[i] : r4[i + 2], kp = b3 ? r4[i + 2] : r4[i]; r2[i] = kp + __shfl_xor(snd, 8); }
    const size_t col = (size_t)t * D + 128 * s + 16 * c + 2 * g;
    const float y0 = bflo(bf.xw) + r2[0], y1 = bfhi(bf.xw) + r2[1];
    const float ss = wave_sum(y0 * y0 + y1 * y1);
    *(v2f*)(out + col) = (v2f){y0, y1};
    if (lane == 0) SSQ2[(size_t)t * 8 + s] = ss;
}
__device__ __forceinline__ void p9_v_phase(unsigned* heads, unsigned xcc, const bf16* X1, const unsigned short* IDX, const float* WV, const unsigned char* V8, float* out, float* SSQ2, int lane) {
    int s = (int)(xcc & 7u), tried = 0;
    for (;;) {
        const int item = q_pull(heads, s, lane);
        if (item >= M / TPI) { if (++tried == 8) break; s = (s + 1) & 7; continue; }
        const int t0 = item * TPI, tl = t0 + TPI - 1;
        UIdx ia, ib, in; VBuf ga, gb;
        u_idx(ia, t0, IDX, lane); u_idx(ib, t0 + 1, IDX, lane);
        v_gather(ga, ia, s, t0, X1, WV, V8, lane);
#pragma unroll 1
        for (int i = 0; i < TPI; i += 2) {
            const int t = t0 + i, t2 = (t + 2) < tl ? (t + 2) : tl, t3 = (t + 3) < tl ? (t + 3) : tl;
            v_gather(gb, ib, s, t + 1, X1, WV, V8, lane);
            u_idx(in, t2, IDX, lane);
            v_compute(ga, s, t, out, SSQ2, lane);
            ia = in;
            v_gather(ga, ia, s, t2, X1, WV, V8, lane);
            u_idx(in, t3, IDX, lane);
            v_compute(gb, s, t + 1, out, SSQ2, lane);
            ib = in;
        }
    }
}
__device__ __forceinline__ void p10_final(float* out, const float* SSQ2, const float* gfin, int gw, int NGW, int lane) {
    f32x4 gf[4];
#pragma unroll
    for (int j = 0; j < 4; ++j) gf[j] = ((const f32x4*)gfin)[lane + 64 * j];
    for (int t = gw; t < M; t += NGW) {
        const float ssp = lane < 8 ? SSQ2[(size_t)t * 8 + lane] : 0.f;
        const float r2 = rsqrtf(wave_sum(ssp) * (1.f / D) + RMS_EPS);
        f32x4* o = (f32x4*)(out + (size_t)t * D) + lane;
#pragma unroll
        for (int j = 0; j < 4; ++j) { const f32x4 v = o[64 * j]; o[64 * j] = (f32x4){v.x * r2 * gf[j].x, v.y * r2 * gf[j].y, v.z * r2 * gf[j].z, v.w * r2 * gf[j].w}; }
    }
}

struct Args { const float* in[15]; float* out; unsigned char* ws; int ph_lo, ph_hi, li, pad; };
__global__ void __launch_bounds__(NWAVES * 64, 2) fwd_kernel(Args args) {
    extern __shared__ __attribute__((aligned(16))) unsigned char lds_raw[];
    LAS unsigned char* lds = (LAS unsigned char*)lds_raw;
    volatile LAS unsigned* MISC = (volatile LAS unsigned*)(lds + MISC_OFF);
    const int tid = threadIdx.x, lane = tid & 63, wave = __builtin_amdgcn_readfirstlane(tid >> 6);
    const int G = gridDim.x; const int bx = blockIdx.x; const int vcu = (G % 8 == 0) ? (bx % 8) * (G / 8) + bx / 8 : bx;
    const int gw = vcu * NWAVES + wave, NGW = G * NWAVES;
    unsigned char* ws = args.ws;
    gu32* ctl = (gu32*)(ws + WS_CTL);
    const float* x = args.in[0]; const float* g_mix = args.in[1]; const float* w_in = args.in[2]; const float* pool_gw = args.in[3]; const float* pool_scale = args.in[4];
    const float* conv_w = args.in[5]; const float* w_bp = args.in[6]; const float* w_bc = args.in[7]; const float* w_out = args.in[8]; const float* g_ffn = args.in[9];
    const float* w_q = args.in[10]; const float* sub_keys = args.in[11]; const float* expert_u = args.in[12]; const float* expert_v = args.in[13]; const float* g_final = args.in[14];
    bf16* Wc_t = (bf16*)(ws + WS_WC); bf16* Wbc_t = (bf16*)(ws + WS_WBC); bf16* Wout_t = (bf16*)(ws + WS_WOUT); bf16* Wpp_t = (bf16*)(ws + WS_WPP);
    float* SU = (float*)(ws + WS_SU); float* SV = (float*)(ws + WS_SV); float* SSQ = (float*)(ws + WS_SSQ);
    unsigned char* U8 = ws + WS_U8; unsigned char* V8 = ws + WS_V8; float* INV = (float*)(ws + WS_INV); float* SSQ2 = (float*)(ws + WS_SSQ2); float* PART = (float*)(ws + WS_PART); float* RSTD = (float*)(ws + WS_RSTD); float* WV = (float*)(ws + WS_WV);
    unsigned char* Hq = ws + WS_B; unsigned char* Winq = ws + WS_WIN; float* SA = (float*)(ws + WS_SA); float* SB = (float*)(ws + WS_SB); unsigned* CMAX = (unsigned*)(ctl + CW_CMAX); bf16* PA = (bf16*)(ws + WS_B); bf16* CA = (bf16*)(ws + WS_B + 64 * MiB); bf16* X1 = (bf16*)(ws + WS_B);
    bf16* Mb = (bf16*)(ws + WS_C); unsigned short* IDX = (unsigned short*)(ws + WS_C); float* EV = (float*)(ws + WS_C + 16 * MiB);
    bf16* Zb = (bf16*)(ws + WS_A); _Float16* SC = (_Float16*)(ws + WS_A);

    for (int u = tid; u < (LDS_BYTES - LDSCTL_OFF) / 4; u += NWAVES * 64) ((LAS unsigned*)(lds + LDSCTL_OFF))[u] = 0u;
    __syncthreads();
    XcdBarrier bar; bar.bar = (unsigned*)(ctl + CW_BAR); bar.x = 0; bar.st = nullptr;
    if (N_LAUNCHES != PER_PHASE) bar = xcd_barrier_post((unsigned*)(ctl + CW_BAR), MISC + 8);
#define GRID_BAR() do { if (N_LAUNCHES != PER_PHASE) xcd_barrier(bar); } while (0)
    const int lo = args.ph_lo, hi = args.ph_hi;
#define IN(k) (lo <= (k) && (k) < hi)
#define BOTH(k) (IN(k) && IN((k) + 1))

    if (IN(0)) for (int rep_ = 0; rep_ < ((PROBE_REPEAT >> 0) & 1) + 1; ++rep_) {
        LAS float* scr = (LAS float*)(lds + wave * 16384);
        constexpr int I_WPP = 1024, I_CMAX = 16 * 16, I_WOUT = (1024 / 64) * (1024 / 32), I_WBC = (512 / 64) * (1024 / 32), I_WC = 512;
        constexpr int NITEMS = I_WPP + I_CMAX + I_WOUT + I_WBC + I_WC;
        for (int it = gw; it < NITEMS; it += NGW) {
            int r = it;
            if (r < I_WPP) { p0_wpp_item(w_q, sub_keys, g_ffn, Wpp_t, scr, r, lane); continue; } r -= I_WPP;
            if (r < I_CMAX) { p0_colmax_item(w_in, 4096, CMAX, r, lane); continue; } r -= I_CMAX;
            if (r < I_WOUT) { p0_transpose_item(w_out, 1024, 1024, Wout_t, scr, r, lane); continue; } r -= I_WOUT;
            if (r < I_WBC) { p0_transpose_item(w_bc, 512, 1024, Wbc_t, scr, r, lane); continue; } r -= I_WBC;
            p0_wc_item(pool_gw, pool_scale, w_bp, Wc_t, r, lane);
        }
        GRID_BAR();
        for (int it = gw; it < (1024 / 64) * (4096 / 32); it += NGW) p0_transpose_i8_item(w_in, 1024, 4096, Winq, CMAX, SB, scr, it, lane);
        for (int e = gw; e < NE; e += 2 * NGW) p0_quant_rows2<false>(expert_u, g_ffn, U8, SU, e, e + NGW, lane);
        for (int e = gw; e < NE; e += 2 * NGW) p0_quant_rows2<true>(expert_v, nullptr, V8, SV, e, e + NGW, lane);
        for (int m = gw; m < M; m += 2 * NGW) p0_h_rows2(x, g_mix, Hq, SA, m, m + NGW, lane);
        if (BOTH(0)) GRID_BAR();
    }
    if (IN(1)) for (int rep_ = 0; rep_ < ((PROBE_REPEAT >> 1) & 1) + 1; ++rep_) {
        pg8::Gemm g{(const bf16*)Hq, (const bf16*)Winq, (const bf16*)Hq, (const bf16*)Winq, M, DIN, D / 2}; pg8::StaticOrder S; S.init(M, DIN, G, bx, 1, 1 + ((PROBE_GEMM_REP >> 1) & 1));
        EpiZ E{Zb, DIN, SA, SB};
        pg8::gemm_phase<EpiZ, pg8::StaticOrder, true, true, true>(lds, g, S, E);
        if (BOTH(1)) GRID_BAR();
    }
    if (IN(2)) for (int rep_ = 0; rep_ < ((PROBE_REPEAT >> 2) & 1) + 1; ++rep_) {
        p2_timemix(Zb, conv_w, PA, CA, gw, NGW, lane);
        if (BOTH(2)) GRID_BAR();
    }
    if (IN(3)) for (int rep_ = 0; rep_ < ((PROBE_REPEAT >> 3) & 1) + 1; ++rep_) {
        pg8::Gemm g{PA, Wc_t, CA, Wbc_t, M, D, DP}; pg8::StaticOrder S; S.init(M, D, G, bx, 2, 1 + ((PROBE_GEMM_REP >> 3) & 1));
        EpiGate E{Zb, Mb};
        pg8::gemm_phase<EpiGate, pg8::StaticOrder, true, true>(lds, g, S, E);
        if (BOTH(3)) GRID_BAR();
    }
    if (IN(4)) for (int rep_ = 0; rep_ < ((PROBE_REPEAT >> 4) & 1) + 1; ++rep_) {
        pg8::Gemm g{Mb, Wout_t, Mb, Wout_t, M, D, D}; pg8::StaticOrder S; S.init(M, D, G, bx, 1, 1 + ((PROBE_GEMM_REP >> 4) & 1));
        EpiRes E{x, X1, SSQ};
        pg8::gemm_phase<EpiRes, pg8::StaticOrder, true, true>(lds, g, S, E);
        if (BOTH(4)) GRID_BAR();
    }
    if (IN(5)) for (int rep_ = 0; rep_ < ((PROBE_REPEAT >> 5) & 1) + 1; ++rep_) {
        pg8::Gemm g{X1, Wpp_t, X1, Wpp_t, M, NSC, D}; pg8::StaticOrder S; S.init(M, NSC, G, bx, 1, 1 + ((PROBE_GEMM_REP >> 5) & 1));
        EpiScore E{SSQ, SC, RSTD};
        pg8::gemm_phase<EpiScore, pg8::StaticOrder, true, true>(lds, g, S, E);
        if (BOTH(5)) GRID_BAR();
    }
    if (IN(6)) for (int rep_ = 0; rep_ < ((PROBE_REPEAT >> 6) & 1) + 1; ++rep_) {
        p6_topk(SC, IDX, EV, INV, lds, gw, NGW, wave, lane);
        if (BOTH(6)) GRID_BAR();
    }
    const unsigned xcc = xb_xcc_id();
    if (IN(7)) for (int rep_ = 0; rep_ < ((PROBE_REPEAT >> 7) & 1) + 1; ++rep_) {
        p7_u_phase((unsigned*)(ctl + CW_QU + 2048 * rep_), xcc, X1, IDX, U8, PART, lane);
        if (BOTH(7)) GRID_BAR();
    }
    if (IN(8)) for (int rep_ = 0; rep_ < ((PROBE_REPEAT >> 8) & 1) + 1; ++rep_) {
        p8_w_phase(PART, RSTD, IDX, EV, INV, SU, SV, WV, gw, NGW, lane);
        if (BOTH(8)) GRID_BAR();
    }
    if (IN(9)) for (int rep_ = 0; rep_ < ((PROBE_REPEAT >> 9) & 1) + 1; ++rep_) {
        p9_v_phase((unsigned*)(ctl + CW_QV + 2048 * rep_), xcc, X1, IDX, WV, V8, args.out, SSQ2, lane);
        if (BOTH(9)) GRID_BAR();
    }
    if (IN(10)) {
        p10_final(args.out, SSQ2, g_final, gw, NGW, lane);
    }
#undef IN
#undef BOTH
#undef GRID_BAR
}

extern "C" void kernel_launch(void* const* d_in, const int* in_sizes, int n_in, void* d_out, int out_size, void* d_ws, size_t ws_size, hipStream_t stream) {
    static int grid = 0;
    if (grid == 0) {
        if (n_in != 15 || in_sizes[0] != M * D || out_size != M * D || ws_size < WS_END) { fprintf(stderr, "kernel_launch: unexpected shapes (n_in %d, in0 %d, out %d, ws %zu); nothing launched\n", n_in, n_in > 0 ? in_sizes[0] : -1, out_size, ws_size); grid = -1; return; }
        int dev = 0, cus = 0, per_cu = 0;
        if (hipGetDevice(&dev) != hipSuccess || hipDeviceGetAttribute(&cus, hipDeviceAttributeMultiprocessorCount, dev) != hipSuccess) { grid = -1; return; }
        if (hipFuncSetAttribute((const void*)fwd_kernel, hipFuncAttributeMaxDynamicSharedMemorySize, LDS_BYTES) != hipSuccess) { fprintf(stderr, "kernel_launch: hipFuncSetAttribute failed\n"); grid = -1; return; }
        if (hipOccupancyMaxActiveBlocksPerMultiprocessor(&per_cu, (const void*)fwd_kernel, NWAVES * 64, LDS_BYTES) != hipSuccess || per_cu < 1)
            fprintf(stderr, "kernel_launch: note: occupancy query reports %d workgroups per CU\n", per_cu);
        (void)hipGetLastError();
        grid = cus;
    }
    if (grid < 0) return;
    if (hipMemsetAsync((char*)d_ws + WS_CTL, 0, CTL_ZERO_BYTES, stream) != hipSuccess) { fprintf(stderr, "kernel_launch: hipMemsetAsync failed\n"); return; }
    Args a{};
    for (int i = 0; i < 15; ++i) a.in[i] = (const float*)d_in[i];
    a.out = (float*)d_out; a.ws = (unsigned char*)d_ws;
    for (int li = 0; li < N_LAUNCHES; ++li) {
        a.ph_lo = (N_LAUNCHES == PER_PHASE) ? li : 0; a.ph_hi = (N_LAUNCHES == PER_PHASE) ? li + 1 : PER_PHASE; a.li = li;
        hipLaunchKernelGGL(fwd_kernel, dim3(grid), dim3(NWAVES * 64), LDS_BYTES, stream, a);
        const hipError_t le = hipPeekAtLastError();
        if (le != hipSuccess) { fprintf(stderr, "kernel_launch: launch %d failed: %s\n", li, hipGetErrorName(le)); break; }
    }
}
```

```cpp
#include <hip/hip_runtime.h>
#include <cstdio>
#include <cstdint>

#ifndef PROBE_REPEAT
#define PROBE_REPEAT 0
#endif
#ifndef PROBE_GEMM_REP
#define PROBE_GEMM_REP 0
#endif
#ifndef MK_N_LAUNCHES
#define MK_N_LAUNCHES 1
#endif

namespace pg8 {
#define PG8_LAS __attribute__((address_space(3)))
typedef unsigned short bf16_t;
typedef short bf16x8 __attribute__((ext_vector_type(8)));
typedef float f32x4 __attribute__((ext_vector_type(4)));
typedef unsigned u32x4 __attribute__((ext_vector_type(4)));
constexpr int BM = 256, BK = 64, HALF = 128, HTB = HALF * BK * 2  , STAGE_BYTES = 8 * HTB, NXCD = 8, WGM = 8;

__host__ __device__ __forceinline__ int lds_byte(int r, int c) { const int st = (r >> 4) * 2 + (c >> 5), rr = r & 15, cc = c & 31, ob = rr * 64 + cc * 2; return st * 1024 + (ob ^ (((ob >> 9) & 1) << 5)); }
__host__ __device__ __forceinline__ void stage_rc(int b, int& R, int& C) { const int st = b / 1024, sb = b % 1024, swz = sb ^ (((sb >> 9) & 1) << 5); R = (st >> 1) * 16 + swz / 64; C = (st & 1) * 32 + (swz % 64) / 2; }
__host__ __device__ __forceinline__ int perm32(int rho) { const int n = rho >> 4, i = rho & 15; return 8 * (i >> 2) + 4 * n + (i & 3); }

struct Unit { int pm, pn, seg; };
struct Gemm { const bf16_t* A; const bf16_t* Bt; const bf16_t* A2; const bf16_t* Bt2; int M, N, K; };

struct StaticOrder {
    int nM, nN, nwg, G, c, segs, rep;
    __host__ __device__ void init(int M, int N, int G_, int c_, int segs_, int rep_ = 1) { nM = M / BM; nN = N / BM; nwg = nM * nN; G = G_; c = c_; segs = segs_; rep = rep_; }
    __host__ __device__ bool next(int i, Unit& u) const {
        const int ti = (segs == 2) ? (i >> 1) : i; u.seg = (segs == 2) ? (i & 1) : 0;
        const long L = (long)ti * G + c; if (L >= (long)nwg * rep) return false;
        int wgid = (int)(L % nwg); { const int q = nwg / NXCD, r = nwg % NXCD, xcd = wgid % NXCD, off = wgid / NXCD; wgid = (xcd < r ? xcd * (q + 1) : r * (q + 1) + (xcd - r) * q) + off; }
        const int nig = WGM * nN, gid = wgid / nig, fm = gid * WGM, gsz = (nM - fm) < WGM ? (nM - fm) : WGM;
        u.pm = fm + ((wgid % nig) % gsz); u.pn = (wgid % nig) / gsz; return true;
    }
    __device__ __forceinline__ void a_ready(const Unit&) const {}
    __device__ __forceinline__ void done(const Unit&) const {}
};

__device__ __forceinline__ unsigned cvt_pk_bf16(float lo, float hi) { unsigned r; asm volatile("v_cvt_pk_bf16_f32 %0, %1, %2" : "=v"(r) : "v"(lo), "v"(hi)); return r; }

typedef int i32x4 __attribute__((ext_vector_type(4)));
template <class Epi, class Sched, bool ALIGN_EPI = false, bool SP2 = false, bool I8 = false>
__device__ __forceinline__ void gemm_phase(PG8_LAS unsigned char* lds, const Gemm g, const Sched& S, const Epi& E) {
    const int tid = threadIdx.x, wid = __builtin_amdgcn_readfirstlane(tid >> 6), lane = tid & 63, wr = wid >> 2, wc = wid & 3, fr = lane & 15, fq = lane >> 4;
    const int K = g.K, nt = K / BK;
    unsigned voffA[2], voffB[2];
#pragma unroll
    for (int i = 0; i < 2; ++i) { int R, C; stage_rc(tid * 16 + i * 8192, R, C); const int Rb = Epi::PERM ? ((R & ~31) + perm32(R & 31)) : R;
        voffA[i] = (unsigned)(R * K + C) * 2u; voffB[i] = (unsigned)(Rb * K + C) * 2u; }
    const size_t kstep = (size_t)(BK * 2);
    const size_t hstep = (size_t)HALF * K * 2;
    const size_t tstep = 2 * hstep;
    const unsigned ldsw = (unsigned)wid * 1024u;
    const int aoff = lds_byte(wr * 64 + fr, fq * 8), boff = lds_byte(wc * 32 + fr, fq * 8);
#define PG8_SA(b, h) (((b) * 2 + (h)) * HTB)
#define PG8_SB(b, h) ((4 + (b) * 2 + (h)) * HTB)
#define PG8_STAGE(bufoff, gbase, voff) do { _Pragma("unroll") for (int _i = 0; _i < 2; ++_i) \
        __builtin_amdgcn_global_load_lds((const unsigned*)((const char*)(gbase) + (voff)[_i]), (PG8_LAS unsigned*)(lds + (bufoff) + ldsw + _i * 8192), 16, 0, 0); } while (0)
#define PG8_LDA(dst, b, h) do { _Pragma("unroll") for (int m = 0; m < 4; ++m) _Pragma("unroll") for (int k = 0; k < 2; ++k) dst[m][k] = *(const PG8_LAS bf16x8*)(lds + PG8_SA(b, h) + aoff + m * 2048 + k * 1024); } while (0)
#define PG8_LDB(dst, b, h) do { _Pragma("unroll") for (int n = 0; n < 2; ++n) _Pragma("unroll") for (int k = 0; k < 2; ++k) dst[n][k] = *(const PG8_LAS bf16x8*)(lds + PG8_SB(b, h) + boff + n * 2048 + k * 1024); } while (0)
#define PG8_MMA(ai, bj, At, Bt) do { __builtin_amdgcn_s_setprio(1); _Pragma("unroll") for (int m = 0; m < 4; ++m) _Pragma("unroll") for (int n = 0; n < 2; ++n) _Pragma("unroll") for (int k = 0; k < 2; ++k) { \
        if constexpr (I8) acc[ai][bj][m][n] = __builtin_bit_cast(f32x4, __builtin_amdgcn_mfma_i32_16x16x64_i8(__builtin_bit_cast(i32x4, Bt[n][k]), __builtin_bit_cast(i32x4, At[m][k]), __builtin_bit_cast(i32x4, acc[ai][bj][m][n]), 0, 0, 0)); \
        else acc[ai][bj][m][n] = __builtin_amdgcn_mfma_f32_16x16x32_bf16(Bt[n][k], At[m][k], acc[ai][bj][m][n], 0, 0, 0); } __builtin_amdgcn_s_setprio(0); } while (0)
#define PG8_WAIT_V(n) asm volatile("s_waitcnt vmcnt(" #n ")" ::: "memory")
#define PG8_WAIT_L(n) asm volatile("s_waitcnt lgkmcnt(" #n ")" ::: "memory")
#define PG8_BAR __builtin_amdgcn_s_barrier()
#define PG8_SCHED __builtin_amdgcn_sched_barrier(0)
    Unit cur, nxt; int ui = 0;
    if (!S.next(0, cur)) return;
    f32x4 acc[2][2][4][2];
#pragma unroll
    for (int a = 0; a < 2; ++a)
#pragma unroll
        for (int b = 0; b < 2; ++b)
#pragma unroll
            for (int m = 0; m < 4; ++m)
#pragma unroll
                for (int n = 0; n < 2; ++n) acc[a][b][m][n] = (f32x4){0.f, 0.f, 0.f, 0.f};
    bf16x8 At[4][2], B0[2][2], B1[2][2];
    const char* cA = (const char*)(cur.seg ? g.A2 : g.A) + (size_t)cur.pm * tstep; const char* cB = (const char*)(cur.seg ? g.Bt2 : g.Bt) + (size_t)cur.pn * tstep;
    S.a_ready(cur);
    if constexpr (SP2) {
        PG8_STAGE(PG8_SB(0, 0), cB, voffB); PG8_STAGE(PG8_SB(0, 1), cB + hstep, voffB); PG8_STAGE(PG8_SA(0, 0), cA, voffA); PG8_STAGE(PG8_SA(0, 1), cA + hstep, voffA);
        if (wr == 1) PG8_BAR;
        PG8_WAIT_V(2); PG8_BAR;
        PG8_STAGE(PG8_SB(1, 0), cB + kstep, voffB); PG8_STAGE(PG8_SA(1, 0), cA + kstep, voffA); PG8_STAGE(PG8_SB(1, 1), cB + hstep + kstep, voffB);
        PG8_WAIT_V(6); PG8_BAR;
    } else {
        PG8_STAGE(PG8_SB(0, 0), cB, voffB); PG8_STAGE(PG8_SA(0, 0), cA, voffA); PG8_STAGE(PG8_SB(0, 1), cB + hstep, voffB); PG8_STAGE(PG8_SA(0, 1), cA + hstep, voffA);
        if (wr == 1) PG8_BAR;
        PG8_WAIT_V(4); PG8_BAR;
        PG8_STAGE(PG8_SB(1, 0), cB + kstep, voffB); PG8_STAGE(PG8_SA(1, 0), cA + kstep, voffA); PG8_STAGE(PG8_SB(1, 1), cB + hstep + kstep, voffB);
        PG8_WAIT_V(6); PG8_BAR;
    }
    for (;;) {
        const bool has_next = S.next(ui + 1, nxt);
        const char* nA = has_next ? (const char*)(nxt.seg ? g.A2 : g.A) + (size_t)nxt.pm * tstep : cA; const char* nB = has_next ? (const char*)(nxt.seg ? g.Bt2 : g.Bt) + (size_t)nxt.pn * tstep : cB;
        for (int t = 0; t < nt; t += 2) {
            const bool last = (t == nt - 2);
            const char* a1 = cA + (size_t)(t + 1) * kstep;
            const char* a2 = last ? nA : cA + (size_t)(t + 2) * kstep; const char* b2 = last ? nB : cB + (size_t)(t + 2) * kstep;
            const char* a3 = a2 + kstep; const char* b3 = b2 + kstep;
            if (last && has_next) S.a_ready(nxt);
            if constexpr (SP2) {
            PG8_LDB(B0, 0, 0); PG8_LDB(B1, 0, 1); PG8_SCHED; PG8_LDA(At, 0, 0); PG8_STAGE(PG8_SA(1, 1), a1 + hstep, voffA);
            PG8_WAIT_V(8); PG8_WAIT_L(0); PG8_BAR; PG8_MMA(0, 0, At, B0); PG8_MMA(0, 1, At, B1); PG8_BAR; PG8_SCHED;
            PG8_LDA(At, 0, 1); PG8_STAGE(PG8_SB(0, 0), b2, voffB); PG8_STAGE(PG8_SB(0, 1), b2 + hstep, voffB); PG8_STAGE(PG8_SA(0, 0), a2, voffA);
            PG8_WAIT_V(8); PG8_WAIT_L(0); PG8_BAR; PG8_MMA(1, 0, At, B0); PG8_MMA(1, 1, At, B1); PG8_BAR; PG8_SCHED;
            PG8_LDB(B0, 1, 0); PG8_LDB(B1, 1, 1); PG8_SCHED; PG8_LDA(At, 1, 0); PG8_STAGE(PG8_SA(0, 1), a2 + hstep, voffA);
            PG8_WAIT_V(8); PG8_WAIT_L(0); PG8_BAR; PG8_MMA(0, 0, At, B0); PG8_MMA(0, 1, At, B1); PG8_BAR; PG8_SCHED;
            PG8_LDA(At, 1, 1); PG8_STAGE(PG8_SB(1, 0), b3, voffB); PG8_STAGE(PG8_SB(1, 1), b3 + hstep, voffB); PG8_STAGE(PG8_SA(1, 0), a3, voffA);
            PG8_WAIT_V(8); PG8_WAIT_L(0); PG8_BAR; PG8_MMA(1, 0, At, B0); PG8_MMA(1, 1, At, B1); PG8_BAR; PG8_SCHED;
            } else {
            PG8_LDB(B0, 0, 0); PG8_SCHED; PG8_LDA(At, 0, 0); PG8_STAGE(PG8_SA(1, 1), a1 + hstep, voffA);
            PG8_WAIT_L(8); PG8_BAR; PG8_WAIT_L(0); PG8_MMA(0, 0, At, B0); PG8_BAR; PG8_SCHED;
            PG8_LDB(B1, 0, 1); PG8_STAGE(PG8_SB(0, 0), b2, voffB);
            PG8_BAR; PG8_WAIT_L(0); PG8_MMA(0, 1, At, B1); PG8_BAR;
            PG8_LDA(At, 0, 1); PG8_STAGE(PG8_SA(0, 0), a2, voffA);
            PG8_BAR; PG8_WAIT_L(0); PG8_MMA(1, 0, At, B0); PG8_BAR; PG8_SCHED;
            PG8_STAGE(PG8_SB(0, 1), b2 + hstep, voffB);
            PG8_WAIT_V(6); PG8_BAR; PG8_MMA(1, 1, At, B1); PG8_BAR;
            PG8_LDB(B0, 1, 0); PG8_SCHED; PG8_LDA(At, 1, 0); PG8_STAGE(PG8_SA(0, 1), a2 + hstep, voffA);
            PG8_WAIT_L(8); PG8_BAR; PG8_WAIT_L(0); PG8_MMA(0, 0, At, B0); PG8_BAR; PG8_SCHED;
            PG8_LDB(B1, 1, 1); PG8_STAGE(PG8_SB(1, 0), b3, voffB);
            PG8_BAR; PG8_WAIT_L(0); PG8_MMA(0, 1, At, B1); PG8_BAR;
            PG8_LDA(At, 1, 1); PG8_STAGE(PG8_SA(1, 0), a3, voffA);
            PG8_BAR; PG8_WAIT_L(0); PG8_MMA(1, 0, At, B0); PG8_BAR; PG8_SCHED;
            PG8_STAGE(PG8_SB(1, 1), b3 + hstep, voffB);
            PG8_WAIT_V(6); PG8_BAR; PG8_MMA(1, 1, At, B1); PG8_BAR;
            }
        }
        if constexpr (ALIGN_EPI) { if (wr == 0) PG8_BAR; }
        const bool keep = E(acc, cur, wr, wc, fr, fq); S.done(cur);
        if (!has_next) break;
        if (!keep) {
#pragma unroll
        for (int a = 0; a < 2; ++a)
#pragma unroll
            for (int b = 0; b < 2; ++b)
#pragma unroll
                for (int m = 0; m < 4; ++m)
#pragma unroll
                    for (int n = 0; n < 2; ++n) acc[a][b][m][n] = (f32x4){0.f, 0.f, 0.f, 0.f};
        }
        cur = nxt; cA = nA; cB = nB; ++ui;
        if constexpr (ALIGN_EPI) { if (wr == 1) PG8_BAR; }
    }
    PG8_WAIT_V(0);
    if constexpr (!ALIGN_EPI) { if (wr == 0) PG8_BAR; }
    PG8_BAR;
#undef PG8_SA
#undef PG8_SB
#undef PG8_STAGE
#undef PG8_LDA
#undef PG8_LDB
#undef PG8_MMA
#undef PG8_WAIT_V
#undef PG8_WAIT_L
#undef PG8_BAR
#undef PG8_SCHED
}
}

constexpr int NWAVES = 8;
constexpr int M = 65536, D = 1024, SEQ = 4096, DIN = 4096, DP = 512, NSC = 2048, NE = 16384, NH = 8, TOPK = 16;
constexpr float RMS_EPS = 1e-6f;
constexpr int N_LAUNCHES = MK_N_LAUNCHES;
constexpr int PER_PHASE = 11;
constexpr int TPI = 32;

constexpr size_t MiB = 1u << 20;
constexpr size_t WS_CTL = 0, CTL_ZERO_BYTES = 1 * MiB;
constexpr size_t WS_WIN = 1 * MiB;
constexpr size_t WS_WC = 9 * MiB;
constexpr size_t WS_WBC = 10 * MiB;
constexpr size_t WS_WOUT = 11 * MiB;
constexpr size_t WS_WPP = 13 * MiB;
constexpr size_t WS_SU = 17 * MiB;
constexpr size_t WS_SV = 17 * MiB + 65536;
constexpr size_t WS_SSQ = 18 * MiB;
constexpr size_t WS_U8 = 22 * MiB;
constexpr size_t WS_V8 = 38 * MiB;
constexpr size_t WS_INV = 54 * MiB;
constexpr size_t WS_SSQ2 = 56 * MiB;
constexpr size_t WS_RSTD = 58 * MiB;
constexpr size_t WS_WT = 58 * MiB + 512 * 1024;
constexpr size_t WS_SA = 59 * MiB;
constexpr size_t WS_SB = 59 * MiB + 512 * 1024;
constexpr int CW_CMAX = 32768;
constexpr size_t WS_WV = 192 * MiB + 48 * MiB;
constexpr size_t WS_PART = 576 * MiB;
constexpr size_t WS_B = 64 * MiB;
constexpr size_t WS_C = 192 * MiB;
constexpr size_t WS_A = 320 * MiB;
constexpr size_t WS_END = 832 * MiB;
constexpr int CW_BAR = 4096;
constexpr int CW_QU = 16384, CW_QV = 16384 + 1024;

constexpr int RING_BYTES = 131072;
constexpr int LDSCTL_OFF = RING_BYTES, MISC_OFF = LDSCTL_OFF + 320;
constexpr int LDS_BYTES = 147456;

#define GAS __attribute__((address_space(1)))
#define LAS __attribute__((address_space(3)))
typedef unsigned short bf16;
typedef unsigned v4u __attribute__((ext_vector_type(4)));
typedef unsigned v2u __attribute__((ext_vector_type(2)));
typedef float f32x4 __attribute__((ext_vector_type(4)));
typedef GAS unsigned gu32;
#define RLX_AGENT __ATOMIC_RELAXED, __HIP_MEMORY_SCOPE_AGENT
#define LDS_WAIT() asm volatile("s_waitcnt lgkmcnt(0)" ::: "memory")
#define VM_WAIT() asm volatile("s_waitcnt vmcnt(0)" ::: "memory")
__device__ __forceinline__ unsigned f2bf(float f) { unsigned u = __builtin_bit_cast(unsigned, f); return (u + 0x7fffu + ((u >> 16) & 1u)) >> 16; }
__device__ __forceinline__ unsigned pk2(float lo, float hi) { return f2bf(lo) | (f2bf(hi) << 16); }
__device__ __forceinline__ float bflo(unsigned w) { return __builtin_bit_cast(float, w << 16); }
__device__ __forceinline__ float bfhi(unsigned w) { return __builtin_bit_cast(float, w & 0xffff0000u); }
__device__ __forceinline__ float wave_sum(float v) {
#pragma unroll
    for (int o = 1; o < 64; o <<= 1) v += __shfl_xor(v, o);
    return v;
}
__device__ __forceinline__ float wave_max(float v) {
#pragma unroll
    for (int o = 1; o < 64; o <<= 1) v = fmaxf(v, __shfl_xor(v, o));
    return v;
}

#define XB_TMO      128
#define XB_XCNT(j)  (256  + 64 * (j))
#define XB_XSUB(j)  (1280 + 64 * (j))
#define XB_XGEN(j)  (2304 + 64 * (j))
#define XB_TOP      3328
#define XB_TOPGEN   3392
#define XCD_BAR_WORDS 3456
#define XB_SPIN_CAP (1u << 18)
__device__ __forceinline__ unsigned xb_ld(unsigned* p)              { return __hip_atomic_load(p, __ATOMIC_RELAXED, __HIP_MEMORY_SCOPE_AGENT); }
__device__ __forceinline__ unsigned xb_add(unsigned* p, unsigned v) { return __hip_atomic_fetch_add(p, v, __ATOMIC_RELAXED, __HIP_MEMORY_SCOPE_AGENT); }
__device__ __forceinline__ unsigned xb_xcc_id() { return (unsigned)__builtin_amdgcn_s_getreg((3 << 11) | 20) & 0xFu; }
#define XB_SPIN(cond, bar) do { unsigned _sp = 0; while (cond) { __builtin_amdgcn_s_sleep(1); \
    if ((++_sp & 255u) == 0u) { if (xb_ld(&(bar)[XB_TMO])) break; if (_sp > XB_SPIN_CAP) { atomicAdd(&(bar)[XB_TMO], 1u); break; } } } } while (0)
struct XcdBarrier { unsigned* bar; unsigned x; volatile LAS unsigned* st; };
__device__ __forceinline__ XcdBarrier xcd_barrier_post(unsigned* bar, volatile LAS unsigned* st) {
    XcdBarrier b; b.bar = bar; b.x = xb_xcc_id(); b.st = st;
    if (threadIdx.x == 0) (void)xb_add(&bar[XB_XCNT(b.x)], 1u);
    return b;
}
__device__ __forceinline__ void xcd_barrier_complete(unsigned* bar, unsigned x, unsigned& nloc, unsigned& nx) {
    const unsigned G = gridDim.x * gridDim.y * gridDim.z;
    unsigned sum, cnt, mine, sp = 0u;
    for (;;) {
        sum = 0u; cnt = 0u; mine = 0u;
#pragma unroll
        for (unsigned j = 0; j < 16; ++j) { const unsigned c = xb_ld(&bar[XB_XCNT(j)]); sum += c; cnt += (c > 0u) ? 1u : 0u; mine = (j == x) ? c : mine; }
        if (sum == G) break;
        __builtin_amdgcn_s_sleep(1);
        if ((++sp & 255u) == 0u) { if (xb_ld(&bar[XB_TMO])) break; if (sp > XB_SPIN_CAP) { atomicAdd(&bar[XB_TMO], 1u); break; } }
    }
    nloc = mine > 0u ? mine : 1u; nx = cnt > 0u ? cnt : 1u;
}
__device__ __forceinline__ void xcd_barrier(const XcdBarrier& b) {
    asm volatile("s_waitcnt vmcnt(0)" ::: "memory");
    __syncthreads();
    if (threadIdx.x == 0) {
        unsigned* bar = b.bar;
        __builtin_amdgcn_s_waitcnt(0);
        unsigned nloc = b.st[0], nx = b.st[1];
        if (nloc == 0u) { xcd_barrier_complete(bar, b.x, nloc, nx); b.st[0] = nloc; b.st[1] = nx; }
        const unsigned old = xb_add(&bar[XB_XSUB(b.x)], 1u);
        const unsigned gen = old / nloc;
        if (old + 1u == (gen + 1u) * nloc) {
            __builtin_amdgcn_fence(__ATOMIC_RELEASE, "agent");
            asm volatile("s_waitcnt vmcnt(0)" ::: "memory");
            const unsigned og = xb_add(&bar[XB_TOP], 1u);
            const unsigned tg = og / nx;
            if (og + 1u == (tg + 1u) * nx) xb_add(&bar[XB_TOPGEN], 1u);
            else XB_SPIN(xb_ld(&bar[XB_TOPGEN]) == tg, bar);
            __builtin_amdgcn_fence(__ATOMIC_ACQUIRE, "agent");
            xb_add(&bar[XB_XGEN(b.x)], 1u);
            asm volatile("s_waitcnt vmcnt(0)" ::: "memory");
        } else {
            XB_SPIN(xb_ld(&bar[XB_XGEN(b.x)]) == gen, bar);
            __builtin_amdgcn_fence(__ATOMIC_ACQUIRE, "agent");
            asm volatile("s_waitcnt vmcnt(0)" ::: "memory");
        }
    }
    __syncthreads();
}

__device__ __forceinline__ void p0_transpose_item(const float* W, int K, int N, bf16* WT, LAS float* scr, int item, int lane) {
    const int nblk = N / 32, kb = item / nblk, nb = item % nblk, k0 = 64 * kb, n0 = 32 * nb;
#pragma unroll 8
    for (int i = 0; i < 32; ++i) { const int kk = 2 * i + (lane >> 5); scr[kk * 33 + (lane & 31)] = W[(size_t)(k0 + kk) * N + n0 + (lane & 31)]; }
    LDS_WAIT(); asm volatile("" ::: "memory");
    const int c = lane & 7;
#pragma unroll
    for (int j = 0; j < 4; ++j) { const int n = (lane >> 3) + 8 * j; const LAS float* s = scr + (8 * c) * 33 + n;
        v4u o; o.x = pk2(s[0 * 33], s[1 * 33]); o.y = pk2(s[2 * 33], s[3 * 33]); o.z = pk2(s[4 * 33], s[5 * 33]); o.w = pk2(s[6 * 33], s[7 * 33]);
        *(v4u*)(WT + (size_t)(n0 + n) * K + k0 + 8 * c) = o; }
    LDS_WAIT(); asm volatile("" ::: "memory");
}
__device__ __forceinline__ void p0_wc_item(const float* gwt, const float* scale, const float* wbp, bf16* WcT, int item, int lane) {
    const int nb = item & 15, cb = (item >> 4) & 7, g = item >> 7;
    const int n = nb * 64 + lane;
    float acc[16];
#pragma unroll
    for (int c = 0; c < 16; ++c) acc[c] = 0.f;
    for (int d = 0; d < 128; ++d) {
        const float b = wbp[(size_t)(g * 128 + d) * 1024 + n] * scale[g * 128 + d];
#pragma unroll
        for (int c = 0; c < 16; ++c) acc[c] += gwt[(size_t)((g * 128 + cb * 16 + c) * 128) + d] * b;
    }
    v4u o0, o1;
    o0.x = pk2(acc[0], acc[1]); o0.y = pk2(acc[2], acc[3]); o0.z = pk2(acc[4], acc[5]); o0.w = pk2(acc[6], acc[7]);
    o1.x = pk2(acc[8], acc[9]); o1.y = pk2(acc[10], acc[11]); o1.z = pk2(acc[12], acc[13]); o1.w = pk2(acc[14], acc[15]);
    bf16* dst = WcT + (size_t)n * 512 + g * 128 + cb * 16;
    *(v4u*)dst = o0; *(v4u*)(dst + 8) = o1;
}
__device__ __forceinline__ void p0_wpp_item(const float* wq, const float* keys, const float* gffn, bf16* WppT, LAS float* scr, int item, int lane) {
    const int kb = item & 3, db = (item >> 2) & 15, hp = item >> 6;
    const int d = db * 64 + lane;
    const f32x4* kbase = (const f32x4*)(keys + (size_t)(hp * 128 + kb * 32) * 128);
    LAS f32x4* kt = (LAS f32x4*)scr;
#pragma unroll
    for (int i = 0; i < 16; ++i) kt[i * 64 + lane] = kbase[i * 64 + lane];
    float acc[32];
#pragma unroll
    for (int k = 0; k < 32; ++k) acc[k] = 0.f;
    const float* arow = wq + (size_t)d * 2048 + hp * 128;
    LDS_WAIT(); asm volatile("" ::: "memory");
#pragma unroll 4
    for (int c4 = 0; c4 < 32; ++c4) {
        const f32x4 a = *(const f32x4*)(arow + 4 * c4);
#pragma unroll
        for (int k = 0; k < 32; ++k) { const f32x4 kr = kt[k * 32 + c4]; acc[k] += (a.x * kr.x + a.y * kr.y) + (a.z * kr.z + a.w * kr.w); }
    }
    const float gs = gffn[d];
#pragma unroll
    for (int k = 0; k < 32; ++k) WppT[(size_t)(hp * 128 + kb * 32 + k) * 1024 + d] = (bf16)f2bf(acc[k] * gs);
    LDS_WAIT(); asm volatile("" ::: "memory");
}
__device__ __forceinline__ void p0_h_row(const float* xrow, const float* g, bf16* orow, int lane) {
    const f32x4* xr = (const f32x4*)xrow + lane; const f32x4* gr = (const f32x4*)g + lane;
    f32x4 v[4]; float s = 0.f;
#pragma unroll
    for (int j = 0; j < 4; ++j) { v[j] = xr[64 * j]; s += (v[j].x * v[j].x + v[j].y * v[j].y) + (v[j].z * v[j].z + v[j].w * v[j].w); }
    const float rstd = rsqrtf(wave_sum(s) * (1.f / D) + RMS_EPS);
    v2u* o8 = (v2u*)orow + lane;
#pragma unroll
    for (int j = 0; j < 4; ++j) { const f32x4 gg = gr[64 * j]; v2u o; o.x = pk2(v[j].x * rstd * gg.x, v[j].y * rstd * gg.y); o.y = pk2(v[j].z * rstd * gg.z, v[j].w * rstd * gg.w); o8[64 * j] = o; }
}
__device__ __forceinline__ void p0_h_rows2(const float* x, const float* g, unsigned char* Hq, float* SA, int m0, int m1, int lane) {
    const f32x4* xr0 = (const f32x4*)(x + (size_t)m0 * D) + lane; const f32x4* xr1 = (const f32x4*)(x + (size_t)m1 * D) + lane; const f32x4* gr = (const f32x4*)g + lane;
    f32x4 v0[4], v1[4]; float s0 = 0.f, s1 = 0.f;
#pragma unroll
    for (int j = 0; j < 4; ++j) { v0[j] = xr0[64 * j]; v1[j] = xr1[64 * j]; }
#pragma unroll
    for (int j = 0; j < 4; ++j) { s0 += (v0[j].x * v0[j].x + v0[j].y * v0[j].y) + (v0[j].z * v0[j].z + v0[j].w * v0[j].w); s1 += (v1[j].x * v1[j].x + v1[j].y * v1[j].y) + (v1[j].z * v1[j].z + v1[j].w * v1[j].w); }
    const float r0 = rsqrtf(wave_sum(s0) * (1.f / D) + RMS_EPS), r1 = rsqrtf(wave_sum(s1) * (1.f / D) + RMS_EPS);
    float mx0 = 0.f, mx1 = 0.f;
#pragma unroll
    for (int j = 0; j < 4; ++j) { const f32x4 gg = gr[64 * j]; v0[j] = v0[j] * gg * r0; v1[j] = v1[j] * gg * r1;
        mx0 = fmaxf(mx0, fmaxf(fmaxf(fabsf(v0[j].x), fabsf(v0[j].y)), fmaxf(fabsf(v0[j].z), fabsf(v0[j].w))));
        mx1 = fmaxf(mx1, fmaxf(fmaxf(fabsf(v1[j].x), fabsf(v1[j].y)), fmaxf(fabsf(v1[j].z), fabsf(v1[j].w)))); }
    mx0 = wave_max(mx0); mx1 = wave_max(mx1);
    const float sc0 = mx0 > 0.f ? mx0 * (1.f / 127.f) : 1.f, sc1 = mx1 > 0.f ? mx1 * (1.f / 127.f) : 1.f, i0 = 1.f / sc0, i1 = 1.f / sc1;
    unsigned* o0 = (unsigned*)(Hq + (size_t)m0 * D) + lane; unsigned* o1 = (unsigned*)(Hq + (size_t)m1 * D) + lane;
#pragma unroll
    for (int j = 0; j < 4; ++j) { unsigned a = 0, b = 0;
#pragma unroll
        for (int c = 0; c < 4; ++c) { int q = (int)rintf(v0[j][c] * i0); q = q > 127 ? 127 : (q < -127 ? -127 : q); a |= ((unsigned)q & 0xffu) << (8 * c);
            int q1 = (int)rintf(v1[j][c] * i1); q1 = q1 > 127 ? 127 : (q1 < -127 ? -127 : q1); b |= ((unsigned)q1 & 0xffu) << (8 * c); }
        o0[64 * j] = a; o1[64 * j] = b; }
    if (lane == 0) { SA[m0] = sc0; SA[m1] = sc1; }
}
__device__ __forceinline__ void p0_colmax_item(const float* W, int N, unsigned* cmax, int item, int lane) {
    const int nblk = N / 256, kb = item / nblk, nb = item % nblk;
    const float* p = W + (size_t)(kb * 64) * N + nb * 256 + 4 * lane;
    f32x4 mx = {0.f, 0.f, 0.f, 0.f};
#pragma unroll 8
    for (int k = 0; k < 64; ++k) { const f32x4 v = *(const f32x4*)(p + (size_t)k * N); mx.x = fmaxf(mx.x, fabsf(v.x)); mx.y = fmaxf(mx.y, fabsf(v.y)); mx.z = fmaxf(mx.z, fabsf(v.z)); mx.w = fmaxf(mx.w, fabsf(v.w)); }
    unsigned* c = cmax + nb * 256 + 4 * lane;
    atomicMax(c + 0, __builtin_bit_cast(unsigned, mx.x)); atomicMax(c + 1, __builtin_bit_cast(unsigned, mx.y)); atomicMax(c + 2, __builtin_bit_cast(unsigned, mx.z)); atomicMax(c + 3, __builtin_bit_cast(unsigned, mx.w));
}
__device__ __forceinline__ void p0_transpose_i8_item(const float* W, int K, int N, unsigned char* WT, const unsigned* cmax, float* SB, LAS float* scr, int item, int lane) {
    const int nblk = N / 32, kb = item / nblk, nb = item % nblk, k0 = 64 * kb, n0 = 32 * nb;
#pragma unroll 8
    for (int i = 0; i < 32; ++i) { const int kk = 2 * i + (lane >> 5); scr[kk * 33 + (lane & 31)] = W[(size_t)(k0 + kk) * N + n0 + (lane & 31)]; }
    LDS_WAIT(); asm volatile("" ::: "memory");
    const int c = lane & 3;
#pragma unroll
    for (int j = 0; j < 2; ++j) { const int n = (lane >> 2) + 16 * j; const LAS float* s = scr + (16 * c) * 33 + n;
        const float mxv = __builtin_bit_cast(float, cmax[n0 + n]); const float sc = mxv > 0.f ? mxv * (1.f / 127.f) : 1.f, inv = 1.f / sc;
        if (kb == 0 && c == 0) SB[n0 + n] = sc;
        v4u o;
#pragma unroll
        for (int q4 = 0; q4 < 4; ++q4) { unsigned a = 0;
#pragma unroll
            for (int b = 0; b < 4; ++b) { int q = (int)rintf(s[(4 * q4 + b) * 33] * inv); q = q > 127 ? 127 : (q < -127 ? -127 : q); a |= ((unsigned)q & 0xffu) << (8 * b); }
            o[q4] = a; }
        *(v4u*)(WT + (size_t)(n0 + n) * K + k0 + 16 * c) = o; }
    LDS_WAIT(); asm volatile("" ::: "memory");
}
template <bool FP8>
__device__ __forceinline__ void p0_quant_rows2(const float* src, const float* gmul, unsigned char* dst, float* scale_out, int e0, int e1, int lane) {
    const f32x4* p0 = (const f32x4*)(src + (size_t)e0 * 1024 + 16 * lane); const f32x4* p1 = (const f32x4*)(src + (size_t)e1 * 1024 + 16 * lane);
    f32x4 v[2][4];
#pragma unroll
    for (int j = 0; j < 4; ++j) { v[0][j] = p0[j]; v[1][j] = p1[j]; }
    if (gmul) { const f32x4* gp = (const f32x4*)(gmul + 16 * lane);
#pragma unroll
        for (int j = 0; j < 4; ++j) { const f32x4 gg = gp[j]; v[0][j] = v[0][j] * gg; v[1][j] = v[1][j] * gg; } }
#pragma unroll
    for (int r = 0; r < 2; ++r) {
        float mx = 0.f;
#pragma unroll
        for (int j = 0; j < 4; ++j) mx = fmaxf(mx, fmaxf(fmaxf(fabsf(v[r][j].x), fabsf(v[r][j].y)), fmaxf(fabsf(v[r][j].z), fabsf(v[r][j].w))));
        mx = wave_max(mx);
        const float sc = mx > 0.f ? mx * (FP8 ? (1.f / 448.f) : (1.f / 127.f)) : 1.f, inv = 1.f / sc;
        v4u w;
#pragma unroll
        for (int j = 0; j < 4; ++j) {
            if (FP8) { int pk = __builtin_amdgcn_cvt_pk_fp8_f32(v[r][j].x * inv, v[r][j].y * inv, 0, false); pk = __builtin_amdgcn_cvt_pk_fp8_f32(v[r][j].z * inv, v[r][j].w * inv, pk, true); w[j] = (unsigned)pk; }
            else { unsigned acc = 0;
#pragma unroll
                for (int c = 0; c < 4; ++c) { int q = (int)rintf(v[r][j][c] * inv); q = q > 127 ? 127 : (q < -127 ? -127 : q); acc |= ((unsigned)q & 0xffu) << (8 * c); }
                w[j] = acc; }
        }
        const int e = r ? e1 : e0;
        *(v4u*)(dst + ((size_t)(lane >> 3) * NE + e) * 128 + 16 * (lane & 7)) = w;
        if (lane == 0) scale_out[e] = sc;
    }
}

typedef pg8::f32x4 (&AccRef)[2][2][4][2];
struct EpiZ {
    static constexpr bool PERM = true;
    bf16* O; int ldc; const float* SA; const float* SB;
    __device__ __forceinline__ bool operator()(AccRef acc, const pg8::Unit& u, int wr, int wc, int fr, int fq) const {
        const int row0 = u.pm * 256 + wr * 64 + fr, col0 = u.pn * 256 + wc * 32 + 8 * fq;
        pg8::f32x4 sb[2][2];
#pragma unroll
        for (int bj = 0; bj < 2; ++bj) { sb[bj][0] = *(const pg8::f32x4*)(SB + col0 + bj * 128); sb[bj][1] = *(const pg8::f32x4*)(SB + col0 + bj * 128 + 4); }
#pragma unroll
        for (int ai = 0; ai < 2; ++ai)
#pragma unroll
            for (int m = 0; m < 4; ++m) { const int r = row0 + ai * 128 + m * 16; bf16* rowp = O + (size_t)r * ldc + col0; const float sa = SA[r];
#pragma unroll
                for (int bj = 0; bj < 2; ++bj) { const pg8::i32x4 i0 = __builtin_bit_cast(pg8::i32x4, acc[ai][bj][m][0]), i1 = __builtin_bit_cast(pg8::i32x4, acc[ai][bj][m][1]);
                    pg8::f32x4 v0 = {(float)i0[0], (float)i0[1], (float)i0[2], (float)i0[3]}, v1 = {(float)i1[0], (float)i1[1], (float)i1[2], (float)i1[3]};
                    v0 = v0 * sb[bj][0] * sa; v1 = v1 * sb[bj][1] * sa; v4u w;
                    w.x = pg8::cvt_pk_bf16(v0[0], v0[1]); w.y = pg8::cvt_pk_bf16(v0[2], v0[3]); w.z = pg8::cvt_pk_bf16(v1[0], v1[1]); w.w = pg8::cvt_pk_bf16(v1[2], v1[3]);
                    *(v4u*)(rowp + bj * 128) = w; } }
        return false;
    }
};
__device__ __forceinline__ float einv(float x) { return 1.f + __builtin_amdgcn_exp2f(x * -1.44269504089f); }
__device__ __forceinline__ float sigm_ratio(float ga, float gb) { return einv(gb) * __builtin_amdgcn_rcpf(einv(ga)); }
struct EpiGate {
    static constexpr bool PERM = true;
    const bf16* Z; bf16* Mo;
    __device__ __forceinline__ bool operator()(AccRef acc, const pg8::Unit& u, int wr, int wc, int fr, int fq) const {
        const int row0 = u.pm * 256 + wr * 64 + fr, col0 = u.pn * 256 + wc * 32 + 8 * fq;
        if (u.seg == 0) {
#pragma unroll
            for (int ai = 0; ai < 2; ++ai)
#pragma unroll
                for (int m = 0; m < 4; ++m) { const bf16* zr = Z + (size_t)(row0 + ai * 128 + m * 16) * DIN + col0;
#pragma unroll
                    for (int bj = 0; bj < 2; ++bj) { const v4u a = *(const v4u*)(zr + 2048 + bj * 128), b = *(const v4u*)(zr + 3072 + bj * 128);
                        pg8::f32x4& v0 = acc[ai][bj][m][0]; pg8::f32x4& v1 = acc[ai][bj][m][1];
                        v0[0] *= sigm_ratio(bflo(a.x), bflo(b.x)); v0[1] *= sigm_ratio(bfhi(a.x), bfhi(b.x)); v0[2] *= sigm_ratio(bflo(a.y), bflo(b.y)); v0[3] *= sigm_ratio(bfhi(a.y), bfhi(b.y));
                        v1[0] *= sigm_ratio(bflo(a.z), bflo(b.z)); v1[1] *= sigm_ratio(bfhi(a.z), bfhi(b.z)); v1[2] *= sigm_ratio(bflo(a.w), bflo(b.w)); v1[3] *= sigm_ratio(bfhi(a.w), bfhi(b.w)); } }
            return true;
        }
#pragma unroll
        for (int ai = 0; ai < 2; ++ai)
#pragma unroll
            for (int m = 0; m < 4; ++m) { const size_t r = (size_t)(row0 + ai * 128 + m * 16); const bf16* zr = Z + r * DIN + col0; bf16* mo = Mo + r * D + col0;
#pragma unroll
                for (int bj = 0; bj < 2; ++bj) { const v4u b = *(const v4u*)(zr + 3072 + bj * 128);
                    const pg8::f32x4 v0 = acc[ai][bj][m][0], v1 = acc[ai][bj][m][1]; v4u w;
#define SG(x) __builtin_amdgcn_rcpf(einv(x))
                    w.x = pg8::cvt_pk_bf16(v0[0] * SG(bflo(b.x)), v0[1] * SG(bfhi(b.x))); w.y = pg8::cvt_pk_bf16(v0[2] * SG(bflo(b.y)), v0[3] * SG(bfhi(b.y)));
                    w.z = pg8::cvt_pk_bf16(v1[0] * SG(bflo(b.z)), v1[1] * SG(bfhi(b.z))); w.w = pg8::cvt_pk_bf16(v1[2] * SG(bflo(b.w)), v1[3] * SG(bfhi(b.w)));
#undef SG
                    *(v4u*)(mo + bj * 128) = w; } }
        return false;
    }
};
struct EpiRes {
    static constexpr bool PERM = true;
    const float* X; bf16* X1; float* SSQ;
    __device__ __forceinline__ bool operator()(AccRef acc, const pg8::Unit& u, int wr, int wc, int fr, int fq) const {
        const int row0 = u.pm * 256 + wr * 64 + fr, col0 = u.pn * 256 + wc * 32 + 8 * fq;
#pragma unroll
        for (int ai = 0; ai < 2; ++ai)
#pragma unroll
            for (int m = 0; m < 4; ++m) { const size_t r = (size_t)(row0 + ai * 128 + m * 16); const float* xr = X + r * D + col0; bf16* o = X1 + r * D + col0; float ss = 0.f;
#pragma unroll
                for (int bj = 0; bj < 2; ++bj) { const pg8::f32x4 x0 = *(const pg8::f32x4*)(xr + bj * 128), x1v = *(const pg8::f32x4*)(xr + bj * 128 + 4);
                    const pg8::f32x4 v0 = acc[ai][bj][m][0] + x0, v1 = acc[ai][bj][m][1] + x1v;
                    ss += (v0[0] * v0[0] + v0[1] * v0[1]) + (v0[2] * v0[2] + v0[3] * v0[3]) + (v1[0] * v1[0] + v1[1] * v1[1]) + (v1[2] * v1[2] + v1[3] * v1[3]);
                    v4u w; w.x = pg8::cvt_pk_bf16(v0[0], v0[1]); w.y = pg8::cvt_pk_bf16(v0[2], v0[3]); w.z = pg8::cvt_pk_bf16(v1[0], v1[1]); w.w = pg8::cvt_pk_bf16(v1[2], v1[3]);
                    *(v4u*)(o + bj * 128) = w; }
                ss += __shfl_xor(ss, 16); ss += __shfl_xor(ss, 32);
                if (fq == 0) SSQ[r * 16 + u.pn * 4 + wc] = ss; }
        return false;
    }
};
struct EpiScore {
    static constexpr bool PERM = true;
    const float* SSQ; _Float16* S; float* RSTD;
    __device__ __forceinline__ bool operator()(AccRef acc, const pg8::Unit& u, int wr, int wc, int fr, int fq) const {
        const int row0 = u.pm * 256 + wr * 64 + fr, col0 = u.pn * 256 + wc * 32 + 8 * fq;
#pragma unroll
        for (int ai = 0; ai < 2; ++ai)
#pragma unroll
            for (int m = 0; m < 4; ++m) { const size_t r = (size_t)(row0 + ai * 128 + m * 16);
                const pg8::f32x4* sp = (const pg8::f32x4*)(SSQ + r * 16); const pg8::f32x4 s0 = sp[0], s1 = sp[1], s2 = sp[2], s3 = sp[3];
                const float tot = ((s0[0] + s0[1]) + (s0[2] + s0[3])) + ((s1[0] + s1[1]) + (s1[2] + s1[3])) + ((s2[0] + s2[1]) + (s2[2] + s2[3])) + ((s3[0] + s3[1]) + (s3[2] + s3[3]));
                const float rstd = rsqrtf(tot * (1.f / D) + RMS_EPS);
                if (u.pn == 0 && wc == 0 && fq == 0) RSTD[r] = rstd;
                _Float16* o = S + r * NSC + col0;
#pragma unroll
                for (int bj = 0; bj < 2; ++bj) { const pg8::f32x4 v0 = acc[ai][bj][m][0] * rstd, v1 = acc[ai][bj][m][1] * rstd;
                    typedef _Float16 h2 __attribute__((ext_vector_type(2)));
                    h2 p0 = {(_Float16)v0[0], (_Float16)v0[1]}, p1 = {(_Float16)v0[2], (_Float16)v0[3]}, p2 = {(_Float16)v1[0], (_Float16)v1[1]}, p3 = {(_Float16)v1[2], (_Float16)v1[3]};
                    v4u w; w.x = __builtin_bit_cast(unsigned, p0); w.y = __builtin_bit_cast(unsigned, p1); w.z = __builtin_bit_cast(unsigned, p2); w.w = __builtin_bit_cast(unsigned, p3);
                    *(v4u*)(o + bj * 128) = w; } }
        return false;
    }
};

__device__ __forceinline__ void unpack8(const v4u w, float (&f)[8]) { f[0] = bflo(w.x); f[1] = bfhi(w.x); f[2] = bflo(w.y); f[3] = bfhi(w.y); f[4] = bflo(w.z); f[5] = bfhi(w.z); f[6] = bflo(w.w); f[7] = bfhi(w.w); }
__device__ __forceinline__ v4u pack8(const float (&f)[8]) { v4u w; w.x = pk2(f[0], f[1]); w.y = pk2(f[2], f[3]); w.z = pk2(f[4], f[5]); w.w = pk2(f[6], f[7]); return w; }
__device__ __forceinline__ void p2_timemix(const bf16* Z, const float* convw, bf16* PA, bf16* CA, int gw, int NGW, int lane) {
    const int w = 2 << (lane >> 4);
    const int ch = 8 * lane;
    float cw0[8], cw1[8], cw2[8];
#pragma unroll
    for (int i = 0; i < 8; ++i) { cw0[i] = convw[ch + i]; cw1[i] = convw[512 + ch + i]; cw2[i] = convw[1024 + ch + i]; }
    for (int chunk = gw; chunk < M / 32; chunk += NGW) {
        const int t0 = chunk * 32, s0 = t0 & (SEQ - 1);
        float sum[8], up1[8], up2[8];
#pragma unroll
        for (int i = 0; i < 8; ++i) { sum[i] = 0.f; up1[i] = 0.f; up2[i] = 0.f; }
        if (s0 > 0) {
            for (int j = 1; j < 16; ++j) {
                if (j < w) { float f[8]; unpack8(*(const v4u*)(Z + (size_t)(t0 - j) * DIN + ch), f);
#pragma unroll
                    for (int i = 0; i < 8; ++i) sum[i] += f[i]; }
            }
            float c[8], v[8];
            unpack8(*(const v4u*)(Z + (size_t)(t0 - 2) * DIN + 512 + ch), c); unpack8(*(const v4u*)(Z + (size_t)(t0 - 2) * DIN + 1536 + ch), v);
#pragma unroll
            for (int i = 0; i < 8; ++i) up2[i] = c[i] * v[i];
            unpack8(*(const v4u*)(Z + (size_t)(t0 - 1) * DIN + 512 + ch), c); unpack8(*(const v4u*)(Z + (size_t)(t0 - 1) * DIN + 1536 + ch), v);
#pragma unroll
            for (int i = 0; i < 8; ++i) up1[i] = c[i] * v[i];
        }
        for (int i2 = 0; i2 < 32; ++i2) {
            const int t = t0 + i2, s = s0 + i2;
            const bf16* zr = Z + (size_t)t * DIN;
            float zt[8], c[8], b[8], v[8], o[8];
            unpack8(*(const v4u*)(zr + ch), zt); unpack8(*(const v4u*)(zr + 512 + ch), c); unpack8(*(const v4u*)(zr + 1024 + ch), b); unpack8(*(const v4u*)(zr + 1536 + ch), v);
            const int cnt = (s + 1) < w ? (s + 1) : w; const float rc = 1.f / (float)cnt;
#pragma unroll
            for (int i = 0; i < 8; ++i) { sum[i] += zt[i]; o[i] = sum[i] * rc - zt[i]; }
            *(v4u*)(PA + (size_t)t * DP + ch) = pack8(o);
            if (s + 1 - w >= 0) { float f[8]; unpack8(*(const v4u*)(Z + (size_t)(t + 1 - w) * DIN + ch), f);
#pragma unroll
                for (int i = 0; i < 8; ++i) sum[i] -= f[i]; }
#pragma unroll
            for (int i = 0; i < 8; ++i) { const float uu = c[i] * v[i]; o[i] = b[i] * (cw0[i] * up2[i] + cw1[i] * up1[i] + cw2[i] * uu); up2[i] = up1[i]; up1[i] = uu; }
            *(v4u*)(CA + (size_t)t * DP + ch) = pack8(o);
        }
    }
}

#define TK_NEG (-3.0e38f)
__device__ __forceinline__ void tk_ce(float& a, float& b) { const float hi = fmaxf(a, b), lo = fminf(a, b); a = hi; b = lo; }
__device__ __forceinline__ void tk_sort8(float (&v)[8]) {
    tk_ce(v[0], v[1]); tk_ce(v[2], v[3]); tk_ce(v[4], v[5]); tk_ce(v[6], v[7]);
    tk_ce(v[0], v[2]); tk_ce(v[1], v[3]); tk_ce(v[4], v[6]); tk_ce(v[5], v[7]);
    tk_ce(v[1], v[2]); tk_ce(v[5], v[6]);
    tk_ce(v[0], v[4]); tk_ce(v[1], v[5]); tk_ce(v[2], v[6]); tk_ce(v[3], v[7]);
    tk_ce(v[2], v[4]); tk_ce(v[3], v[5]);
    tk_ce(v[1], v[2]); tk_ce(v[3], v[4]); tk_ce(v[5], v[6]);
}
__device__ __forceinline__ void tk_bmerge16(float (&x)[16]) {
#pragma unroll
    for (int i = 0; i < 8; ++i) tk_ce(x[i], x[i + 8]);
#pragma unroll
    for (int b = 0; b < 16; b += 8)
#pragma unroll
        for (int i = 0; i < 4; ++i) tk_ce(x[b + i], x[b + i + 4]);
#pragma unroll
    for (int b = 0; b < 16; b += 4)
#pragma unroll
        for (int i = 0; i < 2; ++i) tk_ce(x[b + i], x[b + i + 2]);
#pragma unroll
    for (int b = 0; b < 16; b += 2) tk_ce(x[b], x[b + 1]);
}
__device__ __forceinline__ void tk_add16(float (&L)[16], float (&a)[8], float (&b)[8]) {
    tk_sort8(a); tk_sort8(b);
    float s[16];
#pragma unroll
    for (int i = 0; i < 8; ++i) { s[i] = a[i]; s[8 + i] = b[7 - i]; }
    tk_bmerge16(s);
#pragma unroll
    for (int i = 0; i < 16; ++i) L[i] = fmaxf(L[i], s[15 - i]);
    tk_bmerge16(L);
}
__device__ __forceinline__ void tk_final(const float (&A)[16], const float (&B)[16], float (&FV)[16]) {
    float av[16], bv[16];
#pragma unroll
    for (int i = 0; i < 16; ++i) { av[i] = __builtin_bit_cast(float, __builtin_bit_cast(unsigned, A[i]) & ~0x7fu); bv[i] = __builtin_bit_cast(float, __builtin_bit_cast(unsigned, B[i]) & ~0x7fu); }
#pragma unroll
    for (int j = 0; j < 16; ++j) FV[j] = __builtin_bit_cast(float, (__builtin_bit_cast(unsigned, av[0] + bv[j]) & ~0xffu) | (unsigned)j);
#pragma unroll
    for (int i = 1; i < 16; ++i)
#pragma unroll
        for (int j = 0; j < 16; ++j)
            if ((i + 1) * (j + 1) <= 16) {
                float x = __builtin_bit_cast(float, (__builtin_bit_cast(unsigned, av[i] + bv[j]) & ~0xffu) | (unsigned)(i * 16 + j));
#pragma unroll
                for (int s = (i + 1) * (j + 1) - 1; s < 16; ++s) { const float hi = fmaxf(FV[s], x); x = fminf(FV[s], x); FV[s] = hi; }
            }
}

__device__ __forceinline__ void p6_topk(const _Float16* S, unsigned short* IDX, float* EV, float* INV, LAS unsigned char* lds, int gw, int NGW, int wave, int lane) {
    LAS unsigned char* my = lds + wave * 9216;
    for (int grp = gw; grp < M * NH / 64; grp += NGW) {
        const char* base = (const char*)S + (size_t)grp * 64 * 512;
        float LA[16], LB[16];
#pragma unroll
        for (int half = 0; half < 2; ++half) {
            float L[16];
#pragma unroll
            for (int i = 0; i < 16; ++i) L[i] = TK_NEG;
#pragma unroll 1
            for (int step = 0; step < 2; ++step) {
                const int j = half * 2 + step;
#pragma unroll
                for (int q = 0; q < 8; ++q) { const int row = 8 * q + (lane >> 3), chn = lane & 7;
                    const v4u dd = *(const v4u*)(base + (size_t)row * 512 + 128 * j + 16 * chn); *(LAS v4u*)(my + row * 144 + 16 * chn) = dd; }
                asm volatile("s_waitcnt lgkmcnt(0)" ::: "memory");
#pragma unroll 1
                for (int pr = 0; pr < 4; ++pr) {
                    const v4u d0 = *(const LAS v4u*)(my + lane * 144 + 32 * pr), d1 = *(const LAS v4u*)(my + lane * 144 + 32 * pr + 16);
                    const unsigned w0[4] = {d0.x, d0.y, d0.z, d0.w}, w1[4] = {d1.x, d1.y, d1.z, d1.w};
                    float a[8], b[8];
                    const unsigned kb0 = (unsigned)(127 - (step * 64 + pr * 16));
#pragma unroll
                    for (int e = 0; e < 8; ++e) {
                        const unsigned ha = (e & 1) ? (w0[e >> 1] >> 16) : (w0[e >> 1] & 0xffffu), hb = (e & 1) ? (w1[e >> 1] >> 16) : (w1[e >> 1] & 0xffffu);
                        const float fa = (float)__builtin_bit_cast(_Float16, (unsigned short)ha), fb = (float)__builtin_bit_cast(_Float16, (unsigned short)hb);
                        a[e] = __builtin_bit_cast(float, __builtin_bit_cast(unsigned, fa) | (kb0 - (unsigned)e));
                        b[e] = __builtin_bit_cast(float, __builtin_bit_cast(unsigned, fb) | (kb0 - 8u - (unsigned)e));
                    }
                    tk_add16(L, a, b);
                }
                asm volatile("s_waitcnt lgkmcnt(0)" ::: "memory");
            }
#pragma unroll
            for (int i = 0; i < 16; ++i) { if (half == 0) LA[i] = L[i]; else LB[i] = L[i]; }
        }
        float FV[16];
        tk_final(LA, LB, FV);
        LAS unsigned char* kl = my + lane * 144;
#pragma unroll
        for (int q = 0; q < 4; ++q) { unsigned wa = 0, wb = 0;
#pragma unroll
            for (int e = 0; e < 4; ++e) { wa |= (127u - (__builtin_bit_cast(unsigned, LA[4 * q + e]) & 0x7fu)) << (8 * e); wb |= (127u - (__builtin_bit_cast(unsigned, LB[4 * q + e]) & 0x7fu)) << (8 * e); }
            *(LAS unsigned*)(kl + 4 * q) = wa; *(LAS unsigned*)(kl + 16 + 4 * q) = wb; }
        asm volatile("s_waitcnt lgkmcnt(0)" ::: "memory");
        int FI[16]; float ev[16]; float sum = 0.f;
        const float top = __builtin_bit_cast(float, __builtin_bit_cast(unsigned, FV[0]) & ~0xffu);
#pragma unroll
        for (int s = 0; s < 16; ++s) { const unsigned u = __builtin_bit_cast(unsigned, FV[s]); const unsigned ci = (u >> 4) & 15u, cj = u & 15u;
            const unsigned ka = *(const LAS unsigned char*)(kl + ci), kb = *(const LAS unsigned char*)(kl + 16 + cj);
            FI[s] = (int)(ka * 128u + kb);
            ev[s] = __expf(__builtin_bit_cast(float, u & ~0xffu) - top); sum += ev[s]; }
        asm volatile("s_waitcnt lgkmcnt(0)" ::: "memory");
        const size_t r = (size_t)grp * 64 + lane;
        v4u i0, i1;
        i0.x = (unsigned)FI[0] | ((unsigned)FI[1] << 16); i0.y = (unsigned)FI[2] | ((unsigned)FI[3] << 16); i0.z = (unsigned)FI[4] | ((unsigned)FI[5] << 16); i0.w = (unsigned)FI[6] | ((unsigned)FI[7] << 16);
        i1.x = (unsigned)FI[8] | ((unsigned)FI[9] << 16); i1.y = (unsigned)FI[10] | ((unsigned)FI[11] << 16); i1.z = (unsigned)FI[12] | ((unsigned)FI[13] << 16); i1.w = (unsigned)FI[14] | ((unsigned)FI[15] << 16);
        *(v4u*)(IDX + r * 16) = i0; *(v4u*)(IDX + r * 16 + 8) = i1;
#pragma unroll
        for (int q = 0; q < 4; ++q) *(f32x4*)(EV + r * 16 + 4 * q) = (f32x4){ev[4 * q], ev[4 * q + 1], ev[4 * q + 2], ev[4 * q + 3]};
        INV[r] = 1.f / sum;
    }
}

__device__ __forceinline__ float ubf(unsigned w, int b) { return (float)((w >> (8 * b)) & 0xffu); }
typedef float v2f __attribute__((ext_vector_type(2)));
__device__ __forceinline__ int q_pull(unsigned* heads, int s, int lane) { int it = 0; if (lane == 0) it = (int)__hip_atomic_fetch_add(heads + 64 * s, 1u, __ATOMIC_RELAXED, __HIP_MEMORY_SCOPE_AGENT); return __builtin_amdgcn_readfirstlane(it); }

struct UIdx { v4u ia, ib; };
struct UBuf { v4u ur[16]; v4u xa, xb; };
__device__ __forceinline__ void u_idx(UIdx& p, int t, const unsigned short* IDX, int lane) { const unsigned short* ip = IDX + (size_t)t * 128 + (lane >> 3) * 16; p.ia = *(const v4u*)ip; p.ib = *(const v4u*)(ip + 8); }
__device__ __forceinline__ void u_gather(UBuf& b, const UIdx& p, int s, int t, const bf16* X1, const unsigned char* U8, int lane) {
    const int c = lane & 7;
    const unsigned iw[8] = {p.ia.x, p.ia.y, p.ia.z, p.ia.w, p.ib.x, p.ib.y, p.ib.z, p.ib.w};
    const unsigned char* ub = U8 + (size_t)s * NE * 128 + 16 * c;
#pragma unroll
    for (int i = 0; i < 16; ++i) { const unsigned e = (i & 1) ? (iw[i >> 1] >> 16) : (iw[i >> 1] & 0xffffu); b.ur[i] = *(const v4u*)(ub + (size_t)e * 128); }
    const bf16* xp = X1 + (size_t)t * D + 128 * s + 16 * c;
    b.xa = *(const v4u*)xp; b.xb = *(const v4u*)(xp + 8);
}
__device__ __forceinline__ void u_compute(const UBuf& bf, int s, int t, float* PART, int lane) {
    float xv[16];
    { float f[8]; unpack8(bf.xa, f);
#pragma unroll
      for (int i = 0; i < 8; ++i) xv[i] = f[i];
      unpack8(bf.xb, f);
#pragma unroll
      for (int i = 0; i < 8; ++i) xv[8 + i] = f[i]; }
    float mx = 0.f;
#pragma unroll
    for (int i = 0; i < 16; ++i) mx = fmaxf(mx, fabsf(xv[i]));
    mx = fmaxf(mx, __shfl_xor(mx, 1)); mx = fmaxf(mx, __shfl_xor(mx, 2)); mx = fmaxf(mx, __shfl_xor(mx, 4));
    const float sx = mx > 0.f ? mx * (1.f / 127.f) : 1.f, isx = 1.f / sx;
    int xq[4];
#pragma unroll
    for (int j = 0; j < 4; ++j) { unsigned a = 0;
#pragma unroll
        for (int b = 0; b < 4; ++b) { int q = (int)rintf(xv[4 * j + b] * isx); q = q > 127 ? 127 : (q < -127 ? -127 : q); a |= ((unsigned)q & 0xffu) << (8 * b); }
        xq[j] = (int)a; }
    int p[16];
#pragma unroll
    for (int i = 0; i < 16; ++i) { int a = __builtin_amdgcn_sdot4((int)bf.ur[i].x, xq[0], 0, false); a = __builtin_amdgcn_sdot4((int)bf.ur[i].y, xq[1], a, false);
        a = __builtin_amdgcn_sdot4((int)bf.ur[i].z, xq[2], a, false); a = __builtin_amdgcn_sdot4((int)bf.ur[i].w, xq[3], a, false); p[i] = a; }
    int r8[8], r4[4], r2[2];
    const bool b2 = lane & 4, b1 = lane & 2, b0 = lane & 1;
#pragma unroll
    for (int i = 0; i < 8; ++i) { const int snd = b2 ? p[i] : p[i + 8], kp = b2 ? p[i + 8] : p[i]; r8[i] = kp + __shfl_xor(snd, 4); }
#pragma unroll
    for (int i = 0; i < 4; ++i) { const int snd = b1 ? r8[i] : r8[i + 4], kp = b1 ? r8[i + 4] : r8[i]; r4[i] = kp + __shfl_xor(snd, 2); }
#pragma unroll
    for (int i = 0; i < 2; ++i) { const int snd = b0 ? r4[i] : r4[i + 2], kp = b0 ? r4[i + 2] : r4[i]; r2[i] = kp + __shfl_xor(snd, 1); }
    *(v2f*)(PART + ((size_t)s * M + t) * 128 + 2 * lane) = (v2f){(float)r2[0] * sx, (float)r2[1] * sx};
}
__device__ __forceinline__ void p7_u_phase(unsigned* heads, unsigned xcc, const bf16* X1, const unsigned short* IDX, const unsigned char* U8, float* PART, int lane) {
    int s = (int)(xcc & 7u), tried = 0;
    for (;;) {
        const int item = q_pull(heads, s, lane);
        if (item >= M / TPI) { if (++tried == 8) break; s = (s + 1) & 7; continue; }
        const int t0 = item * TPI, tl = t0 + TPI - 1;
        UIdx ia, ib, in; UBuf ga, gb;
        u_idx(ia, t0, IDX, lane); u_idx(ib, t0 + 1, IDX, lane);
        u_gather(ga, ia, s, t0, X1, U8, lane);
#pragma unroll 1
        for (int i = 0; i < TPI; i += 2) {
            const int t = t0 + i, t2 = (t + 2) < tl ? (t + 2) : tl, t3 = (t + 3) < tl ? (t + 3) : tl;
            u_gather(gb, ib, s, t + 1, X1, U8, lane);
            u_idx(in, t2, IDX, lane);
            u_compute(ga, s, t, PART, lane);
            ia = in;
            u_gather(ga, ia, s, t2, X1, U8, lane);
            u_idx(in, t3, IDX, lane);
            u_compute(gb, s, t + 1, PART, lane);
            ib = in;
        }
    }
}
__device__ __forceinline__ void p8_w_phase(const float* PART, const float* RSTD, const unsigned short* IDX, const float* EV, const float* INV, const float* SU, const float* SV, float* WV, int gw, int NGW, int lane) {
    for (int t = gw; t < M; t += NGW) {
        float a0 = 0.f, a1 = 0.f;
#pragma unroll
        for (int x = 0; x < 8; ++x) { const v2f pp = *(const v2f*)(PART + ((size_t)x * M + t) * 128 + 2 * lane); a0 += pp.x; a1 += pp.y; }
        const unsigned ip = *(const unsigned*)(IDX + (size_t)t * 128 + 2 * lane); const int e0 = (int)(ip & 0xffffu), e1 = (int)(ip >> 16);
        const v2f evp = *(const v2f*)(EV + (size_t)t * 128 + 2 * lane); const float iv = INV[(size_t)t * NH + (lane >> 3)];
        const float rstd = RSTD[t];
        const float act0 = a0 * SU[e0] * rstd, act1 = a1 * SU[e1] * rstd;
        const float w0 = evp.x * iv * (0.5f * act0 * (1.f + erff(act0 * 0.70710678118654752f))) * SV[e0];
        const float w1 = evp.y * iv * (0.5f * act1 * (1.f + erff(act1 * 0.70710678118654752f))) * SV[e1];
        *(v2f*)(WV + (size_t)t * 128 + 2 * lane) = (v2f){w0, w1};
    }
}
struct VBuf { v4u vr[16]; v2f w2; unsigned xw; };
__device__ __forceinline__ void v_gather(VBuf& b, const UIdx& p, int s, int t, const bf16* X1, const float* WV, const unsigned char* V8, int lane) {
    const int c = lane & 7, g = lane >> 3;
    const unsigned iw[8] = {p.ia.x, p.ia.y, p.ia.z, p.ia.w, p.ib.x, p.ib.y, p.ib.z, p.ib.w};
    const unsigned char* vb = V8 + (size_t)s * NE * 128 + 16 * c;
#pragma unroll
    for (int i = 0; i < 16; ++i) { const unsigned e = (i & 1) ? (iw[i >> 1] >> 16) : (iw[i >> 1] & 0xffffu); b.vr[i] = *(const v4u*)(vb + (size_t)e * 128); }
    b.w2 = *(const v2f*)(WV + (size_t)t * 128 + 2 * lane);
    b.xw = *(const unsigned*)(X1 + (size_t)t * D + 128 * s + 16 * c + 2 * g);
}
__device__ __forceinline__ void v_compute(const VBuf& bf, int s, int t, float* out, float* SSQ2, int lane) {
    const int c = lane & 7, g = lane >> 3;
    v2f ac[8];
#pragma unroll
    for (int j = 0; j < 8; ++j) ac[j] = (v2f){0.f, 0.f};
#pragma unroll
    for (int i = 0; i < 16; ++i) { const float wi = __shfl((i & 1) ? bf.w2.y : bf.w2.x, (lane & ~7) | (i >> 1)); const v2f ww = {wi, wi};
#pragma unroll
        for (int j = 0; j < 4; ++j) { const int w = (int)bf.vr[i][j];
            ac[2 * j] = __builtin_elementwise_fma(ww, __builtin_amdgcn_cvt_pk_f32_fp8(w, false), ac[2 * j]);
            ac[2 * j + 1] = __builtin_elementwise_fma(ww, __builtin_amdgcn_cvt_pk_f32_fp8(w, true), ac[2 * j + 1]); } }
    float acc[16];
#pragma unroll
    for (int j = 0; j < 8; ++j) { acc[2 * j] = ac[j].x; acc[2 * j + 1] = ac[j].y; }
    float r8[8], r4[4], r2[2];
    const bool b5 = lane & 32, b4 = lane & 16, b3 = lane & 8;
#pragma unroll
    for (int i = 0; i < 8; ++i) { const float snd = b5 ? acc[i] : acc[i + 8], kp = b5 ? acc[i + 8] : acc[i]; r8[i] = kp + __shfl_xor(snd, 32); }
#pragma unroll
    for (int i = 0; i < 4; ++i) { const float snd = b4 ? r8[i] : r8[i + 4], kp = b4 ? r8[i + 4] : r8[i]; r4[i] = kp + __shfl_xor(snd, 16); }
#pragma unroll
    for (int i = 0; i < 2; ++i) { const float snd = b3 ? r4[i] : r4[i + 2], kp = b3 ? r4[i + 2] : r4[i]; r2[i] = kp + __shfl_xor(snd, 8); }
    const size_t col = (size_t)t * D + 128 * s + 16 * c + 2 * g;
    const float y0 = bflo(bf.xw) + r2[0], y1 = bfhi(bf.xw) + r2[1];
    const float ss = wave_sum(y0 * y0 + y1 * y1);
    *(v2f*)(out + col) = (v2f){y0, y1};
    if (lane == 0) SSQ2[(size_t)t * 8 + s] = ss;
}
__device__ __forceinline__ void p9_v_phase(unsigned* heads, unsigned xcc, const bf16* X1, const unsigned short* IDX, const float* WV, const unsigned char* V8, float* out, float* SSQ2, int lane) {
    int s = (int)(xcc & 7u), tried = 0;
    for (;;) {
        const int item = q_pull(heads, s, lane);
        if (item >= M / TPI) { if (++tried == 8) break; s = (s + 1) & 7; continue; }
        const int t0 = item * TPI, tl = t0 + TPI - 1;
        UIdx ia, ib, in; VBuf ga, gb;
        u_idx(ia, t0, IDX, lane); u_idx(ib, t0 + 1, IDX, lane);
        v_gather(ga, ia, s, t0, X1, WV, V8, lane);
#pragma unroll 1
        for (int i = 0; i < TPI; i += 2) {
            const int t = t0 + i, t2 = (t + 2) < tl ? (t + 2) : tl, t3 = (t + 3) < tl ? (t + 3) : tl;
            v_gather(gb, ib, s, t + 1, X1, WV, V8, lane);
            u_idx(in, t2, IDX, lane);
            v_compute(ga, s, t, out, SSQ2, lane);
            ia = in;
            v_gather(ga, ia, s, t2, X1, WV, V8, lane);
            u_idx(in, t3, IDX, lane);
            v_compute(gb, s, t + 1, out, SSQ2, lane);
            ib = in;
        }
    }
}
__device__ __forceinline__ void p10_final(float* out, const float* SSQ2, const float* gfin, int gw, int NGW, int lane) {
    f32x4 gf[4];
#pragma unroll
    for (int j = 0; j < 4; ++j) gf[j] = ((const f32x4*)gfin)[lane + 64 * j];
    for (int t = gw; t < M; t += NGW) {
        const float ssp = lane < 8 ? SSQ2[(size_t)t * 8 + lane] : 0.f;
        const float r2 = rsqrtf(wave_sum(ssp) * (1.f / D) + RMS_EPS);
        f32x4* o = (f32x4*)(out + (size_t)t * D) + lane;
#pragma unroll
        for (int j = 0; j < 4; ++j) { const f32x4 v = o[64 * j]; o[64 * j] = (f32x4){v.x * r2 * gf[j].x, v.y * r2 * gf[j].y, v.z * r2 * gf[j].z, v.w * r2 * gf[j].w}; }
    }
}

struct Args { const float* in[15]; float* out; unsigned char* ws; int ph_lo, ph_hi, li, pad; };
__global__ void __launch_bounds__(NWAVES * 64, 2) fwd_kernel(Args args) {
    extern __shared__ __attribute__((aligned(16))) unsigned char lds_raw[];
    LAS unsigned char* lds = (LAS unsigned char*)lds_raw;
    volatile LAS unsigned* MISC = (volatile LAS unsigned*)(lds + MISC_OFF);
    const int tid = threadIdx.x, lane = tid & 63, wave = __builtin_amdgcn_readfirstlane(tid >> 6);
    const int G = gridDim.x; const int bx = blockIdx.x; const int vcu = (G % 8 == 0) ? (bx % 8) * (G / 8) + bx / 8 : bx;
    const int gw = vcu * NWAVES + wave, NGW = G * NWAVES;
    unsigned char* ws = args.ws;
    gu32* ctl = (gu32*)(ws + WS_CTL);
    const float* x = args.in[0]; const float* g_mix = args.in[1]; const float* w_in = args.in[2]; const float* pool_gw = args.in[3]; const float* pool_scale = args.in[4];
    const float* conv_w = args.in[5]; const float* w_bp = args.in[6]; const float* w_bc = args.in[7]; const float* w_out = args.in[8]; const float* g_ffn = args.in[9];
    const float* w_q = args.in[10]; const float* sub_keys = args.in[11]; const float* expert_u = args.in[12]; const float* expert_v = args.in[13]; const float* g_final = args.in[14];
    bf16* Wc_t = (bf16*)(ws + WS_WC); bf16* Wbc_t = (bf16*)(ws + WS_WBC); bf16* Wout_t = (bf16*)(ws + WS_WOUT); bf16* Wpp_t = (bf16*)(ws + WS_WPP);
    float* SU = (float*)(ws + WS_SU); float* SV = (float*)(ws + WS_SV); float* SSQ = (float*)(ws + WS_SSQ);
    unsigned char* U8 = ws + WS_U8; unsigned char* V8 = ws + WS_V8; float* INV = (float*)(ws + WS_INV); float* SSQ2 = (float*)(ws + WS_SSQ2); float* PART = (float*)(ws + WS_PART); float* RSTD = (float*)(ws + WS_RSTD); float* WV = (float*)(ws + WS_WV);
    unsigned char* Hq = ws + WS_B; unsigned char* Winq = ws + WS_WIN; float* SA = (float*)(ws + WS_SA); float* SB = (float*)(ws + WS_SB); unsigned* CMAX = (unsigned*)(ctl + CW_CMAX); bf16* PA = (bf16*)(ws + WS_B); bf16* CA = (bf16*)(ws + WS_B + 64 * MiB); bf16* X1 = (bf16*)(ws + WS_B);
    bf16* Mb = (bf16*)(ws + WS_C); unsigned short* IDX = (unsigned short*)(ws + WS_C); float* EV = (float*)(ws + WS_C + 16 * MiB);
    bf16* Zb = (bf16*)(ws + WS_A); _Float16* SC = (_Float16*)(ws + WS_A);

    for (int u = tid; u < (LDS_BYTES - LDSCTL_OFF) / 4; u += NWAVES * 64) ((LAS unsigned*)(lds + LDSCTL_OFF))[u] = 0u;
    __syncthreads();
    XcdBarrier bar; bar.bar = (unsigned*)(ctl + CW_BAR); bar.x = 0; bar.st = nullptr;
    if (N_LAUNCHES != PER_PHASE) bar = xcd_barrier_post((unsigned*)(ctl + CW_BAR), MISC + 8);
#define GRID_BAR() do { if (N_LAUNCHES != PER_PHASE) xcd_barrier(bar); } while (0)
    const int lo = args.ph_lo, hi = args.ph_hi;
#define IN(k) (lo <= (k) && (k) < hi)
#define BOTH(k) (IN(k) && IN((k) + 1))

    if (IN(0)) for (int rep_ = 0; rep_ < ((PROBE_REPEAT >> 0) & 1) + 1; ++rep_) {
        LAS float* scr = (LAS float*)(lds + wave * 16384);
        constexpr int I_WPP = 1024, I_CMAX = 16 * 16, I_WOUT = (1024 / 64) * (1024 / 32), I_WBC = (512 / 64) * (1024 / 32), I_WC = 512;
        constexpr int NITEMS = I_WPP + I_CMAX + I_WOUT + I_WBC + I_WC;
        for (int it = gw; it < NITEMS; it += NGW) {
            int r = it;
            if (r < I_WPP) { p0_wpp_item(w_q, sub_keys, g_ffn, Wpp_t, scr, r, lane); continue; } r -= I_WPP;
            if (r < I_CMAX) { p0_colmax_item(w_in, 4096, CMAX, r, lane); continue; } r -= I_CMAX;
            if (r < I_WOUT) { p0_transpose_item(w_out, 1024, 1024, Wout_t, scr, r, lane); continue; } r -= I_WOUT;
            if (r < I_WBC) { p0_transpose_item(w_bc, 512, 1024, Wbc_t, scr, r, lane); continue; } r -= I_WBC;
            p0_wc_item(pool_gw, pool_scale, w_bp, Wc_t, r, lane);
        }
        GRID_BAR();
        for (int it = gw; it < (1024 / 64) * (4096 / 32); it += NGW) p0_transpose_i8_item(w_in, 1024, 4096, Winq, CMAX, SB, scr, it, lane);
        for (int e = gw; e < NE; e += 2 * NGW) p0_quant_rows2<false>(expert_u, g_ffn, U8, SU, e, e + NGW, lane);
        for (int e = gw; e < NE; e += 2 * NGW) p0_quant_rows2<true>(expert_v, nullptr, V8, SV, e, e + NGW, lane);
        for (int m = gw; m < M; m += 2 * NGW) p0_h_rows2(x, g_mix, Hq, SA, m, m + NGW, lane);
        if (BOTH(0)) GRID_BAR();
    }
    if (IN(1)) for (int rep_ = 0; rep_ < ((PROBE_REPEAT >> 1) & 1) + 1; ++rep_) {
        pg8::Gemm g{(const bf16*)Hq, (const bf16*)Winq, (const bf16*)Hq, (const bf16*)Winq, M, DIN, D / 2}; pg8::StaticOrder S; S.init(M, DIN, G, bx, 1, 1 + ((PROBE_GEMM_REP >> 1) & 1));
        EpiZ E{Zb, DIN, SA, SB};
        pg8::gemm_phase<EpiZ, pg8::StaticOrder, true, true, true>(lds, g, S, E);
        if (BOTH(1)) GRID_BAR();
    }
    if (IN(2)) for (int rep_ = 0; rep_ < ((PROBE_REPEAT >> 2) & 1) + 1; ++rep_) {
        p2_timemix(Zb, conv_w, PA, CA, gw, NGW, lane);
        if (BOTH(2)) GRID_BAR();
    }
    if (IN(3)) for (int rep_ = 0; rep_ < ((PROBE_REPEAT >> 3) & 1) + 1; ++rep_) {
        pg8::Gemm g{PA, Wc_t, CA, Wbc_t, M, D, DP}; pg8::StaticOrder S; S.init(M, D, G, bx, 2, 1 + ((PROBE_GEMM_REP >> 3) & 1));
        EpiGate E{Zb, Mb};
        pg8::gemm_phase<EpiGate, pg8::StaticOrder, true, true>(lds, g, S, E);
        if (BOTH(3)) GRID_BAR();
    }
    if (IN(4)) for (int rep_ = 0; rep_ < ((PROBE_REPEAT >> 4) & 1) + 1; ++rep_) {
        pg8::Gemm g{Mb, Wout_t, Mb, Wout_t, M, D, D}; pg8::StaticOrder S; S.init(M, D, G, bx, 1, 1 + ((PROBE_GEMM_REP >> 4) & 1));
        EpiRes E{x, X1, SSQ};
        pg8::gemm_phase<EpiRes, pg8::StaticOrder, true, true>(lds, g, S, E);
        if (BOTH(4)) GRID_BAR();
    }
    if (IN(5)) for (int rep_ = 0; rep_ < ((PROBE_REPEAT >> 5) & 1) + 1; ++rep_) {
        pg8::Gemm g{X1, Wpp_t, X1, Wpp_t, M, NSC, D}; pg8::StaticOrder S; S.init(M, NSC, G, bx, 1, 1 + ((PROBE_GEMM_REP >> 5) & 1));
        EpiScore E{SSQ, SC, RSTD};
        pg8::gemm_phase<EpiScore, pg8::StaticOrder, true, true>(lds, g, S, E);
        if (BOTH(5)) GRID_BAR();
    }
    if (IN(6)) for (int rep_ = 0; rep_ < ((PROBE_REPEAT >> 6) & 1) + 1; ++rep_) {
        p6_topk(SC, IDX, EV, INV, lds, gw, NGW, wave, lane);
        if (BOTH(6)) GRID_BAR();
    }
    const unsigned xcc = xb_xcc_id();
    if (IN(7)) for (int rep_ = 0; rep_ < ((PROBE_REPEAT >> 7) & 1) + 1; ++rep_) {
        p7_u_phase((unsigned*)(ctl + CW_QU + 2048 * rep_), xcc, X1, IDX, U8, PART, lane);
        if (BOTH(7)) GRID_BAR();
    }
    if (IN(8)) for (int rep_ = 0; rep_ < ((PROBE_REPEAT >> 8) & 1) + 1; ++rep_) {
        p8_w_phase(PART, RSTD, IDX, EV, INV, SU, SV, WV, gw, NGW, lane);
        if (BOTH(8)) GRID_BAR();
    }
    if (IN(9)) for (int rep_ = 0; rep_ < ((PROBE_REPEAT >> 9) & 1) + 1; ++rep_) {
        p9_v_phase((unsigned*)(ctl + CW_QV + 2048 * rep_), xcc, X1, IDX, WV, V8, args.out, SSQ2, lane);
        if (BOTH(9)) GRID_BAR();
    }
    if (IN(10)) {
        p10_final(args.out, SSQ2, g_final, gw, NGW, lane);
    }
#undef IN
#undef BOTH
#undef GRID_BAR
}

extern "C" void kernel_launch(void* const* d_in, const int* in_sizes, int n_in, void* d_out, int out_size, void* d_ws, size_t ws_size, hipStream_t stream) {
    static int grid = 0;
    if (grid == 0) {
        if (n_in != 15 || in_sizes[0] != M * D || out_size != M * D || ws_size < WS_END) { fprintf(stderr, "kernel_launch: unexpected shapes (n_in %d, in0 %d, out %d, ws %zu); nothing launched\n", n_in, n_in > 0 ? in_sizes[0] : -1, out_size, ws_size); grid = -1; return; }
        int dev = 0, cus = 0, per_cu = 0;
        if (hipGetDevice(&dev) != hipSuccess || hipDeviceGetAttribute(&cus, hipDeviceAttributeMultiprocessorCount, dev) != hipSuccess) { grid = -1; return; }
        if (hipFuncSetAttribute((const void*)fwd_kernel, hipFuncAttributeMaxDynamicSharedMemorySize, LDS_BYTES) != hipSuccess) { fprintf(stderr, "kernel_launch: hipFuncSetAttribute failed\n"); grid = -1; return; }
        if (hipOccupancyMaxActiveBlocksPerMultiprocessor(&per_cu, (const void*)fwd_kernel, NWAVES * 64, LDS_BYTES) != hipSuccess || per_cu < 1)
            fprintf(stderr, "kernel_launch: note: occupancy query reports %d workgroups per CU\n", per_cu);
        (void)hipGetLastError();
        grid = cus;
    }
    if (grid < 0) return;
    if (hipMemsetAsync((char*)d_ws + WS_CTL, 0, CTL_ZERO_BYTES, stream) != hipSuccess) { fprintf(stderr, "kernel_launch: hipMemsetAsync failed\n"); return; }
    Args a{};
    for (int i = 0; i < 15; ++i) a.in[i] = (const float*)d_in[i];
    a.out = (float*)d_out; a.ws = (unsigned char*)d_ws;
    for (int li = 0; li < N_LAUNCHES; ++li) {
        a.ph_lo = (N_LAUNCHES == PER_PHASE) ? li : 0; a.ph_hi = (N_LAUNCHES == PER_PHASE) ? li + 1 : PER_PHASE; a.li = li;
        hipLaunchKernelGGL(fwd_kernel, dim3(grid), dim3(NWAVES * 64), LDS_BYTES, stream, a);
        const hipError_t le = hipPeekAtLastError();
        if (le != hipSuccess) { fprintf(stderr, "kernel_launch: launch %d failed: %s\n", li, hipGetErrorName(le)); break; }
    }
}
```

```cpp
#include <hip/hip_runtime.h>
#include <cstdio>
#include <cstdint>

#ifndef PROBE_REPEAT
#define PROBE_REPEAT 0
#endif
#ifndef PROBE_GEMM_REP
#define PROBE_GEMM_REP 0
#endif
#ifndef STAGGER_P1
#define STAGGER_P1 0u
#endif
#ifndef PROBE_SKIP_EPI
#define PROBE_SKIP_EPI 0
#endif
#ifndef MK_N_LAUNCHES
#define MK_N_LAUNCHES 1
#endif

namespace pg8 {
#define PG8_LAS __attribute__((address_space(3)))
typedef unsigned short bf16_t;
typedef short bf16x8 __attribute__((ext_vector_type(8)));
typedef float f32x4 __attribute__((ext_vector_type(4)));
typedef unsigned u32x4 __attribute__((ext_vector_type(4)));
constexpr int BM = 256, BK = 64, HALF = 128, HTB = HALF * BK * 2  , STAGE_BYTES = 8 * HTB, NXCD = 8, WGM = 8;

__host__ __device__ __forceinline__ int lds_byte(int r, int c) { const int st = (r >> 4) * 2 + (c >> 5), rr = r & 15, cc = c & 31, ob = rr * 64 + cc * 2; return st * 1024 + (ob ^ (((ob >> 9) & 1) << 5)); }
__host__ __device__ __forceinline__ void stage_rc(int b, int& R, int& C) { const int st = b / 1024, sb = b % 1024, swz = sb ^ (((sb >> 9) & 1) << 5); R = (st >> 1) * 16 + swz / 64; C = (st & 1) * 32 + (swz % 64) / 2; }
__host__ __device__ __forceinline__ int perm32(int rho) { const int n = rho >> 4, i = rho & 15; return 8 * (i >> 2) + 4 * n + (i & 3); }

struct Unit { int pm, pn, seg, dup; };
struct Gemm { const bf16_t* A; const bf16_t* Bt; const bf16_t* A2; const bf16_t* Bt2; int M, N, K; };

struct StaticOrder {
    int nM, nN, nwg, G, c, segs, rep;
    __host__ __device__ void init(int M, int N, int G_, int c_, int segs_, int rep_ = 1) { nM = M / BM; nN = N / BM; nwg = nM * nN; G = G_; c = c_; segs = segs_; rep = rep_; }
    __host__ __device__ bool next(int i, Unit& u) const {
        const int ti = (segs == 2) ? (i >> 1) : i; u.seg = (segs == 2) ? (i & 1) : 0;
        const long L = (long)ti * G + c; if (L >= (long)nwg * rep) return false;
        int wgid = (int)(L % nwg); u.dup = (L >= nwg) ? 1 : 0; { const int q = nwg / NXCD, r = nwg % NXCD, xcd = wgid % NXCD, off = wgid / NXCD; wgid = (xcd < r ? xcd * (q + 1) : r * (q + 1) + (xcd - r) * q) + off; }
        const int nig = WGM * nN, gid = wgid / nig, fm = gid * WGM, gsz = (nM - fm) < WGM ? (nM - fm) : WGM;
        u.pm = fm + ((wgid % nig) % gsz); u.pn = (wgid % nig) / gsz; return true;
    }
    __device__ __forceinline__ void a_ready(const Unit&) const {}
    __device__ __forceinline__ void done(const Unit&) const {}
};

__device__ __forceinline__ unsigned cvt_pk_bf16(float lo, float hi) { unsigned r; asm volatile("v_cvt_pk_bf16_f32 %0, %1, %2" : "=v"(r) : "v"(lo), "v"(hi)); return r; }

typedef int i32x4 __attribute__((ext_vector_type(4)));
template <class Epi, class Sched, bool ALIGN_EPI = false, bool SP2 = false, bool I8 = false>
__device__ __forceinline__ void gemm_phase(PG8_LAS unsigned char* lds, const Gemm g, const Sched& S, const Epi& E, unsigned stagger_ticks = 0) {
    if (stagger_ticks) { const unsigned long long t0_ = __builtin_amdgcn_s_memrealtime(); while (__builtin_amdgcn_s_memrealtime() - t0_ < (unsigned long long)stagger_ticks) __builtin_amdgcn_s_sleep(8); }
    const int tid = threadIdx.x, wid = __builtin_amdgcn_readfirstlane(tid >> 6), lane = tid & 63, wr = wid >> 2, wc = wid & 3, fr = lane & 15, fq = lane >> 4;
    const int K = g.K, nt = K / BK;
    unsigned voffA[2], voffB[2];
#pragma unroll
    for (int i = 0; i < 2; ++i) { int R, C; stage_rc(tid * 16 + i * 8192, R, C); const int Rb = Epi::PERM ? ((R & ~31) + perm32(R & 31)) : R;
        voffA[i] = (unsigned)(R * K + C) * 2u; voffB[i] = (unsigned)(Rb * K + C) * 2u; }
    const size_t kstep = (size_t)(BK * 2);
    const size_t hstep = (size_t)HALF * K * 2;
    const size_t tstep = 2 * hstep;
    const unsigned ldsw = (unsigned)wid * 1024u;
    const int aoff = lds_byte(wr * 64 + fr, fq * 8), boff = lds_byte(wc * 32 + fr, fq * 8);
#define PG8_SA(b, h) (((b) * 2 + (h)) * HTB)
#define PG8_SB(b, h) ((4 + (b) * 2 + (h)) * HTB)
#define PG8_STAGE(bufoff, gbase, voff) do { _Pragma("unroll") for (int _i = 0; _i < 2; ++_i) \
        __builtin_amdgcn_global_load_lds((const unsigned*)((const char*)(gbase) + (voff)[_i]), (PG8_LAS unsigned*)(lds + (bufoff) + ldsw + _i * 8192), 16, 0, 0); } while (0)
#define PG8_LDA(dst, b, h) do { _Pragma("unroll") for (int m = 0; m < 4; ++m) _Pragma("unroll") for (int k = 0; k < 2; ++k) dst[m][k] = *(const PG8_LAS bf16x8*)(lds + PG8_SA(b, h) + aoff + m * 2048 + k * 1024); } while (0)
#define PG8_LDB(dst, b, h) do { _Pragma("unroll") for (int n = 0; n < 2; ++n) _Pragma("unroll") for (int k = 0; k < 2; ++k) dst[n][k] = *(const PG8_LAS bf16x8*)(lds + PG8_SB(b, h) + boff + n * 2048 + k * 1024); } while (0)
#define PG8_MMA(ai, bj, At, Bt) do { __builtin_amdgcn_s_setprio(1); _Pragma("unroll") for (int m = 0; m < 4; ++m) _Pragma("unroll") for (int n = 0; n < 2; ++n) _Pragma("unroll") for (int k = 0; k < 2; ++k) { \
        if constexpr (I8) acc[ai][bj][m][n] = __builtin_bit_cast(f32x4, __builtin_amdgcn_mfma_i32_16x16x64_i8(__builtin_bit_cast(i32x4, Bt[n][k]), __builtin_bit_cast(i32x4, At[m][k]), __builtin_bit_cast(i32x4, acc[ai][bj][m][n]), 0, 0, 0)); \
        else acc[ai][bj][m][n] = __builtin_amdgcn_mfma_f32_16x16x32_bf16(Bt[n][k], At[m][k], acc[ai][bj][m][n], 0, 0, 0); } __builtin_amdgcn_s_setprio(0); } while (0)
#define PG8_WAIT_V(n) asm volatile("s_waitcnt vmcnt(" #n ")" ::: "memory")
#define PG8_WAIT_L(n) asm volatile("s_waitcnt lgkmcnt(" #n ")" ::: "memory")
#define PG8_BAR __builtin_amdgcn_s_barrier()
#define PG8_SCHED __builtin_amdgcn_sched_barrier(0)
    Unit cur, nxt; int ui = 0;
    if (!S.next(0, cur)) return;
    f32x4 acc[2][2][4][2];
#pragma unroll
    for (int a = 0; a < 2; ++a)
#pragma unroll
        for (int b = 0; b < 2; ++b)
#pragma unroll
            for (int m = 0; m < 4; ++m)
#pragma unroll
                for (int n = 0; n < 2; ++n) acc[a][b][m][n] = (f32x4){0.f, 0.f, 0.f, 0.f};
    bf16x8 At[4][2], B0[2][2], B1[2][2];
    const char* cA = (const char*)(cur.seg ? g.A2 : g.A) + (size_t)cur.pm * tstep; const char* cB = (const char*)(cur.seg ? g.Bt2 : g.Bt) + (size_t)cur.pn * tstep;
    S.a_ready(cur);
    if constexpr (SP2) {
        PG8_STAGE(PG8_SB(0, 0), cB, voffB); PG8_STAGE(PG8_SB(0, 1), cB + hstep, voffB); PG8_STAGE(PG8_SA(0, 0), cA, voffA); PG8_STAGE(PG8_SA(0, 1), cA + hstep, voffA);
        if (wr == 1) PG8_BAR;
        PG8_WAIT_V(2); PG8_BAR;
        PG8_STAGE(PG8_SB(1, 0), cB + kstep, voffB); PG8_STAGE(PG8_SA(1, 0), cA + kstep, voffA); PG8_STAGE(PG8_SB(1, 1), cB + hstep + kstep, voffB);
        PG8_WAIT_V(6); PG8_BAR;
    } else {
        PG8_STAGE(PG8_SB(0, 0), cB, voffB); PG8_STAGE(PG8_SA(0, 0), cA, voffA); PG8_STAGE(PG8_SB(0, 1), cB + hstep, voffB); PG8_STAGE(PG8_SA(0, 1), cA + hstep, voffA);
        if (wr == 1) PG8_BAR;
        PG8_WAIT_V(4); PG8_BAR;
        PG8_STAGE(PG8_SB(1, 0), cB + kstep, voffB); PG8_STAGE(PG8_SA(1, 0), cA + kstep, voffA); PG8_STAGE(PG8_SB(1, 1), cB + hstep + kstep, voffB);
        PG8_WAIT_V(6); PG8_BAR;
    }
    for (;;) {
        const bool has_next = S.next(ui + 1, nxt);
        const char* nA = has_next ? (const char*)(nxt.seg ? g.A2 : g.A) + (size_t)nxt.pm * tstep : cA; const char* nB = has_next ? (const char*)(nxt.seg ? g.Bt2 : g.Bt) + (size_t)nxt.pn * tstep : cB;
        for (int t = 0; t < nt; t += 2) {
            const bool last = (t == nt - 2);
            const char* a1 = cA + (size_t)(t + 1) * kstep;
            const char* a2 = last ? nA : cA + (size_t)(t + 2) * kstep; const char* b2 = last ? nB : cB + (size_t)(t + 2) * kstep;
            const char* a3 = a2 + kstep; const char* b3 = b2 + kstep;
            if (last && has_next) S.a_ready(nxt);
            if constexpr (SP2) {
            PG8_LDB(B0, 0, 0); PG8_LDB(B1, 0, 1); PG8_SCHED; PG8_LDA(At, 0, 0); PG8_STAGE(PG8_SA(1, 1), a1 + hstep, voffA);
            PG8_WAIT_V(8); PG8_WAIT_L(0); PG8_BAR; PG8_MMA(0, 0, At, B0); PG8_MMA(0, 1, At, B1); PG8_BAR; PG8_SCHED;
            PG8_LDA(At, 0, 1); PG8_STAGE(PG8_SB(0, 0), b2, voffB); PG8_STAGE(PG8_SB(0, 1), b2 + hstep, voffB); PG8_STAGE(PG8_SA(0, 0), a2, voffA);
            PG8_WAIT_V(8); PG8_WAIT_L(0); PG8_BAR; PG8_MMA(1, 0, At, B0); PG8_MMA(1, 1, At, B1); PG8_BAR; PG8_SCHED;
            PG8_LDB(B0, 1, 0); PG8_LDB(B1, 1, 1); PG8_SCHED; PG8_LDA(At, 1, 0); PG8_STAGE(PG8_SA(0, 1), a2 + hstep, voffA);
            PG8_WAIT_V(8); PG8_WAIT_L(0); PG8_BAR; PG8_MMA(0, 0, At, B0); PG8_MMA(0, 1, At, B1); PG8_BAR; PG8_SCHED;
            PG8_LDA(At, 1, 1); PG8_STAGE(PG8_SB(1, 0), b3, voffB); PG8_STAGE(PG8_SB(1, 1), b3 + hstep, voffB); PG8_STAGE(PG8_SA(1, 0), a3, voffA);
            PG8_WAIT_V(8); PG8_WAIT_L(0); PG8_BAR; PG8_MMA(1, 0, At, B0); PG8_MMA(1, 1, At, B1); PG8_BAR; PG8_SCHED;
            } else {
            PG8_LDB(B0, 0, 0); PG8_SCHED; PG8_LDA(At, 0, 0); PG8_STAGE(PG8_SA(1, 1), a1 + hstep, voffA);
            PG8_WAIT_L(8); PG8_BAR; PG8_WAIT_L(0); PG8_MMA(0, 0, At, B0); PG8_BAR; PG8_SCHED;
            PG8_LDB(B1, 0, 1); PG8_STAGE(PG8_SB(0, 0), b2, voffB);
            PG8_BAR; PG8_WAIT_L(0); PG8_MMA(0, 1, At, B1); PG8_BAR;
            PG8_LDA(At, 0, 1); PG8_STAGE(PG8_SA(0, 0), a2, voffA);
            PG8_BAR; PG8_WAIT_L(0); PG8_MMA(1, 0, At, B0); PG8_BAR; PG8_SCHED;
            PG8_STAGE(PG8_SB(0, 1), b2 + hstep, voffB);
            PG8_WAIT_V(6); PG8_BAR; PG8_MMA(1, 1, At, B1); PG8_BAR;
            PG8_LDB(B0, 1, 0); PG8_SCHED; PG8_LDA(At, 1, 0); PG8_STAGE(PG8_SA(0, 1), a2 + hstep, voffA);
            PG8_WAIT_L(8); PG8_BAR; PG8_WAIT_L(0); PG8_MMA(0, 0, At, B0); PG8_BAR; PG8_SCHED;
            PG8_LDB(B1, 1, 1); PG8_STAGE(PG8_SB(1, 0), b3, voffB);
            PG8_BAR; PG8_WAIT_L(0); PG8_MMA(0, 1, At, B1); PG8_BAR;
            PG8_LDA(At, 1, 1); PG8_STAGE(PG8_SA(1, 0), a3, voffA);
            PG8_BAR; PG8_WAIT_L(0); PG8_MMA(1, 0, At, B0); PG8_BAR; PG8_SCHED;
            PG8_STAGE(PG8_SB(1, 1), b3 + hstep, voffB);
            PG8_WAIT_V(6); PG8_BAR; PG8_MMA(1, 1, At, B1); PG8_BAR;
            }
        }
        if constexpr (ALIGN_EPI) { if (wr == 0) PG8_BAR; }
        const bool keep = E(acc, cur, wr, wc, fr, fq); S.done(cur);
        if (!has_next) break;
        if (!keep) {
#pragma unroll
        for (int a = 0; a < 2; ++a)
#pragma unroll
            for (int b = 0; b < 2; ++b)
#pragma unroll
                for (int m = 0; m < 4; ++m)
#pragma unroll
                    for (int n = 0; n < 2; ++n) acc[a][b][m][n] = (f32x4){0.f, 0.f, 0.f, 0.f};
        }
        cur = nxt; cA = nA; cB = nB; ++ui;
        if constexpr (ALIGN_EPI) { if (wr == 1) PG8_BAR; }
    }
    PG8_WAIT_V(0);
    if constexpr (!ALIGN_EPI) { if (wr == 0) PG8_BAR; }
    PG8_BAR;
#undef PG8_SA
#undef PG8_SB
#undef PG8_STAGE
#undef PG8_LDA
#undef PG8_LDB
#undef PG8_MMA
#undef PG8_WAIT_V
#undef PG8_WAIT_L
#undef PG8_BAR
#undef PG8_SCHED
}
}

constexpr int NWAVES = 8;
constexpr int M = 65536, D = 1024, SEQ = 4096, DIN = 4096, DP = 512, NSC = 2048, NE = 16384, NH = 8, TOPK = 16;
constexpr float RMS_EPS = 1e-6f;
constexpr int N_LAUNCHES = MK_N_LAUNCHES;
constexpr int PER_PHASE = 11;
constexpr int TPI = 32;
__device__ __forceinline__ int ROW_REV(int t) { return M - 1 - t; }
__device__ __forceinline__ int ROW_QREV(int L) { return ((L >> 11) & 7) * 8192 + (3 - (L >> 14)) * 2048 + (L & 2047); }
__device__ __forceinline__ int GRP_QREV(int L) { return ((L >> 7) & 7) * 512 + (3 - (L >> 10)) * 128 + (L & 127); }

constexpr size_t MiB = 1u << 20;
constexpr size_t WS_CTL = 0, CTL_ZERO_BYTES = 1 * MiB;
constexpr size_t WS_WIN = 1 * MiB;
constexpr size_t WS_WC = 9 * MiB;
constexpr size_t WS_WBC = 10 * MiB;
constexpr size_t WS_SBC = 10 * MiB + 512 * 1024;
constexpr size_t WS_SPC = 62 * MiB;
constexpr size_t WS_WCF = 200 * MiB;
constexpr int CW_CMAXC = 45056;
constexpr size_t WS_WOUT = 11 * MiB;
constexpr size_t WS_WPP = 13 * MiB;
constexpr size_t WS_SBP = 15 * MiB;
constexpr size_t WS_SXR = 15 * MiB + 65536;
constexpr size_t WS_WPPF = 192 * MiB;
constexpr size_t WS_X1Q = 704 * MiB;
constexpr int CW_CMAXP = 40960;
constexpr size_t WS_SU = 17 * MiB;
constexpr size_t WS_SV = 17 * MiB + 65536;
constexpr size_t WS_SSQ = 18 * MiB;
constexpr size_t WS_U8 = 22 * MiB;
constexpr size_t WS_V8 = 38 * MiB;
constexpr size_t WS_INV = 54 * MiB;
constexpr size_t WS_SSQ2 = 56 * MiB;
constexpr size_t WS_RSTD = 58 * MiB;
constexpr size_t WS_SWH = 60 * MiB;
constexpr size_t WS_SA = 59 * MiB;
constexpr size_t WS_SB = 59 * MiB + 512 * 1024;
constexpr int CW_CMAX = 32768;
constexpr size_t WS_WV = 192 * MiB + 48 * MiB;
constexpr size_t WS_PART = 576 * MiB;
constexpr size_t WS_B = 64 * MiB;
constexpr size_t WS_C = 192 * MiB;
constexpr size_t WS_A = 320 * MiB;
constexpr size_t WS_END = 832 * MiB;
constexpr int CW_BAR = 4096;
constexpr int CW_QU = 16384, CW_QV = 16384 + 1024;

constexpr int RING_BYTES = 131072;
constexpr int LDSCTL_OFF = RING_BYTES, MISC_OFF = LDSCTL_OFF + 320;
constexpr int LDS_BYTES = 147456;

#define GAS __attribute__((address_space(1)))
#define LAS __attribute__((address_space(3)))
typedef unsigned short bf16;
typedef unsigned v4u __attribute__((ext_vector_type(4)));
typedef unsigned v2u __attribute__((ext_vector_type(2)));
typedef float f32x4 __attribute__((ext_vector_type(4)));
typedef GAS unsigned gu32;
#define RLX_AGENT __ATOMIC_RELAXED, __HIP_MEMORY_SCOPE_AGENT
#define LDS_WAIT() asm volatile("s_waitcnt lgkmcnt(0)" ::: "memory")
#define VM_WAIT() asm volatile("s_waitcnt vmcnt(0)" ::: "memory")
__device__ __forceinline__ unsigned f2bf(float f) { unsigned u = __builtin_bit_cast(unsigned, f); return (u + 0x7fffu + ((u >> 16) & 1u)) >> 16; }
__device__ __forceinline__ unsigned pk2(float lo, float hi) { return f2bf(lo) | (f2bf(hi) << 16); }
__device__ __forceinline__ float bflo(unsigned w) { return __builtin_bit_cast(float, w << 16); }
__device__ __forceinline__ float bfhi(unsigned w) { return __builtin_bit_cast(float, w & 0xffff0000u); }
template <int CTRL> __device__ __forceinline__ int dppi(int x) { return __builtin_amdgcn_mov_dpp(x, CTRL, 0xf, 0xf, true); }
__device__ __forceinline__ int xor1i(int x) { return dppi<0xB1>(x); }
__device__ __forceinline__ int xor2i(int x) { return dppi<0x4E>(x); }
__device__ __forceinline__ int xor4i(int x) { return dppi<0x1B>(dppi<0x141>(x)); }
__device__ __forceinline__ int xor8i(int x) { return dppi<0x128>(x); }
__device__ __forceinline__ float xor1f(float x) { return __builtin_bit_cast(float, xor1i(__builtin_bit_cast(int, x))); }
__device__ __forceinline__ float xor2f(float x) { return __builtin_bit_cast(float, xor2i(__builtin_bit_cast(int, x))); }
__device__ __forceinline__ float xor4f(float x) { return __builtin_bit_cast(float, xor4i(__builtin_bit_cast(int, x))); }
__device__ __forceinline__ float xor8f(float x) { return __builtin_bit_cast(float, xor8i(__builtin_bit_cast(int, x))); }
__device__ __forceinline__ float swap32_add(float a, float b) { asm volatile("s_nop 1\n\tv_permlane32_swap_b32 %0, %1" : "+v"(a), "+v"(b)); return a + b; }
__device__ __forceinline__ int swap32_addi(int a, int b) { asm volatile("s_nop 1\n\tv_permlane32_swap_b32 %0, %1" : "+v"(a), "+v"(b)); return a + b; }
__device__ __forceinline__ int swap16_addi(int a, int b) { asm volatile("s_nop 1\n\tv_permlane16_swap_b32 %0, %1" : "+v"(a), "+v"(b)); return a + b; }
__device__ __forceinline__ float swap16_add(float a, float b) { asm volatile("s_nop 1\n\tv_permlane16_swap_b32 %0, %1" : "+v"(a), "+v"(b)); return a + b; }
__device__ __forceinline__ float xor16f(float x) { float a = x, b = x; asm volatile("s_nop 1\n\tv_permlane16_swap_b32 %0, %1" : "+v"(a), "+v"(b)); return ((threadIdx.x >> 4) & 1) ? a : b; }
__device__ __forceinline__ float xor32f(float x) { float a = x, b = x; asm volatile("s_nop 1\n\tv_permlane32_swap_b32 %0, %1" : "+v"(a), "+v"(b)); return (threadIdx.x & 32) ? a : b; }
__device__ __forceinline__ float wave_sum(float v) {
    v += xor1f(v); v += xor2f(v); v += xor4f(v); v += xor8f(v);
    v = swap16_add(v, v); v = swap32_add(v, v);
    return v;
}
__device__ __forceinline__ float wave_max(float v) {
    v = fmaxf(v, xor1f(v)); v = fmaxf(v, xor2f(v)); v = fmaxf(v, xor4f(v)); v = fmaxf(v, xor8f(v));
    v = fmaxf(v, xor16f(v)); v = fmaxf(v, xor32f(v));
    return v;
}

__device__ __forceinline__ void unpack8(const v4u w, float (&f)[8]) { f[0] = bflo(w.x); f[1] = bfhi(w.x); f[2] = bflo(w.y); f[3] = bfhi(w.y); f[4] = bflo(w.z); f[5] = bfhi(w.z); f[6] = bflo(w.w); f[7] = bfhi(w.w); }
__device__ __forceinline__ v4u pack8(const float (&f)[8]) { v4u w; w.x = pk2(f[0], f[1]); w.y = pk2(f[2], f[3]); w.z = pk2(f[4], f[5]); w.w = pk2(f[6], f[7]); return w; }

#define XB_TMO      128
#define XB_XCNT(j)  (256  + 64 * (j))
#define XB_XSUB(j)  (1280 + 64 * (j))
#define XB_XGEN(j)  (2304 + 64 * (j))
#define XB_TOP      3328
#define XB_TOPGEN   3392
#define XCD_BAR_WORDS 3456
#define XB_SPIN_CAP (1u << 18)
__device__ __forceinline__ unsigned xb_ld(unsigned* p)              { return __hip_atomic_load(p, __ATOMIC_RELAXED, __HIP_MEMORY_SCOPE_AGENT); }
__device__ __forceinline__ unsigned xb_add(unsigned* p, unsigned v) { return __hip_atomic_fetch_add(p, v, __ATOMIC_RELAXED, __HIP_MEMORY_SCOPE_AGENT); }
__device__ __forceinline__ unsigned xb_xcc_id() { return (unsigned)__builtin_amdgcn_s_getreg((3 << 11) | 20) & 0xFu; }
#define XB_SPIN(cond, bar) do { unsigned _sp = 0; while (cond) { __builtin_amdgcn_s_sleep(0); \
    if ((++_sp & 255u) == 0u) { if (xb_ld(&(bar)[XB_TMO])) break; if (_sp > XB_SPIN_CAP) { atomicAdd(&(bar)[XB_TMO], 1u); break; } } } } while (0)
struct XcdBarrier { unsigned* bar; unsigned x; volatile LAS unsigned* st; };
__device__ __forceinline__ XcdBarrier xcd_barrier_post(unsigned* bar, volatile LAS unsigned* st) {
    XcdBarrier b; b.bar = bar; b.x = xb_xcc_id(); b.st = st;
    if (threadIdx.x == 0) (void)xb_add(&bar[XB_XCNT(b.x)], 1u);
    return b;
}
__device__ __forceinline__ void xcd_barrier_complete(unsigned* bar, unsigned x, unsigned& nloc, unsigned& nx) {
    const unsigned G = gridDim.x * gridDim.y * gridDim.z;
    unsigned sum, cnt, mine, sp = 0u;
    for (;;) {
        sum = 0u; cnt = 0u; mine = 0u;
#pragma unroll
        for (unsigned j = 0; j < 16; ++j) { const unsigned c = xb_ld(&bar[XB_XCNT(j)]); sum += c; cnt += (c > 0u) ? 1u : 0u; mine = (j == x) ? c : mine; }
        if (sum == G) break;
        __builtin_amdgcn_s_sleep(1);
        if ((++sp & 255u) == 0u) { if (xb_ld(&bar[XB_TMO])) break; if (sp > XB_SPIN_CAP) { atomicAdd(&bar[XB_TMO], 1u); break; } }
    }
    nloc = mine > 0u ? mine : 1u; nx = cnt > 0u ? cnt : 1u;
}
__device__ __forceinline__ void xcd_barrier(const XcdBarrier& b) {
    asm volatile("s_waitcnt vmcnt(0)" ::: "memory");
    __syncthreads();
    if (threadIdx.x == 0) {
        unsigned* bar = b.bar;
        __builtin_amdgcn_s_waitcnt(0);
        unsigned nloc = b.st[0], nx = b.st[1];
        if (nloc == 0u) { xcd_barrier_complete(bar, b.x, nloc, nx); b.st[0] = nloc; b.st[1] = nx; }
        const unsigned old = xb_add(&bar[XB_XSUB(b.x)], 1u);
        const unsigned gen = old / nloc;
        if (old + 1u == (gen + 1u) * nloc) {
            __builtin_amdgcn_fence(__ATOMIC_RELEASE, "agent");
            asm volatile("s_waitcnt vmcnt(0)" ::: "memory");
            const unsigned og = xb_add(&bar[XB_TOP], 1u);
            const unsigned tg = og / nx;
            if (og + 1u == (tg + 1u) * nx) xb_add(&bar[XB_TOPGEN], 1u);
            else XB_SPIN(xb_ld(&bar[XB_TOPGEN]) == tg, bar);
            __builtin_amdgcn_fence(__ATOMIC_ACQUIRE, "agent");
            xb_add(&bar[XB_XGEN(b.x)], 1u);
            asm volatile("s_waitcnt vmcnt(0)" ::: "memory");
        } else {
            XB_SPIN(xb_ld(&bar[XB_XGEN(b.x)]) == gen, bar);
            __builtin_amdgcn_fence(__ATOMIC_ACQUIRE, "agent");
            asm volatile("s_waitcnt vmcnt(0)" ::: "memory");
        }
    }
    __syncthreads();
}

__device__ __forceinline__ void p0_transpose_item(const float* W, int K, int N, bf16* WT, LAS float* scr, int item, int lane, const unsigned* kmax = nullptr) {
    const int nblk = N / 32, kb = item / nblk, nb = item % nblk, k0 = 64 * kb, n0 = 32 * nb;
#pragma unroll 8
    for (int i = 0; i < 32; ++i) { const int kk = 2 * i + (lane >> 5); float ks = 1.f; if (kmax) { const float mxv = __builtin_bit_cast(float, kmax[k0 + kk]); ks = mxv > 0.f ? mxv * (1.f / 127.f) : 1.f; }
        scr[kk * 33 + (lane & 31)] = W[(size_t)(k0 + kk) * N + n0 + (lane & 31)] * ks; }
    LDS_WAIT(); asm volatile("" ::: "memory");
    const int c = lane & 7;
#pragma unroll
    for (int j = 0; j < 4; ++j) { const int n = (lane >> 3) + 8 * j; const LAS float* s = scr + (8 * c) * 33 + n;
        v4u o; o.x = pk2(s[0 * 33], s[1 * 33]); o.y = pk2(s[2 * 33], s[3 * 33]); o.z = pk2(s[4 * 33], s[5 * 33]); o.w = pk2(s[6 * 33], s[7 * 33]);
        *(v4u*)(WT + (size_t)(n0 + n) * K + k0 + 8 * c) = o; }
    LDS_WAIT(); asm volatile("" ::: "memory");
}
__device__ __forceinline__ void p0_wc_item(const float* gwt, const float* scale, const float* wbp, float* WcF, unsigned* cmaxc, LAS float* scr, int item, int lane) {
    const int nb = item & 15, cb = (item >> 4) & 7, g = item >> 7;
    const int n = nb * 64 + lane;
    const f32x4* gsrc = (const f32x4*)(gwt + (size_t)((g * 128 + cb * 16) * 128));
    LAS f32x4* gt = (LAS f32x4*)scr;
#pragma unroll
    for (int i = 0; i < 8; ++i) gt[i * 64 + lane] = gsrc[i * 64 + lane];
    float acc[16];
#pragma unroll
    for (int c = 0; c < 16; ++c) acc[c] = 0.f;
    LDS_WAIT(); asm volatile("" ::: "memory");
    const float* bp = wbp + (size_t)(g * 128) * 1024 + n;
#pragma unroll 2
    for (int d4 = 0; d4 < 32; ++d4) {
        const f32x4 sc = *(const f32x4*)(scale + g * 128 + 4 * d4);
        const float b0 = bp[(size_t)(4 * d4 + 0) * 1024] * sc.x, b1 = bp[(size_t)(4 * d4 + 1) * 1024] * sc.y, b2 = bp[(size_t)(4 * d4 + 2) * 1024] * sc.z, b3 = bp[(size_t)(4 * d4 + 3) * 1024] * sc.w;
#pragma unroll
        for (int c = 0; c < 16; ++c) { const f32x4 gq = gt[c * 32 + d4]; acc[c] += (gq.x * b0 + gq.y * b1) + (gq.z * b2 + gq.w * b3); }
    }
    float* dst = WcF + (size_t)n * 512 + g * 128 + cb * 16;
    float mx = 0.f;
#pragma unroll
    for (int q = 0; q < 4; ++q) { *(f32x4*)(dst + 4 * q) = (f32x4){acc[4 * q], acc[4 * q + 1], acc[4 * q + 2], acc[4 * q + 3]};
        mx = fmaxf(mx, fmaxf(fmaxf(fabsf(acc[4 * q]), fabsf(acc[4 * q + 1])), fmaxf(fabsf(acc[4 * q + 2]), fabsf(acc[4 * q + 3])))); }
    atomicMax(cmaxc + n, __builtin_bit_cast(unsigned, mx));
    LDS_WAIT(); asm volatile("" ::: "memory");
}
__device__ __forceinline__ void p0_wc_quant_row(const float* WcF, const unsigned* cmaxc, unsigned char* Wc8, int n, int lane) {
    const f32x4* p = (const f32x4*)(WcF + (size_t)n * 512 + 8 * lane);
    const float mxv = __builtin_bit_cast(float, cmaxc[n]); const float sc = mxv > 0.f ? mxv * (1.f / 127.f) : 1.f, inv = 1.f / sc;
    v2u w;
#pragma unroll
    for (int j = 0; j < 2; ++j) { const f32x4 v = p[j]; unsigned a = 0;
#pragma unroll
        for (int c = 0; c < 4; ++c) { int q = (int)rintf(v[c] * inv); q = q > 127 ? 127 : (q < -127 ? -127 : q); a |= ((unsigned)q & 0xffu) << (8 * c); }
        w[j] = a; }
    *(v2u*)(Wc8 + (size_t)n * 512 + 8 * lane) = w;
}
__device__ __forceinline__ void p0_wpp_item(const float* wq, const float* keys, const float* gffn, float* WppF, unsigned* cmaxp, LAS float* scr, int item, int lane) {
    const int kb = item & 3, db = (item >> 2) & 15, hp = item >> 6;
    const int d = db * 64 + lane;
    const f32x4* kbase = (const f32x4*)(keys + (size_t)(hp * 128 + kb * 32) * 128);
    LAS f32x4* kt = (LAS f32x4*)scr;
#pragma unroll
    for (int i = 0; i < 16; ++i) kt[i * 64 + lane] = kbase[i * 64 + lane];
    float acc[32];
#pragma unroll
    for (int k = 0; k < 32; ++k) acc[k] = 0.f;
    const float* arow = wq + (size_t)d * 2048 + hp * 128;
    LDS_WAIT(); asm volatile("" ::: "memory");
#pragma unroll 4
    for (int c4 = 0; c4 < 32; ++c4) {
        const f32x4 a = *(const f32x4*)(arow + 4 * c4);
#pragma unroll
        for (int k = 0; k < 32; ++k) { const f32x4 kr = kt[k * 32 + c4]; acc[k] += (a.x * kr.x + a.y * kr.y) + (a.z * kr.z + a.w * kr.w); }
    }
    const float gs = gffn[d];
#pragma unroll
    for (int k = 0; k < 32; ++k) { const float v = acc[k] * gs; WppF[(size_t)(hp * 128 + kb * 32 + k) * 1024 + d] = v;
        const float mx = wave_max(fabsf(v)); if (lane == 0) atomicMax(cmaxp + hp * 128 + kb * 32 + k, __builtin_bit_cast(unsigned, mx)); }
    LDS_WAIT(); asm volatile("" ::: "memory");
}
__device__ __forceinline__ void p0_wpp_quant_row(const float* WppF, const unsigned* cmaxp, unsigned char* Wq8, float* SBP, int n, int lane) {
    const f32x4* p = (const f32x4*)(WppF + (size_t)n * 1024 + 16 * lane);
    const float mxv = __builtin_bit_cast(float, cmaxp[n]); const float sc = mxv > 0.f ? mxv * (1.f / 127.f) : 1.f, inv = 1.f / sc;
    v4u w;
#pragma unroll
    for (int j = 0; j < 4; ++j) { const f32x4 v = p[j]; unsigned a = 0;
#pragma unroll
        for (int c = 0; c < 4; ++c) { int q = (int)rintf(v[c] * inv); q = q > 127 ? 127 : (q < -127 ? -127 : q); a |= ((unsigned)q & 0xffu) << (8 * c); }
        w[j] = a; }
    *(v4u*)(Wq8 + (size_t)n * 1024 + 16 * lane) = w;
    if (lane == 0) SBP[n] = sc;
}
struct XRows { v4u a0, a1, b0, b1; float sa, sb; };
__device__ __forceinline__ void p5_x1_load(XRows& r, const bf16* X1, const float* SSQ, int r0, int r1, int lane) {
    r.a0 = *(const v4u*)(X1 + (size_t)r0 * D + 16 * lane); r.a1 = *(const v4u*)(X1 + (size_t)r0 * D + 16 * lane + 8);
    r.b0 = *(const v4u*)(X1 + (size_t)r1 * D + 16 * lane); r.b1 = *(const v4u*)(X1 + (size_t)r1 * D + 16 * lane + 8);
    r.sa = lane < 16 ? SSQ[(size_t)r0 * 16 + lane] : 0.f; r.sb = lane < 16 ? SSQ[(size_t)r1 * 16 + lane] : 0.f;
}
__device__ __forceinline__ void p5_x1_quant_rows2(const XRows& in, unsigned char* X1q, float* SX, float* SXR, float* RSTD, int r0, int r1, int lane) {
    const v4u a0 = in.a0, a1 = in.a1, b0 = in.b0, b1 = in.b1; const float sa = in.sa, sb = in.sb;
    float xa[16], xb[16];
    { float f[8]; unpack8(a0, f);
#pragma unroll
      for (int i = 0; i < 8; ++i) xa[i] = f[i];
      unpack8(a1, f);
#pragma unroll
      for (int i = 0; i < 8; ++i) xa[8 + i] = f[i];
      unpack8(b0, f);
#pragma unroll
      for (int i = 0; i < 8; ++i) xb[i] = f[i];
      unpack8(b1, f);
#pragma unroll
      for (int i = 0; i < 8; ++i) xb[8 + i] = f[i]; }
    float ma = 0.f, mb = 0.f;
#pragma unroll
    for (int i = 0; i < 16; ++i) { ma = fmaxf(ma, fabsf(xa[i])); mb = fmaxf(mb, fabsf(xb[i])); }
    ma = wave_max(ma); mb = wave_max(mb);
    const float ra = rsqrtf(wave_sum(sa) * (1.f / D) + RMS_EPS), rb = rsqrtf(wave_sum(sb) * (1.f / D) + RMS_EPS);
    const float sca = ma > 0.f ? ma * (1.f / 127.f) : 1.f, scb = mb > 0.f ? mb * (1.f / 127.f) : 1.f, ia = 1.f / sca, ib = 1.f / scb;
    v4u wa, wb;
#pragma unroll
    for (int j = 0; j < 4; ++j) { unsigned a = 0, b = 0;
#pragma unroll
        for (int c = 0; c < 4; ++c) { int q = (int)rintf(xa[4 * j + c] * ia); q = q > 127 ? 127 : (q < -127 ? -127 : q); a |= ((unsigned)q & 0xffu) << (8 * c);
            int q1 = (int)rintf(xb[4 * j + c] * ib); q1 = q1 > 127 ? 127 : (q1 < -127 ? -127 : q1); b |= ((unsigned)q1 & 0xffu) << (8 * c); }
        wa[j] = a; wb[j] = b; }
    *(v4u*)(X1q + (size_t)r0 * D + 16 * lane) = wa; *(v4u*)(X1q + (size_t)r1 * D + 16 * lane) = wb;
    if (lane == 0) { SX[r0] = sca; SX[r1] = scb; SXR[r0] = sca * ra; SXR[r1] = scb * rb; RSTD[r0] = ra; RSTD[r1] = rb; }
}
__device__ __forceinline__ void p0_h_row(const float* xrow, const float* g, bf16* orow, int lane) {
    const f32x4* xr = (const f32x4*)xrow + lane; const f32x4* gr = (const f32x4*)g + lane;
    f32x4 v[4]; float s = 0.f;
#pragma unroll
    for (int j = 0; j < 4; ++j) { v[j] = xr[64 * j]; s += (v[j].x * v[j].x + v[j].y * v[j].y) + (v[j].z * v[j].z + v[j].w * v[j].w); }
    const float rstd = rsqrtf(wave_sum(s) * (1.f / D) + RMS_EPS);
    v2u* o8 = (v2u*)orow + lane;
#pragma unroll
    for (int j = 0; j < 4; ++j) { const f32x4 gg = gr[64 * j]; v2u o; o.x = pk2(v[j].x * rstd * gg.x, v[j].y * rstd * gg.y); o.y = pk2(v[j].z * rstd * gg.z, v[j].w * rstd * gg.w); o8[64 * j] = o; }
}
struct HRows { f32x4 v0[4], v1[4]; };
__device__ __forceinline__ void p0_h_load(HRows& r, const float* x, int m0, int m1, int lane) {
    const f32x4* xr0 = (const f32x4*)(x + (size_t)m0 * D) + lane; const f32x4* xr1 = (const f32x4*)(x + (size_t)m1 * D) + lane;
#pragma unroll
    for (int j = 0; j < 4; ++j) { r.v0[j] = xr0[64 * j]; r.v1[j] = xr1[64 * j]; }
}
__device__ __forceinline__ void p0_h_rows2(const HRows& in, const float* g, unsigned char* Hq, float* SA, int m0, int m1, int lane) {
    const f32x4* gr = (const f32x4*)g + lane;
    f32x4 v0[4], v1[4]; float s0 = 0.f, s1 = 0.f;
#pragma unroll
    for (int j = 0; j < 4; ++j) { v0[j] = in.v0[j]; v1[j] = in.v1[j]; }
#pragma unroll
    for (int j = 0; j < 4; ++j) { s0 += (v0[j].x * v0[j].x + v0[j].y * v0[j].y) + (v0[j].z * v0[j].z + v0[j].w * v0[j].w); s1 += (v1[j].x * v1[j].x + v1[j].y * v1[j].y) + (v1[j].z * v1[j].z + v1[j].w * v1[j].w); }
    const float r0 = rsqrtf(wave_sum(s0) * (1.f / D) + RMS_EPS), r1 = rsqrtf(wave_sum(s1) * (1.f / D) + RMS_EPS);
    float mx0 = 0.f, mx1 = 0.f;
#pragma unroll
    for (int j = 0; j < 4; ++j) { const f32x4 gg = gr[64 * j]; v0[j] = v0[j] * gg * r0; v1[j] = v1[j] * gg * r1;
        mx0 = fmaxf(mx0, fmaxf(fmaxf(fabsf(v0[j].x), fabsf(v0[j].y)), fmaxf(fabsf(v0[j].z), fabsf(v0[j].w))));
        mx1 = fmaxf(mx1, fmaxf(fmaxf(fabsf(v1[j].x), fabsf(v1[j].y)), fmaxf(fabsf(v1[j].z), fabsf(v1[j].w)))); }
    mx0 = wave_max(mx0); mx1 = wave_max(mx1);
    const float sc0 = mx0 > 0.f ? mx0 * (1.f / 127.f) : 1.f, sc1 = mx1 > 0.f ? mx1 * (1.f / 127.f) : 1.f, i0 = 1.f / sc0, i1 = 1.f / sc1;
    unsigned* o0 = (unsigned*)(Hq + (size_t)m0 * D) + lane; unsigned* o1 = (unsigned*)(Hq + (size_t)m1 * D) + lane;
#pragma unroll
    for (int j = 0; j < 4; ++j) { unsigned a = 0, b = 0;
#pragma unroll
        for (int c = 0; c < 4; ++c) { int q = (int)rintf(v0[j][c] * i0); q = q > 127 ? 127 : (q < -127 ? -127 : q); a |= ((unsigned)q & 0xffu) << (8 * c);
            int q1 = (int)rintf(v1[j][c] * i1); q1 = q1 > 127 ? 127 : (q1 < -127 ? -127 : q1); b |= ((unsigned)q1 & 0xffu) << (8 * c); }
        o0[64 * j] = a; o1[64 * j] = b; }
    if (lane == 0) { SA[m0] = sc0; SA[m1] = sc1; }
}
__device__ __forceinline__ void p0_colmax_item(const float* W, int N, unsigned* cmax, int item, int lane) {
    const int nblk = N / 256, kb = item / nblk, nb = item % nblk;
    const float* p = W + (size_t)(kb * 64) * N + nb * 256 + 4 * lane;
    f32x4 mx = {0.f, 0.f, 0.f, 0.f};
#pragma unroll 8
    for (int k = 0; k < 64; ++k) { const f32x4 v = *(const f32x4*)(p + (size_t)k * N); mx.x = fmaxf(mx.x, fabsf(v.x)); mx.y = fmaxf(mx.y, fabsf(v.y)); mx.z = fmaxf(mx.z, fabsf(v.z)); mx.w = fmaxf(mx.w, fabsf(v.w)); }
    unsigned* c = cmax + nb * 256 + 4 * lane;
    atomicMax(c + 0, __builtin_bit_cast(unsigned, mx.x)); atomicMax(c + 1, __builtin_bit_cast(unsigned, mx.y)); atomicMax(c + 2, __builtin_bit_cast(unsigned, mx.z)); atomicMax(c + 3, __builtin_bit_cast(unsigned, mx.w));
}
__device__ __forceinline__ void p0_transpose_i8_item(const float* W, int K, int N, unsigned char* WT, const unsigned* cmax, float* SB, LAS float* scr, int item, int lane) {
    const int nblk = N / 32, kb = item / nblk, nb = item % nblk, k0 = 64 * kb, n0 = 32 * nb;
#pragma unroll 8
    for (int i = 0; i < 32; ++i) { const int kk = 2 * i + (lane >> 5); scr[kk * 33 + (lane & 31)] = W[(size_t)(k0 + kk) * N + n0 + (lane & 31)]; }
    LDS_WAIT(); asm volatile("" ::: "memory");
    const int c = lane & 3;
#pragma unroll
    for (int j = 0; j < 2; ++j) { const int n = (lane >> 2) + 16 * j; const LAS float* s = scr + (16 * c) * 33 + n;
        const float mxv = __builtin_bit_cast(float, cmax[n0 + n]); const float sc = mxv > 0.f ? mxv * (1.f / 127.f) : 1.f, inv = 1.f / sc;
        if (kb == 0 && c == 0) SB[n0 + n] = sc;
        v4u o;
#pragma unroll
        for (int q4 = 0; q4 < 4; ++q4) { unsigned a = 0;
#pragma unroll
            for (int b = 0; b < 4; ++b) { int q = (int)rintf(s[(4 * q4 + b) * 33] * inv); q = q > 127 ? 127 : (q < -127 ? -127 : q); a |= ((unsigned)q & 0xffu) << (8 * b); }
            o[q4] = a; }
        *(v4u*)(WT + (size_t)(n0 + n) * K + k0 + 16 * c) = o; }
    LDS_WAIT(); asm volatile("" ::: "memory");
}
__device__ __forceinline__ void p0_q_load(HRows& r, const float* src, int e0, int e1, int lane) {
    const f32x4* p0 = (const f32x4*)(src + (size_t)e0 * 1024 + 16 * lane); const f32x4* p1 = (const f32x4*)(src + (size_t)e1 * 1024 + 16 * lane);
#pragma unroll
    for (int j = 0; j < 4; ++j) { r.v0[j] = p0[j]; r.v1[j] = p1[j]; }
}
template <bool FP8>
__device__ __forceinline__ void p0_quant_rows2(const HRows& in, const float* gmul, unsigned char* dst, float* scale_out, int e0, int e1, int lane) {
    f32x4 v[2][4];
#pragma unroll
    for (int j = 0; j < 4; ++j) { v[0][j] = in.v0[j]; v[1][j] = in.v1[j]; }
    if (gmul) { const f32x4* gp = (const f32x4*)(gmul + 16 * lane);
#pragma unroll
        for (int j = 0; j < 4; ++j) { const f32x4 gg = gp[j]; v[0][j] = v[0][j] * gg; v[1][j] = v[1][j] * gg; } }
#pragma unroll
    for (int r = 0; r < 2; ++r) {
        float mx = 0.f;
#pragma unroll
        for (int j = 0; j < 4; ++j) mx = fmaxf(mx, fmaxf(fmaxf(fabsf(v[r][j].x), fabsf(v[r][j].y)), fmaxf(fabsf(v[r][j].z), fabsf(v[r][j].w))));
        mx = wave_max(mx);
        const float sc = mx > 0.f ? mx * (FP8 ? (1.f / 448.f) : (1.f / 127.f)) : 1.f, inv = 1.f / sc;
        v4u w;
#pragma unroll
        for (int j = 0; j < 4; ++j) {
            if (FP8) { int pk = __builtin_amdgcn_cvt_pk_fp8_f32(v[r][j].x * inv, v[r][j].y * inv, 0, false); pk = __builtin_amdgcn_cvt_pk_fp8_f32(v[r][j].z * inv, v[r][j].w * inv, pk, true); w[j] = (unsigned)pk; }
            else { unsigned acc = 0;
#pragma unroll
                for (int c = 0; c < 4; ++c) { int q = (int)rintf(v[r][j][c] * inv); q = q > 127 ? 127 : (q < -127 ? -127 : q); acc |= ((unsigned)q & 0xffu) << (8 * c); }
                w[j] = acc; }
        }
        const int e = r ? e1 : e0;
        *(v4u*)(dst + ((size_t)(lane >> 3) * NE + e) * 128 + 16 * (lane & 7)) = w;
        if (lane == 0) scale_out[e] = sc;
    }
}

__device__ __forceinline__ float ubf(unsigned w, int b) { return (float)((w >> (8 * b)) & 0xffu); }
typedef pg8::f32x4 (&AccRef)[2][2][4][2];
struct EpiZ {
    static constexpr bool PERM = true;
    unsigned char* O8; float* ZS; unsigned char* G8; const float* SA; const float* SB;
    __device__ __forceinline__ bool operator()(AccRef acc, const pg8::Unit& u, int wr, int wc, int fr, int fq) const {
        if (PROBE_SKIP_EPI == 1 && u.dup) return false;
        const int row0 = u.pm * 256 + wr * 64 + fr, col0 = u.pn * 256 + wc * 32 + 8 * fq;
        pg8::f32x4 sb[2][2];
#pragma unroll
        for (int bj = 0; bj < 2; ++bj) { sb[bj][0] = *(const pg8::f32x4*)(SB + col0 + bj * 128); sb[bj][1] = *(const pg8::f32x4*)(SB + col0 + bj * 128 + 4); }
        float sav[2][4];
#pragma unroll
        for (int ai = 0; ai < 2; ++ai)
#pragma unroll
            for (int m = 0; m < 4; ++m) sav[ai][m] = SA[row0 + ai * 128 + m * 16];
        asm volatile("" ::: "memory");
        const bool gate = u.pn >= 8;
#pragma unroll
        for (int ai = 0; ai < 2; ++ai)
#pragma unroll
            for (int m = 0; m < 4; ++m) { const int r = row0 + ai * 128 + m * 16; const float sa = sav[ai][m];
#pragma unroll
                for (int bj = 0; bj < 2; ++bj) { const pg8::i32x4 i0 = __builtin_bit_cast(pg8::i32x4, acc[ai][bj][m][0]), i1 = __builtin_bit_cast(pg8::i32x4, acc[ai][bj][m][1]);
                    pg8::f32x4 v0 = {(float)i0[0], (float)i0[1], (float)i0[2], (float)i0[3]}, v1 = {(float)i1[0], (float)i1[1], (float)i1[2], (float)i1[3]};
                    v0 = v0 * sb[bj][0] * sa; v1 = v1 * sb[bj][1] * sa;
                    if (!gate) {
                        float am = fmaxf(fmaxf(fmaxf(fabsf(v0[0]), fabsf(v0[1])), fmaxf(fabsf(v0[2]), fabsf(v0[3]))), fmaxf(fmaxf(fabsf(v1[0]), fabsf(v1[1])), fmaxf(fabsf(v1[2]), fabsf(v1[3]))));
                        am = fmaxf(am, xor16f(am)); am = fmaxf(am, xor32f(am));
                        const float sc = am > 0.f ? am * (1.f / 127.f) : 1.f, inv = __builtin_amdgcn_rcpf(sc) * 0.99999f;
#define QZ(x) __builtin_bit_cast(unsigned, fmaf((x), inv, 12582912.f + 128.f))
#define PK4(a, b, c, d) (__builtin_amdgcn_perm(QZ(b), QZ(a), 0x0c0c0400u) | (__builtin_amdgcn_perm(QZ(d), QZ(c), 0x0c0c0400u) << 16))
                        v2u w;
                        w.x = PK4(v0[0], v0[1], v0[2], v0[3]); w.y = PK4(v1[0], v1[1], v1[2], v1[3]);
#undef PK4
#undef QZ
                        *(v2u*)(O8 + (size_t)r * 2048 + col0 + bj * 128) = w;
                        if (fq == 0) ZS[(size_t)r * 64 + ((col0 + bj * 128) >> 5)] = sc;
                    } else { v2u w;
#define SQ(x) __builtin_bit_cast(unsigned, fmaxf(255.f * __builtin_amdgcn_rcpf(1.f + __builtin_amdgcn_exp2f((x) * -1.44269504089f)), 1.f) + 12582912.f)
#define PK4(a, b, c, d) (__builtin_amdgcn_perm(SQ(b), SQ(a), 0x0c0c0400u) | (__builtin_amdgcn_perm(SQ(d), SQ(c), 0x0c0c0400u) << 16))
                        w.x = PK4(v0[0], v0[1], v0[2], v0[3]); w.y = PK4(v1[0], v1[1], v1[2], v1[3]);
#undef PK4
#undef SQ
                        *(v2u*)(G8 + (size_t)r * 2048 + (col0 - 2048) + bj * 128) = w; } } }
        return false;
    }
};
__device__ __forceinline__ float einv(float x) { return 1.f + __builtin_amdgcn_exp2f(x * -1.44269504089f); }
__device__ __forceinline__ float sigm_ratio(float ga, float gb) { return einv(gb) * __builtin_amdgcn_rcpf(einv(ga)); }
__device__ __forceinline__ float iscale(float accbits_as_f, float r) { const int v = __builtin_bit_cast(int, accbits_as_f); const float y = fminf(fmaxf((float)v * r, -2.0e9f), 2.0e9f); return __builtin_bit_cast(float, (int)rintf(y)); }
struct EpiGate {
    static constexpr bool PERM = true;
    const unsigned char* G8; bf16* Mo; const float* SPC;
    __device__ __forceinline__ bool operator()(AccRef acc, const pg8::Unit& u, int wr, int wc, int fr, int fq) const {
        const int row0 = u.pm * 256 + wr * 64 + fr, col0 = u.pn * 256 + wc * 32 + 8 * fq;
        const unsigned goff0 = (unsigned)row0 * 2048u + (unsigned)col0;
        if (u.seg == 0) {
#pragma unroll
            for (int ai = 0; ai < 2; ++ai)
#pragma unroll
            for (int mh = 0; mh < 2; ++mh) {
                v2u ga[2][2], gb[2][2];
#pragma unroll
                for (int mm = 0; mm < 2; ++mm) { const unsigned go = goff0 + (unsigned)((ai * 128 + (2 * mh + mm) * 16) * 2048);
#pragma unroll
                    for (int bj = 0; bj < 2; ++bj) { ga[mm][bj] = *(const v2u*)(G8 + go + bj * 128); gb[mm][bj] = *(const v2u*)(G8 + go + 1024 + bj * 128); } }
                asm volatile("" ::: "memory");
#pragma unroll
                for (int mm = 0; mm < 2; ++mm)
#pragma unroll
                    for (int bj = 0; bj < 2; ++bj) { const v2u a = ga[mm][bj], b = gb[mm][bj]; const int m = 2 * mh + mm;
                        pg8::f32x4& v0 = acc[ai][bj][m][0]; pg8::f32x4& v1 = acc[ai][bj][m][1];
#pragma unroll
                        for (int e = 0; e < 4; ++e) { v0[e] = iscale(v0[e], ubf(a.x, e) * __builtin_amdgcn_rcpf(ubf(b.x, e))); v1[e] = iscale(v1[e], ubf(a.y, e) * __builtin_amdgcn_rcpf(ubf(b.y, e))); } }
                asm volatile("" ::: "memory");
            }
            return true;
        }
#pragma unroll
        for (int ai = 0; ai < 2; ++ai)
#pragma unroll
        for (int mh = 0; mh < 2; ++mh) {
            v2u gb[2][2]; float sr[2];
#pragma unroll
            for (int mm = 0; mm < 2; ++mm) { const int ro = ai * 128 + (2 * mh + mm) * 16; const unsigned go = goff0 + (unsigned)(ro * 2048); sr[mm] = SPC[row0 + ro] * (1.f / 255.f);
#pragma unroll
                for (int bj = 0; bj < 2; ++bj) gb[mm][bj] = *(const v2u*)(G8 + go + 1024 + bj * 128); }
            asm volatile("" ::: "memory");
#pragma unroll
            for (int mm = 0; mm < 2; ++mm) { const int m = 2 * mh + mm; const size_t r = (size_t)(row0 + ai * 128 + m * 16); bf16* mo = Mo + r * D + col0; const float rs = sr[mm];
#pragma unroll
                for (int bj = 0; bj < 2; ++bj) { const v2u b = gb[mm][bj];
                    const pg8::i32x4 i0 = __builtin_bit_cast(pg8::i32x4, acc[ai][bj][m][0]), i1 = __builtin_bit_cast(pg8::i32x4, acc[ai][bj][m][1]);
                    const pg8::f32x4 v0 = (pg8::f32x4){(float)i0[0], (float)i0[1], (float)i0[2], (float)i0[3]} * rs, v1 = (pg8::f32x4){(float)i1[0], (float)i1[1], (float)i1[2], (float)i1[3]} * rs; v4u w;
                    w.x = pg8::cvt_pk_bf16(v0[0] * ubf(b.x, 0), v0[1] * ubf(b.x, 1)); w.y = pg8::cvt_pk_bf16(v0[2] * ubf(b.x, 2), v0[3] * ubf(b.x, 3));
                    w.z = pg8::cvt_pk_bf16(v1[0] * ubf(b.y, 0), v1[1] * ubf(b.y, 1)); w.w = pg8::cvt_pk_bf16(v1[2] * ubf(b.y, 2), v1[3] * ubf(b.y, 3));
                    *(v4u*)(mo + bj * 128) = w; } }
            asm volatile("" ::: "memory");
        }
        return false;
    }
};
struct EpiRes {
    static constexpr bool PERM = true;
    const float* X; bf16* X1; float* SSQ;
    __device__ __forceinline__ bool operator()(AccRef acc, const pg8::Unit& u, int wr, int wc, int fr, int fq) const {
        if (PROBE_SKIP_EPI && u.dup) return false;
        const int row0 = u.pm * 256 + wr * 64 + fr, col0 = u.pn * 256 + wc * 32 + 8 * fq;
#pragma unroll
        for (int ai = 0; ai < 2; ++ai) {
            pg8::f32x4 xr[4][2][2];
#pragma unroll
            for (int m = 0; m < 4; ++m) { const float* xp = X + (size_t)(row0 + ai * 128 + m * 16) * D + col0;
#pragma unroll
                for (int bj = 0; bj < 2; ++bj) { xr[m][bj][0] = *(const pg8::f32x4*)(xp + bj * 128); xr[m][bj][1] = *(const pg8::f32x4*)(xp + bj * 128 + 4); } }
            asm volatile("" ::: "memory");
#pragma unroll
            for (int m = 0; m < 4; ++m) { const size_t r = (size_t)(row0 + ai * 128 + m * 16); bf16* o = X1 + r * D + col0; float ss = 0.f;
#pragma unroll
                for (int bj = 0; bj < 2; ++bj) { const pg8::f32x4 v0 = acc[ai][bj][m][0] + xr[m][bj][0], v1 = acc[ai][bj][m][1] + xr[m][bj][1];
                    ss += (v0[0] * v0[0] + v0[1] * v0[1]) + (v0[2] * v0[2] + v0[3] * v0[3]) + (v1[0] * v1[0] + v1[1] * v1[1]) + (v1[2] * v1[2] + v1[3] * v1[3]);
                    v4u w; w.x = pg8::cvt_pk_bf16(v0[0], v0[1]); w.y = pg8::cvt_pk_bf16(v0[2], v0[3]); w.z = pg8::cvt_pk_bf16(v1[0], v1[1]); w.w = pg8::cvt_pk_bf16(v1[2], v1[3]);
                    *(v4u*)(o + bj * 128) = w; }
                ss += xor16f(ss); ss += xor32f(ss);
                if (fq == 0) SSQ[r * 16 + u.pn * 4 + wc] = ss; }
            asm volatile("" ::: "memory");
        }
        return false;
    }
};
struct EpiScore {
    static constexpr bool PERM = true;
    const float* SXR; const float* SBP; _Float16* S;
    __device__ __forceinline__ bool operator()(AccRef acc, const pg8::Unit& u, int wr, int wc, int fr, int fq) const {
        if (PROBE_SKIP_EPI && u.dup) return false;
        const int row0 = u.pm * 256 + wr * 64 + fr, col0 = u.pn * 256 + wc * 32 + 8 * fq;
        pg8::f32x4 sb[2][2]; float rs[2][4];
#pragma unroll
        for (int bj = 0; bj < 2; ++bj) { sb[bj][0] = *(const pg8::f32x4*)(SBP + col0 + bj * 128); sb[bj][1] = *(const pg8::f32x4*)(SBP + col0 + bj * 128 + 4); }
#pragma unroll
        for (int ai = 0; ai < 2; ++ai)
#pragma unroll
            for (int m = 0; m < 4; ++m) rs[ai][m] = SXR[row0 + ai * 128 + m * 16];
        asm volatile("" ::: "memory");
#pragma unroll
        for (int ai = 0; ai < 2; ++ai)
#pragma unroll
            for (int m = 0; m < 4; ++m) { const size_t r = (size_t)(row0 + ai * 128 + m * 16);
                const float rstd = rs[ai][m];
                _Float16* o = S + r * NSC + col0;
#pragma unroll
                for (int bj = 0; bj < 2; ++bj) { const pg8::i32x4 i0 = __builtin_bit_cast(pg8::i32x4, acc[ai][bj][m][0]), i1 = __builtin_bit_cast(pg8::i32x4, acc[ai][bj][m][1]);
                    pg8::f32x4 v0 = {(float)i0[0], (float)i0[1], (float)i0[2], (float)i0[3]}, v1 = {(float)i1[0], (float)i1[1], (float)i1[2], (float)i1[3]};
                    v0 = v0 * sb[bj][0] * rstd; v1 = v1 * sb[bj][1] * rstd;
                    typedef _Float16 h2 __attribute__((ext_vector_type(2)));
                    h2 p0 = {(_Float16)v0[0], (_Float16)v0[1]}, p1 = {(_Float16)v0[2], (_Float16)v0[3]}, p2 = {(_Float16)v1[0], (_Float16)v1[1]}, p3 = {(_Float16)v1[2], (_Float16)v1[3]};
                    v4u w; w.x = __builtin_bit_cast(unsigned, p0); w.y = __builtin_bit_cast(unsigned, p1); w.z = __builtin_bit_cast(unsigned, p2); w.w = __builtin_bit_cast(unsigned, p3);
                    *(v4u*)(o + bj * 128) = w; } }
        return false;
    }
};

__device__ __forceinline__ void unpack8q(v2u w, float sc, float (&f)[8]) {
    const float bias = -128.f * sc;
    f[0] = fmaf(ubf(w.x, 0), sc, bias); f[1] = fmaf(ubf(w.x, 1), sc, bias); f[2] = fmaf(ubf(w.x, 2), sc, bias); f[3] = fmaf(ubf(w.x, 3), sc, bias);
    f[4] = fmaf(ubf(w.y, 0), sc, bias); f[5] = fmaf(ubf(w.y, 1), sc, bias); f[6] = fmaf(ubf(w.y, 2), sc, bias); f[7] = fmaf(ubf(w.y, 3), sc, bias);
}
__device__ __forceinline__ void p2_timemix(const unsigned char* Z8, const float* ZS, const float* convw, unsigned char* PA, unsigned char* CA, float* SPC, int gw, int NGW, int lane) {
    const int w = 2 << (lane >> 4);
    const int ch = 8 * lane;
    const int sg = lane >> 2;
    float cw0[8], cw1[8], cw2[8];
#pragma unroll
    for (int i = 0; i < 8; ++i) { cw0[i] = convw[ch + i]; cw1[i] = convw[512 + ch + i]; cw2[i] = convw[1024 + ch + i]; }
    for (int chunk = gw; chunk < M / 32; chunk += NGW) {
        const int t0 = chunk * 32, s0 = t0 & (SEQ - 1);
        float sum[8], up1[8], up2[8];
#pragma unroll
        for (int i = 0; i < 8; ++i) { sum[i] = 0.f; up1[i] = 0.f; up2[i] = 0.f; }
        if (s0 > 0) {
            for (int j = 1; j < 16; ++j) {
                if (j < w) { float f[8]; unpack8q(*(const v2u*)(Z8 + (size_t)(t0 - j) * 2048 + ch), ZS[(size_t)(t0 - j) * 64 + sg], f);
#pragma unroll
                    for (int i = 0; i < 8; ++i) sum[i] += f[i]; }
            }
            float c[8], v[8];
            unpack8q(*(const v2u*)(Z8 + (size_t)(t0 - 2) * 2048 + 512 + ch), ZS[(size_t)(t0 - 2) * 64 + 16 + sg], c); unpack8q(*(const v2u*)(Z8 + (size_t)(t0 - 2) * 2048 + 1536 + ch), ZS[(size_t)(t0 - 2) * 64 + 48 + sg], v);
#pragma unroll
            for (int i = 0; i < 8; ++i) up2[i] = c[i] * v[i];
            unpack8q(*(const v2u*)(Z8 + (size_t)(t0 - 1) * 2048 + 512 + ch), ZS[(size_t)(t0 - 1) * 64 + 16 + sg], c); unpack8q(*(const v2u*)(Z8 + (size_t)(t0 - 1) * 2048 + 1536 + ch), ZS[(size_t)(t0 - 1) * 64 + 48 + sg], v);
#pragma unroll
            for (int i = 0; i < 8; ++i) up1[i] = c[i] * v[i];
        }
        v2u nz, nc, nb, nv, nold; float qz, qc, qb, qv, qold;
#define P2_LOAD(tt, ss) { const unsigned char* zr = Z8 + (size_t)(tt) * 2048 + ch; const float* sr = ZS + (size_t)(tt) * 64 + sg; \
          nz = *(const v2u*)zr; nc = *(const v2u*)(zr + 512); nb = *(const v2u*)(zr + 1024); nv = *(const v2u*)(zr + 1536); qz = sr[0]; qc = sr[16]; qb = sr[32]; qv = sr[48]; \
          const int to = ((ss) + 1 - w >= 0) ? ((tt) + 1 - w) : (tt); nold = *(const v2u*)(Z8 + (size_t)to * 2048 + ch); qold = ZS[(size_t)to * 64 + sg]; }
        P2_LOAD(t0, s0)
        float po[8], poc[8], pmx = 0.f; int pt = t0;
#pragma unroll
        for (int i = 0; i < 8; ++i) { po[i] = 0.f; poc[i] = 0.f; }
#define QP(x) __builtin_bit_cast(unsigned, fmaf((x), iq, 12582912.f))
#define PK4(a_, b_, c_, d_) (__builtin_amdgcn_perm(QP(b_), QP(a_), 0x0c0c0400u) | (__builtin_amdgcn_perm(QP(d_), QP(c_), 0x0c0c0400u) << 16))
#define P2_FLUSH() { const float mxw = wave_max(pmx); const float scq = mxw > 0.f ? mxw * (1.f / 127.f) : 1.f, iq = __builtin_amdgcn_rcpf(scq) * 0.99999f; \
            *(v2u*)(PA + (size_t)pt * DP + ch) = (v2u){PK4(po[0], po[1], po[2], po[3]), PK4(po[4], po[5], po[6], po[7])}; \
            *(v2u*)(CA + (size_t)pt * DP + ch) = (v2u){PK4(poc[0], poc[1], poc[2], poc[3]), PK4(poc[4], poc[5], poc[6], poc[7])}; \
            if (lane == 0) SPC[pt] = scq; }
        for (int i2 = 0; i2 < 32; ++i2) {
            const int t = t0 + i2, s = s0 + i2;
            float zt[8], c[8], b[8], v[8], o[8], fo[8];
            unpack8q(nz, qz, zt); unpack8q(nc, qc, c); unpack8q(nb, qb, b); unpack8q(nv, qv, v); unpack8q(nold, qold, fo);
            { const int d1 = (i2 < 31) ? 1 : 0; P2_LOAD(t + d1, s + d1) }
            P2_FLUSH()
            const int cnt = (s + 1) < w ? (s + 1) : w; const float rc = 1.f / (float)cnt;
#pragma unroll
            for (int i = 0; i < 8; ++i) { sum[i] += zt[i]; o[i] = sum[i] * rc - zt[i]; }
            if (s + 1 - w >= 0) {
#pragma unroll
                for (int i = 0; i < 8; ++i) sum[i] -= fo[i]; }
            float oc[8];
#pragma unroll
            for (int i = 0; i < 8; ++i) { const float uu = c[i] * v[i]; oc[i] = b[i] * (cw0[i] * up2[i] + cw1[i] * up1[i] + cw2[i] * uu); up2[i] = up1[i]; up1[i] = uu; }
            float mx = 0.f;
#pragma unroll
            for (int i = 0; i < 8; ++i) { mx = fmaxf(mx, fmaxf(fabsf(o[i]), fabsf(oc[i]))); po[i] = o[i]; poc[i] = oc[i]; }
            pmx = mx; pt = t;
        }
        P2_FLUSH()
#undef P2_FLUSH
#undef PK4
#undef QP
#undef P2_LOAD
    }
}

#define TK_NEG (-3.0e38f)
__device__ __forceinline__ void tk_ce(float& a, float& b) { const float hi = fmaxf(a, b), lo = fminf(a, b); a = hi; b = lo; }
__device__ __forceinline__ void tk_sort8(float (&v)[8]) {
    tk_ce(v[0], v[1]); tk_ce(v[2], v[3]); tk_ce(v[4], v[5]); tk_ce(v[6], v[7]);
    tk_ce(v[0], v[2]); tk_ce(v[1], v[3]); tk_ce(v[4], v[6]); tk_ce(v[5], v[7]);
    tk_ce(v[1], v[2]); tk_ce(v[5], v[6]);
    tk_ce(v[0], v[4]); tk_ce(v[1], v[5]); tk_ce(v[2], v[6]); tk_ce(v[3], v[7]);
    tk_ce(v[2], v[4]); tk_ce(v[3], v[5]);
    tk_ce(v[1], v[2]); tk_ce(v[3], v[4]); tk_ce(v[5], v[6]);
}
__device__ __forceinline__ void tk_bmerge16(float (&x)[16]) {
#pragma unroll
    for (int i = 0; i < 8; ++i) tk_ce(x[i], x[i + 8]);
#pragma unroll
    for (int b = 0; b < 16; b += 8)
#pragma unroll
        for (int i = 0; i < 4; ++i) tk_ce(x[b + i], x[b + i + 4]);
#pragma unroll
    for (int b = 0; b < 16; b += 4)
#pragma unroll
        for (int i = 0; i < 2; ++i) tk_ce(x[b + i], x[b + i + 2]);
#pragma unroll
    for (int b = 0; b < 16; b += 2) tk_ce(x[b], x[b + 1]);
}
__device__ __forceinline__ void tk_add16(float (&L)[16], float (&a)[8], float (&b)[8]) {
    tk_sort8(a); tk_sort8(b);
    float s[16];
#pragma unroll
    for (int i = 0; i < 8; ++i) { s[i] = a[i]; s[8 + i] = b[7 - i]; }
    tk_bmerge16(s);
#pragma unroll
    for (int i = 0; i < 16; ++i) L[i] = fmaxf(L[i], s[15 - i]);
    tk_bmerge16(L);
}
__device__ __forceinline__ void tk_final(const float (&A)[16], const float (&B)[16], float (&FV)[16]) {
    float av[16], bv[16];
#pragma unroll
    for (int i = 0; i < 16; ++i) { av[i] = __builtin_bit_cast(float, __builtin_bit_cast(unsigned, A[i]) & ~0x7fu); bv[i] = __builtin_bit_cast(float, __builtin_bit_cast(unsigned, B[i]) & ~0x7fu); }
#pragma unroll
    for (int j = 0; j < 16; ++j) FV[j] = __builtin_bit_cast(float, (__builtin_bit_cast(unsigned, av[0] + bv[j]) & ~0xffu) | (unsigned)j);
#pragma unroll
    for (int i = 1; i < 16; ++i)
#pragma unroll
        for (int j = 0; j < 16; ++j)
            if ((i + 1) * (j + 1) <= 16) {
                float x = __builtin_bit_cast(float, (__builtin_bit_cast(unsigned, av[i] + bv[j]) & ~0xffu) | (unsigned)(i * 16 + j));
#pragma unroll
                for (int s = (i + 1) * (j + 1) - 1; s < 16; ++s) { const float hi = fmaxf(FV[s], x); x = fminf(FV[s], x); FV[s] = hi; }
            }
}

__device__ __forceinline__ void tk_unpack_octets(const v4u d0, const v4u d1, unsigned kb0, float (&a)[8], float (&b)[8]) {
    const unsigned w0[4] = {d0.x, d0.y, d0.z, d0.w}, w1[4] = {d1.x, d1.y, d1.z, d1.w};
#pragma unroll
    for (int e = 0; e < 8; ++e) {
        const unsigned ha = (e & 1) ? (w0[e >> 1] >> 16) : (w0[e >> 1] & 0xffffu), hb = (e & 1) ? (w1[e >> 1] >> 16) : (w1[e >> 1] & 0xffffu);
        const float fa = (float)__builtin_bit_cast(_Float16, (unsigned short)ha), fb = (float)__builtin_bit_cast(_Float16, (unsigned short)hb);
        a[e] = __builtin_bit_cast(float, __builtin_bit_cast(unsigned, fa) | (kb0 - (unsigned)e));
        b[e] = __builtin_bit_cast(float, __builtin_bit_cast(unsigned, fb) | (kb0 - 8u - (unsigned)e));
    }
}
__device__ __forceinline__ void tk_emit(const float (&LA)[16], const float (&LB)[16], LAS unsigned char* kl, size_t r, unsigned short* IDX, float* EV, float* INV) {
    float FV[16];
    tk_final(LA, LB, FV);
#pragma unroll
    for (int q = 0; q < 4; ++q) { unsigned wa = 0, wb = 0;
#pragma unroll
        for (int e = 0; e < 4; ++e) { wa |= (127u - (__builtin_bit_cast(unsigned, LA[4 * q + e]) & 0x7fu)) << (8 * e); wb |= (127u - (__builtin_bit_cast(unsigned, LB[4 * q + e]) & 0x7fu)) << (8 * e); }
        *(LAS unsigned*)(kl + 4 * q) = wa; *(LAS unsigned*)(kl + 16 + 4 * q) = wb; }
    asm volatile("s_waitcnt lgkmcnt(0)" ::: "memory");
    int FI[16]; float ev[16]; float sum = 0.f;
    const float top = __builtin_bit_cast(float, __builtin_bit_cast(unsigned, FV[0]) & ~0xffu);
#pragma unroll
    for (int s = 0; s < 16; ++s) { const unsigned u = __builtin_bit_cast(unsigned, FV[s]); const unsigned ci = (u >> 4) & 15u, cj = u & 15u;
        const unsigned ka = *(const LAS unsigned char*)(kl + ci), kb = *(const LAS unsigned char*)(kl + 16 + cj);
        FI[s] = (int)(ka * 128u + kb);
        ev[s] = __expf(__builtin_bit_cast(float, u & ~0xffu) - top); sum += ev[s]; }
    v4u i0, i1;
    i0.x = (unsigned)FI[0] | ((unsigned)FI[1] << 16); i0.y = (unsigned)FI[2] | ((unsigned)FI[3] << 16); i0.z = (unsigned)FI[4] | ((unsigned)FI[5] << 16); i0.w = (unsigned)FI[6] | ((unsigned)FI[7] << 16);
    i1.x = (unsigned)FI[8] | ((unsigned)FI[9] << 16); i1.y = (unsigned)FI[10] | ((unsigned)FI[11] << 16); i1.z = (unsigned)FI[12] | ((unsigned)FI[13] << 16); i1.w = (unsigned)FI[14] | ((unsigned)FI[15] << 16);
    *(v4u*)(IDX + r * 16) = i0; *(v4u*)(IDX + r * 16 + 8) = i1;
#pragma unroll
    for (int q = 0; q < 4; ++q) *(f32x4*)(EV + r * 16 + 4 * q) = (f32x4){ev[4 * q], ev[4 * q + 1], ev[4 * q + 2], ev[4 * q + 3]};
    INV[r] = 1.f / sum;
}
__device__ __forceinline__ void p6_topk(const _Float16* S, unsigned short* IDX, float* EV, float* INV, LAS unsigned char* lds, int gw, int NGW, int wave, int lane) {
    LAS unsigned char* my = lds + wave * 10240;
    const int srow = lane >> 2, schn = lane & 3;
    v4u nx[8];
    { const char* b0 = (const char*)S + (size_t)GRP_QREV(gw) * 128 * 512;
#pragma unroll
      for (int q = 0; q < 8; ++q) nx[q] = *(const v4u*)(b0 + (size_t)(16 * q + srow) * 512 + 16 * schn); }
    for (int lg = gw; lg < M * NH / 128; lg += NGW) {
        const int grp = GRP_QREV(lg);
        const char* base = (const char*)S + (size_t)grp * 128 * 512;
        const char* nbase = (const char*)S + (size_t)GRP_QREV((lg + NGW) < M * NH / 128 ? (lg + NGW) : lg) * 128 * 512;
        float LA0[16], LB0[16], LA1[16], LB1[16];
#pragma unroll
        for (int half = 0; half < 2; ++half) {
            float L0[16], L1[16];
#pragma unroll
            for (int i = 0; i < 16; ++i) { L0[i] = TK_NEG; L1[i] = TK_NEG; }
#pragma unroll 1
            for (int step = 0; step < 4; ++step) {
                const int j = half * 4 + step;
#pragma unroll
                for (int q = 0; q < 8; ++q) *(LAS v4u*)(my + (16 * q + srow) * 80 + 16 * schn) = nx[q];
                asm volatile("s_waitcnt lgkmcnt(0)" ::: "memory");
                { const char* pb = (j < 7) ? base + 64 * (j + 1) : nbase;
#pragma unroll
                  for (int q = 0; q < 8; ++q) nx[q] = *(const v4u*)(pb + (size_t)(16 * q + srow) * 512 + 16 * schn); }
                const LAS unsigned char* r0p = my + lane * 80; const LAS unsigned char* r1p = my + (lane + 64) * 80;
                const v4u a0 = *(const LAS v4u*)(r0p), a1 = *(const LAS v4u*)(r0p + 16), a2 = *(const LAS v4u*)(r0p + 32), a3 = *(const LAS v4u*)(r0p + 48);
                const v4u c0 = *(const LAS v4u*)(r1p), c1 = *(const LAS v4u*)(r1p + 16), c2 = *(const LAS v4u*)(r1p + 32), c3 = *(const LAS v4u*)(r1p + 48);
                const unsigned kb0 = (unsigned)(127 - step * 32);
                float pa[8], pb2[8], qa[8], qb[8];
                tk_unpack_octets(a0, a1, kb0, pa, pb2); tk_unpack_octets(c0, c1, kb0, qa, qb);
                tk_add16(L0, pa, pb2); tk_add16(L1, qa, qb);
                tk_unpack_octets(a2, a3, kb0 - 16u, pa, pb2); tk_unpack_octets(c2, c3, kb0 - 16u, qa, qb);
                tk_add16(L0, pa, pb2); tk_add16(L1, qa, qb);
                asm volatile("s_waitcnt lgkmcnt(0)" ::: "memory");
            }
#pragma unroll
            for (int i = 0; i < 16; ++i) { if (half == 0) { LA0[i] = L0[i]; LA1[i] = L1[i]; } else { LB0[i] = L0[i]; LB1[i] = L1[i]; } }
        }
        tk_emit(LA0, LB0, my + lane * 80, (size_t)grp * 128 + lane, IDX, EV, INV);
        tk_emit(LA1, LB1, my + (lane + 64) * 80, (size_t)grp * 128 + 64 + lane, IDX, EV, INV);
        asm volatile("s_waitcnt lgkmcnt(0)" ::: "memory");
    }
}

typedef float v2f __attribute__((ext_vector_type(2)));
__device__ __forceinline__ int q_pull(unsigned* heads, int s, int lane) { int it = 0; if (lane == 0) it = (int)__hip_atomic_fetch_add(heads + 64 * s, 1u, __ATOMIC_RELAXED, __HIP_MEMORY_SCOPE_AGENT); return __builtin_amdgcn_readfirstlane(it); }

struct UIdx { v4u ia, ib; };
struct UBuf { v4u ur[16]; v4u xa, xb; };
__device__ __forceinline__ void u_idx(UIdx& p, int t, const unsigned short* IDX, int lane) { const unsigned short* ip = IDX + (size_t)t * 128 + (lane >> 3) * 16; p.ia = *(const v4u*)ip; p.ib = *(const v4u*)(ip + 8); }
__device__ __forceinline__ void u_gather(UBuf& b, const UIdx& p, int s, int t, const bf16* X1, const unsigned char* U8, int lane) {
    const int c = lane & 7;
    const unsigned iw[8] = {p.ia.x, p.ia.y, p.ia.z, p.ia.w, p.ib.x, p.ib.y, p.ib.z, p.ib.w};
    const unsigned char* ub = U8 + (size_t)s * NE * 128 + 16 * c;
#pragma unroll
    for (int i = 0; i < 16; ++i) { const unsigned e = (i & 1) ? (iw[i >> 1] >> 16) : (iw[i >> 1] & 0xffffu); b.ur[i] = *(const v4u*)(ub + (size_t)e * 128); }
    const bf16* xp = X1 + (size_t)t * D + 128 * s + 16 * c;
    b.xa = *(const v4u*)xp; b.xb = *(const v4u*)(xp + 8);
}
__device__ __forceinline__ void u_compute(const UBuf& bf, int s, int t, float* PART, int lane) {
    float xv[16];
    { float f[8]; unpack8(bf.xa, f);
#pragma unroll
      for (int i = 0; i < 8; ++i) xv[i] = f[i];
      unpack8(bf.xb, f);
#pragma unroll
      for (int i = 0; i < 8; ++i) xv[8 + i] = f[i]; }
    float mx = 0.f;
#pragma unroll
    for (int i = 0; i < 16; ++i) mx = fmaxf(mx, fabsf(xv[i]));
    mx = fmaxf(mx, __shfl_xor(mx, 1)); mx = fmaxf(mx, __shfl_xor(mx, 2)); mx = fmaxf(mx, __shfl_xor(mx, 4));
    const float sx = mx > 0.f ? mx * (1.f / 127.f) : 1.f, isx = 1.f / sx;
    int xq[4];
#pragma unroll
    for (int j = 0; j < 4; ++j) { unsigned a = 0;
#pragma unroll
        for (int b = 0; b < 4; ++b) { int q = (int)rintf(xv[4 * j + b] * isx); q = q > 127 ? 127 : (q < -127 ? -127 : q); a |= ((unsigned)q & 0xffu) << (8 * b); }
        xq[j] = (int)a; }
    int p[16];
#pragma unroll
    for (int i = 0; i < 16; ++i) { int a = __builtin_amdgcn_sdot4((int)bf.ur[i].x, xq[0], 0, false); a = __builtin_amdgcn_sdot4((int)bf.ur[i].y, xq[1], a, false);
        a = __builtin_amdgcn_sdot4((int)bf.ur[i].z, xq[2], a, false); a = __builtin_amdgcn_sdot4((int)bf.ur[i].w, xq[3], a, false); p[i] = a; }
    int r8[8], r4[4], r2[2];
    const bool b2 = lane & 4, b1 = lane & 2, b0 = lane & 1;
#pragma unroll
    for (int i = 0; i < 8; ++i) { const int snd = b2 ? p[i] : p[i + 8], kp = b2 ? p[i + 8] : p[i]; r8[i] = kp + __shfl_xor(snd, 4); }
#pragma unroll
    for (int i = 0; i < 4; ++i) { const int snd = b1 ? r8[i] : r8[i + 4], kp = b1 ? r8[i + 4] : r8[i]; r4[i] = kp + __shfl_xor(snd, 2); }
#pragma unroll
    for (int i = 0; i < 2; ++i) { const int snd = b0 ? r4[i] : r4[i + 2], kp = b0 ? r4[i + 2] : r4[i]; r2[i] = kp + __shfl_xor(snd, 1); }
    *(v2f*)(PART + ((size_t)s * M + t) * 128 + 2 * lane) = (v2f){(float)r2[0] * sx, (float)r2[1] * sx};
}
__device__ __forceinline__ void u_finish(const int (&p)[16], float sx, int s, int t, unsigned* PART, int lane) {
    int r8[8], r4[4], r2[2];
    const bool b2 = lane & 4, b1 = lane & 2, b0 = lane & 1;
#pragma unroll
    for (int i = 0; i < 8; ++i) { const int snd = b2 ? p[i] : p[i + 8], kp = b2 ? p[i + 8] : p[i]; r8[i] = kp + xor4i(snd); }
#pragma unroll
    for (int i = 0; i < 4; ++i) { const int snd = b1 ? r8[i] : r8[i + 4], kp = b1 ? r8[i + 4] : r8[i]; r4[i] = kp + xor2i(snd); }
#pragma unroll
    for (int i = 0; i < 2; ++i) { const int snd = b0 ? r4[i] : r4[i + 2], kp = b0 ? r4[i + 2] : r4[i]; r2[i] = kp + xor1i(snd); }
    typedef _Float16 h2 __attribute__((ext_vector_type(2)));
    const h2 pr = {(_Float16)((float)r2[0] * sx), (_Float16)((float)r2[1] * sx)};
    PART[((size_t)s * M + t) * 64 + lane] = __builtin_bit_cast(unsigned, pr);
}
#define IDX_E(iw, i) (((i) & 1) ? ((iw)[(i) >> 1] >> 16) : ((iw)[(i) >> 1] & 0xffffu))
struct QStream { unsigned* heads; int ps, tried; int cs, ct0, ns, nt0, pos; };
__device__ __forceinline__ bool qs_pull(QStream& q, int& os, int& ot0, int lane) {
    for (;;) { const int it = q_pull(q.heads, q.ps, lane); if (it < M / TPI) { os = q.ps; ot0 = it * TPI; return true; } if (++q.tried >= 8) return false; q.ps = (q.ps + 1) & 7; }
}
__device__ __forceinline__ bool qs_init(QStream& q, unsigned* heads, unsigned xcc, int lane) {
    q.heads = heads; q.ps = (int)(xcc & 7u); q.tried = 0; q.pos = 0; q.ns = 0; q.nt0 = -1;
    if (!qs_pull(q, q.cs, q.ct0, lane)) return false;
    if (!qs_pull(q, q.ns, q.nt0, lane)) q.nt0 = -1;
    return true;
}
__device__ __forceinline__ void qs_peek(const QStream& q, int k, int& s, int& t) {
    int p = q.pos + k;
    if (p < TPI) { s = q.cs; t = q.ct0 + p; }
    else if (q.nt0 >= 0) { s = q.ns; t = q.nt0 + (p - TPI); }
    else { s = q.cs; t = q.ct0 + TPI - 1; }
}
__device__ __forceinline__ bool qs_advance2(QStream& q, int lane) {
    q.pos += 2;
    if (q.pos >= TPI) { if (q.nt0 < 0) return false; q.pos = 0; q.cs = q.ns; q.ct0 = q.nt0; if (!qs_pull(q, q.ns, q.nt0, lane)) q.nt0 = -1; }
    return true;
}
__device__ __forceinline__ void p7_u_phase(unsigned* heads, unsigned xcc, const unsigned char* X1q, const float* SX, const unsigned short* IDX, const unsigned char* U8, unsigned* PART, int lane) {
    const int c = lane & 7;
    QStream q;
    if (!qs_init(q, heads, xcc, lane)) return;
    const unsigned char* ub0 = U8; const unsigned c16 = 16u * (unsigned)c; const unsigned char* xb0 = X1q + 16 * c;
    v4u ring[32]; v4u xA, xB; float sA, sB; UIdx iN, iM;
    { int s0, t0, s1, t1; qs_peek(q, 0, s0, t0); qs_peek(q, 1, s1, t1);
      UIdx iA, iB; u_idx(iA, t0, IDX, lane); u_idx(iB, t1, IDX, lane);
      const unsigned wa[8] = {iA.ia.x, iA.ia.y, iA.ia.z, iA.ia.w, iA.ib.x, iA.ib.y, iA.ib.z, iA.ib.w}, wb[8] = {iB.ia.x, iB.ia.y, iB.ia.z, iB.ia.w, iB.ib.x, iB.ib.y, iB.ib.z, iB.ib.w};
      const unsigned char* ua = ub0 + (size_t)s0 * NE * 128; const unsigned char* ubb = ub0 + (size_t)s1 * NE * 128;
#pragma unroll
      for (int r = 0; r < 16; ++r) ring[r] = *(const v4u*)(ua + (IDX_E(wa, r) * 128u + c16));
      xA = *(const v4u*)(xb0 + (size_t)t0 * D + 128 * s0); sA = SX[t0];
#pragma unroll
      for (int r = 0; r < 16; ++r) ring[16 + r] = *(const v4u*)(ubb + (IDX_E(wb, r) * 128u + c16));
      xB = *(const v4u*)(xb0 + (size_t)t1 * D + 128 * s1); sB = SX[t1];
      int s2, t2, s3, t3; qs_peek(q, 2, s2, t2); qs_peek(q, 3, s3, t3);
      u_idx(iN, t2, IDX, lane); u_idx(iM, t3, IDX, lane); }
#pragma unroll 1
    for (;;) {
        int s0, t0, s1, t1, s2, t2, s3, t3, s4, t4, s5, t5;
        qs_peek(q, 0, s0, t0); qs_peek(q, 1, s1, t1); qs_peek(q, 2, s2, t2); qs_peek(q, 3, s3, t3); qs_peek(q, 4, s4, t4); qs_peek(q, 5, s5, t5);
        int p[16];
        {
            const int x0 = (int)xA.x, x1 = (int)xA.y, x2 = (int)xA.z, x3 = (int)xA.w; const float sx = sA;
            const unsigned wn[8] = {iN.ia.x, iN.ia.y, iN.ia.z, iN.ia.w, iN.ib.x, iN.ib.y, iN.ib.z, iN.ib.w};
            const unsigned char* un = ub0 + (size_t)s2 * NE * 128;
#pragma unroll
            for (int r = 0; r < 16; ++r) { int a = __builtin_amdgcn_sdot4((int)ring[r].x, x0, 0, false); a = __builtin_amdgcn_sdot4((int)ring[r].y, x1, a, false);
                a = __builtin_amdgcn_sdot4((int)ring[r].z, x2, a, false); a = __builtin_amdgcn_sdot4((int)ring[r].w, x3, a, false); p[r] = a;
                ring[r] = *(const v4u*)(un + (IDX_E(wn, r) * 128u + c16)); }
            xA = *(const v4u*)(xb0 + (size_t)t2 * D + 128 * s2); sA = SX[t2];
            u_idx(iN, t4, IDX, lane);
            u_finish(p, sx, s0, t0, PART, lane);
        }
        {
            const int x0 = (int)xB.x, x1 = (int)xB.y, x2 = (int)xB.z, x3 = (int)xB.w; const float sx = sB;
            const unsigned wn[8] = {iM.ia.x, iM.ia.y, iM.ia.z, iM.ia.w, iM.ib.x, iM.ib.y, iM.ib.z, iM.ib.w};
            const unsigned char* un = ub0 + (size_t)s3 * NE * 128;
#pragma unroll
            for (int r = 0; r < 16; ++r) { int a = __builtin_amdgcn_sdot4((int)ring[16 + r].x, x0, 0, false); a = __builtin_amdgcn_sdot4((int)ring[16 + r].y, x1, a, false);
                a = __builtin_amdgcn_sdot4((int)ring[16 + r].z, x2, a, false); a = __builtin_amdgcn_sdot4((int)ring[16 + r].w, x3, a, false); p[r] = a;
                ring[16 + r] = *(const v4u*)(un + (IDX_E(wn, r) * 128u + c16)); }
            xB = *(const v4u*)(xb0 + (size_t)t3 * D + 128 * s3); sB = SX[t3];
            u_idx(iM, t5, IDX, lane);
            u_finish(p, sx, s1, t1, PART, lane);
        }
        if (!qs_advance2(q, lane)) break;
    }
}
__device__ __forceinline__ void p8_w_phase(const unsigned* PART, const float* RSTD, const unsigned short* IDX, const float* EV, const float* INV, const float* SU, const float* SV, unsigned short* WQ, float* SWH, int gw, int NGW, int lane) {
    typedef _Float16 h2 __attribute__((ext_vector_type(2)));
    for (int tb = gw; tb < M; tb += 4 * NGW) {
        unsigned pp[4][8], ip[4]; v2f evp[4]; float iv[4], rs[4];
#pragma unroll
        for (int q = 0; q < 4; ++q) { const int t = ROW_REV(tb + q * NGW);
#pragma unroll
            for (int x = 0; x < 8; ++x) pp[q][x] = PART[((size_t)x * M + t) * 64 + lane];
            ip[q] = *(const unsigned*)(IDX + (size_t)t * 128 + 2 * lane); evp[q] = *(const v2f*)(EV + (size_t)t * 128 + 2 * lane); iv[q] = INV[(size_t)t * NH + (lane >> 3)]; rs[q] = RSTD[t]; }
        float su0[4], su1[4], sv0[4], sv1[4];
#pragma unroll
        for (int q = 0; q < 4; ++q) { const int e0 = (int)(ip[q] & 0xffffu), e1 = (int)(ip[q] >> 16); su0[q] = SU[e0]; su1[q] = SU[e1]; sv0[q] = SV[e0]; sv1[q] = SV[e1]; }
#pragma unroll
        for (int q = 0; q < 4; ++q) { const int t = ROW_REV(tb + q * NGW);
            float a0 = 0.f, a1 = 0.f;
#pragma unroll
            for (int x = 0; x < 8; ++x) { const h2 v = __builtin_bit_cast(h2, pp[q][x]); a0 += (float)v[0]; a1 += (float)v[1]; }
            const float act0 = a0 * su0[q] * rs[q], act1 = a1 * su1[q] * rs[q];
            const float w0 = evp[q].x * iv[q] * (0.5f * act0 * (1.f + erff(act0 * 0.70710678118654752f))) * sv0[q];
            const float w1 = evp[q].y * iv[q] * (0.5f * act1 * (1.f + erff(act1 * 0.70710678118654752f))) * sv1[q];
            const float mx = wave_max(fmaxf(fabsf(w0), fabsf(w1)));
            const float sw = mx > 0.f ? mx * (1.f / 127.f) : 1.f, isw = 1.f / sw;
            int q0 = (int)rintf(w0 * isw), q1 = (int)rintf(w1 * isw); q0 = q0 > 127 ? 127 : (q0 < -127 ? -127 : q0); q1 = q1 > 127 ? 127 : (q1 < -127 ? -127 : q1);
            WQ[(size_t)t * 64 + lane] = (unsigned short)(((unsigned)q0 & 0xffu) | (((unsigned)q1 & 0xffu) << 8));
            if ((lane & 7) == 0) SWH[(size_t)t * NH + (lane >> 3)] = sw; }
    }
}
struct VBuf { v4u vr[16]; v4u w4; float sw; unsigned xw; };
__device__ __forceinline__ void v_gather(VBuf& b, const UIdx& p, int s, int t, const bf16* X1, const unsigned short* WQ, const float* SWH, const unsigned char* V8, int lane) {
    const int c = lane & 7, g = lane >> 3;
    const unsigned iw[8] = {p.ia.x, p.ia.y, p.ia.z, p.ia.w, p.ib.x, p.ib.y, p.ib.z, p.ib.w};
    const unsigned char* vb = V8 + (size_t)s * NE * 128; const unsigned c16 = 16u * (unsigned)c;
#pragma unroll
    for (int i = 0; i < 16; ++i) { const unsigned e = (i & 1) ? (iw[i >> 1] >> 16) : (iw[i >> 1] & 0xffffu); b.vr[i] = *(const v4u*)(vb + (e * 128u + c16)); }
    b.w4 = *(const v4u*)((const unsigned char*)WQ + (size_t)t * 128 + 16 * g); b.sw = SWH[(size_t)t * NH + g];
    b.xw = *(const unsigned*)(X1 + (size_t)t * D + 128 * s + 2 * lane);
}
__device__ __forceinline__ void v_compute(VBuf& bf, int s, int t, bf16* out, float* SSQ2, int lane, const UIdx& nidx, int ns, int nt, const bf16* X1, const unsigned short* WQ, const float* SWH, const unsigned char* V8) {
    const int c = lane & 7, g = lane >> 3;
    const unsigned niw[8] = {nidx.ia.x, nidx.ia.y, nidx.ia.z, nidx.ia.w, nidx.ib.x, nidx.ib.y, nidx.ib.z, nidx.ib.w};
    const unsigned char* nvb = V8 + (size_t)ns * NE * 128; const unsigned c16 = 16u * (unsigned)c;
    int ai[16];
#pragma unroll
    for (int j = 0; j < 16; ++j) ai[j] = 0;
#pragma unroll
    for (int rg = 0; rg < 4; ++rg) { const int w4 = (int)bf.w4[rg];
#pragma unroll
        for (int j = 0; j < 4; ++j) { const unsigned r0 = bf.vr[4 * rg][j], r1 = bf.vr[4 * rg + 1][j], r2q = bf.vr[4 * rg + 2][j], r3 = bf.vr[4 * rg + 3][j];
            const unsigned t0 = __builtin_amdgcn_perm(r1, r0, 0x05010400u), t1 = __builtin_amdgcn_perm(r1, r0, 0x07030602u), t2 = __builtin_amdgcn_perm(r3, r2q, 0x05010400u), t3 = __builtin_amdgcn_perm(r3, r2q, 0x07030602u);
            ai[4 * j + 0] = __builtin_amdgcn_sdot4((int)__builtin_amdgcn_perm(t2, t0, 0x05040100u), w4, ai[4 * j + 0], false);
            ai[4 * j + 1] = __builtin_amdgcn_sdot4((int)__builtin_amdgcn_perm(t2, t0, 0x07060302u), w4, ai[4 * j + 1], false);
            ai[4 * j + 2] = __builtin_amdgcn_sdot4((int)__builtin_amdgcn_perm(t3, t1, 0x05040100u), w4, ai[4 * j + 2], false);
            ai[4 * j + 3] = __builtin_amdgcn_sdot4((int)__builtin_amdgcn_perm(t3, t1, 0x07060302u), w4, ai[4 * j + 3], false); }
#pragma unroll
        for (int i = 0; i < 4; ++i) { const int r = 4 * rg + i; const unsigned e = (r & 1) ? (niw[r >> 1] >> 16) : (niw[r >> 1] & 0xffffu); bf.vr[r] = *(const v4u*)(nvb + (e * 128u + c16)); } }
    const float sw_cur = bf.sw;
    const unsigned xw_cur = bf.xw;
    bf.w4 = *(const v4u*)((const unsigned char*)WQ + (size_t)nt * 128 + 16 * g); bf.sw = SWH[(size_t)nt * NH + g];
    bf.xw = *(const unsigned*)(X1 + (size_t)nt * D + 128 * ns + 2 * lane);
    int r8[8], r4[4], r2[2];
    const bool b3 = lane & 8;
#pragma unroll
    for (int i = 0; i < 8; ++i) r8[i] = swap32_addi(ai[i], ai[i + 8]);
#pragma unroll
    for (int i = 0; i < 4; ++i) r4[i] = swap16_addi(r8[i], r8[i + 4]);
#pragma unroll
    for (int i = 0; i < 2; ++i) { const int snd = b3 ? r4[i] : r4[i + 2], kp = b3 ? r4[i + 2] : r4[i]; r2[i] = kp + xor8i(snd); }
    const int srcl = 8 * (lane & 7) + (lane >> 3);
    const float p0 = (float)__shfl(r2[0], srcl) * sw_cur, p1 = (float)__shfl(r2[1], srcl) * sw_cur;
    const size_t col = (size_t)t * D + 128 * s + 2 * lane;
    const float y0 = bflo(xw_cur) + p0, y1 = bfhi(xw_cur) + p1;
    const float ss = wave_sum(y0 * y0 + y1 * y1);
    *(unsigned*)(out + col) = pk2(y0, y1);
    if (lane == 0) SSQ2[(size_t)t * 8 + s] = ss;
}
__device__ __forceinline__ void p9_v_phase(unsigned* heads, unsigned xcc, const bf16* X1, const unsigned short* IDX, const unsigned short* WQ, const float* SWH, const unsigned char* V8, bf16* out, float* SSQ2, int lane) {
    QStream q;
    if (!qs_init(q, heads, xcc, lane)) return;
    UIdx iN, iM; VBuf ga, gb;
    { int s0, t0, s1, t1, s2, t2, s3, t3; qs_peek(q, 0, s0, t0); qs_peek(q, 1, s1, t1); qs_peek(q, 2, s2, t2); qs_peek(q, 3, s3, t3);
      UIdx ia, ib; u_idx(ia, t0, IDX, lane); u_idx(ib, t1, IDX, lane);
      v_gather(ga, ia, s0, t0, X1, WQ, SWH, V8, lane); v_gather(gb, ib, s1, t1, X1, WQ, SWH, V8, lane);
      u_idx(iN, t2, IDX, lane); u_idx(iM, t3, IDX, lane); }
#pragma unroll 1
    for (;;) {
        int s0, t0, s1, t1, s2, t2, s3, t3, s4, t4, s5, t5;
        qs_peek(q, 0, s0, t0); qs_peek(q, 1, s1, t1); qs_peek(q, 2, s2, t2); qs_peek(q, 3, s3, t3); qs_peek(q, 4, s4, t4); qs_peek(q, 5, s5, t5);
        v_compute(ga, s0, t0, out, SSQ2, lane, iN, s2, t2, X1, WQ, SWH, V8);
        u_idx(iN, t4, IDX, lane);
        v_compute(gb, s1, t1, out, SSQ2, lane, iM, s3, t3, X1, WQ, SWH, V8);
        u_idx(iM, t5, IDX, lane);
        if (!qs_advance2(q, lane)) break;
    }
}
__device__ __forceinline__ void p10_final(const bf16* X2, float* out, const float* SSQ2, const float* gfin, int gw, int NGW, int lane) {
    f32x4 gf[4];
#pragma unroll
    for (int j = 0; j < 4; ++j) gf[j] = ((const f32x4*)gfin)[lane + 64 * j];
    v2u nxa[4], nxb[4]; float nsa, nsb;
#pragma unroll
    for (int j = 0; j < 4; ++j) { nxa[j] = ((const v2u*)(X2 + (size_t)ROW_REV(gw) * D))[lane + 64 * j]; nxb[j] = ((const v2u*)(X2 + (size_t)ROW_REV(gw + NGW) * D))[lane + 64 * j]; }
    nsa = lane < 8 ? SSQ2[(size_t)ROW_REV(gw) * 8 + lane] : 0.f; nsb = lane < 8 ? SSQ2[(size_t)ROW_REV(gw + NGW) * 8 + lane] : 0.f;
    for (int t = gw; t < M; t += 2 * NGW) {
        const int t1 = t + NGW;
        v2u xa[4], xb[4];
#pragma unroll
        for (int j = 0; j < 4; ++j) { xa[j] = nxa[j]; xb[j] = nxb[j]; }
        const float sa = nsa, sb = nsb;
        { const int tn = (t + 2 * NGW) < M ? (t + 2 * NGW) : t, tn1 = tn + NGW;
#pragma unroll
          for (int j = 0; j < 4; ++j) { nxa[j] = ((const v2u*)(X2 + (size_t)ROW_REV(tn) * D))[lane + 64 * j]; nxb[j] = ((const v2u*)(X2 + (size_t)ROW_REV(tn1) * D))[lane + 64 * j]; }
          nsa = lane < 8 ? SSQ2[(size_t)ROW_REV(tn) * 8 + lane] : 0.f; nsb = lane < 8 ? SSQ2[(size_t)ROW_REV(tn1) * 8 + lane] : 0.f; }
        const float ra = rsqrtf(wave_sum(sa) * (1.f / D) + RMS_EPS), rb = rsqrtf(wave_sum(sb) * (1.f / D) + RMS_EPS);
        f32x4* oa = (f32x4*)(out + (size_t)ROW_REV(t) * D) + lane; f32x4* ob = (f32x4*)(out + (size_t)ROW_REV(t1) * D) + lane;
#pragma unroll
        for (int j = 0; j < 4; ++j) {
            oa[64 * j] = (f32x4){bflo(xa[j].x) * ra * gf[j].x, bfhi(xa[j].x) * ra * gf[j].y, bflo(xa[j].y) * ra * gf[j].z, bfhi(xa[j].y) * ra * gf[j].w};
            ob[64 * j] = (f32x4){bflo(xb[j].x) * rb * gf[j].x, bfhi(xb[j].x) * rb * gf[j].y, bflo(xb[j].y) * rb * gf[j].z, bfhi(xb[j].y) * rb * gf[j].w}; }
    }
}

struct Args { const float* in[15]; float* out; unsigned char* ws; int ph_lo, ph_hi, li, pad; };
__global__ void __launch_bounds__(NWAVES * 64, 2) fwd_kernel(Args args) {
    extern __shared__ __attribute__((aligned(16))) unsigned char lds_raw[];
    LAS unsigned char* lds = (LAS unsigned char*)lds_raw;
    volatile LAS unsigned* MISC = (volatile LAS unsigned*)(lds + MISC_OFF);
    const int tid = threadIdx.x, lane = tid & 63, wave = __builtin_amdgcn_readfirstlane(tid >> 6);
    const int G = gridDim.x; const int bx = blockIdx.x; const int vcu = (G % 8 == 0) ? (bx % 8) * (G / 8) + bx / 8 : bx;
    const int gw = vcu * NWAVES + wave, NGW = G * NWAVES;
    unsigned char* ws = args.ws;
    gu32* ctl = (gu32*)(ws + WS_CTL);
    const float* x = args.in[0]; const float* g_mix = args.in[1]; const float* w_in = args.in[2]; const float* pool_gw = args.in[3]; const float* pool_scale = args.in[4];
    const float* conv_w = args.in[5]; const float* w_bp = args.in[6]; const float* w_bc = args.in[7]; const float* w_out = args.in[8]; const float* g_ffn = args.in[9];
    const float* w_q = args.in[10]; const float* sub_keys = args.in[11]; const float* expert_u = args.in[12]; const float* expert_v = args.in[13]; const float* g_final = args.in[14];
    unsigned char* Wc8 = ws + WS_WC; unsigned char* Wbc8 = ws + WS_WBC; float* SBC = (float*)(ws + WS_SBC); float* SPC = (float*)(ws + WS_SPC); float* WcF = (float*)(ws + WS_WCF); unsigned* CMAXC = (unsigned*)(ctl + CW_CMAXC); bf16* Wout_t = (bf16*)(ws + WS_WOUT); unsigned char* Wpp8 = ws + WS_WPP; float* WppF = (float*)(ws + WS_WPPF); float* SBP = (float*)(ws + WS_SBP); float* SXR = (float*)(ws + WS_SXR); unsigned char* X1q = ws + WS_X1Q; unsigned* CMAXP = (unsigned*)(ctl + CW_CMAXP);
    float* SU = (float*)(ws + WS_SU); float* SV = (float*)(ws + WS_SV); float* SSQ = (float*)(ws + WS_SSQ);
    unsigned char* U8 = ws + WS_U8; unsigned char* V8 = ws + WS_V8; float* INV = (float*)(ws + WS_INV); float* SSQ2 = (float*)(ws + WS_SSQ2); unsigned* PART = (unsigned*)(ws + WS_PART); float* RSTD = (float*)(ws + WS_RSTD); unsigned short* WQ = (unsigned short*)(ws + WS_WV); float* SWH = (float*)(ws + WS_SWH);
    unsigned char* Hq = ws + WS_B; unsigned char* Winq = ws + WS_WIN; float* SA = (float*)(ws + WS_SA); float* SB = (float*)(ws + WS_SB); unsigned* CMAX = (unsigned*)(ctl + CW_CMAX); unsigned char* PA = ws + WS_B; unsigned char* CA = ws + WS_B + 64 * MiB; bf16* X1 = (bf16*)(ws + WS_B);
    bf16* Mb = (bf16*)(ws + WS_C); unsigned short* IDX = (unsigned short*)(ws + WS_C); float* EV = (float*)(ws + WS_C + 16 * MiB);
    unsigned char* Z8 = ws + WS_A; float* ZS = (float*)(ws + WS_A + 128 * MiB); unsigned char* G8 = ws + WS_A + 256 * MiB;
     _Float16* SC = (_Float16*)(ws + WS_A); bf16* X2 = (bf16*)(ws + WS_A);

    for (int u = tid; u < (LDS_BYTES - LDSCTL_OFF) / 4; u += NWAVES * 64) ((LAS unsigned*)(lds + LDSCTL_OFF))[u] = 0u;
    __syncthreads();
    XcdBarrier bar; bar.bar = (unsigned*)(ctl + CW_BAR); bar.x = 0; bar.st = nullptr;
    if (N_LAUNCHES != PER_PHASE) bar = xcd_barrier_post((unsigned*)(ctl + CW_BAR), MISC + 8);
#define GRID_BAR() do { if (N_LAUNCHES != PER_PHASE) xcd_barrier(bar); } while (0)
    const int lo = args.ph_lo, hi = args.ph_hi;
#define IN(k) (lo <= (k) && (k) < hi)
#define BOTH(k) (IN(k) && IN((k) + 1))

    if (IN(0)) for (int rep_ = 0; rep_ < ((PROBE_REPEAT >> 0) & 1) + 1; ++rep_) {
        LAS float* scr = (LAS float*)(lds + wave * 16384);
        constexpr int I_WPP = 1024, I_CMAX = 16 * 16, I_WOUT = (1024 / 64) * (1024 / 32), I_WBC = (512 / 64) * (1024 / 256), I_WC = 512;
        constexpr int NITEMS = I_WPP + I_CMAX + I_WBC + I_WC;
        for (int it = gw; it < NITEMS; it += NGW) {
            int r = it;
            if (r < I_WPP) { p0_wpp_item(w_q, sub_keys, g_ffn, WppF, CMAXP, scr, r, lane); continue; } r -= I_WPP;
            if (r < I_WC) { p0_wc_item(pool_gw, pool_scale, w_bp, WcF, CMAXC, scr, r, lane); continue; } r -= I_WC;
            if (r < I_CMAX) { p0_colmax_item(w_in, 4096, CMAX, r, lane); continue; } r -= I_CMAX;
            p0_colmax_item(w_bc, 1024, CMAXC, r, lane);
        }
        GRID_BAR();
        for (int it = gw; it < (1024 / 64) * (4096 / 32); it += NGW) p0_transpose_i8_item(w_in, 1024, 4096, Winq, CMAX, SB, scr, it, lane);
        for (int n = gw; n < NSC; n += NGW) p0_wpp_quant_row(WppF, CMAXP, Wpp8, SBP, n, lane);
        for (int n = gw; n < D; n += NGW) p0_wc_quant_row(WcF, CMAXC, Wc8, n, lane);
        for (int it = gw; it < (512 / 64) * (1024 / 32); it += NGW) p0_transpose_i8_item(w_bc, 512, 1024, Wbc8, CMAXC, SBC, scr, it, lane);
        for (int it = gw; it < I_WOUT; it += NGW) p0_transpose_item(w_out, 1024, 1024, Wout_t, scr, it, lane, CMAXC);
        {
            HRows ra, rb;
            p0_q_load(ra, expert_u, gw, gw + NGW, lane);
            for (int e = gw; e < NE; e += 2 * NGW) { const int en = e + 2 * NGW; if (en < NE) p0_q_load(rb, expert_u, en, en + NGW, lane); else p0_q_load(rb, expert_v, gw, gw + NGW, lane);
                p0_quant_rows2<false>(ra, g_ffn, U8, SU, e, e + NGW, lane); ra = rb; }
            for (int e = gw; e < NE; e += 2 * NGW) { const int en = e + 2 * NGW; if (en < NE) p0_q_load(rb, expert_v, en, en + NGW, lane); else p0_h_load(rb, x, gw, gw + NGW, lane);
                p0_quant_rows2<false>(ra, nullptr, V8, SV, e, e + NGW, lane); ra = rb; }
            for (int m = gw; m < M; m += 2 * NGW) { const int mn = (m + 2 * NGW) < M ? (m + 2 * NGW) : m; p0_h_load(rb, x, mn, mn + NGW, lane);
                p0_h_rows2(ra, g_mix, Hq, SA, m, m + NGW, lane); ra = rb; }
        }
        if (BOTH(0)) GRID_BAR();
    }
    if (IN(1)) for (int rep_ = 0; rep_ < ((PROBE_REPEAT >> 1) & 1) + 1; ++rep_) {
        pg8::Gemm g{(const bf16*)Hq, (const bf16*)Winq, (const bf16*)Hq, (const bf16*)Winq, M, DIN, D / 2}; pg8::StaticOrder S; S.init(M, DIN, G, bx, 1, 1 + ((PROBE_GEMM_REP >> 1) & 1));
        EpiZ E{Z8, ZS, G8, SA, SB};
        pg8::gemm_phase<EpiZ, pg8::StaticOrder, false, true, true>(lds, g, S, E, (unsigned)((bx >> 3) & 3) * STAGGER_P1);
        if (BOTH(1)) GRID_BAR();
    }
    if (IN(2)) for (int rep_ = 0; rep_ < ((PROBE_REPEAT >> 2) & 1) + 1; ++rep_) {
        p2_timemix(Z8, ZS, conv_w, PA, CA, SPC, gw, NGW, lane);
        if (BOTH(2)) GRID_BAR();
    }
    if (IN(3)) for (int rep_ = 0; rep_ < ((PROBE_REPEAT >> 3) & 1) + 1; ++rep_) {
        pg8::Gemm g{(const bf16*)PA, (const bf16*)Wc8, (const bf16*)CA, (const bf16*)Wbc8, M, D, DP / 2}; pg8::StaticOrder S; S.init(M, D, G, bx, 2, 1 + ((PROBE_GEMM_REP >> 3) & 1));
        EpiGate E{G8, Mb, SPC};
        pg8::gemm_phase<EpiGate, pg8::StaticOrder, true, true, true>(lds, g, S, E);
        if (BOTH(3)) GRID_BAR();
    }
    if (IN(4)) for (int rep_ = 0; rep_ < ((PROBE_REPEAT >> 4) & 1) + 1; ++rep_) {
        pg8::Gemm g{Mb, Wout_t, Mb, Wout_t, M, D, D}; pg8::StaticOrder S; S.init(M, D, G, bx, 1, 1 + ((PROBE_GEMM_REP >> 4) & 1));
        EpiRes E{x, X1, SSQ};
        pg8::gemm_phase<EpiRes, pg8::StaticOrder, true, true>(lds, g, S, E);
        if (BOTH(4)) GRID_BAR();
    }
    if (IN(5)) for (int rep_ = 0; rep_ < ((PROBE_REPEAT >> 5) & 1) + 1; ++rep_) {
        { XRows xa, xb; p5_x1_load(xa, X1, SSQ, ROW_QREV(gw), ROW_QREV(gw + NGW), lane);
          for (int r = gw; r < M; r += 2 * NGW) { const int rn = (r + 2 * NGW) < M ? (r + 2 * NGW) : r; p5_x1_load(xb, X1, SSQ, ROW_QREV(rn), ROW_QREV(rn + NGW), lane);
              p5_x1_quant_rows2(xa, X1q, SA, SXR, RSTD, ROW_QREV(r), ROW_QREV(r + NGW), lane); xa = xb; } }
        GRID_BAR();
        pg8::Gemm g{(const bf16*)X1q, (const bf16*)Wpp8, (const bf16*)X1q, (const bf16*)Wpp8, M, NSC, D / 2}; pg8::StaticOrder S; S.init(M, NSC, G, bx, 1, 1 + ((PROBE_GEMM_REP >> 5) & 1));
        EpiScore E{SXR, SBP, SC};
        pg8::gemm_phase<EpiScore, pg8::StaticOrder, false, true, true>(lds, g, S, E);
        if (BOTH(5)) GRID_BAR();
    }
    if (IN(6)) for (int rep_ = 0; rep_ < ((PROBE_REPEAT >> 6) & 1) + 1; ++rep_) {
        p6_topk(SC, IDX, EV, INV, lds, gw, NGW, wave, lane);
        if (BOTH(6)) GRID_BAR();
    }
    const unsigned xcc = xb_xcc_id();
    if (IN(7)) for (int rep_ = 0; rep_ < ((PROBE_REPEAT >> 7) & 1) + 1; ++rep_) {
        p7_u_phase((unsigned*)(ctl + CW_QU + 2048 * rep_), xcc, X1q, SA, IDX, U8, PART, lane);
        if (BOTH(7)) GRID_BAR();
    }
    if (IN(8)) for (int rep_ = 0; rep_ < ((PROBE_REPEAT >> 8) & 1) + 1; ++rep_) {
        p8_w_phase(PART, RSTD, IDX, EV, INV, SU, SV, WQ, SWH, gw, NGW, lane);
        if (BOTH(8)) GRID_BAR();
    }
    if (IN(9)) for (int rep_ = 0; rep_ < ((PROBE_REPEAT >> 9) & 1) + 1; ++rep_) {
        p9_v_phase((unsigned*)(ctl + CW_QV + 2048 * rep_), xcc, X1, IDX, WQ, SWH, V8, X2, SSQ2, lane);
        if (BOTH(9)) GRID_BAR();
    }
    if (IN(10)) {
        p10_final(X2, args.out, SSQ2, g_final, gw, NGW, lane);
    }
#undef IN
#undef BOTH
#undef GRID_BAR
}

extern "C" void kernel_launch(void* const* d_in, const int* in_sizes, int n_in, void* d_out, int out_size, void* d_ws, size_t ws_size, hipStream_t stream) {
    static int grid = 0;
    if (grid == 0) {
        if (n_in != 15 || in_sizes[0] != M * D || out_size != M * D || ws_size < WS_END) { fprintf(stderr, "kernel_launch: unexpected shapes (n_in %d, in0 %d, out %d, ws %zu); nothing launched\n", n_in, n_in > 0 ? in_sizes[0] : -1, out_size, ws_size); grid = -1; return; }
        int dev = 0, cus = 0, per_cu = 0;
        if (hipGetDevice(&dev) != hipSuccess || hipDeviceGetAttribute(&cus, hipDeviceAttributeMultiprocessorCount, dev) != hipSuccess) { grid = -1; return; }
        if (hipFuncSetAttribute((const void*)fwd_kernel, hipFuncAttributeMaxDynamicSharedMemorySize, LDS_BYTES) != hipSuccess) { fprintf(stderr, "kernel_launch: hipFuncSetAttribute failed\n"); grid = -1; return; }
        if (hipOccupancyMaxActiveBlocksPerMultiprocessor(&per_cu, (const void*)fwd_kernel, NWAVES * 64, LDS_BYTES) != hipSuccess || per_cu < 1)
            fprintf(stderr, "kernel_launch: note: occupancy query reports %d workgroups per CU\n", per_cu);
        (void)hipGetLastError();
        grid = cus;
    }
    if (grid < 0) return;
    if (hipMemsetAsync((char*)d_ws + WS_CTL, 0, CTL_ZERO_BYTES, stream) != hipSuccess) { fprintf(stderr, "kernel_launch: hipMemsetAsync failed\n"); return; }
    Args a{};
    for (int i = 0; i < 15; ++i) a.in[i] = (const float*)d_in[i];
    a.out = (float*)d_out; a.ws = (unsigned char*)d_ws;
    for (int li = 0; li < N_LAUNCHES; ++li) {
        a.ph_lo = (N_LAUNCHES == PER_PHASE) ? li : 0; a.ph_hi = (N_LAUNCHES == PER_PHASE) ? li + 1 : PER_PHASE; a.li = li;
        hipLaunchKernelGGL(fwd_kernel, dim3(grid), dim3(NWAVES * 64), LDS_BYTES, stream, a);
        const hipError_t le = hipPeekAtLastError();
        if (le != hipSuccess) { fprintf(stderr, "kernel_launch: launch %d failed: %s\n", li, hipGetErrorName(le)); break; }
    }
}
```

```cpp
#include <hip/hip_runtime.h>
#include <cstdio>
#include <cstdint>

#ifndef PROBE_REPEAT
#define PROBE_REPEAT 0
#endif
#ifndef PROBE_GEMM_REP
#define PROBE_GEMM_REP 0
#endif
#ifndef STAGGER_P1
#define STAGGER_P1 0u
#endif
#ifndef PROBE_SKIP_EPI
#define PROBE_SKIP_EPI 0
#endif
#ifndef MK_N_LAUNCHES
#define MK_N_LAUNCHES 1
#endif

namespace pg8 {
#define PG8_LAS __attribute__((address_space(3)))
typedef unsigned short bf16_t;
typedef short bf16x8 __attribute__((ext_vector_type(8)));
typedef float f32x4 __attribute__((ext_vector_type(4)));
typedef unsigned u32x4 __attribute__((ext_vector_type(4)));
constexpr int BM = 256, BK = 64, HALF = 128, HTB = HALF * BK * 2  , STAGE_BYTES = 8 * HTB, NXCD = 8, WGM = 8;

__host__ __device__ __forceinline__ int lds_byte(int r, int c) { const int st = (r >> 4) * 2 + (c >> 5), rr = r & 15, cc = c & 31, ob = rr * 64 + cc * 2; return st * 1024 + (ob ^ (((ob >> 9) & 1) << 5)); }
__host__ __device__ __forceinline__ void stage_rc(int b, int& R, int& C) { const int st = b / 1024, sb = b % 1024, swz = sb ^ (((sb >> 9) & 1) << 5); R = (st >> 1) * 16 + swz / 64; C = (st & 1) * 32 + (swz % 64) / 2; }
__host__ __device__ __forceinline__ int perm32(int rho) { const int n = rho >> 4, i = rho & 15; return 8 * (i >> 2) + 4 * n + (i & 3); }

struct Unit { int pm, pn, seg, dup; };
struct Gemm { const bf16_t* A; const bf16_t* Bt; const bf16_t* A2; const bf16_t* Bt2; int M, N, K; };

struct StaticOrder {
    int nM, nN, nwg, G, c, segs, rep;
    __host__ __device__ void init(int M, int N, int G_, int c_, int segs_, int rep_ = 1) { nM = M / BM; nN = N / BM; nwg = nM * nN; G = G_; c = c_; segs = segs_; rep = rep_; }
    __host__ __device__ bool next(int i, Unit& u) const {
        const int ti = (segs == 2) ? (i >> 1) : i; u.seg = (segs == 2) ? (i & 1) : 0;
        const long L = (long)ti * G + c; if (L >= (long)nwg * rep) return false;
        int wgid = (int)(L % nwg); u.dup = (L >= nwg) ? 1 : 0; { const int q = nwg / NXCD, r = nwg % NXCD, xcd = wgid % NXCD, off = wgid / NXCD; wgid = (xcd < r ? xcd * (q + 1) : r * (q + 1) + (xcd - r) * q) + off; }
        const int nig = WGM * nN, gid = wgid / nig, fm = gid * WGM, gsz = (nM - fm) < WGM ? (nM - fm) : WGM;
        u.pm = fm + ((wgid % nig) % gsz); u.pn = (wgid % nig) / gsz; return true;
    }
    __device__ __forceinline__ void a_ready(const Unit&) const {}
    __device__ __forceinline__ void done(const Unit&) const {}
};

__device__ __forceinline__ unsigned cvt_pk_bf16(float lo, float hi) { unsigned r; asm volatile("v_cvt_pk_bf16_f32 %0, %1, %2" : "=v"(r) : "v"(lo), "v"(hi)); return r; }

typedef int i32x4 __attribute__((ext_vector_type(4)));
template <class Epi, class Sched, bool ALIGN_EPI = false, bool SP2 = false, bool I8 = false>
__device__ __forceinline__ void gemm_phase(PG8_LAS unsigned char* lds, const Gemm g, const Sched& S, const Epi& E, unsigned stagger_ticks = 0) {
    if (stagger_ticks) { const unsigned long long t0_ = __builtin_amdgcn_s_memrealtime(); while (__builtin_amdgcn_s_memrealtime() - t0_ < (unsigned long long)stagger_ticks) __builtin_amdgcn_s_sleep(8); }
    const int tid = threadIdx.x, wid = __builtin_amdgcn_readfirstlane(tid >> 6), lane = tid & 63, wr = wid >> 2, wc = wid & 3, fr = lane & 15, fq = lane >> 4;
    const int K = g.K, nt = K / BK;
    unsigned voffA[2], voffB[2];
#pragma unroll
    for (int i = 0; i < 2; ++i) { int R, C; stage_rc(tid * 16 + i * 8192, R, C); const int Rb = Epi::PERM ? ((R & ~31) + perm32(R & 31)) : R;
        voffA[i] = (unsigned)(R * K + C) * 2u; voffB[i] = (unsigned)(Rb * K + C) * 2u; }
    const size_t kstep = (size_t)(BK * 2);
    const size_t hstep = (size_t)HALF * K * 2;
    const size_t tstep = 2 * hstep;
    const unsigned ldsw = (unsigned)wid * 1024u;
    const int aoff = lds_byte(wr * 64 + fr, fq * 8), boff = lds_byte(wc * 32 + fr, fq * 8);
#define PG8_SA(b, h) (((b) * 2 + (h)) * HTB)
#define PG8_SB(b, h) ((4 + (b) * 2 + (h)) * HTB)
#define PG8_STAGE(bufoff, gbase, voff) do { _Pragma("unroll") for (int _i = 0; _i < 2; ++_i) \
        __builtin_amdgcn_global_load_lds((const unsigned*)((const char*)(gbase) + (voff)[_i]), (PG8_LAS unsigned*)(lds + (bufoff) + ldsw + _i * 8192), 16, 0, 0); } while (0)
#define PG8_LDA(dst, b, h) do { _Pragma("unroll") for (int m = 0; m < 4; ++m) _Pragma("unroll") for (int k = 0; k < 2; ++k) dst[m][k] = *(const PG8_LAS bf16x8*)(lds + PG8_SA(b, h) + aoff + m * 2048 + k * 1024); } while (0)
#define PG8_LDB(dst, b, h) do { _Pragma("unroll") for (int n = 0; n < 2; ++n) _Pragma("unroll") for (int k = 0; k < 2; ++k) dst[n][k] = *(const PG8_LAS bf16x8*)(lds + PG8_SB(b, h) + boff + n * 2048 + k * 1024); } while (0)
#define PG8_MMA(ai, bj, At, Bt) do { __builtin_amdgcn_s_setprio(1); _Pragma("unroll") for (int m = 0; m < 4; ++m) _Pragma("unroll") for (int n = 0; n < 2; ++n) _Pragma("unroll") for (int k = 0; k < 2; ++k) { \
        if constexpr (I8) acc[ai][bj][m][n] = __builtin_bit_cast(f32x4, __builtin_amdgcn_mfma_i32_16x16x64_i8(__builtin_bit_cast(i32x4, Bt[n][k]), __builtin_bit_cast(i32x4, At[m][k]), __builtin_bit_cast(i32x4, acc[ai][bj][m][n]), 0, 0, 0)); \
        else acc[ai][bj][m][n] = __builtin_amdgcn_mfma_f32_16x16x32_bf16(Bt[n][k], At[m][k], acc[ai][bj][m][n], 0, 0, 0); } __builtin_amdgcn_s_setprio(0); } while (0)
#define PG8_WAIT_V(n) asm volatile("s_waitcnt vmcnt(" #n ")" ::: "memory")
#define PG8_WAIT_L(n) asm volatile("s_waitcnt lgkmcnt(" #n ")" ::: "memory")
#define PG8_BAR __builtin_amdgcn_s_barrier()
#define PG8_SCHED __builtin_amdgcn_sched_barrier(0)
    Unit cur, nxt; int ui = 0;
    if (!S.next(0, cur)) return;
    f32x4 acc[2][2][4][2];
#pragma unroll
    for (int a = 0; a < 2; ++a)
#pragma unroll
        for (int b = 0; b < 2; ++b)
#pragma unroll
            for (int m = 0; m < 4; ++m)
#pragma unroll
                for (int n = 0; n < 2; ++n) acc[a][b][m][n] = (f32x4){0.f, 0.f, 0.f, 0.f};
    bf16x8 At[4][2], B0[2][2], B1[2][2];
    const char* cA = (const char*)(cur.seg ? g.A2 : g.A) + (size_t)cur.pm * tstep; const char* cB = (const char*)(cur.seg ? g.Bt2 : g.Bt) + (size_t)cur.pn * tstep;
    S.a_ready(cur);
    if constexpr (SP2) {
        PG8_STAGE(PG8_SB(0, 0), cB, voffB); PG8_STAGE(PG8_SB(0, 1), cB + hstep, voffB); PG8_STAGE(PG8_SA(0, 0), cA, voffA); PG8_STAGE(PG8_SA(0, 1), cA + hstep, voffA);
        if (wr == 1) PG8_BAR;
        PG8_WAIT_V(2); PG8_BAR;
        PG8_STAGE(PG8_SB(1, 0), cB + kstep, voffB); PG8_STAGE(PG8_SA(1, 0), cA + kstep, voffA); PG8_STAGE(PG8_SB(1, 1), cB + hstep + kstep, voffB);
        PG8_WAIT_V(6); PG8_BAR;
    } else {
        PG8_STAGE(PG8_SB(0, 0), cB, voffB); PG8_STAGE(PG8_SA(0, 0), cA, voffA); PG8_STAGE(PG8_SB(0, 1), cB + hstep, voffB); PG8_STAGE(PG8_SA(0, 1), cA + hstep, voffA);
        if (wr == 1) PG8_BAR;
        PG8_WAIT_V(4); PG8_BAR;
        PG8_STAGE(PG8_SB(1, 0), cB + kstep, voffB); PG8_STAGE(PG8_SA(1, 0), cA + kstep, voffA); PG8_STAGE(PG8_SB(1, 1), cB + hstep + kstep, voffB);
        PG8_WAIT_V(6); PG8_BAR;
    }
    for (;;) {
        const bool has_next = S.next(ui + 1, nxt);
        const char* nA = has_next ? (const char*)(nxt.seg ? g.A2 : g.A) + (size_t)nxt.pm * tstep : cA; const char* nB = has_next ? (const char*)(nxt.seg ? g.Bt2 : g.Bt) + (size_t)nxt.pn * tstep : cB;
        for (int t = 0; t < nt; t += 2) {
            const bool last = (t == nt - 2);
            const char* a1 = cA + (size_t)(t + 1) * kstep;
            const char* a2 = last ? nA : cA + (size_t)(t + 2) * kstep; const char* b2 = last ? nB : cB + (size_t)(t + 2) * kstep;
            const char* a3 = a2 + kstep; const char* b3 = b2 + kstep;
            if (last && has_next) S.a_ready(nxt);
            if constexpr (SP2) {
            PG8_LDB(B0, 0, 0); PG8_LDB(B1, 0, 1); PG8_SCHED; PG8_LDA(At, 0, 0); PG8_STAGE(PG8_SA(1, 1), a1 + hstep, voffA);
            PG8_WAIT_V(8); PG8_WAIT_L(0); PG8_BAR; PG8_MMA(0, 0, At, B0); PG8_MMA(0, 1, At, B1); PG8_BAR; PG8_SCHED;
            PG8_LDA(At, 0, 1); PG8_STAGE(PG8_SB(0, 0), b2, voffB); PG8_STAGE(PG8_SB(0, 1), b2 + hstep, voffB); PG8_STAGE(PG8_SA(0, 0), a2, voffA);
            PG8_WAIT_V(8); PG8_WAIT_L(0); PG8_BAR; PG8_MMA(1, 0, At, B0); PG8_MMA(1, 1, At, B1); PG8_BAR; PG8_SCHED;
            PG8_LDB(B0, 1, 0); PG8_LDB(B1, 1, 1); PG8_SCHED; PG8_LDA(At, 1, 0); PG8_STAGE(PG8_SA(0, 1), a2 + hstep, voffA);
            PG8_WAIT_V(8); PG8_WAIT_L(0); PG8_BAR; PG8_MMA(0, 0, At, B0); PG8_MMA(0, 1, At, B1); PG8_BAR; PG8_SCHED;
            PG8_LDA(At, 1, 1); PG8_STAGE(PG8_SB(1, 0), b3, voffB); PG8_STAGE(PG8_SB(1, 1), b3 + hstep, voffB); PG8_STAGE(PG8_SA(1, 0), a3, voffA);
            PG8_WAIT_V(8); PG8_WAIT_L(0); PG8_BAR; PG8_MMA(1, 0, At, B0); PG8_MMA(1, 1, At, B1); PG8_BAR; PG8_SCHED;
            } else {
            PG8_LDB(B0, 0, 0); PG8_SCHED; PG8_LDA(At, 0, 0); PG8_STAGE(PG8_SA(1, 1), a1 + hstep, voffA);
            PG8_WAIT_L(8); PG8_BAR; PG8_WAIT_L(0); PG8_MMA(0, 0, At, B0); PG8_BAR; PG8_SCHED;
            PG8_LDB(B1, 0, 1); PG8_STAGE(PG8_SB(0, 0), b2, voffB);
            PG8_BAR; PG8_WAIT_L(0); PG8_MMA(0, 1, At, B1); PG8_BAR;
            PG8_LDA(At, 0, 1); PG8_STAGE(PG8_SA(0, 0), a2, voffA);
            PG8_BAR; PG8_WAIT_L(0); PG8_MMA(1, 0, At, B0); PG8_BAR; PG8_SCHED;
            PG8_STAGE(PG8_SB(0, 1), b2 + hstep, voffB);
            PG8_WAIT_V(6); PG8_BAR; PG8_MMA(1, 1, At, B1); PG8_BAR;
            PG8_LDB(B0, 1, 0); PG8_SCHED; PG8_LDA(At, 1, 0); PG8_STAGE(PG8_SA(0, 1), a2 + hstep, voffA);
            PG8_WAIT_L(8); PG8_BAR; PG8_WAIT_L(0); PG8_MMA(0, 0, At, B0); PG8_BAR; PG8_SCHED;
            PG8_LDB(B1, 1, 1); PG8_STAGE(PG8_SB(1, 0), b3, voffB);
            PG8_BAR; PG8_WAIT_L(0); PG8_MMA(0, 1, At, B1); PG8_BAR;
            PG8_LDA(At, 1, 1); PG8_STAGE(PG8_SA(1, 0), a3, voffA);
            PG8_BAR; PG8_WAIT_L(0); PG8_MMA(1, 0, At, B0); PG8_BAR; PG8_SCHED;
            PG8_STAGE(PG8_SB(1, 1), b3 + hstep, voffB);
            PG8_WAIT_V(6); PG8_BAR; PG8_MMA(1, 1, At, B1); PG8_BAR;
            }
        }
        if constexpr (ALIGN_EPI) { if (wr == 0) PG8_BAR; }
        const bool keep = E(acc, cur, wr, wc, fr, fq); S.done(cur);
        if (!has_next) break;
        if (!keep) {
#pragma unroll
        for (int a = 0; a < 2; ++a)
#pragma unroll
            for (int b = 0; b < 2; ++b)
#pragma unroll
                for (int m = 0; m < 4; ++m)
#pragma unroll
                    for (int n = 0; n < 2; ++n) acc[a][b][m][n] = (f32x4){0.f, 0.f, 0.f, 0.f};
        }
        cur = nxt; cA = nA; cB = nB; ++ui;
        if constexpr (ALIGN_EPI) { if (wr == 1) PG8_BAR; }
    }
    PG8_WAIT_V(0);
    if constexpr (!ALIGN_EPI) { if (wr == 0) PG8_BAR; }
    PG8_BAR;
#undef PG8_SA
#undef PG8_SB
#undef PG8_STAGE
#undef PG8_LDA
#undef PG8_LDB
#undef PG8_MMA
#undef PG8_WAIT_V
#undef PG8_WAIT_L
#undef PG8_BAR
#undef PG8_SCHED
}
}

constexpr int NWAVES = 8;
constexpr int M = 65536, D = 1024, SEQ = 4096, DIN = 4096, DP = 512, NSC = 2048, NE = 16384, NH = 8, TOPK = 16;
constexpr float RMS_EPS = 1e-6f;
constexpr int N_LAUNCHES = MK_N_LAUNCHES;
constexpr int PER_PHASE = 11;
constexpr int TPI = 32;
__device__ __forceinline__ int ROW_REV(int t) { return M - 1 - t; }
__device__ __forceinline__ int ROW_QREV(int L) { return ((L >> 11) & 7) * 8192 + (3 - (L >> 14)) * 2048 + (L & 2047); }
__device__ __forceinline__ int GRP_QREV(int L) { return ((L >> 7) & 7) * 512 + (3 - (L >> 10)) * 128 + (L & 127); }

constexpr size_t MiB = 1u << 20;
constexpr size_t WS_CTL = 0, CTL_ZERO_BYTES = 1 * MiB;
constexpr size_t WS_WIN = 1 * MiB;
constexpr size_t WS_WC = 9 * MiB;
constexpr size_t WS_WBC = 10 * MiB;
constexpr size_t WS_SBC = 10 * MiB + 512 * 1024;
constexpr size_t WS_SPC = 62 * MiB;
constexpr size_t WS_WCF = 200 * MiB;
constexpr int CW_CMAXC = 45056;
constexpr size_t WS_WOUT = 11 * MiB;
constexpr size_t WS_WPP = 13 * MiB;
constexpr size_t WS_SBP = 15 * MiB;
constexpr size_t WS_SXR = 15 * MiB + 65536;
constexpr size_t WS_WPPF = 192 * MiB;
constexpr size_t WS_X1Q = 704 * MiB;
constexpr int CW_CMAXP = 40960;
constexpr size_t WS_SU = 17 * MiB;
constexpr size_t WS_SV = 17 * MiB + 65536;
constexpr size_t WS_SSQ = 18 * MiB;
constexpr size_t WS_U8 = 22 * MiB;
constexpr size_t WS_V8 = 38 * MiB;
constexpr size_t WS_INV = 54 * MiB;
constexpr size_t WS_SSQ2 = 56 * MiB;
constexpr size_t WS_RSTD = 58 * MiB;
constexpr size_t WS_SWH = 60 * MiB;
constexpr size_t WS_SA = 59 * MiB;
constexpr size_t WS_SB = 59 * MiB + 512 * 1024;
constexpr int CW_CMAX = 32768;
constexpr size_t WS_WV = 192 * MiB + 48 * MiB;
constexpr size_t WS_PART = 576 * MiB;
constexpr size_t WS_B = 64 * MiB;
constexpr size_t WS_C = 192 * MiB;
constexpr size_t WS_A = 320 * MiB;
constexpr size_t WS_END = 832 * MiB;
constexpr int CW_BAR = 4096;
constexpr int CW_QU = 16384, CW_QV = 16384 + 1024;

constexpr int RING_BYTES = 131072;
constexpr int LDSCTL_OFF = RING_BYTES, MISC_OFF = LDSCTL_OFF + 320;
constexpr int LDS_BYTES = 147456;

#define GAS __attribute__((address_space(1)))
#define LAS __attribute__((address_space(3)))
typedef unsigned short bf16;
typedef unsigned v4u __attribute__((ext_vector_type(4)));
typedef unsigned v2u __attribute__((ext_vector_type(2)));
typedef float f32x4 __attribute__((ext_vector_type(4)));
typedef GAS unsigned gu32;
#define RLX_AGENT __ATOMIC_RELAXED, __HIP_MEMORY_SCOPE_AGENT
#define LDS_WAIT() asm volatile("s_waitcnt lgkmcnt(0)" ::: "memory")
#define VM_WAIT() asm volatile("s_waitcnt vmcnt(0)" ::: "memory")
__device__ __forceinline__ unsigned f2bf(float f) { unsigned u = __builtin_bit_cast(unsigned, f); return (u + 0x7fffu + ((u >> 16) & 1u)) >> 16; }
__device__ __forceinline__ unsigned pk2(float lo, float hi) { return f2bf(lo) | (f2bf(hi) << 16); }
__device__ __forceinline__ float bflo(unsigned w) { return __builtin_bit_cast(float, w << 16); }
__device__ __forceinline__ float bfhi(unsigned w) { return __builtin_bit_cast(float, w & 0xffff0000u); }
template <int CTRL> __device__ __forceinline__ int dppi(int x) { return __builtin_amdgcn_mov_dpp(x, CTRL, 0xf, 0xf, true); }
__device__ __forceinline__ int xor1i(int x) { return dppi<0xB1>(x); }
__device__ __forceinline__ int xor2i(int x) { return dppi<0x4E>(x); }
__device__ __forceinline__ int xor4i(int x) { return dppi<0x1B>(dppi<0x141>(x)); }
__device__ __forceinline__ int xor8i(int x) { return dppi<0x128>(x); }
__device__ __forceinline__ float xor1f(float x) { return __builtin_bit_cast(float, xor1i(__builtin_bit_cast(int, x))); }
__device__ __forceinline__ float xor2f(float x) { return __builtin_bit_cast(float, xor2i(__builtin_bit_cast(int, x))); }
__device__ __forceinline__ float xor4f(float x) { return __builtin_bit_cast(float, xor4i(__builtin_bit_cast(int, x))); }
__device__ __forceinline__ float xor8f(float x) { return __builtin_bit_cast(float, xor8i(__builtin_bit_cast(int, x))); }
__device__ __forceinline__ float swap32_add(float a, float b) { asm volatile("s_nop 1\n\tv_permlane32_swap_b32 %0, %1" : "+v"(a), "+v"(b)); return a + b; }
__device__ __forceinline__ int swap32_addi(int a, int b) { asm volatile("s_nop 1\n\tv_permlane32_swap_b32 %0, %1" : "+v"(a), "+v"(b)); return a + b; }
__device__ __forceinline__ int swap16_addi(int a, int b) { asm volatile("s_nop 1\n\tv_permlane16_swap_b32 %0, %1" : "+v"(a), "+v"(b)); return a + b; }
__device__ __forceinline__ float swap16_add(float a, float b) { asm volatile("s_nop 1\n\tv_permlane16_swap_b32 %0, %1" : "+v"(a), "+v"(b)); return a + b; }
__device__ __forceinline__ float xor16f(float x) { float a = x, b = x; asm volatile("s_nop 1\n\tv_permlane16_swap_b32 %0, %1" : "+v"(a), "+v"(b)); return ((threadIdx.x >> 4) & 1) ? a : b; }
__device__ __forceinline__ float xor32f(float x) { float a = x, b = x; asm volatile("s_nop 1\n\tv_permlane32_swap_b32 %0, %1" : "+v"(a), "+v"(b)); return (threadIdx.x & 32) ? a : b; }
__device__ __forceinline__ float wave_sum(float v) {
    v += xor1f(v); v += xor2f(v); v += xor4f(v); v += xor8f(v);
    v = swap16_add(v, v); v = swap32_add(v, v);
    return v;
}
__device__ __forceinline__ float wave_max(float v) {
    v = fmaxf(v, xor1f(v)); v = fmaxf(v, xor2f(v)); v = fmaxf(v, xor4f(v)); v = fmaxf(v, xor8f(v));
    v = fmaxf(v, xor16f(v)); v = fmaxf(v, xor32f(v));
    return v;
}

__device__ __forceinline__ void unpack8(const v4u w, float (&f)[8]) { f[0] = bflo(w.x); f[1] = bfhi(w.x); f[2] = bflo(w.y); f[3] = bfhi(w.y); f[4] = bflo(w.z); f[5] = bfhi(w.z); f[6] = bflo(w.w); f[7] = bfhi(w.w); }
__device__ __forceinline__ v4u pack8(const float (&f)[8]) { v4u w; w.x = pk2(f[0], f[1]); w.y = pk2(f[2], f[3]); w.z = pk2(f[4], f[5]); w.w = pk2(f[6], f[7]); return w; }

#define XB_TMO      128
#define XB_XCNT(j)  (256  + 64 * (j))
#define XB_XSUB(j)  (1280 + 64 * (j))
#define XB_XGEN(j)  (2304 + 64 * (j))
#define XB_TOP      3328
#define XB_TOPGEN   3392
#define XCD_BAR_WORDS 3456
#define XB_SPIN_CAP (1u << 18)
__device__ __forceinline__ unsigned xb_ld(unsigned* p)              { return __hip_atomic_load(p, __ATOMIC_RELAXED, __HIP_MEMORY_SCOPE_AGENT); }
__device__ __forceinline__ unsigned xb_add(unsigned* p, unsigned v) { return __hip_atomic_fetch_add(p, v, __ATOMIC_RELAXED, __HIP_MEMORY_SCOPE_AGENT); }
__device__ __forceinline__ unsigned xb_xcc_id() { return (unsigned)__builtin_amdgcn_s_getreg((3 << 11) | 20) & 0xFu; }
#define XB_SPIN(cond, bar) do { unsigned _sp = 0; while (cond) { __builtin_amdgcn_s_sleep(0); \
    if ((++_sp & 255u) == 0u) { if (xb_ld(&(bar)[XB_TMO])) break; if (_sp > XB_SPIN_CAP) { atomicAdd(&(bar)[XB_TMO], 1u); break; } } } } while (0)
struct XcdBarrier { unsigned* bar; unsigned x; volatile LAS unsigned* st; };
__device__ __forceinline__ XcdBarrier xcd_barrier_post(unsigned* bar, volatile LAS unsigned* st) {
    XcdBarrier b; b.bar = bar; b.x = xb_xcc_id(); b.st = st;
    if (threadIdx.x == 0) (void)xb_add(&bar[XB_XCNT(b.x)], 1u);
    return b;
}
__device__ __forceinline__ void xcd_barrier_complete(unsigned* bar, unsigned x, unsigned& nloc, unsigned& nx) {
    const unsigned G = gridDim.x * gridDim.y * gridDim.z;
    unsigned sum, cnt, mine, sp = 0u;
    for (;;) {
        sum = 0u; cnt = 0u; mine = 0u;
#pragma unroll
        for (unsigned j = 0; j < 16; ++j) { const unsigned c = xb_ld(&bar[XB_XCNT(j)]); sum += c; cnt += (c > 0u) ? 1u : 0u; mine = (j == x) ? c : mine; }
        if (sum == G) break;
        __builtin_amdgcn_s_sleep(1);
        if ((++sp & 255u) == 0u) { if (xb_ld(&bar[XB_TMO])) break; if (sp > XB_SPIN_CAP) { atomicAdd(&bar[XB_TMO], 1u); break; } }
    }
    nloc = mine > 0u ? mine : 1u; nx = cnt > 0u ? cnt : 1u;
}
__device__ __forceinline__ void xcd_barrier(const XcdBarrier& b) {
    asm volatile("s_waitcnt vmcnt(0)" ::: "memory");
    __syncthreads();
    if (threadIdx.x == 0) {
        unsigned* bar = b.bar;
        __builtin_amdgcn_s_waitcnt(0);
        unsigned nloc = b.st[0], nx = b.st[1];
        if (nloc == 0u) { xcd_barrier_complete(bar, b.x, nloc, nx); b.st[0] = nloc; b.st[1] = nx; }
        const unsigned old = xb_add(&bar[XB_XSUB(b.x)], 1u);
        const unsigned gen = old / nloc;
        if (old + 1u == (gen + 1u) * nloc) {
            __builtin_amdgcn_fence(__ATOMIC_RELEASE, "agent");
            asm volatile("s_waitcnt vmcnt(0)" ::: "memory");
            const unsigned og = xb_add(&bar[XB_TOP], 1u);
            const unsigned tg = og / nx;
            if (og + 1u == (tg + 1u) * nx) xb_add(&bar[XB_TOPGEN], 1u);
            else XB_SPIN(xb_ld(&bar[XB_TOPGEN]) == tg, bar);
            __builtin_amdgcn_fence(__ATOMIC_ACQUIRE, "agent");
            xb_add(&bar[XB_XGEN(b.x)], 1u);
            asm volatile("s_waitcnt vmcnt(0)" ::: "memory");
        } else {
            XB_SPIN(xb_ld(&bar[XB_XGEN(b.x)]) == gen, bar);
            __builtin_amdgcn_fence(__ATOMIC_ACQUIRE, "agent");
            asm volatile("s_waitcnt vmcnt(0)" ::: "memory");
        }
    }
    __syncthreads();
}

__device__ __forceinline__ void p0_transpose_item(const float* W, int K, int N, bf16* WT, LAS float* scr, int item, int lane, const unsigned* kmax = nullptr) {
    const int nblk = N / 32, kb = item / nblk, nb = item % nblk, k0 = 64 * kb, n0 = 32 * nb;
#pragma unroll 8
    for (int i = 0; i < 32; ++i) { const int kk = 2 * i + (lane >> 5); float ks = 1.f; if (kmax) { const float mxv = __builtin_bit_cast(float, kmax[k0 + kk]); ks = mxv > 0.f ? mxv * (1.f / 127.f) : 1.f; }
        scr[kk * 33 + (lane & 31)] = W[(size_t)(k0 + kk) * N + n0 + (lane & 31)] * ks; }
    LDS_WAIT(); asm volatile("" ::: "memory");
    const int c = lane & 7;
#pragma unroll
    for (int j = 0; j < 4; ++j) { const int n = (lane >> 3) + 8 * j; const LAS float* s = scr + (8 * c) * 33 + n;
        v4u o; o.x = pk2(s[0 * 33], s[1 * 33]); o.y = pk2(s[2 * 33], s[3 * 33]); o.z = pk2(s[4 * 33], s[5 * 33]); o.w = pk2(s[6 * 33], s[7 * 33]);
        *(v4u*)(WT + (size_t)(n0 + n) * K + k0 + 8 * c) = o; }
    LDS_WAIT(); asm volatile("" ::: "memory");
}
__device__ __forceinline__ void p0_wc_item(const float* gwt, const float* scale, const float* wbp, float* WcF, unsigned* cmaxc, LAS float* scr, int item, int lane) {
    const int nb = item & 15, cb = (item >> 4) & 7, g = item >> 7;
    const int n = nb * 64 + lane;
    const f32x4* gsrc = (const f32x4*)(gwt + (size_t)((g * 128 + cb * 16) * 128));
    LAS f32x4* gt = (LAS f32x4*)scr;
#pragma unroll
    for (int i = 0; i < 8; ++i) gt[i * 64 + lane] = gsrc[i * 64 + lane];
    float acc[16];
#pragma unroll
    for (int c = 0; c < 16; ++c) acc[c] = 0.f;
    LDS_WAIT(); asm volatile("" ::: "memory");
    const float* bp = wbp + (size_t)(g * 128) * 1024 + n;
#pragma unroll 2
    for (int d4 = 0; d4 < 32; ++d4) {
        const f32x4 sc = *(const f32x4*)(scale + g * 128 + 4 * d4);
        const float b0 = bp[(size_t)(4 * d4 + 0) * 1024] * sc.x, b1 = bp[(size_t)(4 * d4 + 1) * 1024] * sc.y, b2 = bp[(size_t)(4 * d4 + 2) * 1024] * sc.z, b3 = bp[(size_t)(4 * d4 + 3) * 1024] * sc.w;
#pragma unroll
        for (int c = 0; c < 16; ++c) { const f32x4 gq = gt[c * 32 + d4]; acc[c] += (gq.x * b0 + gq.y * b1) + (gq.z * b2 + gq.w * b3); }
    }
    float* dst = WcF + (size_t)n * 512 + g * 128 + cb * 16;
    float mx = 0.f;
#pragma unroll
    for (int q = 0; q < 4; ++q) { *(f32x4*)(dst + 4 * q) = (f32x4){acc[4 * q], acc[4 * q + 1], acc[4 * q + 2], acc[4 * q + 3]};
        mx = fmaxf(mx, fmaxf(fmaxf(fabsf(acc[4 * q]), fabsf(acc[4 * q + 1])), fmaxf(fabsf(acc[4 * q + 2]), fabsf(acc[4 * q + 3])))); }
    atomicMax(cmaxc + n, __builtin_bit_cast(unsigned, mx));
    LDS_WAIT(); asm volatile("" ::: "memory");
}
__device__ __forceinline__ void p0_wc_quant_row(const float* WcF, const unsigned* cmaxc, unsigned char* Wc8, int n, int lane) {
    const f32x4* p = (const f32x4*)(WcF + (size_t)n * 512 + 8 * lane);
    const float mxv = __builtin_bit_cast(float, cmaxc[n]); const float sc = mxv > 0.f ? mxv * (1.f / 127.f) : 1.f, inv = 1.f / sc;
    v2u w;
#pragma unroll
    for (int j = 0; j < 2; ++j) { const f32x4 v = p[j]; unsigned a = 0;
#pragma unroll
        for (int c = 0; c < 4; ++c) { int q = (int)rintf(v[c] * inv); q = q > 127 ? 127 : (q < -127 ? -127 : q); a |= ((unsigned)q & 0xffu) << (8 * c); }
        w[j] = a; }
    *(v2u*)(Wc8 + (size_t)n * 512 + 8 * lane) = w;
}
__device__ __forceinline__ void p0_wpp_item(const float* wq, const float* keys, const float* gffn, float* WppF, unsigned* cmaxp, LAS float* scr, int item, int lane) {
    const int kb = item & 3, db = (item >> 2) & 15, hp = item >> 6;
    const int d = db * 64 + lane;
    const f32x4* kbase = (const f32x4*)(keys + (size_t)(hp * 128 + kb * 32) * 128);
    LAS f32x4* kt = (LAS f32x4*)scr;
#pragma unroll
    for (int i = 0; i < 16; ++i) kt[i * 64 + lane] = kbase[i * 64 + lane];
    float acc[32];
#pragma unroll
    for (int k = 0; k < 32; ++k) acc[k] = 0.f;
    const float* arow = wq + (size_t)d * 2048 + hp * 128;
    LDS_WAIT(); asm volatile("" ::: "memory");
#pragma unroll 4
    for (int c4 = 0; c4 < 32; ++c4) {
        const f32x4 a = *(const f32x4*)(arow + 4 * c4);
#pragma unroll
        for (int k = 0; k < 32; ++k) { const f32x4 kr = kt[k * 32 + c4]; acc[k] += (a.x * kr.x + a.y * kr.y) + (a.z * kr.z + a.w * kr.w); }
    }
    const float gs = gffn[d];
#pragma unroll
    for (int k = 0; k < 32; ++k) { const float v = acc[k] * gs; WppF[(size_t)(hp * 128 + kb * 32 + k) * 1024 + d] = v;
        const float mx = wave_max(fabsf(v)); if (lane == 0) atomicMax(cmaxp + hp * 128 + kb * 32 + k, __builtin_bit_cast(unsigned, mx)); }
    LDS_WAIT(); asm volatile("" ::: "memory");
}
__device__ __forceinline__ void p0_wpp_quant_row(const float* WppF, const unsigned* cmaxp, unsigned char* Wq8, float* SBP, int n, int lane) {
    const f32x4* p = (const f32x4*)(WppF + (size_t)n * 1024 + 16 * lane);
    const float mxv = __builtin_bit_cast(float, cmaxp[n]); const float sc = mxv > 0.f ? mxv * (1.f / 127.f) : 1.f, inv = 1.f / sc;
    v4u w;
#pragma unroll
    for (int j = 0; j < 4; ++j) { const f32x4 v = p[j]; unsigned a = 0;
#pragma unroll
        for (int c = 0; c < 4; ++c) { int q = (int)rintf(v[c] * inv); q = q > 127 ? 127 : (q < -127 ? -127 : q); a |= ((unsigned)q & 0xffu) << (8 * c); }
        w[j] = a; }
    *(v4u*)(Wq8 + (size_t)n * 1024 + 16 * lane) = w;
    if (lane == 0) SBP[n] = sc;
}
struct XRows { v4u a0, a1, b0, b1; float sa, sb; };
__device__ __forceinline__ void p5_x1_load(XRows& r, const bf16* X1, const float* SSQ, int r0, int r1, int lane) {
    r.a0 = *(const v4u*)(X1 + (size_t)r0 * D + 16 * lane); r.a1 = *(const v4u*)(X1 + (size_t)r0 * D + 16 * lane + 8);
    r.b0 = *(const v4u*)(X1 + (size_t)r1 * D + 16 * lane); r.b1 = *(const v4u*)(X1 + (size_t)r1 * D + 16 * lane + 8);
    r.sa = lane < 16 ? SSQ[(size_t)r0 * 16 + lane] : 0.f; r.sb = lane < 16 ? SSQ[(size_t)r1 * 16 + lane] : 0.f;
}
__device__ __forceinline__ void p5_x1_quant_rows2(const XRows& in, unsigned char* X1q, float* SX, float* SXR, float* RSTD, int r0, int r1, int lane) {
    const v4u a0 = in.a0, a1 = in.a1, b0 = in.b0, b1 = in.b1; const float sa = in.sa, sb = in.sb;
    float xa[16], xb[16];
    { float f[8]; unpack8(a0, f);
#pragma unroll
      for (int i = 0; i < 8; ++i) xa[i] = f[i];
      unpack8(a1, f);
#pragma unroll
      for (int i = 0; i < 8; ++i) xa[8 + i] = f[i];
      unpack8(b0, f);
#pragma unroll
      for (int i = 0; i < 8; ++i) xb[i] = f[i];
      unpack8(b1, f);
#pragma unroll
      for (int i = 0; i < 8; ++i) xb[8 + i] = f[i]; }
    float ma = 0.f, mb = 0.f;
#pragma unroll
    for (int i = 0; i < 16; ++i) { ma = fmaxf(ma, fabsf(xa[i])); mb = fmaxf(mb, fabsf(xb[i])); }
    ma = wave_max(ma); mb = wave_max(mb);
    const float ra = rsqrtf(wave_sum(sa) * (1.f / D) + RMS_EPS), rb = rsqrtf(wave_sum(sb) * (1.f / D) + RMS_EPS);
    const float sca = ma > 0.f ? ma * (1.f / 127.f) : 1.f, scb = mb > 0.f ? mb * (1.f / 127.f) : 1.f, ia = 1.f / sca, ib = 1.f / scb;
    v4u wa, wb;
#pragma unroll
    for (int j = 0; j < 4; ++j) { unsigned a = 0, b = 0;
#pragma unroll
        for (int c = 0; c < 4; ++c) { int q = (int)rintf(xa[4 * j + c] * ia); q = q > 127 ? 127 : (q < -127 ? -127 : q); a |= ((unsigned)q & 0xffu) << (8 * c);
            int q1 = (int)rintf(xb[4 * j + c] * ib); q1 = q1 > 127 ? 127 : (q1 < -127 ? -127 : q1); b |= ((unsigned)q1 & 0xffu) << (8 * c); }
        wa[j] = a; wb[j] = b; }
    *(v4u*)(X1q + (size_t)r0 * D + 16 * lane) = wa; *(v4u*)(X1q + (size_t)r1 * D + 16 * lane) = wb;
    if (lane == 0) { SX[r0] = sca; SX[r1] = scb; SXR[r0] = sca * ra; SXR[r1] = scb * rb; RSTD[r0] = ra; RSTD[r1] = rb; }
}
__device__ __forceinline__ void p0_h_row(const float* xrow, const float* g, bf16* orow, int lane) {
    const f32x4* xr = (const f32x4*)xrow + lane; const f32x4* gr = (const f32x4*)g + lane;
    f32x4 v[4]; float s = 0.f;
#pragma unroll
    for (int j = 0; j < 4; ++j) { v[j] = xr[64 * j]; s += (v[j].x * v[j].x + v[j].y * v[j].y) + (v[j].z * v[j].z + v[j].w * v[j].w); }
    const float rstd = rsqrtf(wave_sum(s) * (1.f / D) + RMS_EPS);
    v2u* o8 = (v2u*)orow + lane;
#pragma unroll
    for (int j = 0; j < 4; ++j) { const f32x4 gg = gr[64 * j]; v2u o; o.x = pk2(v[j].x * rstd * gg.x, v[j].y * rstd * gg.y); o.y = pk2(v[j].z * rstd * gg.z, v[j].w * rstd * gg.w); o8[64 * j] = o; }
}
struct HRows { f32x4 v0[4], v1[4]; };
__device__ __forceinline__ void p0_h_load(HRows& r, const float* x, int m0, int m1, int lane) {
    const f32x4* xr0 = (const f32x4*)(x + (size_t)m0 * D) + lane; const f32x4* xr1 = (const f32x4*)(x + (size_t)m1 * D) + lane;
#pragma unroll
    for (int j = 0; j < 4; ++j) { r.v0[j] = xr0[64 * j]; r.v1[j] = xr1[64 * j]; }
}
__device__ __forceinline__ void p0_h_rows2(const HRows& in, const float* g, unsigned char* Hq, float* SA, int m0, int m1, int lane) {
    const f32x4* gr = (const f32x4*)g + lane;
    f32x4 v0[4], v1[4]; float s0 = 0.f, s1 = 0.f;
#pragma unroll
    for (int j = 0; j < 4; ++j) { v0[j] = in.v0[j]; v1[j] = in.v1[j]; }
#pragma unroll
    for (int j = 0; j < 4; ++j) { s0 += (v0[j].x * v0[j].x + v0[j].y * v0[j].y) + (v0[j].z * v0[j].z + v0[j].w * v0[j].w); s1 += (v1[j].x * v1[j].x + v1[j].y * v1[j].y) + (v1[j].z * v1[j].z + v1[j].w * v1[j].w); }
    const float r0 = rsqrtf(wave_sum(s0) * (1.f / D) + RMS_EPS), r1 = rsqrtf(wave_sum(s1) * (1.f / D) + RMS_EPS);
    float mx0 = 0.f, mx1 = 0.f;
#pragma unroll
    for (int j = 0; j < 4; ++j) { const f32x4 gg = gr[64 * j]; v0[j] = v0[j] * gg * r0; v1[j] = v1[j] * gg * r1;
        mx0 = fmaxf(mx0, fmaxf(fmaxf(fabsf(v0[j].x), fabsf(v0[j].y)), fmaxf(fabsf(v0[j].z), fabsf(v0[j].w))));
        mx1 = fmaxf(mx1, fmaxf(fmaxf(fabsf(v1[j].x), fabsf(v1[j].y)), fmaxf(fabsf(v1[j].z), fabsf(v1[j].w)))); }
    mx0 = wave_max(mx0); mx1 = wave_max(mx1);
    const float sc0 = mx0 > 0.f ? mx0 * (1.f / 127.f) : 1.f, sc1 = mx1 > 0.f ? mx1 * (1.f / 127.f) : 1.f, i0 = 1.f / sc0, i1 = 1.f / sc1;
    unsigned* o0 = (unsigned*)(Hq + (size_t)m0 * D) + lane; unsigned* o1 = (unsigned*)(Hq + (size_t)m1 * D) + lane;
#pragma unroll
    for (int j = 0; j < 4; ++j) { unsigned a = 0, b = 0;
#pragma unroll
        for (int c = 0; c < 4; ++c) { int q = (int)rintf(v0[j][c] * i0); q = q > 127 ? 127 : (q < -127 ? -127 : q); a |= ((unsigned)q & 0xffu) << (8 * c);
            int q1 = (int)rintf(v1[j][c] * i1); q1 = q1 > 127 ? 127 : (q1 < -127 ? -127 : q1); b |= ((unsigned)q1 & 0xffu) << (8 * c); }
        o0[64 * j] = a; o1[64 * j] = b; }
    if (lane == 0) { SA[m0] = sc0; SA[m1] = sc1; }
}
__device__ __forceinline__ void p0_colmax_item(const float* W, int N, unsigned* cmax, int item, int lane) {
    const int nblk = N / 256, kb = item / nblk, nb = item % nblk;
    const float* p = W + (size_t)(kb * 64) * N + nb * 256 + 4 * lane;
    f32x4 mx = {0.f, 0.f, 0.f, 0.f};
#pragma unroll 8
    for (int k = 0; k < 64; ++k) { const f32x4 v = *(const f32x4*)(p + (size_t)k * N); mx.x = fmaxf(mx.x, fabsf(v.x)); mx.y = fmaxf(mx.y, fabsf(v.y)); mx.z = fmaxf(mx.z, fabsf(v.z)); mx.w = fmaxf(mx.w, fabsf(v.w)); }
    unsigned* c = cmax + nb * 256 + 4 * lane;
    atomicMax(c + 0, __builtin_bit_cast(unsigned, mx.x)); atomicMax(c + 1, __builtin_bit_cast(unsigned, mx.y)); atomicMax(c + 2, __builtin_bit_cast(unsigned, mx.z)); atomicMax(c + 3, __builtin_bit_cast(unsigned, mx.w));
}
__device__ __forceinline__ void p0_transpose_i8_item(const float* W, int K, int N, unsigned char* WT, const unsigned* cmax, float* SB, LAS float* scr, int item, int lane) {
    const int nblk = N / 32, kb = item / nblk, nb = item % nblk, k0 = 64 * kb, n0 = 32 * nb;
#pragma unroll 8
    for (int i = 0; i < 32; ++i) { const int kk = 2 * i + (lane >> 5); scr[kk * 33 + (lane & 31)] = W[(size_t)(k0 + kk) * N + n0 + (lane & 31)]; }
    LDS_WAIT(); asm volatile("" ::: "memory");
    const int c = lane & 3;
#pragma unroll
    for (int j = 0; j < 2; ++j) { const int n = (lane >> 2) + 16 * j; const LAS float* s = scr + (16 * c) * 33 + n;
        const float mxv = __builtin_bit_cast(float, cmax[n0 + n]); const float sc = mxv > 0.f ? mxv * (1.f / 127.f) : 1.f, inv = 1.f / sc;
        if (kb == 0 && c == 0) SB[n0 + n] = sc;
        v4u o;
#pragma unroll
        for (int q4 = 0; q4 < 4; ++q4) { unsigned a = 0;
#pragma unroll
            for (int b = 0; b < 4; ++b) { int q = (int)rintf(s[(4 * q4 + b) * 33] * inv); q = q > 127 ? 127 : (q < -127 ? -127 : q); a |= ((unsigned)q & 0xffu) << (8 * b); }
            o[q4] = a; }
        *(v4u*)(WT + (size_t)(n0 + n) * K + k0 + 16 * c) = o; }
    LDS_WAIT(); asm volatile("" ::: "memory");
}
__device__ __forceinline__ void p0_q_load(HRows& r, const float* src, int e0, int e1, int lane) {
    const f32x4* p0 = (const f32x4*)(src + (size_t)e0 * 1024 + 16 * lane); const f32x4* p1 = (const f32x4*)(src + (size_t)e1 * 1024 + 16 * lane);
#pragma unroll
    for (int j = 0; j < 4; ++j) { r.v0[j] = p0[j]; r.v1[j] = p1[j]; }
}
template <bool FP8>
__device__ __forceinline__ void p0_quant_rows2(const HRows& in, const float* gmul, unsigned char* dst, float* scale_out, int e0, int e1, int lane) {
    f32x4 v[2][4];
#pragma unroll
    for (int j = 0; j < 4; ++j) { v[0][j] = in.v0[j]; v[1][j] = in.v1[j]; }
    if (gmul) { const f32x4* gp = (const f32x4*)(gmul + 16 * lane);
#pragma unroll
        for (int j = 0; j < 4; ++j) { const f32x4 gg = gp[j]; v[0][j] = v[0][j] * gg; v[1][j] = v[1][j] * gg; } }
#pragma unroll
    for (int r = 0; r < 2; ++r) {
        float mx = 0.f;
#pragma unroll
        for (int j = 0; j < 4; ++j) mx = fmaxf(mx, fmaxf(fmaxf(fabsf(v[r][j].x), fabsf(v[r][j].y)), fmaxf(fabsf(v[r][j].z), fabsf(v[r][j].w))));
        mx = wave_max(mx);
        const float sc = mx > 0.f ? mx * (FP8 ? (1.f / 448.f) : (1.f / 127.f)) : 1.f, inv = 1.f / sc;
        v4u w;
#pragma unroll
        for (int j = 0; j < 4; ++j) {
            if (FP8) { int pk = __builtin_amdgcn_cvt_pk_fp8_f32(v[r][j].x * inv, v[r][j].y * inv, 0, false); pk = __builtin_amdgcn_cvt_pk_fp8_f32(v[r][j].z * inv, v[r][j].w * inv, pk, true); w[j] = (unsigned)pk; }
            else { unsigned acc = 0;
#pragma unroll
                for (int c = 0; c < 4; ++c) { int q = (int)rintf(v[r][j][c] * inv); q = q > 127 ? 127 : (q < -127 ? -127 : q); acc |= ((unsigned)q & 0xffu) << (8 * c); }
                w[j] = acc; }
        }
        const int e = r ? e1 : e0;
        *(v4u*)(dst + ((size_t)(lane >> 3) * NE + e) * 128 + 16 * (lane & 7)) = w;
        if (lane == 0) scale_out[e] = sc;
    }
}

__device__ __forceinline__ float ubf(unsigned w, int b) { return (float)((w >> (8 * b)) & 0xffu); }
typedef pg8::f32x4 (&AccRef)[2][2][4][2];
struct EpiZ {
    static constexpr bool PERM = true;
    unsigned char* O8; float* ZS; unsigned char* G8; const float* SA; const float* SB;
    __device__ __forceinline__ bool operator()(AccRef acc, const pg8::Unit& u, int wr, int wc, int fr, int fq) const {
        if (PROBE_SKIP_EPI == 1 && u.dup) return false;
        const int row0 = u.pm * 256 + wr * 64 + fr, col0 = u.pn * 256 + wc * 32 + 8 * fq;
        pg8::f32x4 sb[2][2];
#pragma unroll
        for (int bj = 0; bj < 2; ++bj) { sb[bj][0] = *(const pg8::f32x4*)(SB + col0 + bj * 128); sb[bj][1] = *(const pg8::f32x4*)(SB + col0 + bj * 128 + 4); }
        float sav[2][4];
#pragma unroll
        for (int ai = 0; ai < 2; ++ai)
#pragma unroll
            for (int m = 0; m < 4; ++m) sav[ai][m] = SA[row0 + ai * 128 + m * 16];
        asm volatile("" ::: "memory");
        const bool gate = u.pn >= 8;
#pragma unroll
        for (int ai = 0; ai < 2; ++ai)
#pragma unroll
            for (int m = 0; m < 4; ++m) { const int r = row0 + ai * 128 + m * 16; const float sa = sav[ai][m];
#pragma unroll
                for (int bj = 0; bj < 2; ++bj) { const pg8::i32x4 i0 = __builtin_bit_cast(pg8::i32x4, acc[ai][bj][m][0]), i1 = __builtin_bit_cast(pg8::i32x4, acc[ai][bj][m][1]);
                    pg8::f32x4 v0 = {(float)i0[0], (float)i0[1], (float)i0[2], (float)i0[3]}, v1 = {(float)i1[0], (float)i1[1], (float)i1[2], (float)i1[3]};
                    v0 = v0 * sb[bj][0] * sa; v1 = v1 * sb[bj][1] * sa;
                    if (!gate) {
                        float am = fmaxf(fmaxf(fmaxf(fabsf(v0[0]), fabsf(v0[1])), fmaxf(fabsf(v0[2]), fabsf(v0[3]))), fmaxf(fmaxf(fabsf(v1[0]), fabsf(v1[1])), fmaxf(fabsf(v1[2]), fabsf(v1[3]))));
                        am = fmaxf(am, xor16f(am)); am = fmaxf(am, xor32f(am));
                        const float sc = am > 0.f ? am * (1.f / 127.f) : 1.f, inv = __builtin_amdgcn_rcpf(sc) * 0.99999f;
#define QZ(x) __builtin_bit_cast(unsigned, fmaf((x), inv, 12582912.f + 128.f))
#define PK4(a, b, c, d) (__builtin_amdgcn_perm(QZ(b), QZ(a), 0x0c0c0400u) | (__builtin_amdgcn_perm(QZ(d), QZ(c), 0x0c0c0400u) << 16))
                        v2u w;
                        w.x = PK4(v0[0], v0[1], v0[2], v0[3]); w.y = PK4(v1[0], v1[1], v1[2], v1[3]);
#undef PK4
#undef QZ
                        *(v2u*)(O8 + (size_t)r * 2048 + col0 + bj * 128) = w;
                        if (fq == 0) ZS[(size_t)r * 64 + ((col0 + bj * 128) >> 5)] = sc;
                    } else { v2u w;
#define SQ(x) __builtin_bit_cast(unsigned, fmaxf(255.f * __builtin_amdgcn_rcpf(1.f + __builtin_amdgcn_exp2f((x) * -1.44269504089f)), 1.f) + 12582912.f)
#define PK4(a, b, c, d) (__builtin_amdgcn_perm(SQ(b), SQ(a), 0x0c0c0400u) | (__builtin_amdgcn_perm(SQ(d), SQ(c), 0x0c0c0400u) << 16))
                        w.x = PK4(v0[0], v0[1], v0[2], v0[3]); w.y = PK4(v1[0], v1[1], v1[2], v1[3]);
#undef PK4
#undef SQ
                        *(v2u*)(G8 + (size_t)r * 2048 + (col0 - 2048) + bj * 128) = w; } } }
        return false;
    }
};
__device__ __forceinline__ float einv(float x) { return 1.f + __builtin_amdgcn_exp2f(x * -1.44269504089f); }
__device__ __forceinline__ float sigm_ratio(float ga, float gb) { return einv(gb) * __builtin_amdgcn_rcpf(einv(ga)); }
__device__ __forceinline__ float iscale(float accbits_as_f, float r) { const int v = __builtin_bit_cast(int, accbits_as_f); const float y = fminf(fmaxf((float)v * r, -2.0e9f), 2.0e9f); return __builtin_bit_cast(float, (int)rintf(y)); }
struct EpiGate {
    static constexpr bool PERM = true;
    const unsigned char* G8; bf16* Mo; const float* SPC;
    __device__ __forceinline__ bool operator()(AccRef acc, const pg8::Unit& u, int wr, int wc, int fr, int fq) const {
        const int row0 = u.pm * 256 + wr * 64 + fr, col0 = u.pn * 256 + wc * 32 + 8 * fq;
        const unsigned goff0 = (unsigned)row0 * 2048u + (unsigned)col0;
        if (u.seg == 0) {
#pragma unroll
            for (int ai = 0; ai < 2; ++ai)
#pragma unroll
            for (int mh = 0; mh < 2; ++mh) {
                v2u ga[2][2], gb[2][2];
#pragma unroll
                for (int mm = 0; mm < 2; ++mm) { const unsigned go = goff0 + (unsigned)((ai * 128 + (2 * mh + mm) * 16) * 2048);
#pragma unroll
                    for (int bj = 0; bj < 2; ++bj) { ga[mm][bj] = *(const v2u*)(G8 + go + bj * 128); gb[mm][bj] = *(const v2u*)(G8 + go + 1024 + bj * 128); } }
                asm volatile("" ::: "memory");
#pragma unroll
                for (int mm = 0; mm < 2; ++mm)
#pragma unroll
                    for (int bj = 0; bj < 2; ++bj) { const v2u a = ga[mm][bj], b = gb[mm][bj]; const int m = 2 * mh + mm;
                        pg8::f32x4& v0 = acc[ai][bj][m][0]; pg8::f32x4& v1 = acc[ai][bj][m][1];
#pragma unroll
                        for (int e = 0; e < 4; ++e) { v0[e] = iscale(v0[e], ubf(a.x, e) * __builtin_amdgcn_rcpf(ubf(b.x, e))); v1[e] = iscale(v1[e], ubf(a.y, e) * __builtin_amdgcn_rcpf(ubf(b.y, e))); } }
                asm volatile("" ::: "memory");
            }
            return true;
        }
#pragma unroll
        for (int ai = 0; ai < 2; ++ai)
#pragma unroll
        for (int mh = 0; mh < 2; ++mh) {
            v2u gb[2][2]; float sr[2];
#pragma unroll
            for (int mm = 0; mm < 2; ++mm) { const int ro = ai * 128 + (2 * mh + mm) * 16; const unsigned go = goff0 + (unsigned)(ro * 2048); sr[mm] = SPC[row0 + ro] * (1.f / 255.f);
#pragma unroll
                for (int bj = 0; bj < 2; ++bj) gb[mm][bj] = *(const v2u*)(G8 + go + 1024 + bj * 128); }
            asm volatile("" ::: "memory");
#pragma unroll
            for (int mm = 0; mm < 2; ++mm) { const int m = 2 * mh + mm; const size_t r = (size_t)(row0 + ai * 128 + m * 16); bf16* mo = Mo + r * D + col0; const float rs = sr[mm];
#pragma unroll
                for (int bj = 0; bj < 2; ++bj) { const v2u b = gb[mm][bj];
                    const pg8::i32x4 i0 = __builtin_bit_cast(pg8::i32x4, acc[ai][bj][m][0]), i1 = __builtin_bit_cast(pg8::i32x4, acc[ai][bj][m][1]);
                    const pg8::f32x4 v0 = (pg8::f32x4){(float)i0[0], (float)i0[1], (float)i0[2], (float)i0[3]} * rs, v1 = (pg8::f32x4){(float)i1[0], (float)i1[1], (float)i1[2], (float)i1[3]} * rs; v4u w;
                    w.x = pg8::cvt_pk_bf16(v0[0] * ubf(b.x, 0), v0[1] * ubf(b.x, 1)); w.y = pg8::cvt_pk_bf16(v0[2] * ubf(b.x, 2), v0[3] * ubf(b.x, 3));
                    w.z = pg8::cvt_pk_bf16(v1[0] * ubf(b.y, 0), v1[1] * ubf(b.y, 1)); w.w = pg8::cvt_pk_bf16(v1[2] * ubf(b.y, 2), v1[3] * ubf(b.y, 3));
                    *(v4u*)(mo + bj * 128) = w; } }
            asm volatile("" ::: "memory");
        }
        return false;
    }
};
struct EpiRes {
    static constexpr bool PERM = true;
    const float* X; bf16* X1; float* SSQ;
    __device__ __forceinline__ bool operator()(AccRef acc, const pg8::Unit& u, int wr, int wc, int fr, int fq) const {
        if (PROBE_SKIP_EPI && u.dup) return false;
        const int row0 = u.pm * 256 + wr * 64 + fr, col0 = u.pn * 256 + wc * 32 + 8 * fq;
#pragma unroll
        for (int ai = 0; ai < 2; ++ai) {
            pg8::f32x4 xr[4][2][2];
#pragma unroll
            for (int m = 0; m < 4; ++m) { const float* xp = X + (size_t)(row0 + ai * 128 + m * 16) * D + col0;
#pragma unroll
                for (int bj = 0; bj < 2; ++bj) { xr[m][bj][0] = *(const pg8::f32x4*)(xp + bj * 128); xr[m][bj][1] = *(const pg8::f32x4*)(xp + bj * 128 + 4); } }
            asm volatile("" ::: "memory");
#pragma unroll
            for (int m = 0; m < 4; ++m) { const size_t r = (size_t)(row0 + ai * 128 + m * 16); bf16* o = X1 + r * D + col0; float ss = 0.f;
#pragma unroll
                for (int bj = 0; bj < 2; ++bj) { const pg8::f32x4 v0 = acc[ai][bj][m][0] + xr[m][bj][0], v1 = acc[ai][bj][m][1] + xr[m][bj][1];
                    ss += (v0[0] * v0[0] + v0[1] * v0[1]) + (v0[2] * v0[2] + v0[3] * v0[3]) + (v1[0] * v1[0] + v1[1] * v1[1]) + (v1[2] * v1[2] + v1[3] * v1[3]);
                    v4u w; w.x = pg8::cvt_pk_bf16(v0[0], v0[1]); w.y = pg8::cvt_pk_bf16(v0[2], v0[3]); w.z = pg8::cvt_pk_bf16(v1[0], v1[1]); w.w = pg8::cvt_pk_bf16(v1[2], v1[3]);
                    *(v4u*)(o + bj * 128) = w; }
                ss += xor16f(ss); ss += xor32f(ss);
                if (fq == 0) SSQ[r * 16 + u.pn * 4 + wc] = ss; }
            asm volatile("" ::: "memory");
        }
        return false;
    }
};
struct EpiScore {
    static constexpr bool PERM = true;
    const float* SXR; const float* SBP; _Float16* S;
    __device__ __forceinline__ bool operator()(AccRef acc, const pg8::Unit& u, int wr, int wc, int fr, int fq) const {
        if (PROBE_SKIP_EPI && u.dup) return false;
        const int row0 = u.pm * 256 + wr * 64 + fr, col0 = u.pn * 256 + wc * 32 + 8 * fq;
        pg8::f32x4 sb[2][2]; float rs[2][4];
#pragma unroll
        for (int bj = 0; bj < 2; ++bj) { sb[bj][0] = *(const pg8::f32x4*)(SBP + col0 + bj * 128); sb[bj][1] = *(const pg8::f32x4*)(SBP + col0 + bj * 128 + 4); }
#pragma unroll
        for (int ai = 0; ai < 2; ++ai)
#pragma unroll
            for (int m = 0; m < 4; ++m) rs[ai][m] = SXR[row0 + ai * 128 + m * 16];
        asm volatile("" ::: "memory");
#pragma unroll
        for (int ai = 0; ai < 2; ++ai)
#pragma unroll
            for (int m = 0; m < 4; ++m) { const size_t r = (size_t)(row0 + ai * 128 + m * 16);
                const float rstd = rs[ai][m];
                _Float16* o = S + r * NSC + col0;
#pragma unroll
                for (int bj = 0; bj < 2; ++bj) { const pg8::i32x4 i0 = __builtin_bit_cast(pg8::i32x4, acc[ai][bj][m][0]), i1 = __builtin_bit_cast(pg8::i32x4, acc[ai][bj][m][1]);
                    pg8::f32x4 v0 = {(float)i0[0], (float)i0[1], (float)i0[2], (float)i0[3]}, v1 = {(float)i1[0], (float)i1[1], (float)i1[2], (float)i1[3]};
                    v0 = v0 * sb[bj][0] * rstd; v1 = v1 * sb[bj][1] * rstd;
                    typedef _Float16 h2 __attribute__((ext_vector_type(2)));
                    h2 p0 = {(_Float16)v0[0], (_Float16)v0[1]}, p1 = {(_Float16)v0[2], (_Float16)v0[3]}, p2 = {(_Float16)v1[0], (_Float16)v1[1]}, p3 = {(_Float16)v1[2], (_Float16)v1[3]};
                    v4u w; w.x = __builtin_bit_cast(unsigned, p0); w.y = __builtin_bit_cast(unsigned, p1); w.z = __builtin_bit_cast(unsigned, p2); w.w = __builtin_bit_cast(unsigned, p3);
                    *(v4u*)(o + bj * 128) = w; } }
        return false;
    }
};

__device__ __forceinline__ void unpack8q(v2u w, float sc, float (&f)[8]) {
    const float bias = -128.f * sc;
    f[0] = fmaf(ubf(w.x, 0), sc, bias); f[1] = fmaf(ubf(w.x, 1), sc, bias); f[2] = fmaf(ubf(w.x, 2), sc, bias); f[3] = fmaf(ubf(w.x, 3), sc, bias);
    f[4] = fmaf(ubf(w.y, 0), sc, bias); f[5] = fmaf(ubf(w.y, 1), sc, bias); f[6] = fmaf(ubf(w.y, 2), sc, bias); f[7] = fmaf(ubf(w.y, 3), sc, bias);
}
__device__ __forceinline__ void p2_timemix(const unsigned char* Z8, const float* ZS, const float* convw, unsigned char* PA, unsigned char* CA, float* SPC, int gw, int NGW, int lane) {
    const int w = 2 << (lane >> 4);
    const int ch = 8 * lane;
    const int sg = lane >> 2;
    float cw0[8], cw1[8], cw2[8];
#pragma unroll
    for (int i = 0; i < 8; ++i) { cw0[i] = convw[ch + i]; cw1[i] = convw[512 + ch + i]; cw2[i] = convw[1024 + ch + i]; }
    for (int chunk = gw; chunk < M / 32; chunk += NGW) {
        const int t0 = chunk * 32, s0 = t0 & (SEQ - 1);
        float sum[8], up1[8], up2[8];
#pragma unroll
        for (int i = 0; i < 8; ++i) { sum[i] = 0.f; up1[i] = 0.f; up2[i] = 0.f; }
        if (s0 > 0) {
            for (int j = 1; j < 16; ++j) {
                if (j < w) { float f[8]; unpack8q(*(const v2u*)(Z8 + (size_t)(t0 - j) * 2048 + ch), ZS[(size_t)(t0 - j) * 64 + sg], f);
#pragma unroll
                    for (int i = 0; i < 8; ++i) sum[i] += f[i]; }
            }
            float c[8], v[8];
            unpack8q(*(const v2u*)(Z8 + (size_t)(t0 - 2) * 2048 + 512 + ch), ZS[(size_t)(t0 - 2) * 64 + 16 + sg], c); unpack8q(*(const v2u*)(Z8 + (size_t)(t0 - 2) * 2048 + 1536 + ch), ZS[(size_t)(t0 - 2) * 64 + 48 + sg], v);
#pragma unroll
            for (int i = 0; i < 8; ++i) up2[i] = c[i] * v[i];
            unpack8q(*(const v2u*)(Z8 + (size_t)(t0 - 1) * 2048 + 512 + ch), ZS[(size_t)(t0 - 1) * 64 + 16 + sg], c); unpack8q(*(const v2u*)(Z8 + (size_t)(t0 - 1) * 2048 + 1536 + ch), ZS[(size_t)(t0 - 1) * 64 + 48 + sg], v);
#pragma unroll
            for (int i = 0; i < 8; ++i) up1[i] = c[i] * v[i];
        }
        v2u nz, nc, nb, nv, nold; float qz, qc, qb, qv, qold;
#define P2_LOAD(tt, ss) { const unsigned char* zr = Z8 + (size_t)(tt) * 2048 + ch; const float* sr = ZS + (size_t)(tt) * 64 + sg; \
          nz = *(const v2u*)zr; nc = *(const v2u*)(zr + 512); nb = *(const v2u*)(zr + 1024); nv = *(const v2u*)(zr + 1536); qz = sr[0]; qc = sr[16]; qb = sr[32]; qv = sr[48]; \
          const int to = ((ss) + 1 - w >= 0) ? ((tt) + 1 - w) : (tt); nold = *(const v2u*)(Z8 + (size_t)to * 2048 + ch); qold = ZS[(size_t)to * 64 + sg]; }
        P2_LOAD(t0, s0)
        float po[8], poc[8], pmx = 0.f; int pt = t0;
#pragma unroll
        for (int i = 0; i < 8; ++i) { po[i] = 0.f; poc[i] = 0.f; }
#define QP(x) __builtin_bit_cast(unsigned, fmaf((x), iq, 12582912.f))
#define PK4(a_, b_, c_, d_) (__builtin_amdgcn_perm(QP(b_), QP(a_), 0x0c0c0400u) | (__builtin_amdgcn_perm(QP(d_), QP(c_), 0x0c0c0400u) << 16))
#define P2_FLUSH() { const float mxw = wave_max(pmx); const float scq = mxw > 0.f ? mxw * (1.f / 127.f) : 1.f, iq = __builtin_amdgcn_rcpf(scq) * 0.99999f; \
            *(v2u*)(PA + (size_t)pt * DP + ch) = (v2u){PK4(po[0], po[1], po[2], po[3]), PK4(po[4], po[5], po[6], po[7])}; \
            *(v2u*)(CA + (size_t)pt * DP + ch) = (v2u){PK4(poc[0], poc[1], poc[2], poc[3]), PK4(poc[4], poc[5], poc[6], poc[7])}; \
            if (lane == 0) SPC[pt] = scq; }
        for (int i2 = 0; i2 < 32; ++i2) {
            const int t = t0 + i2, s = s0 + i2;
            float zt[8], c[8], b[8], v[8], o[8], fo[8];
            unpack8q(nz, qz, zt); unpack8q(nc, qc, c); unpack8q(nb, qb, b); unpack8q(nv, qv, v); unpack8q(nold, qold, fo);
            { const int d1 = (i2 < 31) ? 1 : 0; P2_LOAD(t + d1, s + d1) }
            P2_FLUSH()
            const int cnt = (s + 1) < w ? (s + 1) : w; const float rc = 1.f / (float)cnt;
#pragma unroll
            for (int i = 0; i < 8; ++i) { sum[i] += zt[i]; o[i] = sum[i] * rc - zt[i]; }
            if (s + 1 - w >= 0) {
#pragma unroll
                for (int i = 0; i < 8; ++i) sum[i] -= fo[i]; }
            float oc[8];
#pragma unroll
            for (int i = 0; i < 8; ++i) { const float uu = c[i] * v[i]; oc[i] = b[i] * (cw0[i] * up2[i] + cw1[i] * up1[i] + cw2[i] * uu); up2[i] = up1[i]; up1[i] = uu; }
            float mx = 0.f;
#pragma unroll
            for (int i = 0; i < 8; ++i) { mx = fmaxf(mx, fmaxf(fabsf(o[i]), fabsf(oc[i]))); po[i] = o[i]; poc[i] = oc[i]; }
            pmx = mx; pt = t;
        }
        P2_FLUSH()
#undef P2_FLUSH
#undef PK4
#undef QP
#undef P2_LOAD
    }
}

#define TK_NEG (-3.0e38f)
__device__ __forceinline__ void tk_ce(float& a, float& b) { const float hi = fmaxf(a, b), lo = fminf(a, b); a = hi; b = lo; }
__device__ __forceinline__ void tk_sort8(float (&v)[8]) {
    tk_ce(v[0], v[1]); tk_ce(v[2], v[3]); tk_ce(v[4], v[5]); tk_ce(v[6], v[7]);
    tk_ce(v[0], v[2]); tk_ce(v[1], v[3]); tk_ce(v[4], v[6]); tk_ce(v[5], v[7]);
    tk_ce(v[1], v[2]); tk_ce(v[5], v[6]);
    tk_ce(v[0], v[4]); tk_ce(v[1], v[5]); tk_ce(v[2], v[6]); tk_ce(v[3], v[7]);
    tk_ce(v[2], v[4]); tk_ce(v[3], v[5]);
    tk_ce(v[1], v[2]); tk_ce(v[3], v[4]); tk_ce(v[5], v[6]);
}
__device__ __forceinline__ void tk_bmerge16(float (&x)[16]) {
#pragma unroll
    for (int i = 0; i < 8; ++i) tk_ce(x[i], x[i + 8]);
#pragma unroll
    for (int b = 0; b < 16; b += 8)
#pragma unroll
        for (int i = 0; i < 4; ++i) tk_ce(x[b + i], x[b + i + 4]);
#pragma unroll
    for (int b = 0; b < 16; b += 4)
#pragma unroll
        for (int i = 0; i < 2; ++i) tk_ce(x[b + i], x[b + i + 2]);
#pragma unroll
    for (int b = 0; b < 16; b += 2) tk_ce(x[b], x[b + 1]);
}
__device__ __forceinline__ void tk_add16(float (&L)[16], float (&a)[8], float (&b)[8]) {
    tk_sort8(a); tk_sort8(b);
    float s[16];
#pragma unroll
    for (int i = 0; i < 8; ++i) { s[i] = a[i]; s[8 + i] = b[7 - i]; }
    tk_bmerge16(s);
#pragma unroll
    for (int i = 0; i < 16; ++i) L[i] = fmaxf(L[i], s[15 - i]);
    tk_bmerge16(L);
}
__device__ __forceinline__ void tk_final(const float (&A)[16], const float (&B)[16], float (&FV)[16]) {
    float av[16], bv[16];
#pragma unroll
    for (int i = 0; i < 16; ++i) { av[i] = __builtin_bit_cast(float, __builtin_bit_cast(unsigned, A[i]) & ~0x7fu); bv[i] = __builtin_bit_cast(float, __builtin_bit_cast(unsigned, B[i]) & ~0x7fu); }
#pragma unroll
    for (int j = 0; j < 16; ++j) FV[j] = __builtin_bit_cast(float, (__builtin_bit_cast(unsigned, av[0] + bv[j]) & ~0xffu) | (unsigned)j);
#pragma unroll
    for (int i = 1; i < 16; ++i)
#pragma unroll
        for (int j = 0; j < 16; ++j)
            if ((i + 1) * (j + 1) <= 16) {
                float x = __builtin_bit_cast(float, (__builtin_bit_cast(unsigned, av[i] + bv[j]) & ~0xffu) | (unsigned)(i * 16 + j));
#pragma unroll
                for (int s = (i + 1) * (j + 1) - 1; s < 16; ++s) { const float hi = fmaxf(FV[s], x); x = fminf(FV[s], x); FV[s] = hi; }
            }
}

__device__ __forceinline__ void tk_unpack_octets(const v4u d0, const v4u d1, unsigned kb0, float (&a)[8], float (&b)[8]) {
    const unsigned w0[4] = {d0.x, d0.y, d0.z, d0.w}, w1[4] = {d1.x, d1.y, d1.z, d1.w};
#pragma unroll
    for (int e = 0; e < 8; ++e) {
        const unsigned ha = (e & 1) ? (w0[e >> 1] >> 16) : (w0[e >> 1] & 0xffffu), hb = (e & 1) ? (w1[e >> 1] >> 16) : (w1[e >> 1] & 0xffffu);
        const float fa = (float)__builtin_bit_cast(_Float16, (unsigned short)ha), fb = (float)__builtin_bit_cast(_Float16, (unsigned short)hb);
        a[e] = __builtin_bit_cast(float, __builtin_bit_cast(unsigned, fa) | (kb0 - (unsigned)e));
        b[e] = __builtin_bit_cast(float, __builtin_bit_cast(unsigned, fb) | (kb0 - 8u - (unsigned)e));
    }
}
__device__ __forceinline__ void tk_emit(const float (&LA)[16], const float (&LB)[16], LAS unsigned char* kl, size_t r, unsigned short* IDX, float* EV, float* INV) {
    float FV[16];
    tk_final(LA, LB, FV);
#pragma unroll
    for (int q = 0; q < 4; ++q) { unsigned wa = 0, wb = 0;
#pragma unroll
        for (int e = 0; e < 4; ++e) { wa |= (127u - (__builtin_bit_cast(unsigned, LA[4 * q + e]) & 0x7fu)) << (8 * e); wb |= (127u - (__builtin_bit_cast(unsigned, LB[4 * q + e]) & 0x7fu)) << (8 * e); }
        *(LAS unsigned*)(kl + 4 * q) = wa; *(LAS unsigned*)(kl + 16 + 4 * q) = wb; }
    asm volatile("s_waitcnt lgkmcnt(0)" ::: "memory");
    int FI[16]; float ev[16]; float sum = 0.f;
    const float top = __builtin_bit_cast(float, __builtin_bit_cast(unsigned, FV[0]) & ~0xffu);
#pragma unroll
    for (int s = 0; s < 16; ++s) { const unsigned u = __builtin_bit_cast(unsigned, FV[s]); const unsigned ci = (u >> 4) & 15u, cj = u & 15u;
        const unsigned ka = *(const LAS unsigned char*)(kl + ci), kb = *(const LAS unsigned char*)(kl + 16 + cj);
        FI[s] = (int)(ka * 128u + kb);
        ev[s] = __expf(__builtin_bit_cast(float, u & ~0xffu) - top); sum += ev[s]; }
    v4u i0, i1;
    i0.x = (unsigned)FI[0] | ((unsigned)FI[1] << 16); i0.y = (unsigned)FI[2] | ((unsigned)FI[3] << 16); i0.z = (unsigned)FI[4] | ((unsigned)FI[5] << 16); i0.w = (unsigned)FI[6] | ((unsigned)FI[7] << 16);
    i1.x = (unsigned)FI[8] | ((unsigned)FI[9] << 16); i1.y = (unsigned)FI[10] | ((unsigned)FI[11] << 16); i1.z = (unsigned)FI[12] | ((unsigned)FI[13] << 16); i1.w = (unsigned)FI[14] | ((unsigned)FI[15] << 16);
    *(v4u*)(IDX + r * 16) = i0; *(v4u*)(IDX + r * 16 + 8) = i1;
#pragma unroll
    for (int q = 0; q < 4; ++q) *(f32x4*)(EV + r * 16 + 4 * q) = (f32x4){ev[4 * q], ev[4 * q + 1], ev[4 * q + 2], ev[4 * q + 3]};
    INV[r] = 1.f / sum;
}
__device__ __forceinline__ void p6_topk(const _Float16* S, unsigned short* IDX, float* EV, float* INV, LAS unsigned char* lds, int gw, int NGW, int wave, int lane) {
    LAS unsigned char* my = lds + wave * 10240;
    const int srow = lane >> 2, schn = lane & 3;
    v4u nx[8];
    { const char* b0 = (const char*)S + (size_t)GRP_QREV(gw) * 128 * 512;
#pragma unroll
      for (int q = 0; q < 8; ++q) nx[q] = *(const v4u*)(b0 + (size_t)(16 * q + srow) * 512 + 16 * schn); }
    for (int lg = gw; lg < M * NH / 128; lg += NGW) {
        const int grp = GRP_QREV(lg);
        const char* base = (const char*)S + (size_t)grp * 128 * 512;
        const char* nbase = (const char*)S + (size_t)GRP_QREV((lg + NGW) < M * NH / 128 ? (lg + NGW) : lg) * 128 * 512;
        float LA0[16], LB0[16], LA1[16], LB1[16];
#pragma unroll
        for (int half = 0; half < 2; ++half) {
            float L0[16], L1[16];
#pragma unroll
            for (int i = 0; i < 16; ++i) { L0[i] = TK_NEG; L1[i] = TK_NEG; }
#pragma unroll 1
            for (int step = 0; step < 4; ++step) {
                const int j = half * 4 + step;
#pragma unroll
                for (int q = 0; q < 8; ++q) *(LAS v4u*)(my + (16 * q + srow) * 80 + 16 * schn) = nx[q];
                asm volatile("s_waitcnt lgkmcnt(0)" ::: "memory");
                { const char* pb = (j < 7) ? base + 64 * (j + 1) : nbase;
#pragma unroll
                  for (int q = 0; q < 8; ++q) nx[q] = *(const v4u*)(pb + (size_t)(16 * q + srow) * 512 + 16 * schn); }
                const LAS unsigned char* r0p = my + lane * 80; const LAS unsigned char* r1p = my + (lane + 64) * 80;
                const v4u a0 = *(const LAS v4u*)(r0p), a1 = *(const LAS v4u*)(r0p + 16), a2 = *(const LAS v4u*)(r0p + 32), a3 = *(const LAS v4u*)(r0p + 48);
                const v4u c0 = *(const LAS v4u*)(r1p), c1 = *(const LAS v4u*)(r1p + 16), c2 = *(const LAS v4u*)(r1p + 32), c3 = *(const LAS v4u*)(r1p + 48);
                const unsigned kb0 = (unsigned)(127 - step * 32);
                float pa[8], pb2[8], qa[8], qb[8];
                tk_unpack_octets(a0, a1, kb0, pa, pb2); tk_unpack_octets(c0, c1, kb0, qa, qb);
                tk_add16(L0, pa, pb2); tk_add16(L1, qa, qb);
                tk_unpack_octets(a2, a3, kb0 - 16u, pa, pb2); tk_unpack_octets(c2, c3, kb0 - 16u, qa, qb);
                tk_add16(L0, pa, pb2); tk_add16(L1, qa, qb);
                asm volatile("s_waitcnt lgkmcnt(0)" ::: "memory");
            }
#pragma unroll
            for (int i = 0; i < 16; ++i) { if (half == 0) { LA0[i] = L0[i]; LA1[i] = L1[i]; } else { LB0[i] = L0[i]; LB1[i] = L1[i]; } }
        }
        tk_emit(LA0, LB0, my + lane * 80, (size_t)grp * 128 + lane, IDX, EV, INV);
        tk_emit(LA1, LB1, my + (lane + 64) * 80, (size_t)grp * 128 + 64 + lane, IDX, EV, INV);
        asm volatile("s_waitcnt lgkmcnt(0)" ::: "memory");
    }
}

typedef float v2f __attribute__((ext_vector_type(2)));
__device__ __forceinline__ int q_pull(unsigned* heads, int s, int lane) { int it = 0; if (lane == 0) it = (int)__hip_atomic_fetch_add(heads + 64 * s, 1u, __ATOMIC_RELAXED, __HIP_MEMORY_SCOPE_AGENT); return __builtin_amdgcn_readfirstlane(it); }

struct UIdx { v4u ia, ib; };
struct UBuf { v4u ur[16]; v4u xa, xb; };
__device__ __forceinline__ void u_idx(UIdx& p, int t, const unsigned short* IDX, int lane) { const unsigned short* ip = IDX + (size_t)t * 128 + (lane >> 3) * 16; p.ia = *(const v4u*)ip; p.ib = *(const v4u*)(ip + 8); }
__device__ __forceinline__ void u_gather(UBuf& b, const UIdx& p, int s, int t, const bf16* X1, const unsigned char* U8, int lane) {
    const int c = lane & 7;
    const unsigned iw[8] = {p.ia.x, p.ia.y, p.ia.z, p.ia.w, p.ib.x, p.ib.y, p.ib.z, p.ib.w};
    const unsigned char* ub = U8 + (size_t)s * NE * 128 + 16 * c;
#pragma unroll
    for (int i = 0; i < 16; ++i) { const unsigned e = (i & 1) ? (iw[i >> 1] >> 16) : (iw[i >> 1] & 0xffffu); b.ur[i] = *(const v4u*)(ub + (size_t)e * 128); }
    const bf16* xp = X1 + (size_t)t * D + 128 * s + 16 * c;
    b.xa = *(const v4u*)xp; b.xb = *(const v4u*)(xp + 8);
}
__device__ __forceinline__ void u_compute(const UBuf& bf, int s, int t, float* PART, int lane) {
    float xv[16];
    { float f[8]; unpack8(bf.xa, f);
#pragma unroll
      for (int i = 0; i < 8; ++i) xv[i] = f[i];
      unpack8(bf.xb, f);
#pragma unroll
      for (int i = 0; i < 8; ++i) xv[8 + i] = f[i]; }
    float mx = 0.f;
#pragma unroll
    for (int i = 0; i < 16; ++i) mx = fmaxf(mx, fabsf(xv[i]));
    mx = fmaxf(mx, __shfl_xor(mx, 1)); mx = fmaxf(mx, __shfl_xor(mx, 2)); mx = fmaxf(mx, __shfl_xor(mx, 4));
    const float sx = mx > 0.f ? mx * (1.f / 127.f) : 1.f, isx = 1.f / sx;
    int xq[4];
#pragma unroll
    for (int j = 0; j < 4; ++j) { unsigned a = 0;
#pragma unroll
        for (int b = 0; b < 4; ++b) { int q = (int)rintf(xv[4 * j + b] * isx); q = q > 127 ? 127 : (q < -127 ? -127 : q); a |= ((unsigned)q & 0xffu) << (8 * b); }
        xq[j] = (int)a; }
    int p[16];
#pragma unroll
    for (int i = 0; i < 16; ++i) { int a = __builtin_amdgcn_sdot4((int)bf.ur[i].x, xq[0], 0, false); a = __builtin_amdgcn_sdot4((int)bf.ur[i].y, xq[1], a, false);
        a = __builtin_amdgcn_sdot4((int)bf.ur[i].z, xq[2], a, false); a = __builtin_amdgcn_sdot4((int)bf.ur[i].w, xq[3], a, false); p[i] = a; }
    int r8[8], r4[4], r2[2];
    const bool b2 = lane & 4, b1 = lane & 2, b0 = lane & 1;
#pragma unroll
    for (int i = 0; i < 8; ++i) { const int snd = b2 ? p[i] : p[i + 8], kp = b2 ? p[i + 8] : p[i]; r8[i] = kp + __shfl_xor(snd, 4); }
#pragma unroll
    for (int i = 0; i < 4; ++i) { const int snd = b1 ? r8[i] : r8[i + 4], kp = b1 ? r8[i + 4] : r8[i]; r4[i] = kp + __shfl_xor(snd, 2); }
#pragma unroll
    for (int i = 0; i < 2; ++i) { const int snd = b0 ? r4[i] : r4[i + 2], kp = b0 ? r4[i + 2] : r4[i]; r2[i] = kp + __shfl_xor(snd, 1); }
    *(v2f*)(PART + ((size_t)s * M + t) * 128 + 2 * lane) = (v2f){(float)r2[0] * sx, (float)r2[1] * sx};
}
__device__ __forceinline__ void u_finish(const int (&p)[16], float sx, int s, int t, unsigned* PART, int lane) {
    int r8[8], r4[4], r2[2];
    const bool b2 = lane & 4, b1 = lane & 2, b0 = lane & 1;
#pragma unroll
    for (int i = 0; i < 8; ++i) { const int snd = b2 ? p[i] : p[i + 8], kp = b2 ? p[i + 8] : p[i]; r8[i] = kp + xor4i(snd); }
#pragma unroll
    for (int i = 0; i < 4; ++i) { const int snd = b1 ? r8[i] : r8[i + 4], kp = b1 ? r8[i + 4] : r8[i]; r4[i] = kp + xor2i(snd); }
#pragma unroll
    for (int i = 0; i < 2; ++i) { const int snd = b0 ? r4[i] : r4[i + 2], kp = b0 ? r4[i + 2] : r4[i]; r2[i] = kp + xor1i(snd); }
    typedef _Float16 h2 __attribute__((ext_vector_type(2)));
    const h2 pr = {(_Float16)((float)r2[0] * sx), (_Float16)((float)r2[1] * sx)};
    PART[((size_t)s * M + t) * 64 + lane] = __builtin_bit_cast(unsigned, pr);
}
#define IDX_E(iw, i) (((i) & 1) ? ((iw)[(i) >> 1] >> 16) : ((iw)[(i) >> 1] & 0xffffu))
struct QStream { unsigned* heads; int ps, tried; int cs, ct0, ns, nt0, pos; };
__device__ __forceinline__ bool qs_pull(QStream& q, int& os, int& ot0, int lane) {
    for (;;) { const int it = q_pull(q.heads, q.ps, lane); if (it < M / TPI) { os = q.ps; ot0 = it * TPI; return true; } if (++q.tried >= 8) return false; q.ps = (q.ps + 1) & 7; }
}
__device__ __forceinline__ bool qs_init(QStream& q, unsigned* heads, unsigned xcc, int lane) {
    q.heads = heads; q.ps = (int)(xcc & 7u); q.tried = 0; q.pos = 0; q.ns = 0; q.nt0 = -1;
    if (!qs_pull(q, q.cs, q.ct0, lane)) return false;
    if (!qs_pull(q, q.ns, q.nt0, lane)) q.nt0 = -1;
    return true;
}
__device__ __forceinline__ void qs_peek(const QStream& q, int k, int& s, int& t) {
    int p = q.pos + k;
    if (p < TPI) { s = q.cs; t = q.ct0 + p; }
    else if (q.nt0 >= 0) { s = q.ns; t = q.nt0 + (p - TPI); }
    else { s = q.cs; t = q.ct0 + TPI - 1; }
}
__device__ __forceinline__ bool qs_advance2(QStream& q, int lane) {
    q.pos += 2;
    if (q.pos >= TPI) { if (q.nt0 < 0) return false; q.pos = 0; q.cs = q.ns; q.ct0 = q.nt0; if (!qs_pull(q, q.ns, q.nt0, lane)) q.nt0 = -1; }
    return true;
}
__device__ __forceinline__ void p7_u_phase(unsigned* heads, unsigned xcc, const unsigned char* X1q, const float* SX, const unsigned short* IDX, const unsigned char* U8, unsigned* PART, int lane) {
    const int c = lane & 7;
    QStream q;
    if (!qs_init(q, heads, xcc, lane)) return;
    const unsigned char* ub0 = U8; const unsigned c16 = 16u * (unsigned)c; const unsigned char* xb0 = X1q + 16 * c;
    v4u ring[32]; v4u xA, xB; float sA, sB; UIdx iN, iM;
    { int s0, t0, s1, t1; qs_peek(q, 0, s0, t0); qs_peek(q, 1, s1, t1);
      UIdx iA, iB; u_idx(iA, t0, IDX, lane); u_idx(iB, t1, IDX, lane);
      const unsigned wa[8] = {iA.ia.x, iA.ia.y, iA.ia.z, iA.ia.w, iA.ib.x, iA.ib.y, iA.ib.z, iA.ib.w}, wb[8] = {iB.ia.x, iB.ia.y, iB.ia.z, iB.ia.w, iB.ib.x, iB.ib.y, iB.ib.z, iB.ib.w};
      const unsigned char* ua = ub0 + (size_t)s0 * NE * 128; const unsigned char* ubb = ub0 + (size_t)s1 * NE * 128;
#pragma unroll
      for (int r = 0; r < 16; ++r) ring[r] = *(const v4u*)(ua + (IDX_E(wa, r) * 128u + c16));
      xA = *(const v4u*)(xb0 + (size_t)t0 * D + 128 * s0); sA = SX[t0];
#pragma unroll
      for (int r = 0; r < 16; ++r) ring[16 + r] = *(const v4u*)(ubb + (IDX_E(wb, r) * 128u + c16));
      xB = *(const v4u*)(xb0 + (size_t)t1 * D + 128 * s1); sB = SX[t1];
      int s2, t2, s3, t3; qs_peek(q, 2, s2, t2); qs_peek(q, 3, s3, t3);
      u_idx(iN, t2, IDX, lane); u_idx(iM, t3, IDX, lane); }
#pragma unroll 1
    for (;;) {
        int s0, t0, s1, t1, s2, t2, s3, t3, s4, t4, s5, t5;
        qs_peek(q, 0, s0, t0); qs_peek(q, 1, s1, t1); qs_peek(q, 2, s2, t2); qs_peek(q, 3, s3, t3); qs_peek(q, 4, s4, t4); qs_peek(q, 5, s5, t5);
        int p[16];
        {
            const int x0 = (int)xA.x, x1 = (int)xA.y, x2 = (int)xA.z, x3 = (int)xA.w; const float sx = sA;
            const unsigned wn[8] = {iN.ia.x, iN.ia.y, iN.ia.z, iN.ia.w, iN.ib.x, iN.ib.y, iN.ib.z, iN.ib.w};
            const unsigned char* un = ub0 + (size_t)s2 * NE * 128;
#pragma unroll
            for (int r = 0; r < 16; ++r) { int a = __builtin_amdgcn_sdot4((int)ring[r].x, x0, 0, false); a = __builtin_amdgcn_sdot4((int)ring[r].y, x1, a, false);
                a = __builtin_amdgcn_sdot4((int)ring[r].z, x2, a, false); a = __builtin_amdgcn_sdot4((int)ring[r].w, x3, a, false); p[r] = a;
                ring[r] = *(const v4u*)(un + (IDX_E(wn, r) * 128u + c16)); }
            xA = *(const v4u*)(xb0 + (size_t)t2 * D + 128 * s2); sA = SX[t2];
            u_idx(iN, t4, IDX, lane);
            u_finish(p, sx, s0, t0, PART, lane);
        }
        {
            const int x0 = (int)xB.x, x1 = (int)xB.y, x2 = (int)xB.z, x3 = (int)xB.w; const float sx = sB;
            const unsigned wn[8] = {iM.ia.x, iM.ia.y, iM.ia.z, iM.ia.w, iM.ib.x, iM.ib.y, iM.ib.z, iM.ib.w};
            const unsigned char* un = ub0 + (size_t)s3 * NE * 128;
#pragma unroll
            for (int r = 0; r < 16; ++r) { int a = __builtin_amdgcn_sdot4((int)ring[16 + r].x, x0, 0, false); a = __builtin_amdgcn_sdot4((int)ring[16 + r].y, x1, a, false);
                a = __builtin_amdgcn_sdot4((int)ring[16 + r].z, x2, a, false); a = __builtin_amdgcn_sdot4((int)ring[16 + r].w, x3, a, false); p[r] = a;
                ring[16 + r] = *(const v4u*)(un + (IDX_E(wn, r) * 128u + c16)); }
            xB = *(const v4u*)(xb0 + (size_t)t3 * D + 128 * s3); sB = SX[t3];
            u_idx(iM, t5, IDX, lane);
            u_finish(p, sx, s1, t1, PART, lane);
        }
        if (!qs_advance2(q, lane)) break;
    }
}
__device__ __forceinline__ void p8_w_phase(const unsigned* PART, const float* RSTD, const unsigned short* IDX, const float* EV, const float* INV, const float* SU, const float* SV, unsigned short* WQ, float* SWH, int gw, int NGW, int lane) {
    typedef _Float16 h2 __attribute__((ext_vector_type(2)));
    for (int tb = gw; tb < M; tb += 4 * NGW) {
        unsigned pp[4][8], ip[4]; v2f evp[4]; float iv[4], rs[4];
#pragma unroll
        for (int q = 0; q < 4; ++q) { const int t = ROW_REV(tb + q * NGW);
#pragma unroll
            for (int x = 0; x < 8; ++x) pp[q][x] = PART[((size_t)x * M + t) * 64 + lane];
            ip[q] = *(const unsigned*)(IDX + (size_t)t * 128 + 2 * lane); evp[q] = *(const v2f*)(EV + (size_t)t * 128 + 2 * lane); iv[q] = INV[(size_t)t * NH + (lane >> 3)]; rs[q] = RSTD[t]; }
        float su0[4], su1[4], sv0[4], sv1[4];
#pragma unroll
        for (int q = 0; q < 4; ++q) { const int e0 = (int)(ip[q] & 0xffffu), e1 = (int)(ip[q] >> 16); su0[q] = SU[e0]; su1[q] = SU[e1]; sv0[q] = SV[e0]; sv1[q] = SV[e1]; }
#pragma unroll
        for (int q = 0; q < 4; ++q) { const int t = ROW_REV(tb + q * NGW);
            float a0 = 0.f, a1 = 0.f;
#pragma unroll
            for (int x = 0; x < 8; ++x) { const h2 v = __builtin_bit_cast(h2, pp[q][x]); a0 += (float)v[0]; a1 += (float)v[1]; }
            const float act0 = a0 * su0[q] * rs[q], act1 = a1 * su1[q] * rs[q];
            const float w0 = evp[q].x * iv[q] * (0.5f * act0 * (1.f + erff(act0 * 0.70710678118654752f))) * sv0[q];
            const float w1 = evp[q].y * iv[q] * (0.5f * act1 * (1.f + erff(act1 * 0.70710678118654752f))) * sv1[q];
            const float mx = wave_max(fmaxf(fabsf(w0), fabsf(w1)));
            const float sw = mx > 0.f ? mx * (1.f / 127.f) : 1.f, isw = 1.f / sw;
            int q0 = (int)rintf(w0 * isw), q1 = (int)rintf(w1 * isw); q0 = q0 > 127 ? 127 : (q0 < -127 ? -127 : q0); q1 = q1 > 127 ? 127 : (q1 < -127 ? -127 : q1);
            WQ[(size_t)t * 64 + lane] = (unsigned short)(((unsigned)q0 & 0xffu) | (((unsigned)q1 & 0xffu) << 8));
            if ((lane & 7) == 0) SWH[(size_t)t * NH + (lane >> 3)] = sw; }
    }
}
struct VBuf { v4u vr[16]; v4u w4; float sw; unsigned xw; };
__device__ __forceinline__ void v_gather(VBuf& b, const UIdx& p, int s, int t, const bf16* X1, const unsigned short* WQ, const float* SWH, const unsigned char* V8, int lane) {
    const int c = lane & 7, g = lane >> 3;
    const unsigned iw[8] = {p.ia.x, p.ia.y, p.ia.z, p.ia.w, p.ib.x, p.ib.y, p.ib.z, p.ib.w};
    const unsigned char* vb = V8 + (size_t)s * NE * 128; const unsigned c16 = 16u * (unsigned)c;
#pragma unroll
    for (int i = 0; i < 16; ++i) { const unsigned e = (i & 1) ? (iw[i >> 1] >> 16) : (iw[i >> 1] & 0xffffu); b.vr[i] = *(const v4u*)(vb + (e * 128u + c16)); }
    b.w4 = *(const v4u*)((const unsigned char*)WQ + (size_t)t * 128 + 16 * g); b.sw = SWH[(size_t)t * NH + g];
    b.xw = *(const unsigned*)(X1 + (size_t)t * D + 128 * s + 16 * (lane & 7) + 2 * (lane >> 3));
}
__device__ __forceinline__ void v_compute(VBuf& bf, int s, int t, bf16* out, float* SSQ2, int lane, const UIdx& nidx, int ns, int nt, const bf16* X1, const unsigned short* WQ, const float* SWH, const unsigned char* V8) {
    const int c = lane & 7, g = lane >> 3;
    const unsigned niw[8] = {nidx.ia.x, nidx.ia.y, nidx.ia.z, nidx.ia.w, nidx.ib.x, nidx.ib.y, nidx.ib.z, nidx.ib.w};
    const unsigned char* nvb = V8 + (size_t)ns * NE * 128; const unsigned c16 = 16u * (unsigned)c;
    int ai[16];
#pragma unroll
    for (int j = 0; j < 16; ++j) ai[j] = 0;
#pragma unroll
    for (int rg = 0; rg < 4; ++rg) { const int w4 = (int)bf.w4[rg];
#pragma unroll
        for (int j = 0; j < 4; ++j) { const unsigned r0 = bf.vr[4 * rg][j], r1 = bf.vr[4 * rg + 1][j], r2q = bf.vr[4 * rg + 2][j], r3 = bf.vr[4 * rg + 3][j];
            const unsigned t0 = __builtin_amdgcn_perm(r1, r0, 0x05010400u), t1 = __builtin_amdgcn_perm(r1, r0, 0x07030602u), t2 = __builtin_amdgcn_perm(r3, r2q, 0x05010400u), t3 = __builtin_amdgcn_perm(r3, r2q, 0x07030602u);
            ai[4 * j + 0] = __builtin_amdgcn_sdot4((int)__builtin_amdgcn_perm(t2, t0, 0x05040100u), w4, ai[4 * j + 0], false);
            ai[4 * j + 1] = __builtin_amdgcn_sdot4((int)__builtin_amdgcn_perm(t2, t0, 0x07060302u), w4, ai[4 * j + 1], false);
            ai[4 * j + 2] = __builtin_amdgcn_sdot4((int)__builtin_amdgcn_perm(t3, t1, 0x05040100u), w4, ai[4 * j + 2], false);
            ai[4 * j + 3] = __builtin_amdgcn_sdot4((int)__builtin_amdgcn_perm(t3, t1, 0x07060302u), w4, ai[4 * j + 3], false); }
#pragma unroll
        for (int i = 0; i < 4; ++i) { const int r = 4 * rg + i; const unsigned e = (r & 1) ? (niw[r >> 1] >> 16) : (niw[r >> 1] & 0xffffu); bf.vr[r] = *(const v4u*)(nvb + (e * 128u + c16)); } }
    const float sw_cur = bf.sw;
    const unsigned xw_cur = bf.xw;
    bf.w4 = *(const v4u*)((const unsigned char*)WQ + (size_t)nt * 128 + 16 * g); bf.sw = SWH[(size_t)nt * NH + g];
    bf.xw = *(const unsigned*)(X1 + (size_t)nt * D + 128 * ns + 16 * (lane & 7) + 2 * (lane >> 3));
    int r8[8], r4[4], r2[2];
    const bool b3 = lane & 8;
#pragma unroll
    for (int i = 0; i < 8; ++i) r8[i] = swap32_addi(ai[i], ai[i + 8]);
#pragma unroll
    for (int i = 0; i < 4; ++i) r4[i] = swap16_addi(r8[i], r8[i + 4]);
#pragma unroll
    for (int i = 0; i < 2; ++i) { const int snd = b3 ? r4[i] : r4[i + 2], kp = b3 ? r4[i + 2] : r4[i]; r2[i] = kp + xor8i(snd); }
    const float p0 = (float)r2[0] * sw_cur, p1 = (float)r2[1] * sw_cur;
    const size_t col = (size_t)t * D + 128 * s + 16 * (lane & 7) + 2 * (lane >> 3);
    const float y0 = bflo(xw_cur) + p0, y1 = bfhi(xw_cur) + p1;
    const float ss = wave_sum(y0 * y0 + y1 * y1);
    *(unsigned*)(out + col) = pk2(y0, y1);
    if (lane == 0) SSQ2[(size_t)t * 8 + s] = ss;
}
__device__ __forceinline__ void p9_v_phase(unsigned* heads, unsigned xcc, const bf16* X1, const unsigned short* IDX, const unsigned short* WQ, const float* SWH, const unsigned char* V8, bf16* out, float* SSQ2, int lane) {
    QStream q;
    if (!qs_init(q, heads, xcc, lane)) return;
    UIdx iN, iM; VBuf ga, gb;
    { int s0, t0, s1, t1, s2, t2, s3, t3; qs_peek(q, 0, s0, t0); qs_peek(q, 1, s1, t1); qs_peek(q, 2, s2, t2); qs_peek(q, 3, s3, t3);
      UIdx ia, ib; u_idx(ia, t0, IDX, lane); u_idx(ib, t1, IDX, lane);
      v_gather(ga, ia, s0, t0, X1, WQ, SWH, V8, lane); v_gather(gb, ib, s1, t1, X1, WQ, SWH, V8, lane);
      u_idx(iN, t2, IDX, lane); u_idx(iM, t3, IDX, lane); }
#pragma unroll 1
    for (;;) {
        int s0, t0, s1, t1, s2, t2, s3, t3, s4, t4, s5, t5;
        qs_peek(q, 0, s0, t0); qs_peek(q, 1, s1, t1); qs_peek(q, 2, s2, t2); qs_peek(q, 3, s3, t3); qs_peek(q, 4, s4, t4); qs_peek(q, 5, s5, t5);
        v_compute(ga, s0, t0, out, SSQ2, lane, iN, s2, t2, X1, WQ, SWH, V8);
        u_idx(iN, t4, IDX, lane);
        v_compute(gb, s1, t1, out, SSQ2, lane, iM, s3, t3, X1, WQ, SWH, V8);
        u_idx(iM, t5, IDX, lane);
        if (!qs_advance2(q, lane)) break;
    }
}
__device__ __forceinline__ void p10_final(const bf16* X2, float* out, const float* SSQ2, const float* gfin, int gw, int NGW, int lane) {
    f32x4 gf[4];
#pragma unroll
    for (int j = 0; j < 4; ++j) gf[j] = ((const f32x4*)gfin)[lane + 64 * j];
    v2u nxa[4], nxb[4]; float nsa, nsb;
#pragma unroll
    for (int j = 0; j < 4; ++j) { nxa[j] = ((const v2u*)(X2 + (size_t)ROW_REV(gw) * D))[lane + 64 * j]; nxb[j] = ((const v2u*)(X2 + (size_t)ROW_REV(gw + NGW) * D))[lane + 64 * j]; }
    nsa = lane < 8 ? SSQ2[(size_t)ROW_REV(gw) * 8 + lane] : 0.f; nsb = lane < 8 ? SSQ2[(size_t)ROW_REV(gw + NGW) * 8 + lane] : 0.f;
    for (int t = gw; t < M; t += 2 * NGW) {
        const int t1 = t + NGW;
        v2u xa[4], xb[4];
#pragma unroll
        for (int j = 0; j < 4; ++j) { xa[j] = nxa[j]; xb[j] = nxb[j]; }
        const float sa = nsa, sb = nsb;
        { const int tn = (t + 2 * NGW) < M ? (t + 2 * NGW) : t, tn1 = tn + NGW;
#pragma unroll
          for (int j = 0; j < 4; ++j) { nxa[j] = ((const v2u*)(X2 + (size_t)ROW_REV(tn) * D))[lane + 64 * j]; nxb[j] = ((const v2u*)(X2 + (size_t)ROW_REV(tn1) * D))[lane + 64 * j]; }
          nsa = lane < 8 ? SSQ2[(size_t)ROW_REV(tn) * 8 + lane] : 0.f; nsb = lane < 8 ? SSQ2[(size_t)ROW_REV(tn1) * 8 + lane] : 0.f; }
        const float ra = rsqrtf(wave_sum(sa) * (1.f / D) + RMS_EPS), rb = rsqrtf(wave_sum(sb) * (1.f / D) + RMS_EPS);
        f32x4* oa = (f32x4*)(out + (size_t)ROW_REV(t) * D) + lane; f32x4* ob = (f32x4*)(out + (size_t)ROW_REV(t1) * D) + lane;
#pragma unroll
        for (int j = 0; j < 4; ++j) {
            oa[64 * j] = (f32x4){bflo(xa[j].x) * ra * gf[j].x, bfhi(xa[j].x) * ra * gf[j].y, bflo(xa[j].y) * ra * gf[j].z, bfhi(xa[j].y) * ra * gf[j].w};
            ob[64 * j] = (f32x4){bflo(xb[j].x) * rb * gf[j].x, bfhi(xb[j].x) * rb * gf[j].y, bflo(xb[j].y) * rb * gf[j].z, bfhi(xb[j].y) * rb * gf[j].w}; }
    }
}

struct Args { const float* in[15]; float* out; unsigned char* ws; int ph_lo, ph_hi, li, pad; };
__global__ void __launch_bounds__(NWAVES * 64, 2) fwd_kernel(Args args) {
    extern __shared__ __attribute__((aligned(16))) unsigned char lds_raw[];
    LAS unsigned char* lds = (LAS unsigned char*)lds_raw;
    volatile LAS unsigned* MISC = (volatile LAS unsigned*)(lds + MISC_OFF);
    const int tid = threadIdx.x, lane = tid & 63, wave = __builtin_amdgcn_readfirstlane(tid >> 6);
    const int G = gridDim.x; const int bx = blockIdx.x; const int vcu = (G % 8 == 0) ? (bx % 8) * (G / 8) + bx / 8 : bx;
    const int gw = vcu * NWAVES + wave, NGW = G * NWAVES;
    unsigned char* ws = args.ws;
    gu32* ctl = (gu32*)(ws + WS_CTL);
    const float* x = args.in[0]; const float* g_mix = args.in[1]; const float* w_in = args.in[2]; const float* pool_gw = args.in[3]; const float* pool_scale = args.in[4];
    const float* conv_w = args.in[5]; const float* w_bp = args.in[6]; const float* w_bc = args.in[7]; const float* w_out = args.in[8]; const float* g_ffn = args.in[9];
    const float* w_q = args.in[10]; const float* sub_keys = args.in[11]; const float* expert_u = args.in[12]; const float* expert_v = args.in[13]; const float* g_final = args.in[14];
    unsigned char* Wc8 = ws + WS_WC; unsigned char* Wbc8 = ws + WS_WBC; float* SBC = (float*)(ws + WS_SBC); float* SPC = (float*)(ws + WS_SPC); float* WcF = (float*)(ws + WS_WCF); unsigned* CMAXC = (unsigned*)(ctl + CW_CMAXC); bf16* Wout_t = (bf16*)(ws + WS_WOUT); unsigned char* Wpp8 = ws + WS_WPP; float* WppF = (float*)(ws + WS_WPPF); float* SBP = (float*)(ws + WS_SBP); float* SXR = (float*)(ws + WS_SXR); unsigned char* X1q = ws + WS_X1Q; unsigned* CMAXP = (unsigned*)(ctl + CW_CMAXP);
    float* SU = (float*)(ws + WS_SU); float* SV = (float*)(ws + WS_SV); float* SSQ = (float*)(ws + WS_SSQ);
    unsigned char* U8 = ws + WS_U8; unsigned char* V8 = ws + WS_V8; float* INV = (float*)(ws + WS_INV); float* SSQ2 = (float*)(ws + WS_SSQ2); unsigned* PART = (unsigned*)(ws + WS_PART); float* RSTD = (float*)(ws + WS_RSTD); unsigned short* WQ = (unsigned short*)(ws + WS_WV); float* SWH = (float*)(ws + WS_SWH);
    unsigned char* Hq = ws + WS_B; unsigned char* Winq = ws + WS_WIN; float* SA = (float*)(ws + WS_SA); float* SB = (float*)(ws + WS_SB); unsigned* CMAX = (unsigned*)(ctl + CW_CMAX); unsigned char* PA = ws + WS_B; unsigned char* CA = ws + WS_B + 64 * MiB; bf16* X1 = (bf16*)(ws + WS_B);
    bf16* Mb = (bf16*)(ws + WS_C); unsigned short* IDX = (unsigned short*)(ws + WS_C); float* EV = (float*)(ws + WS_C + 16 * MiB);
    unsigned char* Z8 = ws + WS_A; float* ZS = (float*)(ws + WS_A + 128 * MiB); unsigned char* G8 = ws + WS_A + 256 * MiB;
     _Float16* SC = (_Float16*)(ws + WS_A); bf16* X2 = (bf16*)(ws + WS_A);

    for (int u = tid; u < (LDS_BYTES - LDSCTL_OFF) / 4; u += NWAVES * 64) ((LAS unsigned*)(lds + LDSCTL_OFF))[u] = 0u;
    __syncthreads();
    XcdBarrier bar; bar.bar = (unsigned*)(ctl + CW_BAR); bar.x = 0; bar.st = nullptr;
    if (N_LAUNCHES != PER_PHASE) bar = xcd_barrier_post((unsigned*)(ctl + CW_BAR), MISC + 8);
#define GRID_BAR() do { if (N_LAUNCHES != PER_PHASE) xcd_barrier(bar); } while (0)
    const int lo = args.ph_lo, hi = args.ph_hi;
#define IN(k) (lo <= (k) && (k) < hi)
#define BOTH(k) (IN(k) && IN((k) + 1))

    if (IN(0)) for (int rep_ = 0; rep_ < ((PROBE_REPEAT >> 0) & 1) + 1; ++rep_) {
        LAS float* scr = (LAS float*)(lds + wave * 16384);
        constexpr int I_WPP = 1024, I_CMAX = 16 * 16, I_WOUT = (1024 / 64) * (1024 / 32), I_WBC = (512 / 64) * (1024 / 256), I_WC = 512;
        constexpr int NITEMS = I_WPP + I_CMAX + I_WBC + I_WC;
        for (int it = gw; it < NITEMS; it += NGW) {
            int r = it;
            if (r < I_WPP) { p0_wpp_item(w_q, sub_keys, g_ffn, WppF, CMAXP, scr, r, lane); continue; } r -= I_WPP;
            if (r < I_WC) { p0_wc_item(pool_gw, pool_scale, w_bp, WcF, CMAXC, scr, r, lane); continue; } r -= I_WC;
            if (r < I_CMAX) { p0_colmax_item(w_in, 4096, CMAX, r, lane); continue; } r -= I_CMAX;
            p0_colmax_item(w_bc, 1024, CMAXC, r, lane);
        }
        GRID_BAR();
        for (int it = gw; it < (1024 / 64) * (4096 / 32); it += NGW) p0_transpose_i8_item(w_in, 1024, 4096, Winq, CMAX, SB, scr, it, lane);
        for (int n = gw; n < NSC; n += NGW) p0_wpp_quant_row(WppF, CMAXP, Wpp8, SBP, n, lane);
        for (int n = gw; n < D; n += NGW) p0_wc_quant_row(WcF, CMAXC, Wc8, n, lane);
        for (int it = gw; it < (512 / 64) * (1024 / 32); it += NGW) p0_transpose_i8_item(w_bc, 512, 1024, Wbc8, CMAXC, SBC, scr, it, lane);
        for (int it = gw; it < I_WOUT; it += NGW) p0_transpose_item(w_out, 1024, 1024, Wout_t, scr, it, lane, CMAXC);
        {
            HRows ra, rb;
            p0_q_load(ra, expert_u, gw, gw + NGW, lane);
            for (int e = gw; e < NE; e += 2 * NGW) { const int en = e + 2 * NGW; if (en < NE) p0_q_load(rb, expert_u, en, en + NGW, lane); else p0_q_load(rb, expert_v, gw, gw + NGW, lane);
                p0_quant_rows2<false>(ra, g_ffn, U8, SU, e, e + NGW, lane); ra = rb; }
            for (int e = gw; e < NE; e += 2 * NGW) { const int en = e + 2 * NGW; if (en < NE) p0_q_load(rb, expert_v, en, en + NGW, lane); else p0_h_load(rb, x, gw, gw + NGW, lane);
                p0_quant_rows2<false>(ra, nullptr, V8, SV, e, e + NGW, lane); ra = rb; }
            for (int m = gw; m < M; m += 2 * NGW) { const int mn = (m + 2 * NGW) < M ? (m + 2 * NGW) : m; p0_h_load(rb, x, mn, mn + NGW, lane);
                p0_h_rows2(ra, g_mix, Hq, SA, m, m + NGW, lane); ra = rb; }
        }
        if (BOTH(0)) GRID_BAR();
    }
    if (IN(1)) for (int rep_ = 0; rep_ < ((PROBE_REPEAT >> 1) & 1) + 1; ++rep_) {
        pg8::Gemm g{(const bf16*)Hq, (const bf16*)Winq, (const bf16*)Hq, (const bf16*)Winq, M, DIN, D / 2}; pg8::StaticOrder S; S.init(M, DIN, G, bx, 1, 1 + ((PROBE_GEMM_REP >> 1) & 1));
        EpiZ E{Z8, ZS, G8, SA, SB};
        pg8::gemm_phase<EpiZ, pg8::StaticOrder, true, true, true>(lds, g, S, E, (unsigned)((bx >> 3) & 3) * STAGGER_P1);
        if (BOTH(1)) GRID_BAR();
    }
    if (IN(2)) for (int rep_ = 0; rep_ < ((PROBE_REPEAT >> 2) & 1) + 1; ++rep_) {
        p2_timemix(Z8, ZS, conv_w, PA, CA, SPC, gw, NGW, lane);
        if (BOTH(2)) GRID_BAR();
    }
    if (IN(3)) for (int rep_ = 0; rep_ < ((PROBE_REPEAT >> 3) & 1) + 1; ++rep_) {
        pg8::Gemm g{(const bf16*)PA, (const bf16*)Wc8, (const bf16*)CA, (const bf16*)Wbc8, M, D, DP / 2}; pg8::StaticOrder S; S.init(M, D, G, bx, 2, 1 + ((PROBE_GEMM_REP >> 3) & 1));
        EpiGate E{G8, Mb, SPC};
        pg8::gemm_phase<EpiGate, pg8::StaticOrder, true, true, true>(lds, g, S, E);
        if (BOTH(3)) GRID_BAR();
    }
    if (IN(4)) for (int rep_ = 0; rep_ < ((PROBE_REPEAT >> 4) & 1) + 1; ++rep_) {
        pg8::Gemm g{Mb, Wout_t, Mb, Wout_t, M, D, D}; pg8::StaticOrder S; S.init(M, D, G, bx, 1, 1 + ((PROBE_GEMM_REP >> 4) & 1));
        EpiRes E{x, X1, SSQ};
        pg8::gemm_phase<EpiRes, pg8::StaticOrder, true, true>(lds, g, S, E);
        if (BOTH(4)) GRID_BAR();
    }
    if (IN(5)) for (int rep_ = 0; rep_ < ((PROBE_REPEAT >> 5) & 1) + 1; ++rep_) {
        { XRows xa, xb; p5_x1_load(xa, X1, SSQ, ROW_QREV(gw), ROW_QREV(gw + NGW), lane);
          for (int r = gw; r < M; r += 2 * NGW) { const int rn = (r + 2 * NGW) < M ? (r + 2 * NGW) : r; p5_x1_load(xb, X1, SSQ, ROW_QREV(rn), ROW_QREV(rn + NGW), lane);
              p5_x1_quant_rows2(xa, X1q, SA, SXR, RSTD, ROW_QREV(r), ROW_QREV(r + NGW), lane); xa = xb; } }
        GRID_BAR();
        pg8::Gemm g{(const bf16*)X1q, (const bf16*)Wpp8, (const bf16*)X1q, (const bf16*)Wpp8, M, NSC, D / 2}; pg8::StaticOrder S; S.init(M, NSC, G, bx, 1, 1 + ((PROBE_GEMM_REP >> 5) & 1));
        EpiScore E{SXR, SBP, SC};
        pg8::gemm_phase<EpiScore, pg8::StaticOrder, true, true, true>(lds, g, S, E);
        if (BOTH(5)) GRID_BAR();
    }
    if (IN(6)) for (int rep_ = 0; rep_ < ((PROBE_REPEAT >> 6) & 1) + 1; ++rep_) {
        p6_topk(SC, IDX, EV, INV, lds, gw, NGW, wave, lane);
        if (BOTH(6)) GRID_BAR();
    }
    const unsigned xcc = xb_xcc_id();
    if (IN(7)) for (int rep_ = 0; rep_ < ((PROBE_REPEAT >> 7) & 1) + 1; ++rep_) {
        p7_u_phase((unsigned*)(ctl + CW_QU + 2048 * rep_), xcc, X1q, SA, IDX, U8, PART, lane);
        if (BOTH(7)) GRID_BAR();
    }
    if (IN(8)) for (int rep_ = 0; rep_ < ((PROBE_REPEAT >> 8) & 1) + 1; ++rep_) {
        p8_w_phase(PART, RSTD, IDX, EV, INV, SU, SV, WQ, SWH, gw, NGW, lane);
        if (BOTH(8)) GRID_BAR();
    }
    if (IN(9)) for (int rep_ = 0; rep_ < ((PROBE_REPEAT >> 9) & 1) + 1; ++rep_) {
        p9_v_phase((unsigned*)(ctl + CW_QV + 2048 * rep_), xcc, X1, IDX, WQ, SWH, V8, X2, SSQ2, lane);
        if (BOTH(9)) GRID_BAR();
    }
    if (IN(10)) {
        p10_final(X2, args.out, SSQ2, g_final, gw, NGW, lane);
    }
#undef IN
#undef BOTH
#undef GRID_BAR
}

extern "C" void kernel_launch(void* const* d_in, const int* in_sizes, int n_in, void* d_out, int out_size, void* d_ws, size_t ws_size, hipStream_t stream) {
    static int grid = 0;
    if (grid == 0) {
        if (n_in != 15 || in_sizes[0] != M * D || out_size != M * D || ws_size < WS_END) { fprintf(stderr, "kernel_launch: unexpected shapes (n_in %d, in0 %d, out %d, ws %zu); nothing launched\n", n_in, n_in > 0 ? in_sizes[0] : -1, out_size, ws_size); grid = -1; return; }
        int dev = 0, cus = 0, per_cu = 0;
        if (hipGetDevice(&dev) != hipSuccess || hipDeviceGetAttribute(&cus, hipDeviceAttributeMultiprocessorCount, dev) != hipSuccess) { grid = -1; return; }
        if (hipFuncSetAttribute((const void*)fwd_kernel, hipFuncAttributeMaxDynamicSharedMemorySize, LDS_BYTES) != hipSuccess) { fprintf(stderr, "kernel_launch: hipFuncSetAttribute failed\n"); grid = -1; return; }
        if (hipOccupancyMaxActiveBlocksPerMultiprocessor(&per_cu, (const void*)fwd_kernel, NWAVES * 64, LDS_BYTES) != hipSuccess || per_cu < 1)
            fprintf(stderr, "kernel_launch: note: occupancy query reports %d workgroups per CU\n", per_cu);
        (void)hipGetLastError();
        grid = cus;
    }
    if (grid < 0) return;
    if (hipMemsetAsync((char*)d_ws + WS_CTL, 0, CTL_ZERO_BYTES, stream) != hipSuccess) { fprintf(stderr, "kernel_launch: hipMemsetAsync failed\n"); return; }
    Args a{};
    for (int i = 0; i < 15; ++i) a.in[i] = (const float*)d_in[i];
    a.out = (float*)d_out; a.ws = (unsigned char*)d_ws;
    for (int li = 0; li < N_LAUNCHES; ++li) {
        a.ph_lo = (N_LAUNCHES == PER_PHASE) ? li : 0; a.ph_hi = (N_LAUNCHES == PER_PHASE) ? li + 1 : PER_PHASE; a.li = li;
        hipLaunchKernelGGL(fwd_kernel, dim3(grid), dim3(NWAVES * 64), LDS_BYTES, stream, a);
        const hipError_t le = hipPeekAtLastError();
        if (le != hipSuccess) { fprintf(stderr, "kernel_launch: launch %d failed: %s\n", li, hipGetErrorName(le)); break; }
    }
}
```

```cpp
#include <hip/hip_runtime.h>
#include <cstdio>
#include <cstdint>

#ifndef PROBE_REPEAT
#define PROBE_REPEAT 0
#endif
#ifndef PROBE_GEMM_REP
#define PROBE_GEMM_REP 0
#endif
#ifndef STAGGER_P1
#define STAGGER_P1 0u
#endif
#ifndef PROBE_SKIP_EPI
#define PROBE_SKIP_EPI 0
#endif
#ifndef MK_N_LAUNCHES
#define MK_N_LAUNCHES 1
#endif

namespace pg8 {
#define PG8_LAS __attribute__((address_space(3)))
typedef unsigned short bf16_t;
typedef short bf16x8 __attribute__((ext_vector_type(8)));
typedef float f32x4 __attribute__((ext_vector_type(4)));
typedef unsigned u32x4 __attribute__((ext_vector_type(4)));
constexpr int BM = 256, BK = 64, HALF = 128, HTB = HALF * BK * 2  , STAGE_BYTES = 8 * HTB, NXCD = 8, WGM = 8;

__host__ __device__ __forceinline__ int lds_byte(int r, int c) { const int st = (r >> 4) * 2 + (c >> 5), rr = r & 15, cc = c & 31, ob = rr * 64 + cc * 2; return st * 1024 + (ob ^ (((ob >> 9) & 1) << 5)); }
__host__ __device__ __forceinline__ void stage_rc(int b, int& R, int& C) { const int st = b / 1024, sb = b % 1024, swz = sb ^ (((sb >> 9) & 1) << 5); R = (st >> 1) * 16 + swz / 64; C = (st & 1) * 32 + (swz % 64) / 2; }
__host__ __device__ __forceinline__ int perm32(int rho) { const int n = rho >> 4, i = rho & 15; return 8 * (i >> 2) + 4 * n + (i & 3); }

struct Unit { int pm, pn, seg, dup; };
struct Gemm { const bf16_t* A; const bf16_t* Bt; const bf16_t* A2; const bf16_t* Bt2; int M, N, K; };

struct StaticOrder {
    int nM, nN, nwg, G, c, segs, rep;
    __host__ __device__ void init(int M, int N, int G_, int c_, int segs_, int rep_ = 1) { nM = M / BM; nN = N / BM; nwg = nM * nN; G = G_; c = c_; segs = segs_; rep = rep_; }
    __host__ __device__ bool next(int i, Unit& u) const {
        const int ti = (segs == 2) ? (i >> 1) : i; u.seg = (segs == 2) ? (i & 1) : 0;
        const long L = (long)ti * G + c; if (L >= (long)nwg * rep) return false;
        int wgid = (int)(L % nwg); u.dup = (L >= nwg) ? 1 : 0; { const int q = nwg / NXCD, r = nwg % NXCD, xcd = wgid % NXCD, off = wgid / NXCD; wgid = (xcd < r ? xcd * (q + 1) : r * (q + 1) + (xcd - r) * q) + off; }
        const int nig = WGM * nN, gid = wgid / nig, fm = gid * WGM, gsz = (nM - fm) < WGM ? (nM - fm) : WGM;
        u.pm = fm + ((wgid % nig) % gsz); u.pn = (wgid % nig) / gsz; return true;
    }
    __device__ __forceinline__ void a_ready(const Unit&) const {}
    __device__ __forceinline__ void done(const Unit&) const {}
};

__device__ __forceinline__ unsigned cvt_pk_bf16(float lo, float hi) { unsigned r; asm volatile("v_cvt_pk_bf16_f32 %0, %1, %2" : "=v"(r) : "v"(lo), "v"(hi)); return r; }

typedef int i32x4 __attribute__((ext_vector_type(4)));
template <class Epi, class Sched, bool ALIGN_EPI = false, bool SP2 = false, bool I8 = false>
__device__ __forceinline__ void gemm_phase(PG8_LAS unsigned char* lds, const Gemm g, const Sched& S, const Epi& E, unsigned stagger_ticks = 0) {
    if (stagger_ticks) { const unsigned long long t0_ = __builtin_amdgcn_s_memrealtime(); while (__builtin_amdgcn_s_memrealtime() - t0_ < (unsigned long long)stagger_ticks) __builtin_amdgcn_s_sleep(8); }
    const int tid = threadIdx.x, wid = __builtin_amdgcn_readfirstlane(tid >> 6), lane = tid & 63, wr = wid >> 2, wc = wid & 3, fr = lane & 15, fq = lane >> 4;
    const int K = g.K, nt = K / BK;
    unsigned voffA[2], voffB[2];
#pragma unroll
    for (int i = 0; i < 2; ++i) { int R, C; stage_rc(tid * 16 + i * 8192, R, C); const int Rb = Epi::PERM ? ((R & ~31) + perm32(R & 31)) : R;
        voffA[i] = (unsigned)(R * K + C) * 2u; voffB[i] = (unsigned)(Rb * K + C) * 2u; }
    const size_t kstep = (size_t)(BK * 2);
    const size_t hstep = (size_t)HALF * K * 2;
    const size_t tstep = 2 * hstep;
    const unsigned ldsw = (unsigned)wid * 1024u;
    const int aoff = lds_byte(wr * 64 + fr, fq * 8), boff = lds_byte(wc * 32 + fr, fq * 8);
#define PG8_SA(b, h) (((b) * 2 + (h)) * HTB)
#define PG8_SB(b, h) ((4 + (b) * 2 + (h)) * HTB)
#define PG8_STAGE(bufoff, gbase, voff) do { _Pragma("unroll") for (int _i = 0; _i < 2; ++_i) \
        __builtin_amdgcn_global_load_lds((const unsigned*)((const char*)(gbase) + (voff)[_i]), (PG8_LAS unsigned*)(lds + (bufoff) + ldsw + _i * 8192), 16, 0, 0); } while (0)
#define PG8_LDA(dst, b, h) do { _Pragma("unroll") for (int m = 0; m < 4; ++m) _Pragma("unroll") for (int k = 0; k < 2; ++k) dst[m][k] = *(const PG8_LAS bf16x8*)(lds + PG8_SA(b, h) + aoff + m * 2048 + k * 1024); } while (0)
#define PG8_LDB(dst, b, h) do { _Pragma("unroll") for (int n = 0; n < 2; ++n) _Pragma("unroll") for (int k = 0; k < 2; ++k) dst[n][k] = *(const PG8_LAS bf16x8*)(lds + PG8_SB(b, h) + boff + n * 2048 + k * 1024); } while (0)
#define PG8_MMA(ai, bj, At, Bt) do { __builtin_amdgcn_s_setprio(1); _Pragma("unroll") for (int m = 0; m < 4; ++m) _Pragma("unroll") for (int n = 0; n < 2; ++n) _Pragma("unroll") for (int k = 0; k < 2; ++k) { \
        if constexpr (I8) acc[ai][bj][m][n] = __builtin_bit_cast(f32x4, __builtin_amdgcn_mfma_i32_16x16x64_i8(__builtin_bit_cast(i32x4, Bt[n][k]), __builtin_bit_cast(i32x4, At[m][k]), __builtin_bit_cast(i32x4, acc[ai][bj][m][n]), 0, 0, 0)); \
        else acc[ai][bj][m][n] = __builtin_amdgcn_mfma_f32_16x16x32_bf16(Bt[n][k], At[m][k], acc[ai][bj][m][n], 0, 0, 0); } __builtin_amdgcn_s_setprio(0); } while (0)
#define PG8_WAIT_V(n) asm volatile("s_waitcnt vmcnt(" #n ")" ::: "memory")
#define PG8_WAIT_L(n) asm volatile("s_waitcnt lgkmcnt(" #n ")" ::: "memory")
#define PG8_BAR __builtin_amdgcn_s_barrier()
#define PG8_SCHED __builtin_amdgcn_sched_barrier(0)
    Unit cur, nxt; int ui = 0;
    if (!S.next(0, cur)) return;
    f32x4 acc[2][2][4][2];
#pragma unroll
    for (int a = 0; a < 2; ++a)
#pragma unroll
        for (int b = 0; b < 2; ++b)
#pragma unroll
            for (int m = 0; m < 4; ++m)
#pragma unroll
                for (int n = 0; n < 2; ++n) acc[a][b][m][n] = (f32x4){0.f, 0.f, 0.f, 0.f};
    bf16x8 At[4][2], B0[2][2], B1[2][2];
    const char* cA = (const char*)(cur.seg ? g.A2 : g.A) + (size_t)cur.pm * tstep; const char* cB = (const char*)(cur.seg ? g.Bt2 : g.Bt) + (size_t)cur.pn * tstep;
    S.a_ready(cur);
    if constexpr (SP2) {
        PG8_STAGE(PG8_SB(0, 0), cB, voffB); PG8_STAGE(PG8_SB(0, 1), cB + hstep, voffB); PG8_STAGE(PG8_SA(0, 0), cA, voffA); PG8_STAGE(PG8_SA(0, 1), cA + hstep, voffA);
        if (wr == 1) PG8_BAR;
        PG8_WAIT_V(2); PG8_BAR;
        PG8_STAGE(PG8_SB(1, 0), cB + kstep, voffB); PG8_STAGE(PG8_SA(1, 0), cA + kstep, voffA); PG8_STAGE(PG8_SB(1, 1), cB + hstep + kstep, voffB);
        PG8_WAIT_V(6); PG8_BAR;
    } else {
        PG8_STAGE(PG8_SB(0, 0), cB, voffB); PG8_STAGE(PG8_SA(0, 0), cA, voffA); PG8_STAGE(PG8_SB(0, 1), cB + hstep, voffB); PG8_STAGE(PG8_SA(0, 1), cA + hstep, voffA);
        if (wr == 1) PG8_BAR;
        PG8_WAIT_V(4); PG8_BAR;
        PG8_STAGE(PG8_SB(1, 0), cB + kstep, voffB); PG8_STAGE(PG8_SA(1, 0), cA + kstep, voffA); PG8_STAGE(PG8_SB(1, 1), cB + hstep + kstep, voffB);
        PG8_WAIT_V(6); PG8_BAR;
    }
    for (;;) {
        const bool has_next = S.next(ui + 1, nxt);
        const char* nA = has_next ? (const char*)(nxt.seg ? g.A2 : g.A) + (size_t)nxt.pm * tstep : cA; const char* nB = has_next ? (const char*)(nxt.seg ? g.Bt2 : g.Bt) + (size_t)nxt.pn * tstep : cB;
        for (int t = 0; t < nt; t += 2) {
            const bool last = (t == nt - 2);
            const char* a1 = cA + (size_t)(t + 1) * kstep;
            const char* a2 = last ? nA : cA + (size_t)(t + 2) * kstep; const char* b2 = last ? nB : cB + (size_t)(t + 2) * kstep;
            const char* a3 = a2 + kstep; const char* b3 = b2 + kstep;
            if (last && has_next) S.a_ready(nxt);
            if constexpr (SP2) {
            PG8_LDB(B0, 0, 0); PG8_LDB(B1, 0, 1); PG8_SCHED; PG8_LDA(At, 0, 0); PG8_STAGE(PG8_SA(1, 1), a1 + hstep, voffA);
            PG8_WAIT_V(8); PG8_WAIT_L(0); PG8_BAR; PG8_MMA(0, 0, At, B0); PG8_MMA(0, 1, At, B1); PG8_BAR; PG8_SCHED;
            PG8_LDA(At, 0, 1); PG8_STAGE(PG8_SB(0, 0), b2, voffB); PG8_STAGE(PG8_SB(0, 1), b2 + hstep, voffB); PG8_STAGE(PG8_SA(0, 0), a2, voffA);
            PG8_WAIT_V(8); PG8_WAIT_L(0); PG8_BAR; PG8_MMA(1, 0, At, B0); PG8_MMA(1, 1, At, B1); PG8_BAR; PG8_SCHED;
            PG8_LDB(B0, 1, 0); PG8_LDB(B1, 1, 1); PG8_SCHED; PG8_LDA(At, 1, 0); PG8_STAGE(PG8_SA(0, 1), a2 + hstep, voffA);
            PG8_WAIT_V(8); PG8_WAIT_L(0); PG8_BAR; PG8_MMA(0, 0, At, B0); PG8_MMA(0, 1, At, B1); PG8_BAR; PG8_SCHED;
            PG8_LDA(At, 1, 1); PG8_STAGE(PG8_SB(1, 0), b3, voffB); PG8_STAGE(PG8_SB(1, 1), b3 + hstep, voffB); PG8_STAGE(PG8_SA(1, 0), a3, voffA);
            PG8_WAIT_V(8); PG8_WAIT_L(0); PG8_BAR; PG8_MMA(1, 0, At, B0); PG8_MMA(1, 1, At, B1); PG8_BAR; PG8_SCHED;
            } else {
            PG8_LDB(B0, 0, 0); PG8_SCHED; PG8_LDA(At, 0, 0); PG8_STAGE(PG8_SA(1, 1), a1 + hstep, voffA);
            PG8_WAIT_L(8); PG8_BAR; PG8_WAIT_L(0); PG8_MMA(0, 0, At, B0); PG8_BAR; PG8_SCHED;
            PG8_LDB(B1, 0, 1); PG8_STAGE(PG8_SB(0, 0), b2, voffB);
            PG8_BAR; PG8_WAIT_L(0); PG8_MMA(0, 1, At, B1); PG8_BAR;
            PG8_LDA(At, 0, 1); PG8_STAGE(PG8_SA(0, 0), a2, voffA);
            PG8_BAR; PG8_WAIT_L(0); PG8_MMA(1, 0, At, B0); PG8_BAR; PG8_SCHED;
            PG8_STAGE(PG8_SB(0, 1), b2 + hstep, voffB);
            PG8_WAIT_V(6); PG8_BAR; PG8_MMA(1, 1, At, B1); PG8_BAR;
            PG8_LDB(B0, 1, 0); PG8_SCHED; PG8_LDA(At, 1, 0); PG8_STAGE(PG8_SA(0, 1), a2 + hstep, voffA);
            PG8_WAIT_L(8); PG8_BAR; PG8_WAIT_L(0); PG8_MMA(0, 0, At, B0); PG8_BAR; PG8_SCHED;
            PG8_LDB(B1, 1, 1); PG8_STAGE(PG8_SB(1, 0), b3, voffB);
            PG8_BAR; PG8_WAIT_L(0); PG8_MMA(0, 1, At, B1); PG8_BAR;
            PG8_LDA(At, 1, 1); PG8_STAGE(PG8_SA(1, 0), a3, voffA);
            PG8_BAR; PG8_WAIT_L(0); PG8_MMA(1, 0, At, B0); PG8_BAR; PG8_SCHED;
            PG8_STAGE(PG8_SB(1, 1), b3 + hstep, voffB);
            PG8_WAIT_V(6); PG8_BAR; PG8_MMA(1, 1, At, B1); PG8_BAR;
            }
        }
        if constexpr (ALIGN_EPI) { if (wr == 0) PG8_BAR; }
        const bool keep = E(acc, cur, wr, wc, fr, fq); S.done(cur);
        if (!has_next) break;
        if (!keep) {
#pragma unroll
        for (int a = 0; a < 2; ++a)
#pragma unroll
            for (int b = 0; b < 2; ++b)
#pragma unroll
                for (int m = 0; m < 4; ++m)
#pragma unroll
                    for (int n = 0; n < 2; ++n) acc[a][b][m][n] = (f32x4){0.f, 0.f, 0.f, 0.f};
        }
        cur = nxt; cA = nA; cB = nB; ++ui;
        if constexpr (ALIGN_EPI) { if (wr == 1) PG8_BAR; }
    }
    PG8_WAIT_V(0);
    if constexpr (!ALIGN_EPI) { if (wr == 0) PG8_BAR; }
    PG8_BAR;
#undef PG8_SA
#undef PG8_SB
#undef PG8_STAGE
#undef PG8_LDA
#undef PG8_LDB
#undef PG8_MMA
#undef PG8_WAIT_V
#undef PG8_WAIT_L
#undef PG8_BAR
#undef PG8_SCHED
}
}

constexpr int NWAVES = 8;
constexpr int M = 65536, D = 1024, SEQ = 4096, DIN = 4096, DP = 512, NSC = 2048, NE = 16384, NH = 8, TOPK = 16;
constexpr float RMS_EPS = 1e-6f;
constexpr int N_LAUNCHES = MK_N_LAUNCHES;
constexpr int PER_PHASE = 11;
constexpr int TPI = 32;
__device__ __forceinline__ int ROW_REV(int t) { return M - 1 - t; }
__device__ __forceinline__ int ROW_QREV(int L) { return ((L >> 11) & 7) * 8192 + (3 - (L >> 14)) * 2048 + (L & 2047); }
__device__ __forceinline__ int GRP_QREV(int L) { return ((L >> 7) & 7) * 512 + (3 - (L >> 10)) * 128 + (L & 127); }

constexpr size_t MiB = 1u << 20;
constexpr size_t WS_CTL = 0, CTL_ZERO_BYTES = 1 * MiB;
constexpr size_t WS_WIN = 1 * MiB;
constexpr size_t WS_WC = 9 * MiB;
constexpr size_t WS_WBC = 10 * MiB;
constexpr size_t WS_SBC = 10 * MiB + 512 * 1024;
constexpr size_t WS_SPC = 62 * MiB;
constexpr size_t WS_WCF = 200 * MiB;
constexpr int CW_CMAXC = 45056;
constexpr size_t WS_WOUT = 11 * MiB;
constexpr size_t WS_WPP = 13 * MiB;
constexpr size_t WS_SBP = 15 * MiB;
constexpr size_t WS_SXR = 15 * MiB + 65536;
constexpr size_t WS_WPPF = 192 * MiB;
constexpr size_t WS_X1Q = 704 * MiB;
constexpr int CW_CMAXP = 40960;
constexpr size_t WS_SU = 17 * MiB;
constexpr size_t WS_SV = 17 * MiB + 65536;
constexpr size_t WS_SSQ = 18 * MiB;
constexpr size_t WS_U8 = 22 * MiB;
constexpr size_t WS_V8 = 38 * MiB;
constexpr size_t WS_INV = 54 * MiB;
constexpr size_t WS_SSQ2 = 56 * MiB;
constexpr size_t WS_RSTD = 58 * MiB;
constexpr size_t WS_SWH = 60 * MiB;
constexpr size_t WS_SA = 59 * MiB;
constexpr size_t WS_SB = 59 * MiB + 512 * 1024;
constexpr int CW_CMAX = 32768;
constexpr size_t WS_WV = 192 * MiB + 48 * MiB;
constexpr size_t WS_PART = 576 * MiB;
constexpr size_t WS_B = 64 * MiB;
constexpr size_t WS_C = 192 * MiB;
constexpr size_t WS_A = 320 * MiB;
constexpr size_t WS_END = 832 * MiB;
constexpr int CW_BAR = 4096;
constexpr int CW_QU = 16384, CW_QV = 16384 + 1024;

constexpr int RING_BYTES = 131072;
constexpr int LDSCTL_OFF = RING_BYTES, MISC_OFF = LDSCTL_OFF + 320;
constexpr int LDS_BYTES = 147456;

#define GAS __attribute__((address_space(1)))
#define LAS __attribute__((address_space(3)))
typedef unsigned short bf16;
typedef unsigned v4u __attribute__((ext_vector_type(4)));
typedef unsigned v2u __attribute__((ext_vector_type(2)));
typedef float f32x4 __attribute__((ext_vector_type(4)));
typedef GAS unsigned gu32;
#define RLX_AGENT __ATOMIC_RELAXED, __HIP_MEMORY_SCOPE_AGENT
#define LDS_WAIT() asm volatile("s_waitcnt lgkmcnt(0)" ::: "memory")
#define VM_WAIT() asm volatile("s_waitcnt vmcnt(0)" ::: "memory")
__device__ __forceinline__ unsigned f2bf(float f) { unsigned u = __builtin_bit_cast(unsigned, f); return (u + 0x7fffu + ((u >> 16) & 1u)) >> 16; }
__device__ __forceinline__ unsigned pk2(float lo, float hi) { return f2bf(lo) | (f2bf(hi) << 16); }
__device__ __forceinline__ float bflo(unsigned w) { return __builtin_bit_cast(float, w << 16); }
__device__ __forceinline__ float bfhi(unsigned w) { return __builtin_bit_cast(float, w & 0xffff0000u); }
template <int CTRL> __device__ __forceinline__ int dppi(int x) { return __builtin_amdgcn_mov_dpp(x, CTRL, 0xf, 0xf, true); }
__device__ __forceinline__ int xor1i(int x) { return dppi<0xB1>(x); }
__device__ __forceinline__ int xor2i(int x) { return dppi<0x4E>(x); }
__device__ __forceinline__ int xor4i(int x) { return dppi<0x1B>(dppi<0x141>(x)); }
__device__ __forceinline__ int xor8i(int x) { return dppi<0x128>(x); }
__device__ __forceinline__ float xor1f(float x) { return __builtin_bit_cast(float, xor1i(__builtin_bit_cast(int, x))); }
__device__ __forceinline__ float xor2f(float x) { return __builtin_bit_cast(float, xor2i(__builtin_bit_cast(int, x))); }
__device__ __forceinline__ float xor4f(float x) { return __builtin_bit_cast(float, xor4i(__builtin_bit_cast(int, x))); }
__device__ __forceinline__ float xor8f(float x) { return __builtin_bit_cast(float, xor8i(__builtin_bit_cast(int, x))); }
__device__ __forceinline__ float swap32_add(float a, float b) { asm volatile("s_nop 1\n\tv_permlane32_swap_b32 %0, %1" : "+v"(a), "+v"(b)); return a + b; }
__device__ __forceinline__ int swap32_addi(int a, int b) { asm volatile("s_nop 1\n\tv_permlane32_swap_b32 %0, %1" : "+v"(a), "+v"(b)); return a + b; }
__device__ __forceinline__ int swap16_addi(int a, int b) { asm volatile("s_nop 1\n\tv_permlane16_swap_b32 %0, %1" : "+v"(a), "+v"(b)); return a + b; }
__device__ __forceinline__ float swap16_add(float a, float b) { asm volatile("s_nop 1\n\tv_permlane16_swap_b32 %0, %1" : "+v"(a), "+v"(b)); return a + b; }
__device__ __forceinline__ float xor16f(float x) { float a = x, b = x; asm volatile("s_nop 1\n\tv_permlane16_swap_b32 %0, %1" : "+v"(a), "+v"(b)); return ((threadIdx.x >> 4) & 1) ? a : b; }
__device__ __forceinline__ float xor32f(float x) { float a = x, b = x; asm volatile("s_nop 1\n\tv_permlane32_swap_b32 %0, %1" : "+v"(a), "+v"(b)); return (threadIdx.x & 32) ? a : b; }
__device__ __forceinline__ float wave_sum(float v) {
    v += xor1f(v); v += xor2f(v); v += xor4f(v); v += xor8f(v);
    v = swap16_add(v, v); v = swap32_add(v, v);
    return v;
}
__device__ __forceinline__ float wave_max(float v) {
    v = fmaxf(v, xor1f(v)); v = fmaxf(v, xor2f(v)); v = fmaxf(v, xor4f(v)); v = fmaxf(v, xor8f(v));
    v = fmaxf(v, xor16f(v)); v = fmaxf(v, xor32f(v));
    return v;
}

__device__ __forceinline__ void unpack8(const v4u w, float (&f)[8]) { f[0] = bflo(w.x); f[1] = bfhi(w.x); f[2] = bflo(w.y); f[3] = bfhi(w.y); f[4] = bflo(w.z); f[5] = bfhi(w.z); f[6] = bflo(w.w); f[7] = bfhi(w.w); }
__device__ __forceinline__ v4u pack8(const float (&f)[8]) { v4u w; w.x = pk2(f[0], f[1]); w.y = pk2(f[2], f[3]); w.z = pk2(f[4], f[5]); w.w = pk2(f[6], f[7]); return w; }

#define XB_TMO      128
#define XB_XCNT(j)  (256  + 64 * (j))
#define XB_XSUB(j)  (1280 + 64 * (j))
#define XB_XGEN(j)  (2304 + 64 * (j))
#define XB_TOP      3328
#define XB_TOPGEN   3392
#define XCD_BAR_WORDS 3456
#define XB_SPIN_CAP (1u << 18)
__device__ __forceinline__ unsigned xb_ld(unsigned* p)              { return __hip_atomic_load(p, __ATOMIC_RELAXED, __HIP_MEMORY_SCOPE_AGENT); }
__device__ __forceinline__ unsigned xb_add(unsigned* p, unsigned v) { return __hip_atomic_fetch_add(p, v, __ATOMIC_RELAXED, __HIP_MEMORY_SCOPE_AGENT); }
__device__ __forceinline__ unsigned xb_xcc_id() { return (unsigned)__builtin_amdgcn_s_getreg((3 << 11) | 20) & 0xFu; }
#define XB_SPIN(cond, bar) do { unsigned _sp = 0; while (cond) { __builtin_amdgcn_s_sleep(0); \
    if ((++_sp & 255u) == 0u) { if (xb_ld(&(bar)[XB_TMO])) break; if (_sp > XB_SPIN_CAP) { atomicAdd(&(bar)[XB_TMO], 1u); break; } } } } while (0)
struct XcdBarrier { unsigned* bar; unsigned x; volatile LAS unsigned* st; };
__device__ __forceinline__ XcdBarrier xcd_barrier_post(unsigned* bar, volatile LAS unsigned* st) {
    XcdBarrier b; b.bar = bar; b.x = xb_xcc_id(); b.st = st;
    if (threadIdx.x == 0) (void)xb_add(&bar[XB_XCNT(b.x)], 1u);
    return b;
}
__device__ __forceinline__ void xcd_barrier_complete(unsigned* bar, unsigned x, unsigned& nloc, unsigned& nx) {
    const unsigned G = gridDim.x * gridDim.y * gridDim.z;
    unsigned sum, cnt, mine, sp = 0u;
    for (;;) {
        sum = 0u; cnt = 0u; mine = 0u;
#pragma unroll
        for (unsigned j = 0; j < 16; ++j) { const unsigned c = xb_ld(&bar[XB_XCNT(j)]); sum += c; cnt += (c > 0u) ? 1u : 0u; mine = (j == x) ? c : mine; }
        if (sum == G) break;
        __builtin_amdgcn_s_sleep(1);
        if ((++sp & 255u) == 0u) { if (xb_ld(&bar[XB_TMO])) break; if (sp > XB_SPIN_CAP) { atomicAdd(&bar[XB_TMO], 1u); break; } }
    }
    nloc = mine > 0u ? mine : 1u; nx = cnt > 0u ? cnt : 1u;
}
__device__ __forceinline__ void xcd_barrier(const XcdBarrier& b) {
    asm volatile("s_waitcnt vmcnt(0)" ::: "memory");
    __syncthreads();
    if (threadIdx.x == 0) {
        unsigned* bar = b.bar;
        __builtin_amdgcn_s_waitcnt(0);
        unsigned nloc = b.st[0], nx = b.st[1];
        if (nloc == 0u) { xcd_barrier_complete(bar, b.x, nloc, nx); b.st[0] = nloc; b.st[1] = nx; }
        const unsigned old = xb_add(&bar[XB_XSUB(b.x)], 1u);
        const unsigned gen = old / nloc;
        if (old + 1u == (gen + 1u) * nloc) {
            __builtin_amdgcn_fence(__ATOMIC_RELEASE, "agent");
            asm volatile("s_waitcnt vmcnt(0)" ::: "memory");
            const unsigned og = xb_add(&bar[XB_TOP], 1u);
            const unsigned tg = og / nx;
            if (og + 1u == (tg + 1u) * nx) xb_add(&bar[XB_TOPGEN], 1u);
            else XB_SPIN(xb_ld(&bar[XB_TOPGEN]) == tg, bar);
            __builtin_amdgcn_fence(__ATOMIC_ACQUIRE, "agent");
            xb_add(&bar[XB_XGEN(b.x)], 1u);
            asm volatile("s_waitcnt vmcnt(0)" ::: "memory");
        } else {
            XB_SPIN(xb_ld(&bar[XB_XGEN(b.x)]) == gen, bar);
            __builtin_amdgcn_fence(__ATOMIC_ACQUIRE, "agent");
            asm volatile("s_waitcnt vmcnt(0)" ::: "memory");
        }
    }
    __syncthreads();
}

__device__ __forceinline__ void p0_transpose_item(const float* W, int K, int N, bf16* WT, LAS float* scr, int item, int lane, const unsigned* kmax = nullptr) {
    const int nblk = N / 32, kb = item / nblk, nb = item % nblk, k0 = 64 * kb, n0 = 32 * nb;
#pragma unroll 8
    for (int i = 0; i < 32; ++i) { const int kk = 2 * i + (lane >> 5); float ks = 1.f; if (kmax) { const float mxv = __builtin_bit_cast(float, kmax[k0 + kk]); ks = mxv > 0.f ? mxv * (1.f / 127.f) : 1.f; }
        scr[kk * 33 + (lane & 31)] = W[(size_t)(k0 + kk) * N + n0 + (lane & 31)] * ks; }
    LDS_WAIT(); asm volatile("" ::: "memory");
    const int c = lane & 7;
#pragma unroll
    for (int j = 0; j < 4; ++j) { const int n = (lane >> 3) + 8 * j; const LAS float* s = scr + (8 * c) * 33 + n;
        v4u o; o.x = pk2(s[0 * 33], s[1 * 33]); o.y = pk2(s[2 * 33], s[3 * 33]); o.z = pk2(s[4 * 33], s[5 * 33]); o.w = pk2(s[6 * 33], s[7 * 33]);
        *(v4u*)(WT + (size_t)(n0 + n) * K + k0 + 8 * c) = o; }
    LDS_WAIT(); asm volatile("" ::: "memory");
}
__device__ __forceinline__ void p0_wc_item(const float* gwt, const float* scale, const float* wbp, float* WcF, unsigned* cmaxc, LAS float* scr, int item, int lane) {
    const int nb = item & 15, cb = (item >> 4) & 7, g = item >> 7;
    const int n = nb * 64 + lane;
    const f32x4* gsrc = (const f32x4*)(gwt + (size_t)((g * 128 + cb * 16) * 128));
    LAS f32x4* gt = (LAS f32x4*)scr;
#pragma unroll
    for (int i = 0; i < 8; ++i) gt[i * 64 + lane] = gsrc[i * 64 + lane];
    float acc[16];
#pragma unroll
    for (int c = 0; c < 16; ++c) acc[c] = 0.f;
    LDS_WAIT(); asm volatile("" ::: "memory");
    const float* bp = wbp + (size_t)(g * 128) * 1024 + n;
#pragma unroll 2
    for (int d4 = 0; d4 < 32; ++d4) {
        const f32x4 sc = *(const f32x4*)(scale + g * 128 + 4 * d4);
        const float b0 = bp[(size_t)(4 * d4 + 0) * 1024] * sc.x, b1 = bp[(size_t)(4 * d4 + 1) * 1024] * sc.y, b2 = bp[(size_t)(4 * d4 + 2) * 1024] * sc.z, b3 = bp[(size_t)(4 * d4 + 3) * 1024] * sc.w;
#pragma unroll
        for (int c = 0; c < 16; ++c) { const f32x4 gq = gt[c * 32 + d4]; acc[c] += (gq.x * b0 + gq.y * b1) + (gq.z * b2 + gq.w * b3); }
    }
    float* dst = WcF + (size_t)n * 512 + g * 128 + cb * 16;
    float mx = 0.f;
#pragma unroll
    for (int q = 0; q < 4; ++q) { *(f32x4*)(dst + 4 * q) = (f32x4){acc[4 * q], acc[4 * q + 1], acc[4 * q + 2], acc[4 * q + 3]};
        mx = fmaxf(mx, fmaxf(fmaxf(fabsf(acc[4 * q]), fabsf(acc[4 * q + 1])), fmaxf(fabsf(acc[4 * q + 2]), fabsf(acc[4 * q + 3])))); }
    atomicMax(cmaxc + n, __builtin_bit_cast(unsigned, mx));
    LDS_WAIT(); asm volatile("" ::: "memory");
}
__device__ __forceinline__ void p0_wc_quant_row(const float* WcF, const unsigned* cmaxc, unsigned char* Wc8, int n, int lane) {
    const f32x4* p = (const f32x4*)(WcF + (size_t)n * 512 + 8 * lane);
    const float mxv = __builtin_bit_cast(float, cmaxc[n]); const float sc = mxv > 0.f ? mxv * (1.f / 127.f) : 1.f, inv = 1.f / sc;
    v2u w;
#pragma unroll
    for (int j = 0; j < 2; ++j) { const f32x4 v = p[j]; unsigned a = 0;
#pragma unroll
        for (int c = 0; c < 4; ++c) { int q = (int)rintf(v[c] * inv); q = q > 127 ? 127 : (q < -127 ? -127 : q); a |= ((unsigned)q & 0xffu) << (8 * c); }
        w[j] = a; }
    *(v2u*)(Wc8 + (size_t)n * 512 + 8 * lane) = w;
}
__device__ __forceinline__ void p0_wpp_item(const float* wq, const float* keys, const float* gffn, float* WppF, unsigned* cmaxp, LAS float* scr, int item, int lane) {
    const int kb = item & 3, db = (item >> 2) & 15, hp = item >> 6;
    const int d = db * 64 + lane;
    const f32x4* kbase = (const f32x4*)(keys + (size_t)(hp * 128 + kb * 32) * 128);
    LAS f32x4* kt = (LAS f32x4*)scr;
#pragma unroll
    for (int i = 0; i < 16; ++i) kt[i * 64 + lane] = kbase[i * 64 + lane];
    float acc[32];
#pragma unroll
    for (int k = 0; k < 32; ++k) acc[k] = 0.f;
    const float* arow = wq + (size_t)d * 2048 + hp * 128;
    LDS_WAIT(); asm volatile("" ::: "memory");
#pragma unroll 4
    for (int c4 = 0; c4 < 32; ++c4) {
        const f32x4 a = *(const f32x4*)(arow + 4 * c4);
#pragma unroll
        for (int k = 0; k < 32; ++k) { const f32x4 kr = kt[k * 32 + c4]; acc[k] += (a.x * kr.x + a.y * kr.y) + (a.z * kr.z + a.w * kr.w); }
    }
    const float gs = gffn[d];
#pragma unroll
    for (int k = 0; k < 32; ++k) { const float v = acc[k] * gs; WppF[(size_t)(hp * 128 + kb * 32 + k) * 1024 + d] = v;
        const float mx = wave_max(fabsf(v)); if (lane == 0) atomicMax(cmaxp + hp * 128 + kb * 32 + k, __builtin_bit_cast(unsigned, mx)); }
    LDS_WAIT(); asm volatile("" ::: "memory");
}
__device__ __forceinline__ void p0_wpp_quant_row(const float* WppF, const unsigned* cmaxp, unsigned char* Wq8, float* SBP, int n, int lane) {
    const f32x4* p = (const f32x4*)(WppF + (size_t)n * 1024 + 16 * lane);
    const float mxv = __builtin_bit_cast(float, cmaxp[n]); const float sc = mxv > 0.f ? mxv * (1.f / 127.f) : 1.f, inv = 1.f / sc;
    v4u w;
#pragma unroll
    for (int j = 0; j < 4; ++j) { const f32x4 v = p[j]; unsigned a = 0;
#pragma unroll
        for (int c = 0; c < 4; ++c) { int q = (int)rintf(v[c] * inv); q = q > 127 ? 127 : (q < -127 ? -127 : q); a |= ((unsigned)q & 0xffu) << (8 * c); }
        w[j] = a; }
    *(v4u*)(Wq8 + (size_t)n * 1024 + 16 * lane) = w;
    if (lane == 0) SBP[n] = sc;
}
struct XRows { v4u a0, a1, b0, b1; float sa, sb; };
__device__ __forceinline__ void p5_x1_load(XRows& r, const bf16* X1, const float* SSQ, int r0, int r1, int lane) {
    r.a0 = *(const v4u*)(X1 + (size_t)r0 * D + 16 * lane); r.a1 = *(const v4u*)(X1 + (size_t)r0 * D + 16 * lane + 8);
    r.b0 = *(const v4u*)(X1 + (size_t)r1 * D + 16 * lane); r.b1 = *(const v4u*)(X1 + (size_t)r1 * D + 16 * lane + 8);
    r.sa = lane < 16 ? SSQ[(size_t)r0 * 16 + lane] : 0.f; r.sb = lane < 16 ? SSQ[(size_t)r1 * 16 + lane] : 0.f;
}
__device__ __forceinline__ void p5_x1_quant_rows2(const XRows& in, unsigned char* X1q, float* SX, float* SXR, float* RSTD, int r0, int r1, int lane) {
    const v4u a0 = in.a0, a1 = in.a1, b0 = in.b0, b1 = in.b1; const float sa = in.sa, sb = in.sb;
    float xa[16], xb[16];
    { float f[8]; unpack8(a0, f);
#pragma unroll
      for (int i = 0; i < 8; ++i) xa[i] = f[i];
      unpack8(a1, f);
#pragma unroll
      for (int i = 0; i < 8; ++i) xa[8 + i] = f[i];
      unpack8(b0, f);
#pragma unroll
      for (int i = 0; i < 8; ++i) xb[i] = f[i];
      unpack8(b1, f);
#pragma unroll
      for (int i = 0; i < 8; ++i) xb[8 + i] = f[i]; }
    float ma = 0.f, mb = 0.f;
#pragma unroll
    for (int i = 0; i < 16; ++i) { ma = fmaxf(ma, fabsf(xa[i])); mb = fmaxf(mb, fabsf(xb[i])); }
    ma = wave_max(ma); mb = wave_max(mb);
    const float ra = rsqrtf(wave_sum(sa) * (1.f / D) + RMS_EPS), rb = rsqrtf(wave_sum(sb) * (1.f / D) + RMS_EPS);
    const float sca = ma > 0.f ? ma * (1.f / 127.f) : 1.f, scb = mb > 0.f ? mb * (1.f / 127.f) : 1.f, ia = 1.f / sca, ib = 1.f / scb;
    v4u wa, wb;
#pragma unroll
    for (int j = 0; j < 4; ++j) { unsigned a = 0, b = 0;
#pragma unroll
        for (int c = 0; c < 4; ++c) { int q = (int)rintf(xa[4 * j + c] * ia); q = q > 127 ? 127 : (q < -127 ? -127 : q); a |= ((unsigned)q & 0xffu) << (8 * c);
            int q1 = (int)rintf(xb[4 * j + c] * ib); q1 = q1 > 127 ? 127 : (q1 < -127 ? -127 : q1); b |= ((unsigned)q1 & 0xffu) << (8 * c); }
        wa[j] = a; wb[j] = b; }
    *(v4u*)(X1q + (size_t)r0 * D + 16 * lane) = wa; *(v4u*)(X1q + (size_t)r1 * D + 16 * lane) = wb;
    if (lane == 0) { SX[r0] = sca; SX[r1] = scb; SXR[r0] = sca * ra; SXR[r1] = scb * rb; RSTD[r0] = ra; RSTD[r1] = rb; }
}
__device__ __forceinline__ void p0_h_row(const float* xrow, const float* g, bf16* orow, int lane) {
    const f32x4* xr = (const f32x4*)xrow + lane; const f32x4* gr = (const f32x4*)g + lane;
    f32x4 v[4]; float s = 0.f;
#pragma unroll
    for (int j = 0; j < 4; ++j) { v[j] = xr[64 * j]; s += (v[j].x * v[j].x + v[j].y * v[j].y) + (v[j].z * v[j].z + v[j].w * v[j].w); }
    const float rstd = rsqrtf(wave_sum(s) * (1.f / D) + RMS_EPS);
    v2u* o8 = (v2u*)orow + lane;
#pragma unroll
    for (int j = 0; j < 4; ++j) { const f32x4 gg = gr[64 * j]; v2u o; o.x = pk2(v[j].x * rstd * gg.x, v[j].y * rstd * gg.y); o.y = pk2(v[j].z * rstd * gg.z, v[j].w * rstd * gg.w); o8[64 * j] = o; }
}
struct HRows { f32x4 v0[4], v1[4]; };
__device__ __forceinline__ void p0_h_load(HRows& r, const float* x, int m0, int m1, int lane) {
    const f32x4* xr0 = (const f32x4*)(x + (size_t)m0 * D) + lane; const f32x4* xr1 = (const f32x4*)(x + (size_t)m1 * D) + lane;
#pragma unroll
    for (int j = 0; j < 4; ++j) { r.v0[j] = xr0[64 * j]; r.v1[j] = xr1[64 * j]; }
}
__device__ __forceinline__ void p0_h_rows2(const HRows& in, const float* g, unsigned char* Hq, float* SA, int m0, int m1, int lane) {
    const f32x4* gr = (const f32x4*)g + lane;
    f32x4 v0[4], v1[4]; float s0 = 0.f, s1 = 0.f;
#pragma unroll
    for (int j = 0; j < 4; ++j) { v0[j] = in.v0[j]; v1[j] = in.v1[j]; }
#pragma unroll
    for (int j = 0; j < 4; ++j) { s0 += (v0[j].x * v0[j].x + v0[j].y * v0[j].y) + (v0[j].z * v0[j].z + v0[j].w * v0[j].w); s1 += (v1[j].x * v1[j].x + v1[j].y * v1[j].y) + (v1[j].z * v1[j].z + v1[j].w * v1[j].w); }
    const float r0 = rsqrtf(wave_sum(s0) * (1.f / D) + RMS_EPS), r1 = rsqrtf(wave_sum(s1) * (1.f / D) + RMS_EPS);
    float mx0 = 0.f, mx1 = 0.f;
#pragma unroll
    for (int j = 0; j < 4; ++j) { const f32x4 gg = gr[64 * j]; v0[j] = v0[j] * gg * r0; v1[j] = v1[j] * gg * r1;
        mx0 = fmaxf(mx0, fmaxf(fmaxf(fabsf(v0[j].x), fabsf(v0[j].y)), fmaxf(fabsf(v0[j].z), fabsf(v0[j].w))));
        mx1 = fmaxf(mx1, fmaxf(fmaxf(fabsf(v1[j].x), fabsf(v1[j].y)), fmaxf(fabsf(v1[j].z), fabsf(v1[j].w)))); }
    mx0 = wave_max(mx0); mx1 = wave_max(mx1);
    const float sc0 = mx0 > 0.f ? mx0 * (1.f / 127.f) : 1.f, sc1 = mx1 > 0.f ? mx1 * (1.f / 127.f) : 1.f, i0 = 1.f / sc0, i1 = 1.f / sc1;
    unsigned* o0 = (unsigned*)(Hq + (size_t)m0 * D) + lane; unsigned* o1 = (unsigned*)(Hq + (size_t)m1 * D) + lane;
#pragma unroll
    for (int j = 0; j < 4; ++j) { unsigned a = 0, b = 0;
#pragma unroll
        for (int c = 0; c < 4; ++c) { int q = (int)rintf(v0[j][c] * i0); q = q > 127 ? 127 : (q < -127 ? -127 : q); a |= ((unsigned)q & 0xffu) << (8 * c);
            int q1 = (int)rintf(v1[j][c] * i1); q1 = q1 > 127 ? 127 : (q1 < -127 ? -127 : q1); b |= ((unsigned)q1 & 0xffu) << (8 * c); }
        o0[64 * j] = a; o1[64 * j] = b; }
    if (lane == 0) { SA[m0] = sc0; SA[m1] = sc1; }
}
__device__ __forceinline__ void p0_colmax_item(const float* W, int N, unsigned* cmax, int item, int lane) {
    const int nblk = N / 256, kb = item / nblk, nb = item % nblk;
    const float* p = W + (size_t)(kb * 64) * N + nb * 256 + 4 * lane;
    f32x4 mx = {0.f, 0.f, 0.f, 0.f};
#pragma unroll 8
    for (int k = 0; k < 64; ++k) { const f32x4 v = *(const f32x4*)(p + (size_t)k * N); mx.x = fmaxf(mx.x, fabsf(v.x)); mx.y = fmaxf(mx.y, fabsf(v.y)); mx.z = fmaxf(mx.z, fabsf(v.z)); mx.w = fmaxf(mx.w, fabsf(v.w)); }
    unsigned* c = cmax + nb * 256 + 4 * lane;
    atomicMax(c + 0, __builtin_bit_cast(unsigned, mx.x)); atomicMax(c + 1, __builtin_bit_cast(unsigned, mx.y)); atomicMax(c + 2, __builtin_bit_cast(unsigned, mx.z)); atomicMax(c + 3, __builtin_bit_cast(unsigned, mx.w));
}
__device__ __forceinline__ void p0_transpose_i8_item(const float* W, int K, int N, unsigned char* WT, const unsigned* cmax, float* SB, LAS float* scr, int item, int lane) {
    const int nblk = N / 32, kb = item / nblk, nb = item % nblk, k0 = 64 * kb, n0 = 32 * nb;
#pragma unroll 8
    for (int i = 0; i < 32; ++i) { const int kk = 2 * i + (lane >> 5); scr[kk * 33 + (lane & 31)] = W[(size_t)(k0 + kk) * N + n0 + (lane & 31)]; }
    LDS_WAIT(); asm volatile("" ::: "memory");
    const int c = lane & 3;
#pragma unroll
    for (int j = 0; j < 2; ++j) { const int n = (lane >> 2) + 16 * j; const LAS float* s = scr + (16 * c) * 33 + n;
        const float mxv = __builtin_bit_cast(float, cmax[n0 + n]); const float sc = mxv > 0.f ? mxv * (1.f / 127.f) : 1.f, inv = 1.f / sc;
        if (kb == 0 && c == 0) SB[n0 + n] = sc;
        v4u o;
#pragma unroll
        for (int q4 = 0; q4 < 4; ++q4) { unsigned a = 0;
#pragma unroll
            for (int b = 0; b < 4; ++b) { int q = (int)rintf(s[(4 * q4 + b) * 33] * inv); q = q > 127 ? 127 : (q < -127 ? -127 : q); a |= ((unsigned)q & 0xffu) << (8 * b); }
            o[q4] = a; }
        *(v4u*)(WT + (size_t)(n0 + n) * K + k0 + 16 * c) = o; }
    LDS_WAIT(); asm volatile("" ::: "memory");
}
__device__ __forceinline__ void p0_q_load(HRows& r, const float* src, int e0, int e1, int lane) {
    const f32x4* p0 = (const f32x4*)(src + (size_t)e0 * 1024 + 16 * lane); const f32x4* p1 = (const f32x4*)(src + (size_t)e1 * 1024 + 16 * lane);
#pragma unroll
    for (int j = 0; j < 4; ++j) { r.v0[j] = p0[j]; r.v1[j] = p1[j]; }
}
template <bool FP8>
__device__ __forceinline__ void p0_quant_rows2(const HRows& in, const float* gmul, unsigned char* dst, float* scale_out, int e0, int e1, int lane) {
    f32x4 v[2][4];
#pragma unroll
    for (int j = 0; j < 4; ++j) { v[0][j] = in.v0[j]; v[1][j] = in.v1[j]; }
    if (gmul) { const f32x4* gp = (const f32x4*)(gmul + 16 * lane);
#pragma unroll
        for (int j = 0; j < 4; ++j) { const f32x4 gg = gp[j]; v[0][j] = v[0][j] * gg; v[1][j] = v[1][j] * gg; } }
#pragma unroll
    for (int r = 0; r < 2; ++r) {
        float mx = 0.f;
#pragma unroll
        for (int j = 0; j < 4; ++j) mx = fmaxf(mx, fmaxf(fmaxf(fabsf(v[r][j].x), fabsf(v[r][j].y)), fmaxf(fabsf(v[r][j].z), fabsf(v[r][j].w))));
        mx = wave_max(mx);
        const float sc = mx > 0.f ? mx * (FP8 ? (1.f / 448.f) : (1.f / 127.f)) : 1.f, inv = 1.f / sc;
        v4u w;
#pragma unroll
        for (int j = 0; j < 4; ++j) {
            if (FP8) { int pk = __builtin_amdgcn_cvt_pk_fp8_f32(v[r][j].x * inv, v[r][j].y * inv, 0, false); pk = __builtin_amdgcn_cvt_pk_fp8_f32(v[r][j].z * inv, v[r][j].w * inv, pk, true); w[j] = (unsigned)pk; }
            else { unsigned acc = 0;
#pragma unroll
                for (int c = 0; c < 4; ++c) { int q = (int)rintf(v[r][j][c] * inv); q = q > 127 ? 127 : (q < -127 ? -127 : q); acc |= ((unsigned)q & 0xffu) << (8 * c); }
                w[j] = acc; }
        }
        const int e = r ? e1 : e0;
        *(v4u*)(dst + ((size_t)(lane >> 3) * NE + e) * 128 + 16 * (lane & 7)) = w;
        if (lane == 0) scale_out[e] = sc;
    }
}

__device__ __forceinline__ float ubf(unsigned w, int b) { return (float)((w >> (8 * b)) & 0xffu); }
typedef pg8::f32x4 (&AccRef)[2][2][4][2];
struct EpiZ {
    static constexpr bool PERM = true;
    unsigned char* O8; float* ZS; unsigned char* G8; const float* SA; const float* SB;
    __device__ __forceinline__ bool operator()(AccRef acc, const pg8::Unit& u, int wr, int wc, int fr, int fq) const {
        if (PROBE_SKIP_EPI == 1 && u.dup) return false;
        const int row0 = u.pm * 256 + wr * 64 + fr, col0 = u.pn * 256 + wc * 32 + 8 * fq;
        pg8::f32x4 sb[2][2];
#pragma unroll
        for (int bj = 0; bj < 2; ++bj) { sb[bj][0] = *(const pg8::f32x4*)(SB + col0 + bj * 128); sb[bj][1] = *(const pg8::f32x4*)(SB + col0 + bj * 128 + 4); }
        float sav[2][4];
#pragma unroll
        for (int ai = 0; ai < 2; ++ai)
#pragma unroll
            for (int m = 0; m < 4; ++m) sav[ai][m] = SA[row0 + ai * 128 + m * 16];
        asm volatile("" ::: "memory");
        const bool gate = u.pn >= 8;
#pragma unroll
        for (int ai = 0; ai < 2; ++ai)
#pragma unroll
            for (int m = 0; m < 4; ++m) { const int r = row0 + ai * 128 + m * 16; const float sa = sav[ai][m];
#pragma unroll
                for (int bj = 0; bj < 2; ++bj) { const pg8::i32x4 i0 = __builtin_bit_cast(pg8::i32x4, acc[ai][bj][m][0]), i1 = __builtin_bit_cast(pg8::i32x4, acc[ai][bj][m][1]);
                    pg8::f32x4 v0 = {(float)i0[0], (float)i0[1], (float)i0[2], (float)i0[3]}, v1 = {(float)i1[0], (float)i1[1], (float)i1[2], (float)i1[3]};
                    v0 = v0 * sb[bj][0] * sa; v1 = v1 * sb[bj][1] * sa;
                    if (!gate) {
                        float am = fmaxf(fmaxf(fmaxf(fabsf(v0[0]), fabsf(v0[1])), fmaxf(fabsf(v0[2]), fabsf(v0[3]))), fmaxf(fmaxf(fabsf(v1[0]), fabsf(v1[1])), fmaxf(fabsf(v1[2]), fabsf(v1[3]))));
                        am = fmaxf(am, xor16f(am)); am = fmaxf(am, xor32f(am));
                        const float sc = am > 0.f ? am * (1.f / 127.f) : 1.f, inv = __builtin_amdgcn_rcpf(sc) * 0.99999f;
#define QZ(x) __builtin_bit_cast(unsigned, fmaf((x), inv, 12582912.f + 128.f))
#define PK4(a, b, c, d) (__builtin_amdgcn_perm(QZ(b), QZ(a), 0x0c0c0400u) | (__builtin_amdgcn_perm(QZ(d), QZ(c), 0x0c0c0400u) << 16))
                        v2u w;
                        w.x = PK4(v0[0], v0[1], v0[2], v0[3]); w.y = PK4(v1[0], v1[1], v1[2], v1[3]);
#undef PK4
#undef QZ
                        *(v2u*)(O8 + (size_t)r * 2048 + col0 + bj * 128) = w;
                        if (fq == 0) ZS[(size_t)r * 64 + ((col0 + bj * 128) >> 5)] = sc;
                    } else { v2u w;
#define SQ(x) __builtin_bit_cast(unsigned, fmaxf(255.f * __builtin_amdgcn_rcpf(1.f + __builtin_amdgcn_exp2f((x) * -1.44269504089f)), 1.f) + 12582912.f)
#define PK4(a, b, c, d) (__builtin_amdgcn_perm(SQ(b), SQ(a), 0x0c0c0400u) | (__builtin_amdgcn_perm(SQ(d), SQ(c), 0x0c0c0400u) << 16))
                        w.x = PK4(v0[0], v0[1], v0[2], v0[3]); w.y = PK4(v1[0], v1[1], v1[2], v1[3]);
#undef PK4
#undef SQ
                        *(v2u*)(G8 + (size_t)r * 2048 + (col0 - 2048) + bj * 128) = w; } } }
        return false;
    }
};
__device__ __forceinline__ float einv(float x) { return 1.f + __builtin_amdgcn_exp2f(x * -1.44269504089f); }
__device__ __forceinline__ float sigm_ratio(float ga, float gb) { return einv(gb) * __builtin_amdgcn_rcpf(einv(ga)); }
__device__ __forceinline__ float iscale(float accbits_as_f, float r) { const int v = __builtin_bit_cast(int, accbits_as_f); const float y = fminf(fmaxf((float)v * r, -2.0e9f), 2.0e9f); return __builtin_bit_cast(float, (int)rintf(y)); }
struct EpiGate {
    static constexpr bool PERM = true;
    const unsigned char* G8; bf16* Mo; const float* SPC;
    __device__ __forceinline__ bool operator()(AccRef acc, const pg8::Unit& u, int wr, int wc, int fr, int fq) const {
        const int row0 = u.pm * 256 + wr * 64 + fr, col0 = u.pn * 256 + wc * 32 + 8 * fq;
        const unsigned goff0 = (unsigned)row0 * 2048u + (unsigned)col0;
        if (u.seg == 0) {
#pragma unroll
            for (int ai = 0; ai < 2; ++ai)
#pragma unroll
            for (int mh = 0; mh < 2; ++mh) {
                v2u ga[2][2], gb[2][2];
#pragma unroll
                for (int mm = 0; mm < 2; ++mm) { const unsigned go = goff0 + (unsigned)((ai * 128 + (2 * mh + mm) * 16) * 2048);
#pragma unroll
                    for (int bj = 0; bj < 2; ++bj) { ga[mm][bj] = *(const v2u*)(G8 + go + bj * 128); gb[mm][bj] = *(const v2u*)(G8 + go + 1024 + bj * 128); } }
                asm volatile("" ::: "memory");
#pragma unroll
                for (int mm = 0; mm < 2; ++mm)
#pragma unroll
                    for (int bj = 0; bj < 2; ++bj) { const v2u a = ga[mm][bj], b = gb[mm][bj]; const int m = 2 * mh + mm;
                        pg8::f32x4& v0 = acc[ai][bj][m][0]; pg8::f32x4& v1 = acc[ai][bj][m][1];
#pragma unroll
                        for (int e = 0; e < 4; ++e) { v0[e] = iscale(v0[e], ubf(a.x, e) * __builtin_amdgcn_rcpf(ubf(b.x, e))); v1[e] = iscale(v1[e], ubf(a.y, e) * __builtin_amdgcn_rcpf(ubf(b.y, e))); } }
                asm volatile("" ::: "memory");
            }
            return true;
        }
#pragma unroll
        for (int ai = 0; ai < 2; ++ai)
#pragma unroll
        for (int mh = 0; mh < 2; ++mh) {
            v2u gb[2][2]; float sr[2];
#pragma unroll
            for (int mm = 0; mm < 2; ++mm) { const int ro = ai * 128 + (2 * mh + mm) * 16; const unsigned go = goff0 + (unsigned)(ro * 2048); sr[mm] = SPC[row0 + ro] * (1.f / 255.f);
#pragma unroll
                for (int bj = 0; bj < 2; ++bj) gb[mm][bj] = *(const v2u*)(G8 + go + 1024 + bj * 128); }
            asm volatile("" ::: "memory");
#pragma unroll
            for (int mm = 0; mm < 2; ++mm) { const int m = 2 * mh + mm; const size_t r = (size_t)(row0 + ai * 128 + m * 16); bf16* mo = Mo + r * D + col0; const float rs = sr[mm];
#pragma unroll
                for (int bj = 0; bj < 2; ++bj) { const v2u b = gb[mm][bj];
                    const pg8::i32x4 i0 = __builtin_bit_cast(pg8::i32x4, acc[ai][bj][m][0]), i1 = __builtin_bit_cast(pg8::i32x4, acc[ai][bj][m][1]);
                    const pg8::f32x4 v0 = (pg8::f32x4){(float)i0[0], (float)i0[1], (float)i0[2], (float)i0[3]} * rs, v1 = (pg8::f32x4){(float)i1[0], (float)i1[1], (float)i1[2], (float)i1[3]} * rs; v4u w;
                    w.x = pg8::cvt_pk_bf16(v0[0] * ubf(b.x, 0), v0[1] * ubf(b.x, 1)); w.y = pg8::cvt_pk_bf16(v0[2] * ubf(b.x, 2), v0[3] * ubf(b.x, 3));
                    w.z = pg8::cvt_pk_bf16(v1[0] * ubf(b.y, 0), v1[1] * ubf(b.y, 1)); w.w = pg8::cvt_pk_bf16(v1[2] * ubf(b.y, 2), v1[3] * ubf(b.y, 3));
                    *(v4u*)(mo + bj * 128) = w; } }
            asm volatile("" ::: "memory");
        }
        return false;
    }
};
struct EpiRes {
    static constexpr bool PERM = true;
    const float* X; bf16* X1; float* SSQ;
    __device__ __forceinline__ bool operator()(AccRef acc, const pg8::Unit& u, int wr, int wc, int fr, int fq) const {
        if (PROBE_SKIP_EPI && u.dup) return false;
        const int row0 = u.pm * 256 + wr * 64 + fr, col0 = u.pn * 256 + wc * 32 + 8 * fq;
#pragma unroll
        for (int ai = 0; ai < 2; ++ai) {
            pg8::f32x4 xr[4][2][2];
#pragma unroll
            for (int m = 0; m < 4; ++m) { const float* xp = X + (size_t)(row0 + ai * 128 + m * 16) * D + col0;
#pragma unroll
                for (int bj = 0; bj < 2; ++bj) { xr[m][bj][0] = *(const pg8::f32x4*)(xp + bj * 128); xr[m][bj][1] = *(const pg8::f32x4*)(xp + bj * 128 + 4); } }
            asm volatile("" ::: "memory");
#pragma unroll
            for (int m = 0; m < 4; ++m) { const size_t r = (size_t)(row0 + ai * 128 + m * 16); bf16* o = X1 + r * D + col0; float ss = 0.f;
#pragma unroll
                for (int bj = 0; bj < 2; ++bj) { const pg8::f32x4 v0 = acc[ai][bj][m][0] + xr[m][bj][0], v1 = acc[ai][bj][m][1] + xr[m][bj][1];
                    ss += (v0[0] * v0[0] + v0[1] * v0[1]) + (v0[2] * v0[2] + v0[3] * v0[3]) + (v1[0] * v1[0] + v1[1] * v1[1]) + (v1[2] * v1[2] + v1[3] * v1[3]);
                    v4u w; w.x = pg8::cvt_pk_bf16(v0[0], v0[1]); w.y = pg8::cvt_pk_bf16(v0[2], v0[3]); w.z = pg8::cvt_pk_bf16(v1[0], v1[1]); w.w = pg8::cvt_pk_bf16(v1[2], v1[3]);
                    *(v4u*)(o + bj * 128) = w; }
                ss += xor16f(ss); ss += xor32f(ss);
                if (fq == 0) SSQ[r * 16 + u.pn * 4 + wc] = ss; }
            asm volatile("" ::: "memory");
        }
        return false;
    }
};
struct EpiScore {
    static constexpr bool PERM = true;
    const float* SXR; const float* SBP; _Float16* S;
    __device__ __forceinline__ bool operator()(AccRef acc, const pg8::Unit& u, int wr, int wc, int fr, int fq) const {
        if (PROBE_SKIP_EPI && u.dup) return false;
        const int row0 = u.pm * 256 + wr * 64 + fr, col0 = u.pn * 256 + wc * 32 + 8 * fq;
        pg8::f32x4 sb[2][2]; float rs[2][4];
#pragma unroll
        for (int bj = 0; bj < 2; ++bj) { sb[bj][0] = *(const pg8::f32x4*)(SBP + col0 + bj * 128); sb[bj][1] = *(const pg8::f32x4*)(SBP + col0 + bj * 128 + 4); }
#pragma unroll
        for (int ai = 0; ai < 2; ++ai)
#pragma unroll
            for (int m = 0; m < 4; ++m) rs[ai][m] = SXR[row0 + ai * 128 + m * 16];
        asm volatile("" ::: "memory");
#pragma unroll
        for (int ai = 0; ai < 2; ++ai)
#pragma unroll
            for (int m = 0; m < 4; ++m) { const size_t r = (size_t)(row0 + ai * 128 + m * 16);
                const float rstd = rs[ai][m];
                _Float16* o = S + r * NSC + col0;
#pragma unroll
                for (int bj = 0; bj < 2; ++bj) { const pg8::i32x4 i0 = __builtin_bit_cast(pg8::i32x4, acc[ai][bj][m][0]), i1 = __builtin_bit_cast(pg8::i32x4, acc[ai][bj][m][1]);
                    pg8::f32x4 v0 = {(float)i0[0], (float)i0[1], (float)i0[2], (float)i0[3]}, v1 = {(float)i1[0], (float)i1[1], (float)i1[2], (float)i1[3]};
                    v0 = v0 * sb[bj][0] * rstd; v1 = v1 * sb[bj][1] * rstd;
                    typedef _Float16 h2 __attribute__((ext_vector_type(2)));
                    h2 p0 = {(_Float16)v0[0], (_Float16)v0[1]}, p1 = {(_Float16)v0[2], (_Float16)v0[3]}, p2 = {(_Float16)v1[0], (_Float16)v1[1]}, p3 = {(_Float16)v1[2], (_Float16)v1[3]};
                    v4u w; w.x = __builtin_bit_cast(unsigned, p0); w.y = __builtin_bit_cast(unsigned, p1); w.z = __builtin_bit_cast(unsigned, p2); w.w = __builtin_bit_cast(unsigned, p3);
                    *(v4u*)(o + bj * 128) = w; } }
        return false;
    }
};

__device__ __forceinline__ void unpack8q(v2u w, float sc, float (&f)[8]) {
    const float bias = -128.f * sc;
    f[0] = fmaf(ubf(w.x, 0), sc, bias); f[1] = fmaf(ubf(w.x, 1), sc, bias); f[2] = fmaf(ubf(w.x, 2), sc, bias); f[3] = fmaf(ubf(w.x, 3), sc, bias);
    f[4] = fmaf(ubf(w.y, 0), sc, bias); f[5] = fmaf(ubf(w.y, 1), sc, bias); f[6] = fmaf(ubf(w.y, 2), sc, bias); f[7] = fmaf(ubf(w.y, 3), sc, bias);
}
__device__ __forceinline__ void p2_timemix(const unsigned char* Z8, const float* ZS, const float* convw, unsigned char* PA, unsigned char* CA, float* SPC, int gw, int NGW, int lane) {
    const int w = 2 << (lane >> 4);
    const int ch = 8 * lane;
    const int sg = lane >> 2;
    float cw0[8], cw1[8], cw2[8];
#pragma unroll
    for (int i = 0; i < 8; ++i) { cw0[i] = convw[ch + i]; cw1[i] = convw[512 + ch + i]; cw2[i] = convw[1024 + ch + i]; }
    for (int chunk = gw; chunk < M / 32; chunk += NGW) {
        const int t0 = chunk * 32, s0 = t0 & (SEQ - 1);
        float sum[8], up1[8], up2[8];
#pragma unroll
        for (int i = 0; i < 8; ++i) { sum[i] = 0.f; up1[i] = 0.f; up2[i] = 0.f; }
        if (s0 > 0) {
            for (int j = 1; j < 16; ++j) {
                if (j < w) { float f[8]; unpack8q(*(const v2u*)(Z8 + (size_t)(t0 - j) * 2048 + ch), ZS[(size_t)(t0 - j) * 64 + sg], f);
#pragma unroll
                    for (int i = 0; i < 8; ++i) sum[i] += f[i]; }
            }
            float c[8], v[8];
            unpack8q(*(const v2u*)(Z8 + (size_t)(t0 - 2) * 2048 + 512 + ch), ZS[(size_t)(t0 - 2) * 64 + 16 + sg], c); unpack8q(*(const v2u*)(Z8 + (size_t)(t0 - 2) * 2048 + 1536 + ch), ZS[(size_t)(t0 - 2) * 64 + 48 + sg], v);
#pragma unroll
            for (int i = 0; i < 8; ++i) up2[i] = c[i] * v[i];
            unpack8q(*(const v2u*)(Z8 + (size_t)(t0 - 1) * 2048 + 512 + ch), ZS[(size_t)(t0 - 1) * 64 + 16 + sg], c); unpack8q(*(const v2u*)(Z8 + (size_t)(t0 - 1) * 2048 + 1536 + ch), ZS[(size_t)(t0 - 1) * 64 + 48 + sg], v);
#pragma unroll
            for (int i = 0; i < 8; ++i) up1[i] = c[i] * v[i];
        }
        v2u nz, nc, nb, nv, nold; float qz, qc, qb, qv, qold;
#define P2_LOAD(tt, ss) { const unsigned char* zr = Z8 + (size_t)(tt) * 2048 + ch; const float* sr = ZS + (size_t)(tt) * 64 + sg; \
          nz = *(const v2u*)zr; nc = *(const v2u*)(zr + 512); nb = *(const v2u*)(zr + 1024); nv = *(const v2u*)(zr + 1536); qz = sr[0]; qc = sr[16]; qb = sr[32]; qv = sr[48]; \
          const int to = ((ss) + 1 - w >= 0) ? ((tt) + 1 - w) : (tt); nold = *(const v2u*)(Z8 + (size_t)to * 2048 + ch); qold = ZS[(size_t)to * 64 + sg]; }
        P2_LOAD(t0, s0)
        float po[8], poc[8], pmx = 0.f; int pt = t0;
#pragma unroll
        for (int i = 0; i < 8; ++i) { po[i] = 0.f; poc[i] = 0.f; }
#define QP(x) __builtin_bit_cast(unsigned, fmaf((x), iq, 12582912.f))
#define PK4(a_, b_, c_, d_) (__builtin_amdgcn_perm(QP(b_), QP(a_), 0x0c0c0400u) | (__builtin_amdgcn_perm(QP(d_), QP(c_), 0x0c0c0400u) << 16))
#define P2_FLUSH() { const float mxw = wave_max(pmx); const float scq = mxw > 0.f ? mxw * (1.f / 127.f) : 1.f, iq = __builtin_amdgcn_rcpf(scq) * 0.99999f; \
            *(v2u*)(PA + (size_t)pt * DP + ch) = (v2u){PK4(po[0], po[1], po[2], po[3]), PK4(po[4], po[5], po[6], po[7])}; \
            *(v2u*)(CA + (size_t)pt * DP + ch) = (v2u){PK4(poc[0], poc[1], poc[2], poc[3]), PK4(poc[4], poc[5], poc[6], poc[7])}; \
            if (lane == 0) SPC[pt] = scq; }
        for (int i2 = 0; i2 < 32; ++i2) {
            const int t = t0 + i2, s = s0 + i2;
            float zt[8], c[8], b[8], v[8], o[8], fo[8];
            unpack8q(nz, qz, zt); unpack8q(nc, qc, c); unpack8q(nb, qb, b); unpack8q(nv, qv, v); unpack8q(nold, qold, fo);
            { const int d1 = (i2 < 31) ? 1 : 0; P2_LOAD(t + d1, s + d1) }
            P2_FLUSH()
            const int cnt = (s + 1) < w ? (s + 1) : w; const float rc = 1.f / (float)cnt;
#pragma unroll
            for (int i = 0; i < 8; ++i) { sum[i] += zt[i]; o[i] = sum[i] * rc - zt[i]; }
            if (s + 1 - w >= 0) {
#pragma unroll
                for (int i = 0; i < 8; ++i) sum[i] -= fo[i]; }
            float oc[8];
#pragma unroll
            for (int i = 0; i < 8; ++i) { const float uu = c[i] * v[i]; oc[i] = b[i] * (cw0[i] * up2[i] + cw1[i] * up1[i] + cw2[i] * uu); up2[i] = up1[i]; up1[i] = uu; }
            float mx = 0.f;
#pragma unroll
            for (int i = 0; i < 8; ++i) { mx = fmaxf(mx, fmaxf(fabsf(o[i]), fabsf(oc[i]))); po[i] = o[i]; poc[i] = oc[i]; }
            pmx = mx; pt = t;
        }
        P2_FLUSH()
#undef P2_FLUSH
#undef PK4
#undef QP
#undef P2_LOAD
    }
}

#define TK_NEG (-3.0e38f)
__device__ __forceinline__ void tk_ce(float& a, float& b) { const float hi = fmaxf(a, b), lo = fminf(a, b); a = hi; b = lo; }
__device__ __forceinline__ void tk_sort8(float (&v)[8]) {
    tk_ce(v[0], v[1]); tk_ce(v[2], v[3]); tk_ce(v[4], v[5]); tk_ce(v[6], v[7]);
    tk_ce(v[0], v[2]); tk_ce(v[1], v[3]); tk_ce(v[4], v[6]); tk_ce(v[5], v[7]);
    tk_ce(v[1], v[2]); tk_ce(v[5], v[6]);
    tk_ce(v[0], v[4]); tk_ce(v[1], v[5]); tk_ce(v[2], v[6]); tk_ce(v[3], v[7]);
    tk_ce(v[2], v[4]); tk_ce(v[3], v[5]);
    tk_ce(v[1], v[2]); tk_ce(v[3], v[4]); tk_ce(v[5], v[6]);
}
__device__ __forceinline__ void tk_bmerge16(float (&x)[16]) {
#pragma unroll
    for (int i = 0; i < 8; ++i) tk_ce(x[i], x[i + 8]);
#pragma unroll
    for (int b = 0; b < 16; b += 8)
#pragma unroll
        for (int i = 0; i < 4; ++i) tk_ce(x[b + i], x[b + i + 4]);
#pragma unroll
    for (int b = 0; b < 16; b += 4)
#pragma unroll
        for (int i = 0; i < 2; ++i) tk_ce(x[b + i], x[b + i + 2]);
#pragma unroll
    for (int b = 0; b < 16; b += 2) tk_ce(x[b], x[b + 1]);
}
__device__ __forceinline__ void tk_add16(float (&L)[16], float (&a)[8], float (&b)[8]) {
    tk_sort8(a); tk_sort8(b);
    float s[16];
#pragma unroll
    for (int i = 0; i < 8; ++i) { s[i] = a[i]; s[8 + i] = b[7 - i]; }
    tk_bmerge16(s);
#pragma unroll
    for (int i = 0; i < 16; ++i) L[i] = fmaxf(L[i], s[15 - i]);
    tk_bmerge16(L);
}
__device__ __forceinline__ void tk_final(const float (&A)[16], const float (&B)[16], float (&FV)[16]) {
    float av[16], bv[16];
#pragma unroll
    for (int i = 0; i < 16; ++i) { av[i] = __builtin_bit_cast(float, __builtin_bit_cast(unsigned, A[i]) & ~0x7fu); bv[i] = __builtin_bit_cast(float, __builtin_bit_cast(unsigned, B[i]) & ~0x7fu); }
#pragma unroll
    for (int j = 0; j < 16; ++j) FV[j] = __builtin_bit_cast(float, (__builtin_bit_cast(unsigned, av[0] + bv[j]) & ~0xffu) | (unsigned)j);
#pragma unroll
    for (int i = 1; i < 16; ++i)
#pragma unroll
        for (int j = 0; j < 16; ++j)
            if ((i + 1) * (j + 1) <= 16) {
                float x = __builtin_bit_cast(float, (__builtin_bit_cast(unsigned, av[i] + bv[j]) & ~0xffu) | (unsigned)(i * 16 + j));
#pragma unroll
                for (int s = (i + 1) * (j + 1) - 1; s < 16; ++s) { const float hi = fmaxf(FV[s], x); x = fminf(FV[s], x); FV[s] = hi; }
            }
}

__device__ __forceinline__ void tk_unpack_octets(const v4u d0, const v4u d1, unsigned kb0, float (&a)[8], float (&b)[8]) {
    const unsigned w0[4] = {d0.x, d0.y, d0.z, d0.w}, w1[4] = {d1.x, d1.y, d1.z, d1.w};
#pragma unroll
    for (int e = 0; e < 8; ++e) {
        const unsigned ha = (e & 1) ? (w0[e >> 1] >> 16) : (w0[e >> 1] & 0xffffu), hb = (e & 1) ? (w1[e >> 1] >> 16) : (w1[e >> 1] & 0xffffu);
        const float fa = (float)__builtin_bit_cast(_Float16, (unsigned short)ha), fb = (float)__builtin_bit_cast(_Float16, (unsigned short)hb);
        a[e] = __builtin_bit_cast(float, __builtin_bit_cast(unsigned, fa) | (kb0 - (unsigned)e));
        b[e] = __builtin_bit_cast(float, __builtin_bit_cast(unsigned, fb) | (kb0 - 8u - (unsigned)e));
    }
}
__device__ __forceinline__ void tk_emit(const float (&LA)[16], const float (&LB)[16], LAS unsigned char* kl, size_t r, unsigned short* IDX, float* EV, float* INV) {
    float FV[16];
    tk_final(LA, LB, FV);
#pragma unroll
    for (int q = 0; q < 4; ++q) { unsigned wa = 0, wb = 0;
#pragma unroll
        for (int e = 0; e < 4; ++e) { wa |= (127u - (__builtin_bit_cast(unsigned, LA[4 * q + e]) & 0x7fu)) << (8 * e); wb |= (127u - (__builtin_bit_cast(unsigned, LB[4 * q + e]) & 0x7fu)) << (8 * e); }
        *(LAS unsigned*)(kl + 4 * q) = wa; *(LAS unsigned*)(kl + 16 + 4 * q) = wb; }
    asm volatile("s_waitcnt lgkmcnt(0)" ::: "memory");
    int FI[16]; float ev[16]; float sum = 0.f;
    const float top = __builtin_bit_cast(float, __builtin_bit_cast(unsigned, FV[0]) & ~0xffu);
#pragma unroll
    for (int s = 0; s < 16; ++s) { const unsigned u = __builtin_bit_cast(unsigned, FV[s]); const unsigned ci = (u >> 4) & 15u, cj = u & 15u;
        const unsigned ka = *(const LAS unsigned char*)(kl + ci), kb = *(const LAS unsigned char*)(kl + 16 + cj);
        FI[s] = (int)(ka * 128u + kb);
        ev[s] = __expf(__builtin_bit_cast(float, u & ~0xffu) - top); sum += ev[s]; }
    v4u i0, i1;
    i0.x = (unsigned)FI[0] | ((unsigned)FI[1] << 16); i0.y = (unsigned)FI[2] | ((unsigned)FI[3] << 16); i0.z = (unsigned)FI[4] | ((unsigned)FI[5] << 16); i0.w = (unsigned)FI[6] | ((unsigned)FI[7] << 16);
    i1.x = (unsigned)FI[8] | ((unsigned)FI[9] << 16); i1.y = (unsigned)FI[10] | ((unsigned)FI[11] << 16); i1.z = (unsigned)FI[12] | ((unsigned)FI[13] << 16); i1.w = (unsigned)FI[14] | ((unsigned)FI[15] << 16);
    *(v4u*)(IDX + r * 16) = i0; *(v4u*)(IDX + r * 16 + 8) = i1;
#pragma unroll
    for (int q = 0; q < 4; ++q) *(f32x4*)(EV + r * 16 + 4 * q) = (f32x4){ev[4 * q], ev[4 * q + 1], ev[4 * q + 2], ev[4 * q + 3]};
    INV[r] = 1.f / sum;
}
__device__ __forceinline__ void p6_topk(const _Float16* S, unsigned short* IDX, float* EV, float* INV, LAS unsigned char* lds, int gw, int NGW, int wave, int lane) {
    LAS unsigned char* my = lds + wave * 10240;
    const int srow = lane >> 2, schn = lane & 3;
    v4u nx[8];
    { const char* b0 = (const char*)S + (size_t)GRP_QREV(gw) * 128 * 512;
#pragma unroll
      for (int q = 0; q < 8; ++q) nx[q] = *(const v4u*)(b0 + (size_t)(16 * q + srow) * 512 + 16 * schn); }
    for (int lg = gw; lg < M * NH / 128; lg += NGW) {
        const int grp = GRP_QREV(lg);
        const char* base = (const char*)S + (size_t)grp * 128 * 512;
        const char* nbase = (const char*)S + (size_t)GRP_QREV((lg + NGW) < M * NH / 128 ? (lg + NGW) : lg) * 128 * 512;
        float LA0[16], LB0[16], LA1[16], LB1[16];
#pragma unroll
        for (int half = 0; half < 2; ++half) {
            float L0[16], L1[16];
#pragma unroll
            for (int i = 0; i < 16; ++i) { L0[i] = TK_NEG; L1[i] = TK_NEG; }
#pragma unroll 1
            for (int step = 0; step < 4; ++step) {
                const int j = half * 4 + step;
#pragma unroll
                for (int q = 0; q < 8; ++q) *(LAS v4u*)(my + (16 * q + srow) * 80 + 16 * schn) = nx[q];
                asm volatile("s_waitcnt lgkmcnt(0)" ::: "memory");
                { const char* pb = (j < 7) ? base + 64 * (j + 1) : nbase;
#pragma unroll
                  for (int q = 0; q < 8; ++q) nx[q] = *(const v4u*)(pb + (size_t)(16 * q + srow) * 512 + 16 * schn); }
                const LAS unsigned char* r0p = my + lane * 80; const LAS unsigned char* r1p = my + (lane + 64) * 80;
                const v4u a0 = *(const LAS v4u*)(r0p), a1 = *(const LAS v4u*)(r0p + 16), a2 = *(const LAS v4u*)(r0p + 32), a3 = *(const LAS v4u*)(r0p + 48);
                const v4u c0 = *(const LAS v4u*)(r1p), c1 = *(const LAS v4u*)(r1p + 16), c2 = *(const LAS v4u*)(r1p + 32), c3 = *(const LAS v4u*)(r1p + 48);
                const unsigned kb0 = (unsigned)(127 - step * 32);
                float pa[8], pb2[8], qa[8], qb[8];
                tk_unpack_octets(a0, a1, kb0, pa, pb2); tk_unpack_octets(c0, c1, kb0, qa, qb);
                tk_add16(L0, pa, pb2); tk_add16(L1, qa, qb);
                tk_unpack_octets(a2, a3, kb0 - 16u, pa, pb2); tk_unpack_octets(c2, c3, kb0 - 16u, qa, qb);
                tk_add16(L0, pa, pb2); tk_add16(L1, qa, qb);
                asm volatile("s_waitcnt lgkmcnt(0)" ::: "memory");
            }
#pragma unroll
            for (int i = 0; i < 16; ++i) { if (half == 0) { LA0[i] = L0[i]; LA1[i] = L1[i]; } else { LB0[i] = L0[i]; LB1[i] = L1[i]; } }
        }
        tk_emit(LA0, LB0, my + lane * 80, (size_t)grp * 128 + lane, IDX, EV, INV);
        tk_emit(LA1, LB1, my + (lane + 64) * 80, (size_t)grp * 128 + 64 + lane, IDX, EV, INV);
        asm volatile("s_waitcnt lgkmcnt(0)" ::: "memory");
    }
}

typedef float v2f __attribute__((ext_vector_type(2)));
__device__ __forceinline__ int q_pull(unsigned* heads, int s, int lane) { int it = 0; if (lane == 0) it = (int)__hip_atomic_fetch_add(heads + 64 * s, 1u, __ATOMIC_RELAXED, __HIP_MEMORY_SCOPE_AGENT); return __builtin_amdgcn_readfirstlane(it); }

struct UIdx { v4u ia, ib; };
struct UBuf { v4u ur[16]; v4u xa, xb; };
__device__ __forceinline__ void u_idx(UIdx& p, int t, const unsigned short* IDX, int lane) { const unsigned short* ip = IDX + (size_t)t * 128 + (lane >> 3) * 16; p.ia = *(const v4u*)ip; p.ib = *(const v4u*)(ip + 8); }
__device__ __forceinline__ void u_gather(UBuf& b, const UIdx& p, int s, int t, const bf16* X1, const unsigned char* U8, int lane) {
    const int c = lane & 7;
    const unsigned iw[8] = {p.ia.x, p.ia.y, p.ia.z, p.ia.w, p.ib.x, p.ib.y, p.ib.z, p.ib.w};
    const unsigned char* ub = U8 + (size_t)s * NE * 128 + 16 * c;
#pragma unroll
    for (int i = 0; i < 16; ++i) { const unsigned e = (i & 1) ? (iw[i >> 1] >> 16) : (iw[i >> 1] & 0xffffu); b.ur[i] = *(const v4u*)(ub + (size_t)e * 128); }
    const bf16* xp = X1 + (size_t)t * D + 128 * s + 16 * c;
    b.xa = *(const v4u*)xp; b.xb = *(const v4u*)(xp + 8);
}
__device__ __forceinline__ void u_compute(const UBuf& bf, int s, int t, float* PART, int lane) {
    float xv[16];
    { float f[8]; unpack8(bf.xa, f);
#pragma unroll
      for (int i = 0; i < 8; ++i) xv[i] = f[i];
      unpack8(bf.xb, f);
#pragma unroll
      for (int i = 0; i < 8; ++i) xv[8 + i] = f[i]; }
    float mx = 0.f;
#pragma unroll
    for (int i = 0; i < 16; ++i) mx = fmaxf(mx, fabsf(xv[i]));
    mx = fmaxf(mx, __shfl_xor(mx, 1)); mx = fmaxf(mx, __shfl_xor(mx, 2)); mx = fmaxf(mx, __shfl_xor(mx, 4));
    const float sx = mx > 0.f ? mx * (1.f / 127.f) : 1.f, isx = 1.f / sx;
    int xq[4];
#pragma unroll
    for (int j = 0; j < 4; ++j) { unsigned a = 0;
#pragma unroll
        for (int b = 0; b < 4; ++b) { int q = (int)rintf(xv[4 * j + b] * isx); q = q > 127 ? 127 : (q < -127 ? -127 : q); a |= ((unsigned)q & 0xffu) << (8 * b); }
        xq[j] = (int)a; }
    int p[16];
#pragma unroll
    for (int i = 0; i < 16; ++i) { int a = __builtin_amdgcn_sdot4((int)bf.ur[i].x, xq[0], 0, false); a = __builtin_amdgcn_sdot4((int)bf.ur[i].y, xq[1], a, false);
        a = __builtin_amdgcn_sdot4((int)bf.ur[i].z, xq[2], a, false); a = __builtin_amdgcn_sdot4((int)bf.ur[i].w, xq[3], a, false); p[i] = a; }
    int r8[8], r4[4], r2[2];
    const bool b2 = lane & 4, b1 = lane & 2, b0 = lane & 1;
#pragma unroll
    for (int i = 0; i < 8; ++i) { const int snd = b2 ? p[i] : p[i + 8], kp = b2 ? p[i + 8] : p[i]; r8[i] = kp + __shfl_xor(snd, 4); }
#pragma unroll
    for (int i = 0; i < 4; ++i) { const int snd = b1 ? r8[i] : r8[i + 4], kp = b1 ? r8[i + 4] : r8[i]; r4[i] = kp + __shfl_xor(snd, 2); }
#pragma unroll
    for (int i = 0; i < 2; ++i) { const int snd = b0 ? r4[i] : r4[i + 2], kp = b0 ? r4[i + 2] : r4[i]; r2[i] = kp + __shfl_xor(snd, 1); }
    *(v2f*)(PART + ((size_t)s * M + t) * 128 + 2 * lane) = (v2f){(float)r2[0] * sx, (float)r2[1] * sx};
}
__device__ __forceinline__ void u_finish(const int (&p)[16], float sx, int s, int t, unsigned* PART, int lane) {
    int r8[8], r4[4], r2[2];
    const bool b2 = lane & 4, b1 = lane & 2, b0 = lane & 1;
#pragma unroll
    for (int i = 0; i < 8; ++i) { const int snd = b2 ? p[i] : p[i + 8], kp = b2 ? p[i + 8] : p[i]; r8[i] = kp + xor4i(snd); }
#pragma unroll
    for (int i = 0; i < 4; ++i) { const int snd = b1 ? r8[i] : r8[i + 4], kp = b1 ? r8[i + 4] : r8[i]; r4[i] = kp + xor2i(snd); }
#pragma unroll
    for (int i = 0; i < 2; ++i) { const int snd = b0 ? r4[i] : r4[i + 2], kp = b0 ? r4[i + 2] : r4[i]; r2[i] = kp + xor1i(snd); }
    typedef _Float16 h2 __attribute__((ext_vector_type(2)));
    const h2 pr = {(_Float16)((float)r2[0] * sx), (_Float16)((float)r2[1] * sx)};
    PART[((size_t)s * M + t) * 64 + lane] = __builtin_bit_cast(unsigned, pr);
}
#define IDX_E(iw, i) (((i) & 1) ? ((iw)[(i) >> 1] >> 16) : ((iw)[(i) >> 1] & 0xffffu))
struct QStream { unsigned* heads; int ps, tried; int cs, ct0, ns, nt0, pos; };
__device__ __forceinline__ bool qs_pull(QStream& q, int& os, int& ot0, int lane) {
    for (;;) { const int it = q_pull(q.heads, q.ps, lane); if (it < M / TPI) { os = q.ps; ot0 = it * TPI; return true; } if (++q.tried >= 8) return false; q.ps = (q.ps + 1) & 7; }
}
__device__ __forceinline__ bool qs_init(QStream& q, unsigned* heads, unsigned xcc, int lane) {
    q.heads = heads; q.ps = (int)(xcc & 7u); q.tried = 0; q.pos = 0; q.ns = 0; q.nt0 = -1;
    if (!qs_pull(q, q.cs, q.ct0, lane)) return false;
    if (!qs_pull(q, q.ns, q.nt0, lane)) q.nt0 = -1;
    return true;
}
__device__ __forceinline__ void qs_peek(const QStream& q, int k, int& s, int& t) {
    int p = q.pos + k;
    if (p < TPI) { s = q.cs; t = q.ct0 + p; }
    else if (q.nt0 >= 0) { s = q.ns; t = q.nt0 + (p - TPI); }
    else { s = q.cs; t = q.ct0 + TPI - 1; }
}
__device__ __forceinline__ bool qs_advance2(QStream& q, int lane) {
    q.pos += 2;
    if (q.pos >= TPI) { if (q.nt0 < 0) return false; q.pos = 0; q.cs = q.ns; q.ct0 = q.nt0; if (!qs_pull(q, q.ns, q.nt0, lane)) q.nt0 = -1; }
    return true;
}
__device__ __forceinline__ void p7_u_phase(unsigned* heads, unsigned xcc, const unsigned char* X1q, const float* SX, const unsigned short* IDX, const unsigned char* U8, unsigned* PART, int lane) {
    const int c = lane & 7;
    QStream q;
    if (!qs_init(q, heads, xcc, lane)) return;
    const unsigned char* ub0 = U8; const unsigned c16 = 16u * (unsigned)c; const unsigned char* xb0 = X1q + 16 * c;
    v4u ring[32]; v4u xA, xB; float sA, sB; UIdx iN, iM;
    { int s0, t0, s1, t1; qs_peek(q, 0, s0, t0); qs_peek(q, 1, s1, t1);
      UIdx iA, iB; u_idx(iA, t0, IDX, lane); u_idx(iB, t1, IDX, lane);
      const unsigned wa[8] = {iA.ia.x, iA.ia.y, iA.ia.z, iA.ia.w, iA.ib.x, iA.ib.y, iA.ib.z, iA.ib.w}, wb[8] = {iB.ia.x, iB.ia.y, iB.ia.z, iB.ia.w, iB.ib.x, iB.ib.y, iB.ib.z, iB.ib.w};
      const unsigned char* ua = ub0 + (size_t)s0 * NE * 128; const unsigned char* ubb = ub0 + (size_t)s1 * NE * 128;
#pragma unroll
      for (int r = 0; r < 16; ++r) ring[r] = *(const v4u*)(ua + (IDX_E(wa, r) * 128u + c16));
      xA = *(const v4u*)(xb0 + (size_t)t0 * D + 128 * s0); sA = SX[t0];
#pragma unroll
      for (int r = 0; r < 16; ++r) ring[16 + r] = *(const v4u*)(ubb + (IDX_E(wb, r) * 128u + c16));
      xB = *(const v4u*)(xb0 + (size_t)t1 * D + 128 * s1); sB = SX[t1];
      int s2, t2, s3, t3; qs_peek(q, 2, s2, t2); qs_peek(q, 3, s3, t3);
      u_idx(iN, t2, IDX, lane); u_idx(iM, t3, IDX, lane); }
#pragma unroll 1
    for (;;) {
        int s0, t0, s1, t1, s2, t2, s3, t3, s4, t4, s5, t5;
        qs_peek(q, 0, s0, t0); qs_peek(q, 1, s1, t1); qs_peek(q, 2, s2, t2); qs_peek(q, 3, s3, t3); qs_peek(q, 4, s4, t4); qs_peek(q, 5, s5, t5);
        int p[16];
        {
            const int x0 = (int)xA.x, x1 = (int)xA.y, x2 = (int)xA.z, x3 = (int)xA.w; const float sx = sA;
            const unsigned wn[8] = {iN.ia.x, iN.ia.y, iN.ia.z, iN.ia.w, iN.ib.x, iN.ib.y, iN.ib.z, iN.ib.w};
            const unsigned char* un = ub0 + (size_t)s2 * NE * 128;
#pragma unroll
            for (int r = 0; r < 16; ++r) { int a = __builtin_amdgcn_sdot4((int)ring[r].x, x0, 0, false); a = __builtin_amdgcn_sdot4((int)ring[r].y, x1, a, false);
                a = __builtin_amdgcn_sdot4((int)ring[r].z, x2, a, false); a = __builtin_amdgcn_sdot4((int)ring[r].w, x3, a, false); p[r] = a;
                ring[r] = *(const v4u*)(un + (IDX_E(wn, r) * 128u + c16)); }
            xA = *(const v4u*)(xb0 + (size_t)t2 * D + 128 * s2); sA = SX[t2];
            u_idx(iN, t4, IDX, lane);
            u_finish(p, sx, s0, t0, PART, lane);
        }
        {
            const int x0 = (int)xB.x, x1 = (int)xB.y, x2 = (int)xB.z, x3 = (int)xB.w; const float sx = sB;
            const unsigned wn[8] = {iM.ia.x, iM.ia.y, iM.ia.z, iM.ia.w, iM.ib.x, iM.ib.y, iM.ib.z, iM.ib.w};
            const unsigned char* un = ub0 + (size_t)s3 * NE * 128;
#pragma unroll
            for (int r = 0; r < 16; ++r) { int a = __builtin_amdgcn_sdot4((int)ring[16 + r].x, x0, 0, false); a = __builtin_amdgcn_sdot4((int)ring[16 + r].y, x1, a, false);
                a = __builtin_amdgcn_sdot4((int)ring[16 + r].z, x2, a, false); a = __builtin_amdgcn_sdot4((int)ring[16 + r].w, x3, a, false); p[r] = a;
                ring[16 + r] = *(const v4u*)(un + (IDX_E(wn, r) * 128u + c16)); }
            xB = *(const v4u*)(xb0 + (size_t)t3 * D + 128 * s3); sB = SX[t3];
            u_idx(iM, t5, IDX, lane);
            u_finish(p, sx, s1, t1, PART, lane);
        }
        if (!qs_advance2(q, lane)) break;
    }
}
__device__ __forceinline__ void p8_w_phase(const unsigned* PART, const float* RSTD, const unsigned short* IDX, const float* EV, const float* INV, const float* SU, const float* SV, unsigned short* WQ, float* SWH, int gw, int NGW, int lane) {
    typedef _Float16 h2 __attribute__((ext_vector_type(2)));
    for (int tb = gw; tb < M; tb += 4 * NGW) {
        unsigned pp[4][8], ip[4]; v2f evp[4]; float iv[4], rs[4];
#pragma unroll
        for (int q = 0; q < 4; ++q) { const int t = ROW_REV(tb + q * NGW);
#pragma unroll
            for (int x = 0; x < 8; ++x) pp[q][x] = PART[((size_t)x * M + t) * 64 + lane];
            ip[q] = *(const unsigned*)(IDX + (size_t)t * 128 + 2 * lane); evp[q] = *(const v2f*)(EV + (size_t)t * 128 + 2 * lane); iv[q] = INV[(size_t)t * NH + (lane >> 3)]; rs[q] = RSTD[t]; }
        float su0[4], su1[4], sv0[4], sv1[4];
#pragma unroll
        for (int q = 0; q < 4; ++q) { const int e0 = (int)(ip[q] & 0xffffu), e1 = (int)(ip[q] >> 16); su0[q] = SU[e0]; su1[q] = SU[e1]; sv0[q] = SV[e0]; sv1[q] = SV[e1]; }
#pragma unroll
        for (int q = 0; q < 4; ++q) { const int t = ROW_REV(tb + q * NGW);
            float a0 = 0.f, a1 = 0.f;
#pragma unroll
            for (int x = 0; x < 8; ++x) { const h2 v = __builtin_bit_cast(h2, pp[q][x]); a0 += (float)v[0]; a1 += (float)v[1]; }
            const float act0 = a0 * su0[q] * rs[q], act1 = a1 * su1[q] * rs[q];
            const float w0 = evp[q].x * iv[q] * (0.5f * act0 * (1.f + erff(act0 * 0.70710678118654752f))) * sv0[q];
            const float w1 = evp[q].y * iv[q] * (0.5f * act1 * (1.f + erff(act1 * 0.70710678118654752f))) * sv1[q];
            const float mx = wave_max(fmaxf(fabsf(w0), fabsf(w1)));
            const float sw = mx > 0.f ? mx * (1.f / 127.f) : 1.f, isw = 1.f / sw;
            int q0 = (int)rintf(w0 * isw), q1 = (int)rintf(w1 * isw); q0 = q0 > 127 ? 127 : (q0 < -127 ? -127 : q0); q1 = q1 > 127 ? 127 : (q1 < -127 ? -127 : q1);
            WQ[(size_t)t * 64 + lane] = (unsigned short)(((unsigned)q0 & 0xffu) | (((unsigned)q1 & 0xffu) << 8));
            if ((lane & 7) == 0) SWH[(size_t)t * NH + (lane >> 3)] = sw; }
    }
}
struct VBuf { v4u vr[16]; v4u w4; float sw; unsigned xw; };
__device__ __forceinline__ void v_gather(VBuf& b, const UIdx& p, int s, int t, const bf16* X1, const unsigned short* WQ, const float* SWH, const unsigned char* V8, int lane) {
    const int c = lane & 7, g = lane >> 3;
    const unsigned iw[8] = {p.ia.x, p.ia.y, p.ia.z, p.ia.w, p.ib.x, p.ib.y, p.ib.z, p.ib.w};
    const unsigned char* vb = V8 + (size_t)s * NE * 128; const unsigned c16 = 16u * (unsigned)c;
#pragma unroll
    for (int i = 0; i < 16; ++i) { const unsigned e = (i & 1) ? (iw[i >> 1] >> 16) : (iw[i >> 1] & 0xffffu); b.vr[i] = *(const v4u*)(vb + (e * 128u + c16)); }
    b.w4 = *(const v4u*)((const unsigned char*)WQ + (size_t)t * 128 + 16 * g); b.sw = SWH[(size_t)t * NH + g];
    b.xw = *(const unsigned*)(X1 + (size_t)t * D + 128 * s + 2 * lane);
}
__device__ __forceinline__ void v_compute(VBuf& bf, int s, int t, bf16* out, float* SSQ2, int lane, float& ssv, int pos, const UIdx& nidx, int ns, int nt, const bf16* X1, const unsigned short* WQ, const float* SWH, const unsigned char* V8) {
    const int c = lane & 7, g = lane >> 3;
    const unsigned niw[8] = {nidx.ia.x, nidx.ia.y, nidx.ia.z, nidx.ia.w, nidx.ib.x, nidx.ib.y, nidx.ib.z, nidx.ib.w};
    const unsigned char* nvb = V8 + (size_t)ns * NE * 128; const unsigned c16 = 16u * (unsigned)c;
    int ai[16];
#pragma unroll
    for (int j = 0; j < 16; ++j) ai[j] = 0;
#pragma unroll
    for (int rg = 0; rg < 4; ++rg) { const int w4 = (int)bf.w4[rg];
#pragma unroll
        for (int j = 0; j < 4; ++j) { const unsigned r0 = bf.vr[4 * rg][j], r1 = bf.vr[4 * rg + 1][j], r2q = bf.vr[4 * rg + 2][j], r3 = bf.vr[4 * rg + 3][j];
            const unsigned t0 = __builtin_amdgcn_perm(r1, r0, 0x05010400u), t1 = __builtin_amdgcn_perm(r1, r0, 0x07030602u), t2 = __builtin_amdgcn_perm(r3, r2q, 0x05010400u), t3 = __builtin_amdgcn_perm(r3, r2q, 0x07030602u);
            ai[4 * j + 0] = __builtin_amdgcn_sdot4((int)__builtin_amdgcn_perm(t2, t0, 0x05040100u), w4, ai[4 * j + 0], false);
            ai[4 * j + 1] = __builtin_amdgcn_sdot4((int)__builtin_amdgcn_perm(t2, t0, 0x07060302u), w4, ai[4 * j + 1], false);
            ai[4 * j + 2] = __builtin_amdgcn_sdot4((int)__builtin_amdgcn_perm(t3, t1, 0x05040100u), w4, ai[4 * j + 2], false);
            ai[4 * j + 3] = __builtin_amdgcn_sdot4((int)__builtin_amdgcn_perm(t3, t1, 0x07060302u), w4, ai[4 * j + 3], false); }
#pragma unroll
        for (int i = 0; i < 4; ++i) { const int r = 4 * rg + i; const unsigned e = (r & 1) ? (niw[r >> 1] >> 16) : (niw[r >> 1] & 0xffffu); bf.vr[r] = *(const v4u*)(nvb + (e * 128u + c16)); } }
    const float sw_cur = bf.sw;
    const unsigned xw_cur = bf.xw;
    bf.w4 = *(const v4u*)((const unsigned char*)WQ + (size_t)nt * 128 + 16 * g); bf.sw = SWH[(size_t)nt * NH + g];
    bf.xw = *(const unsigned*)(X1 + (size_t)nt * D + 128 * ns + 2 * lane);
    int r8[8], r4[4], r2[2];
    const bool b3 = lane & 8;
#pragma unroll
    for (int i = 0; i < 8; ++i) r8[i] = swap32_addi(ai[i], ai[i + 8]);
#pragma unroll
    for (int i = 0; i < 4; ++i) r4[i] = swap16_addi(r8[i], r8[i + 4]);
#pragma unroll
    for (int i = 0; i < 2; ++i) { const int snd = b3 ? r4[i] : r4[i + 2], kp = b3 ? r4[i + 2] : r4[i]; r2[i] = kp + xor8i(snd); }
    const int srcl = 8 * (lane & 7) + (lane >> 3);
    const float p0 = (float)__shfl(r2[0], srcl) * sw_cur, p1 = (float)__shfl(r2[1], srcl) * sw_cur;
    const size_t col = (size_t)t * D + 128 * s + 2 * lane;
    const float y0 = bflo(xw_cur) + p0, y1 = bfhi(xw_cur) + p1;
    const float ss = wave_sum(y0 * y0 + y1 * y1);
    *(unsigned*)(out + col) = pk2(y0, y1);
    ssv = (lane == pos) ? ss : ssv;
    if (pos == TPI - 1 && lane < TPI) SSQ2[(size_t)s * M + (t - pos) + lane] = ssv;
}
__device__ __forceinline__ void p9_v_phase(unsigned* heads, unsigned xcc, const bf16* X1, const unsigned short* IDX, const unsigned short* WQ, const float* SWH, const unsigned char* V8, bf16* out, float* SSQ2, int lane) {
    QStream q;
    if (!qs_init(q, heads, xcc, lane)) return;
    UIdx iN, iM; VBuf ga, gb; float ssv = 0.f;
    { int s0, t0, s1, t1, s2, t2, s3, t3; qs_peek(q, 0, s0, t0); qs_peek(q, 1, s1, t1); qs_peek(q, 2, s2, t2); qs_peek(q, 3, s3, t3);
      UIdx ia, ib; u_idx(ia, t0, IDX, lane); u_idx(ib, t1, IDX, lane);
      v_gather(ga, ia, s0, t0, X1, WQ, SWH, V8, lane); v_gather(gb, ib, s1, t1, X1, WQ, SWH, V8, lane);
      u_idx(iN, t2, IDX, lane); u_idx(iM, t3, IDX, lane); }
#pragma unroll 1
    for (;;) {
        int s0, t0, s1, t1, s2, t2, s3, t3, s4, t4, s5, t5;
        qs_peek(q, 0, s0, t0); qs_peek(q, 1, s1, t1); qs_peek(q, 2, s2, t2); qs_peek(q, 3, s3, t3); qs_peek(q, 4, s4, t4); qs_peek(q, 5, s5, t5);
        v_compute(ga, s0, t0, out, SSQ2, lane, ssv, q.pos, iN, s2, t2, X1, WQ, SWH, V8);
        u_idx(iN, t4, IDX, lane);
        v_compute(gb, s1, t1, out, SSQ2, lane, ssv, q.pos + 1, iM, s3, t3, X1, WQ, SWH, V8);
        u_idx(iM, t5, IDX, lane);
        if (!qs_advance2(q, lane)) break;
    }
}
__device__ __forceinline__ void p10_final(const bf16* X2, float* out, const float* SSQ2, const float* gfin, int gw, int NGW, int lane) {
    f32x4 gf[4];
#pragma unroll
    for (int j = 0; j < 4; ++j) gf[j] = ((const f32x4*)gfin)[lane + 64 * j];
    v2u nxa[4], nxb[4]; float nsa, nsb;
#pragma unroll
    for (int j = 0; j < 4; ++j) { nxa[j] = ((const v2u*)(X2 + (size_t)ROW_REV(gw) * D))[lane + 64 * j]; nxb[j] = ((const v2u*)(X2 + (size_t)ROW_REV(gw + NGW) * D))[lane + 64 * j]; }
    nsa = lane < 8 ? SSQ2[(size_t)lane * M + ROW_REV(gw)] : 0.f; nsb = lane < 8 ? SSQ2[(size_t)lane * M + ROW_REV(gw + NGW)] : 0.f;
    for (int t = gw; t < M; t += 2 * NGW) {
        const int t1 = t + NGW;
        v2u xa[4], xb[4];
#pragma unroll
        for (int j = 0; j < 4; ++j) { xa[j] = nxa[j]; xb[j] = nxb[j]; }
        const float sa = nsa, sb = nsb;
        { const int tn = (t + 2 * NGW) < M ? (t + 2 * NGW) : t, tn1 = tn + NGW;
#pragma unroll
          for (int j = 0; j < 4; ++j) { nxa[j] = ((const v2u*)(X2 + (size_t)ROW_REV(tn) * D))[lane + 64 * j]; nxb[j] = ((const v2u*)(X2 + (size_t)ROW_REV(tn1) * D))[lane + 64 * j]; }
          nsa = lane < 8 ? SSQ2[(size_t)lane * M + ROW_REV(tn)] : 0.f; nsb = lane < 8 ? SSQ2[(size_t)lane * M + ROW_REV(tn1)] : 0.f; }
        const float ra = rsqrtf(wave_sum(sa) * (1.f / D) + RMS_EPS), rb = rsqrtf(wave_sum(sb) * (1.f / D) + RMS_EPS);
        f32x4* oa = (f32x4*)(out + (size_t)ROW_REV(t) * D) + lane; f32x4* ob = (f32x4*)(out + (size_t)ROW_REV(t1) * D) + lane;
#pragma unroll
        for (int j = 0; j < 4; ++j) {
            oa[64 * j] = (f32x4){bflo(xa[j].x) * ra * gf[j].x, bfhi(xa[j].x) * ra * gf[j].y, bflo(xa[j].y) * ra * gf[j].z, bfhi(xa[j].y) * ra * gf[j].w};
            ob[64 * j] = (f32x4){bflo(xb[j].x) * rb * gf[j].x, bfhi(xb[j].x) * rb * gf[j].y, bflo(xb[j].y) * rb * gf[j].z, bfhi(xb[j].y) * rb * gf[j].w}; }
    }
}

struct Args { const float* in[15]; float* out; unsigned char* ws; int ph_lo, ph_hi, li, pad; };
__global__ void __launch_bounds__(NWAVES * 64, 2) fwd_kernel(Args args) {
    extern __shared__ __attribute__((aligned(16))) unsigned char lds_raw[];
    LAS unsigned char* lds = (LAS unsigned char*)lds_raw;
    volatile LAS unsigned* MISC = (volatile LAS unsigned*)(lds + MISC_OFF);
    const int tid = threadIdx.x, lane = tid & 63, wave = __builtin_amdgcn_readfirstlane(tid >> 6);
    const int G = gridDim.x; const int bx = blockIdx.x; const int vcu = (G % 8 == 0) ? (bx % 8) * (G / 8) + bx / 8 : bx;
    const int gw = vcu * NWAVES + wave, NGW = G * NWAVES;
    unsigned char* ws = args.ws;
    gu32* ctl = (gu32*)(ws + WS_CTL);
    const float* x = args.in[0]; const float* g_mix = args.in[1]; const float* w_in = args.in[2]; const float* pool_gw = args.in[3]; const float* pool_scale = args.in[4];
    const float* conv_w = args.in[5]; const float* w_bp = args.in[6]; const float* w_bc = args.in[7]; const float* w_out = args.in[8]; const float* g_ffn = args.in[9];
    const float* w_q = args.in[10]; const float* sub_keys = args.in[11]; const float* expert_u = args.in[12]; const float* expert_v = args.in[13]; const float* g_final = args.in[14];
    unsigned char* Wc8 = ws + WS_WC; unsigned char* Wbc8 = ws + WS_WBC; float* SBC = (float*)(ws + WS_SBC); float* SPC = (float*)(ws + WS_SPC); float* WcF = (float*)(ws + WS_WCF); unsigned* CMAXC = (unsigned*)(ctl + CW_CMAXC); bf16* Wout_t = (bf16*)(ws + WS_WOUT); unsigned char* Wpp8 = ws + WS_WPP; float* WppF = (float*)(ws + WS_WPPF); float* SBP = (float*)(ws + WS_SBP); float* SXR = (float*)(ws + WS_SXR); unsigned char* X1q = ws + WS_X1Q; unsigned* CMAXP = (unsigned*)(ctl + CW_CMAXP);
    float* SU = (float*)(ws + WS_SU); float* SV = (float*)(ws + WS_SV); float* SSQ = (float*)(ws + WS_SSQ);
    unsigned char* U8 = ws + WS_U8; unsigned char* V8 = ws + WS_V8; float* INV = (float*)(ws + WS_INV); float* SSQ2 = (float*)(ws + WS_SSQ2); unsigned* PART = (unsigned*)(ws + WS_PART); float* RSTD = (float*)(ws + WS_RSTD); unsigned short* WQ = (unsigned short*)(ws + WS_WV); float* SWH = (float*)(ws + WS_SWH);
    unsigned char* Hq = ws + WS_B; unsigned char* Winq = ws + WS_WIN; float* SA = (float*)(ws + WS_SA); float* SB = (float*)(ws + WS_SB); unsigned* CMAX = (unsigned*)(ctl + CW_CMAX); unsigned char* PA = ws + WS_B; unsigned char* CA = ws + WS_B + 64 * MiB; bf16* X1 = (bf16*)(ws + WS_B);
    bf16* Mb = (bf16*)(ws + WS_C); unsigned short* IDX = (unsigned short*)(ws + WS_C); float* EV = (float*)(ws + WS_C + 16 * MiB);
    unsigned char* Z8 = ws + WS_A; float* ZS = (float*)(ws + WS_A + 128 * MiB); unsigned char* G8 = ws + WS_A + 256 * MiB;
     _Float16* SC = (_Float16*)(ws + WS_A); bf16* X2 = (bf16*)(ws + WS_A);

    for (int u = tid; u < (LDS_BYTES - LDSCTL_OFF) / 4; u += NWAVES * 64) ((LAS unsigned*)(lds + LDSCTL_OFF))[u] = 0u;
    __syncthreads();
    XcdBarrier bar; bar.bar = (unsigned*)(ctl + CW_BAR); bar.x = 0; bar.st = nullptr;
    if (N_LAUNCHES != PER_PHASE) bar = xcd_barrier_post((unsigned*)(ctl + CW_BAR), MISC + 8);
#define GRID_BAR() do { if (N_LAUNCHES != PER_PHASE) xcd_barrier(bar); } while (0)
    const int lo = args.ph_lo, hi = args.ph_hi;
#define IN(k) (lo <= (k) && (k) < hi)
#define BOTH(k) (IN(k) && IN((k) + 1))

    if (IN(0)) for (int rep_ = 0; rep_ < ((PROBE_REPEAT >> 0) & 1) + 1; ++rep_) {
        LAS float* scr = (LAS float*)(lds + wave * 16384);
        constexpr int I_WPP = 1024, I_CMAX = 16 * 16, I_WOUT = (1024 / 64) * (1024 / 32), I_WBC = (512 / 64) * (1024 / 256), I_WC = 512;
        constexpr int NITEMS = I_WPP + I_CMAX + I_WBC + I_WC;
        for (int it = gw; it < NITEMS; it += NGW) {
            int r = it;
            if (r < I_WPP) { p0_wpp_item(w_q, sub_keys, g_ffn, WppF, CMAXP, scr, r, lane); continue; } r -= I_WPP;
            if (r < I_WC) { p0_wc_item(pool_gw, pool_scale, w_bp, WcF, CMAXC, scr, r, lane); continue; } r -= I_WC;
            if (r < I_CMAX) { p0_colmax_item(w_in, 4096, CMAX, r, lane); continue; } r -= I_CMAX;
            p0_colmax_item(w_bc, 1024, CMAXC, r, lane);
        }
        GRID_BAR();
        for (int it = gw; it < (1024 / 64) * (4096 / 32); it += NGW) p0_transpose_i8_item(w_in, 1024, 4096, Winq, CMAX, SB, scr, it, lane);
        for (int n = gw; n < NSC; n += NGW) p0_wpp_quant_row(WppF, CMAXP, Wpp8, SBP, n, lane);
        for (int n = gw; n < D; n += NGW) p0_wc_quant_row(WcF, CMAXC, Wc8, n, lane);
        for (int it = gw; it < (512 / 64) * (1024 / 32); it += NGW) p0_transpose_i8_item(w_bc, 512, 1024, Wbc8, CMAXC, SBC, scr, it, lane);
        for (int it = gw; it < I_WOUT; it += NGW) p0_transpose_item(w_out, 1024, 1024, Wout_t, scr, it, lane, CMAXC);
        {
            HRows ra, rb;
            p0_q_load(ra, expert_u, gw, gw + NGW, lane);
            for (int e = gw; e < NE; e += 2 * NGW) { const int en = e + 2 * NGW; if (en < NE) p0_q_load(rb, expert_u, en, en + NGW, lane); else p0_q_load(rb, expert_v, gw, gw + NGW, lane);
                p0_quant_rows2<false>(ra, g_ffn, U8, SU, e, e + NGW, lane); ra = rb; }
            for (int e = gw; e < NE; e += 2 * NGW) { const int en = e + 2 * NGW; if (en < NE) p0_q_load(rb, expert_v, en, en + NGW, lane); else p0_h_load(rb, x, gw, gw + NGW, lane);
                p0_quant_rows2<false>(ra, nullptr, V8, SV, e, e + NGW, lane); ra = rb; }
            for (int m = gw; m < M; m += 2 * NGW) { const int mn = (m + 2 * NGW) < M ? (m + 2 * NGW) : m; p0_h_load(rb, x, mn, mn + NGW, lane);
                p0_h_rows2(ra, g_mix, Hq, SA, m, m + NGW, lane); ra = rb; }
        }
        if (BOTH(0)) GRID_BAR();
    }
    if (IN(1)) for (int rep_ = 0; rep_ < ((PROBE_REPEAT >> 1) & 1) + 1; ++rep_) {
        pg8::Gemm g{(const bf16*)Hq, (const bf16*)Winq, (const bf16*)Hq, (const bf16*)Winq, M, DIN, D / 2}; pg8::StaticOrder S; S.init(M, DIN, G, bx, 1, 1 + ((PROBE_GEMM_REP >> 1) & 1));
        EpiZ E{Z8, ZS, G8, SA, SB};
        pg8::gemm_phase<EpiZ, pg8::StaticOrder, true, true, true>(lds, g, S, E, (unsigned)((bx >> 3) & 3) * STAGGER_P1);
        if (BOTH(1)) GRID_BAR();
    }
    if (IN(2)) for (int rep_ = 0; rep_ < ((PROBE_REPEAT >> 2) & 1) + 1; ++rep_) {
        p2_timemix(Z8, ZS, conv_w, PA, CA, SPC, gw, NGW, lane);
        if (BOTH(2)) GRID_BAR();
    }
    if (IN(3)) for (int rep_ = 0; rep_ < ((PROBE_REPEAT >> 3) & 1) + 1; ++rep_) {
        pg8::Gemm g{(const bf16*)PA, (const bf16*)Wc8, (const bf16*)CA, (const bf16*)Wbc8, M, D, DP / 2}; pg8::StaticOrder S; S.init(M, D, G, bx, 2, 1 + ((PROBE_GEMM_REP >> 3) & 1));
        EpiGate E{G8, Mb, SPC};
        pg8::gemm_phase<EpiGate, pg8::StaticOrder, true, true, true>(lds, g, S, E);
        if (BOTH(3)) GRID_BAR();
    }
    if (IN(4)) for (int rep_ = 0; rep_ < ((PROBE_REPEAT >> 4) & 1) + 1; ++rep_) {
        pg8::Gemm g{Mb, Wout_t, Mb, Wout_t, M, D, D}; pg8::StaticOrder S; S.init(M, D, G, bx, 1, 1 + ((PROBE_GEMM_REP >> 4) & 1));
        EpiRes E{x, X1, SSQ};
        pg8::gemm_phase<EpiRes, pg8::StaticOrder, true, true>(lds, g, S, E);
        if (BOTH(4)) GRID_BAR();
    }
    if (IN(5)) for (int rep_ = 0; rep_ < ((PROBE_REPEAT >> 5) & 1) + 1; ++rep_) {
        { XRows xa, xb; p5_x1_load(xa, X1, SSQ, ROW_QREV(gw), ROW_QREV(gw + NGW), lane);
          for (int r = gw; r < M; r += 2 * NGW) { const int rn = (r + 2 * NGW) < M ? (r + 2 * NGW) : r; p5_x1_load(xb, X1, SSQ, ROW_QREV(rn), ROW_QREV(rn + NGW), lane);
              p5_x1_quant_rows2(xa, X1q, SA, SXR, RSTD, ROW_QREV(r), ROW_QREV(r + NGW), lane); xa = xb; } }
        GRID_BAR();
        pg8::Gemm g{(const bf16*)X1q, (const bf16*)Wpp8, (const bf16*)X1q, (const bf16*)Wpp8, M, NSC, D / 2}; pg8::StaticOrder S; S.init(M, NSC, G, bx, 1, 1 + ((PROBE_GEMM_REP >> 5) & 1));
        EpiScore E{SXR, SBP, SC};
        pg8::gemm_phase<EpiScore, pg8::StaticOrder, true, true, true>(lds, g, S, E);
        if (BOTH(5)) GRID_BAR();
    }
    if (IN(6)) for (int rep_ = 0; rep_ < ((PROBE_REPEAT >> 6) & 1) + 1; ++rep_) {
        p6_topk(SC, IDX, EV, INV, lds, gw, NGW, wave, lane);
        if (BOTH(6)) GRID_BAR();
    }
    const unsigned xcc = xb_xcc_id();
    if (IN(7)) for (int rep_ = 0; rep_ < ((PROBE_REPEAT >> 7) & 1) + 1; ++rep_) {
        p7_u_phase((unsigned*)(ctl + CW_QU + 2048 * rep_), xcc, X1q, SA, IDX, U8, PART, lane);
        if (BOTH(7)) GRID_BAR();
    }
    if (IN(8)) for (int rep_ = 0; rep_ < ((PROBE_REPEAT >> 8) & 1) + 1; ++rep_) {
        p8_w_phase(PART, RSTD, IDX, EV, INV, SU, SV, WQ, SWH, gw, NGW, lane);
        if (BOTH(8)) GRID_BAR();
    }
    if (IN(9)) for (int rep_ = 0; rep_ < ((PROBE_REPEAT >> 9) & 1) + 1; ++rep_) {
        p9_v_phase((unsigned*)(ctl + CW_QV + 2048 * rep_), xcc, X1, IDX, WQ, SWH, V8, X2, SSQ2, lane);
        if (BOTH(9)) GRID_BAR();
    }
    if (IN(10)) {
        p10_final(X2, args.out, SSQ2, g_final, gw, NGW, lane);
    }
#undef IN
#undef BOTH
#undef GRID_BAR
}

extern "C" void kernel_launch(void* const* d_in, const int* in_sizes, int n_in, void* d_out, int out_size, void* d_ws, size_t ws_size, hipStream_t stream) {
    static int grid = 0;
    if (grid == 0) {
        if (n_in != 15 || in_sizes[0] != M * D || out_size != M * D || ws_size < WS_END) { fprintf(stderr, "kernel_launch: unexpected shapes (n_in %d, in0 %d, out %d, ws %zu); nothing launched\n", n_in, n_in > 0 ? in_sizes[0] : -1, out_size, ws_size); grid = -1; return; }
        int dev = 0, cus = 0, per_cu = 0;
        if (hipGetDevice(&dev) != hipSuccess || hipDeviceGetAttribute(&cus, hipDeviceAttributeMultiprocessorCount, dev) != hipSuccess) { grid = -1; return; }
        if (hipFuncSetAttribute((const void*)fwd_kernel, hipFuncAttributeMaxDynamicSharedMemorySize, LDS_BYTES) != hipSuccess) { fprintf(stderr, "kernel_launch: hipFuncSetAttribute failed\n"); grid = -1; return; }
        if (hipOccupancyMaxActiveBlocksPerMultiprocessor(&per_cu, (const void*)fwd_kernel, NWAVES * 64, LDS_BYTES) != hipSuccess || per_cu < 1)
            fprintf(stderr, "kernel_launch: note: occupancy query reports %d workgroups per CU\n", per_cu);
        (void)hipGetLastError();
        grid = cus;
    }
    if (grid < 0) return;
    if (hipMemsetAsync((char*)d_ws + WS_CTL, 0, CTL_ZERO_BYTES, stream) != hipSuccess) { fprintf(stderr, "kernel_launch: hipMemsetAsync failed\n"); return; }
    Args a{};
    for (int i = 0; i < 15; ++i) a.in[i] = (const float*)d_in[i];
    a.out = (float*)d_out; a.ws = (unsigned char*)d_ws;
    for (int li = 0; li < N_LAUNCHES; ++li) {
        a.ph_lo = (N_LAUNCHES == PER_PHASE) ? li : 0; a.ph_hi = (N_LAUNCHES == PER_PHASE) ? li + 1 : PER_PHASE; a.li = li;
        hipLaunchKernelGGL(fwd_kernel, dim3(grid), dim3(NWAVES * 64), LDS_BYTES, stream, a);
        const hipError_t le = hipPeekAtLastError();
        if (le != hipSuccess) { fprintf(stderr, "kernel_launch: launch %d failed: %s\n", li, hipGetErrorName(le)); break; }
    }
}
```

```cpp
#include <hip/hip_runtime.h>
#include <cstdio>
#include <cstdint>

#ifndef PROBE_REPEAT
#define PROBE_REPEAT 0
#endif
#ifndef PROBE_GEMM_REP
#define PROBE_GEMM_REP 0
#endif
#ifndef STAGGER_P1
#define STAGGER_P1 0u
#endif
#ifndef PROBE_SKIP_EPI
#define PROBE_SKIP_EPI 0
#endif
#ifndef MK_N_LAUNCHES
#define MK_N_LAUNCHES 1
#endif

namespace pg8 {
#define PG8_LAS __attribute__((address_space(3)))
typedef unsigned short bf16_t;
typedef short bf16x8 __attribute__((ext_vector_type(8)));
typedef float f32x4 __attribute__((ext_vector_type(4)));
typedef unsigned u32x4 __attribute__((ext_vector_type(4)));
constexpr int BM = 256, BK = 64, HALF = 128, HTB = HALF * BK * 2  , STAGE_BYTES = 8 * HTB, NXCD = 8, WGM = 8;

__host__ __device__ __forceinline__ int lds_byte(int r, int c) { const int st = (r >> 4) * 2 + (c >> 5), rr = r & 15, cc = c & 31, ob = rr * 64 + cc * 2; return st * 1024 + (ob ^ (((ob >> 9) & 1) << 5)); }
__host__ __device__ __forceinline__ void stage_rc(int b, int& R, int& C) { const int st = b / 1024, sb = b % 1024, swz = sb ^ (((sb >> 9) & 1) << 5); R = (st >> 1) * 16 + swz / 64; C = (st & 1) * 32 + (swz % 64) / 2; }
__host__ __device__ __forceinline__ int perm32(int rho) { const int n = rho >> 4, i = rho & 15; return 8 * (i >> 2) + 4 * n + (i & 3); }

struct Unit { int pm, pn, seg, dup; };
struct Gemm { const bf16_t* A; const bf16_t* Bt; const bf16_t* A2; const bf16_t* Bt2; int M, N, K; };

struct StaticOrder {
    int nM, nN, nwg, G, c, segs, rep;
    __host__ __device__ void init(int M, int N, int G_, int c_, int segs_, int rep_ = 1) { nM = M / BM; nN = N / BM; nwg = nM * nN; G = G_; c = c_; segs = segs_; rep = rep_; }
    __host__ __device__ bool next(int i, Unit& u) const {
        const int ti = (segs == 2) ? (i >> 1) : i; u.seg = (segs == 2) ? (i & 1) : 0;
        const long L = (long)ti * G + c; if (L >= (long)nwg * rep) return false;
        int wgid = (int)(L % nwg); u.dup = (L >= nwg) ? 1 : 0; { const int q = nwg / NXCD, r = nwg % NXCD, xcd = wgid % NXCD, off = wgid / NXCD; wgid = (xcd < r ? xcd * (q + 1) : r * (q + 1) + (xcd - r) * q) + off; }
        const int nig = WGM * nN, gid = wgid / nig, fm = gid * WGM, gsz = (nM - fm) < WGM ? (nM - fm) : WGM;
        u.pm = fm + ((wgid % nig) % gsz); u.pn = (wgid % nig) / gsz; return true;
    }
    __device__ __forceinline__ void a_ready(const Unit&) const {}
    __device__ __forceinline__ void done(const Unit&) const {}
};

__device__ __forceinline__ unsigned cvt_pk_bf16(float lo, float hi) { unsigned r; asm volatile("v_cvt_pk_bf16_f32 %0, %1, %2" : "=v"(r) : "v"(lo), "v"(hi)); return r; }

typedef int i32x4 __attribute__((ext_vector_type(4)));
template <class Epi, class Sched, bool ALIGN_EPI = false, bool SP2 = false, bool I8 = false>
__device__ __forceinline__ void gemm_phase(PG8_LAS unsigned char* lds, const Gemm g, const Sched& S, const Epi& E, unsigned stagger_ticks = 0) {
    if (stagger_ticks) { const unsigned long long t0_ = __builtin_amdgcn_s_memrealtime(); while (__builtin_amdgcn_s_memrealtime() - t0_ < (unsigned long long)stagger_ticks) __builtin_amdgcn_s_sleep(8); }
    const int tid = threadIdx.x, wid = __builtin_amdgcn_readfirstlane(tid >> 6), lane = tid & 63, wr = wid >> 2, wc = wid & 3, fr = lane & 15, fq = lane >> 4;
    const int K = g.K, nt = K / BK;
    unsigned voffA[2], voffB[2];
#pragma unroll
    for (int i = 0; i < 2; ++i) { int R, C; stage_rc(tid * 16 + i * 8192, R, C); const int Rb = Epi::PERM ? ((R & ~31) + perm32(R & 31)) : R;
        voffA[i] = (unsigned)(R * K + C) * 2u; voffB[i] = (unsigned)(Rb * K + C) * 2u; }
    const size_t kstep = (size_t)(BK * 2);
    const size_t hstep = (size_t)HALF * K * 2;
    const size_t tstep = 2 * hstep;
    const unsigned ldsw = (unsigned)wid * 1024u;
    const int aoff = lds_byte(wr * 64 + fr, fq * 8), boff = lds_byte(wc * 32 + fr, fq * 8);
#define PG8_SA(b, h) (((b) * 2 + (h)) * HTB)
#define PG8_SB(b, h) ((4 + (b) * 2 + (h)) * HTB)
#define PG8_STAGE(bufoff, gbase, voff) do { _Pragma("unroll") for (int _i = 0; _i < 2; ++_i) \
        __builtin_amdgcn_global_load_lds((const unsigned*)((const char*)(gbase) + (voff)[_i]), (PG8_LAS unsigned*)(lds + (bufoff) + ldsw + _i * 8192), 16, 0, 0); } while (0)
#define PG8_LDA(dst, b, h) do { _Pragma("unroll") for (int m = 0; m < 4; ++m) _Pragma("unroll") for (int k = 0; k < 2; ++k) dst[m][k] = *(const PG8_LAS bf16x8*)(lds + PG8_SA(b, h) + aoff + m * 2048 + k * 1024); } while (0)
#define PG8_LDB(dst, b, h) do { _Pragma("unroll") for (int n = 0; n < 2; ++n) _Pragma("unroll") for (int k = 0; k < 2; ++k) dst[n][k] = *(const PG8_LAS bf16x8*)(lds + PG8_SB(b, h) + boff + n * 2048 + k * 1024); } while (0)
#define PG8_MMA(ai, bj, At, Bt) do { __builtin_amdgcn_s_setprio(1); _Pragma("unroll") for (int m = 0; m < 4; ++m) _Pragma("unroll") for (int n = 0; n < 2; ++n) _Pragma("unroll") for (int k = 0; k < 2; ++k) { \
        if constexpr (I8) acc[ai][bj][m][n] = __builtin_bit_cast(f32x4, __builtin_amdgcn_mfma_i32_16x16x64_i8(__builtin_bit_cast(i32x4, Bt[n][k]), __builtin_bit_cast(i32x4, At[m][k]), __builtin_bit_cast(i32x4, acc[ai][bj][m][n]), 0, 0, 0)); \
        else acc[ai][bj][m][n] = __builtin_amdgcn_mfma_f32_16x16x32_bf16(Bt[n][k], At[m][k], acc[ai][bj][m][n], 0, 0, 0); } __builtin_amdgcn_s_setprio(0); } while (0)
#define PG8_WAIT_V(n) asm volatile("s_waitcnt vmcnt(" #n ")" ::: "memory")
#define PG8_WAIT_L(n) asm volatile("s_waitcnt lgkmcnt(" #n ")" ::: "memory")
#define PG8_BAR __builtin_amdgcn_s_barrier()
#define PG8_SCHED __builtin_amdgcn_sched_barrier(0)
    Unit cur, nxt; int ui = 0;
    if (!S.next(0, cur)) return;
    f32x4 acc[2][2][4][2];
#pragma unroll
    for (int a = 0; a < 2; ++a)
#pragma unroll
        for (int b = 0; b < 2; ++b)
#pragma unroll
            for (int m = 0; m < 4; ++m)
#pragma unroll
                for (int n = 0; n < 2; ++n) acc[a][b][m][n] = (f32x4){0.f, 0.f, 0.f, 0.f};
    bf16x8 At[4][2], B0[2][2], B1[2][2];
    const char* cA = (const char*)(cur.seg ? g.A2 : g.A) + (size_t)cur.pm * tstep; const char* cB = (const char*)(cur.seg ? g.Bt2 : g.Bt) + (size_t)cur.pn * tstep;
    S.a_ready(cur);
    if constexpr (SP2) {
        PG8_STAGE(PG8_SB(0, 0), cB, voffB); PG8_STAGE(PG8_SB(0, 1), cB + hstep, voffB); PG8_STAGE(PG8_SA(0, 0), cA, voffA); PG8_STAGE(PG8_SA(0, 1), cA + hstep, voffA);
        if (wr == 1) PG8_BAR;
        PG8_WAIT_V(2); PG8_BAR;
        PG8_STAGE(PG8_SB(1, 0), cB + kstep, voffB); PG8_STAGE(PG8_SA(1, 0), cA + kstep, voffA); PG8_STAGE(PG8_SB(1, 1), cB + hstep + kstep, voffB);
        PG8_WAIT_V(6); PG8_BAR;
    } else {
        PG8_STAGE(PG8_SB(0, 0), cB, voffB); PG8_STAGE(PG8_SA(0, 0), cA, voffA); PG8_STAGE(PG8_SB(0, 1), cB + hstep, voffB); PG8_STAGE(PG8_SA(0, 1), cA + hstep, voffA);
        if (wr == 1) PG8_BAR;
        PG8_WAIT_V(4); PG8_BAR;
        PG8_STAGE(PG8_SB(1, 0), cB + kstep, voffB); PG8_STAGE(PG8_SA(1, 0), cA + kstep, voffA); PG8_STAGE(PG8_SB(1, 1), cB + hstep + kstep, voffB);
        PG8_WAIT_V(6); PG8_BAR;
    }
    for (;;) {
        const bool has_next = S.next(ui + 1, nxt);
        const char* nA = has_next ? (const char*)(nxt.seg ? g.A2 : g.A) + (size_t)nxt.pm * tstep : cA; const char* nB = has_next ? (const char*)(nxt.seg ? g.Bt2 : g.Bt) + (size_t)nxt.pn * tstep : cB;
        for (int t = 0; t < nt; t += 2) {
            const bool last = (t == nt - 2);
            const char* a1 = cA + (size_t)(t + 1) * kstep;
            const char* a2 = last ? nA : cA + (size_t)(t + 2) * kstep; const char* b2 = last ? nB : cB + (size_t)(t + 2) * kstep;
            const char* a3 = a2 + kstep; const char* b3 = b2 + kstep;
            if (last && has_next) S.a_ready(nxt);
            if constexpr (SP2) {
            PG8_LDB(B0, 0, 0); PG8_LDB(B1, 0, 1); PG8_SCHED; PG8_LDA(At, 0, 0); PG8_STAGE(PG8_SA(1, 1), a1 + hstep, voffA);
            PG8_WAIT_V(8); PG8_WAIT_L(0); PG8_BAR; PG8_MMA(0, 0, At, B0); PG8_MMA(0, 1, At, B1); PG8_BAR; PG8_SCHED;
            PG8_LDA(At, 0, 1); PG8_STAGE(PG8_SB(0, 0), b2, voffB); PG8_STAGE(PG8_SB(0, 1), b2 + hstep, voffB); PG8_STAGE(PG8_SA(0, 0), a2, voffA);
            PG8_WAIT_V(8); PG8_WAIT_L(0); PG8_BAR; PG8_MMA(1, 0, At, B0); PG8_MMA(1, 1, At, B1); PG8_BAR; PG8_SCHED;
            PG8_LDB(B0, 1, 0); PG8_LDB(B1, 1, 1); PG8_SCHED; PG8_LDA(At, 1, 0); PG8_STAGE(PG8_SA(0, 1), a2 + hstep, voffA);
            PG8_WAIT_V(8); PG8_WAIT_L(0); PG8_BAR; PG8_MMA(0, 0, At, B0); PG8_MMA(0, 1, At, B1); PG8_BAR; PG8_SCHED;
            PG8_LDA(At, 1, 1); PG8_STAGE(PG8_SB(1, 0), b3, voffB); PG8_STAGE(PG8_SB(1, 1), b3 + hstep, voffB); PG8_STAGE(PG8_SA(1, 0), a3, voffA);
            PG8_WAIT_V(8); PG8_WAIT_L(0); PG8_BAR; PG8_MMA(1, 0, At, B0); PG8_MMA(1, 1, At, B1); PG8_BAR; PG8_SCHED;
            } else {
            PG8_LDB(B0, 0, 0); PG8_SCHED; PG8_LDA(At, 0, 0); PG8_STAGE(PG8_SA(1, 1), a1 + hstep, voffA);
            PG8_WAIT_L(8); PG8_BAR; PG8_WAIT_L(0); PG8_MMA(0, 0, At, B0); PG8_BAR; PG8_SCHED;
            PG8_LDB(B1, 0, 1); PG8_STAGE(PG8_SB(0, 0), b2, voffB);
            PG8_BAR; PG8_WAIT_L(0); PG8_MMA(0, 1, At, B1); PG8_BAR;
            PG8_LDA(At, 0, 1); PG8_STAGE(PG8_SA(0, 0), a2, voffA);
            PG8_BAR; PG8_WAIT_L(0); PG8_MMA(1, 0, At, B0); PG8_BAR; PG8_SCHED;
            PG8_STAGE(PG8_SB(0, 1), b2 + hstep, voffB);
            PG8_WAIT_V(6); PG8_BAR; PG8_MMA(1, 1, At, B1); PG8_BAR;
            PG8_LDB(B0, 1, 0); PG8_SCHED; PG8_LDA(At, 1, 0); PG8_STAGE(PG8_SA(0, 1), a2 + hstep, voffA);
            PG8_WAIT_L(8); PG8_BAR; PG8_WAIT_L(0); PG8_MMA(0, 0, At, B0); PG8_BAR; PG8_SCHED;
            PG8_LDB(B1, 1, 1); PG8_STAGE(PG8_SB(1, 0), b3, voffB);
            PG8_BAR; PG8_WAIT_L(0); PG8_MMA(0, 1, At, B1); PG8_BAR;
            PG8_LDA(At, 1, 1); PG8_STAGE(PG8_SA(1, 0), a3, voffA);
            PG8_BAR; PG8_WAIT_L(0); PG8_MMA(1, 0, At, B0); PG8_BAR; PG8_SCHED;
            PG8_STAGE(PG8_SB(1, 1), b3 + hstep, voffB);
            PG8_WAIT_V(6); PG8_BAR; PG8_MMA(1, 1, At, B1); PG8_BAR;
            }
        }
        if constexpr (ALIGN_EPI) { if (wr == 0) PG8_BAR; }
        const bool keep = E(acc, cur, wr, wc, fr, fq); S.done(cur);
        if (!has_next) break;
        if (!keep) {
#pragma unroll
        for (int a = 0; a < 2; ++a)
#pragma unroll
            for (int b = 0; b < 2; ++b)
#pragma unroll
                for (int m = 0; m < 4; ++m)
#pragma unroll
                    for (int n = 0; n < 2; ++n) acc[a][b][m][n] = (f32x4){0.f, 0.f, 0.f, 0.f};
        }
        cur = nxt; cA = nA; cB = nB; ++ui;
        if constexpr (ALIGN_EPI) { if (wr == 1) PG8_BAR; }
    }
    PG8_WAIT_V(0);
    if constexpr (!ALIGN_EPI) { if (wr == 0) PG8_BAR; }
    PG8_BAR;
#undef PG8_SA
#undef PG8_SB
#undef PG8_STAGE
#undef PG8_LDA
#undef PG8_LDB
#undef PG8_MMA
#undef PG8_WAIT_V
#undef PG8_WAIT_L
#undef PG8_BAR
#undef PG8_SCHED
}
}

constexpr int NWAVES = 8;
constexpr int M = 65536, D = 1024, SEQ = 4096, DIN = 4096, DP = 512, NSC = 2048, NE = 16384, NH = 8, TOPK = 16;
constexpr float RMS_EPS = 1e-6f;
constexpr int N_LAUNCHES = MK_N_LAUNCHES;
constexpr int PER_PHASE = 11;
constexpr int TPI = 32;
__device__ __forceinline__ int ROW_REV(int t) { return M - 1 - t; }
__device__ __forceinline__ int ROW_QREV(int L) { return ((L >> 11) & 7) * 8192 + (3 - (L >> 14)) * 2048 + (L & 2047); }
__device__ __forceinline__ int GRP_QREV(int L) { return ((L >> 7) & 7) * 512 + (3 - (L >> 10)) * 128 + (L & 127); }

constexpr size_t MiB = 1u << 20;
constexpr size_t WS_CTL = 0, CTL_ZERO_BYTES = 1 * MiB;
constexpr size_t WS_WIN = 1 * MiB;
constexpr size_t WS_WC = 9 * MiB;
constexpr size_t WS_WBC = 10 * MiB;
constexpr size_t WS_SBC = 10 * MiB + 512 * 1024;
constexpr size_t WS_SPC = 62 * MiB;
constexpr size_t WS_WCF = 200 * MiB;
constexpr int CW_CMAXC = 45056;
constexpr size_t WS_WOUT = 11 * MiB;
constexpr size_t WS_WPP = 13 * MiB;
constexpr size_t WS_SBP = 15 * MiB;
constexpr size_t WS_SXR = 15 * MiB + 65536;
constexpr size_t WS_WPPF = 192 * MiB;
constexpr size_t WS_X1Q = 704 * MiB;
constexpr int CW_CMAXP = 40960;
constexpr size_t WS_SU = 17 * MiB;
constexpr size_t WS_SV = 17 * MiB + 65536;
constexpr size_t WS_SSQ = 18 * MiB;
constexpr size_t WS_U8 = 22 * MiB;
constexpr size_t WS_V8 = 38 * MiB;
constexpr size_t WS_INV = 54 * MiB;
constexpr size_t WS_SSQ2 = 56 * MiB;
constexpr size_t WS_RSTD = 58 * MiB;
constexpr size_t WS_SWH = 60 * MiB;
constexpr size_t WS_SA = 59 * MiB;
constexpr size_t WS_SB = 59 * MiB + 512 * 1024;
constexpr int CW_CMAX = 32768;
constexpr size_t WS_WV = 192 * MiB + 48 * MiB;
constexpr size_t WS_PART = 576 * MiB;
constexpr size_t WS_B = 64 * MiB;
constexpr size_t WS_C = 192 * MiB;
constexpr size_t WS_A = 320 * MiB;
constexpr size_t WS_END = 832 * MiB;
constexpr int CW_BAR = 4096;
constexpr int CW_QU = 16384, CW_QV = 16384 + 1024;

constexpr int RING_BYTES = 131072;
constexpr int LDSCTL_OFF = RING_BYTES, MISC_OFF = LDSCTL_OFF + 320;
constexpr int LDS_BYTES = 147456;

#define GAS __attribute__((address_space(1)))
#define LAS __attribute__((address_space(3)))
typedef unsigned short bf16;
typedef unsigned v4u __attribute__((ext_vector_type(4)));
typedef unsigned v2u __attribute__((ext_vector_type(2)));
typedef float f32x4 __attribute__((ext_vector_type(4)));
typedef GAS unsigned gu32;
#define RLX_AGENT __ATOMIC_RELAXED, __HIP_MEMORY_SCOPE_AGENT
#define LDS_WAIT() asm volatile("s_waitcnt lgkmcnt(0)" ::: "memory")
#define VM_WAIT() asm volatile("s_waitcnt vmcnt(0)" ::: "memory")
__device__ __forceinline__ unsigned f2bf(float f) { unsigned u = __builtin_bit_cast(unsigned, f); return (u + 0x7fffu + ((u >> 16) & 1u)) >> 16; }
__device__ __forceinline__ unsigned pk2(float lo, float hi) { return f2bf(lo) | (f2bf(hi) << 16); }
__device__ __forceinline__ float bflo(unsigned w) { return __builtin_bit_cast(float, w << 16); }
__device__ __forceinline__ float bfhi(unsigned w) { return __builtin_bit_cast(float, w & 0xffff0000u); }
template <int CTRL> __device__ __forceinline__ int dppi(int x) { return __builtin_amdgcn_mov_dpp(x, CTRL, 0xf, 0xf, true); }
__device__ __forceinline__ int xor1i(int x) { return dppi<0xB1>(x); }
__device__ __forceinline__ int xor2i(int x) { return dppi<0x4E>(x); }
__device__ __forceinline__ int xor4i(int x) { return dppi<0x1B>(dppi<0x141>(x)); }
__device__ __forceinline__ int xor8i(int x) { return dppi<0x128>(x); }
__device__ __forceinline__ float xor1f(float x) { return __builtin_bit_cast(float, xor1i(__builtin_bit_cast(int, x))); }
__device__ __forceinline__ float xor2f(float x) { return __builtin_bit_cast(float, xor2i(__builtin_bit_cast(int, x))); }
__device__ __forceinline__ float xor4f(float x) { return __builtin_bit_cast(float, xor4i(__builtin_bit_cast(int, x))); }
__device__ __forceinline__ float xor8f(float x) { return __builtin_bit_cast(float, xor8i(__builtin_bit_cast(int, x))); }
__device__ __forceinline__ float swap32_add(float a, float b) { asm volatile("s_nop 1\n\tv_permlane32_swap_b32 %0, %1" : "+v"(a), "+v"(b)); return a + b; }
__device__ __forceinline__ int swap32_addi(int a, int b) { asm volatile("s_nop 1\n\tv_permlane32_swap_b32 %0, %1" : "+v"(a), "+v"(b)); return a + b; }
__device__ __forceinline__ int swap16_addi(int a, int b) { asm volatile("s_nop 1\n\tv_permlane16_swap_b32 %0, %1" : "+v"(a), "+v"(b)); return a + b; }
__device__ __forceinline__ float swap16_add(float a, float b) { asm volatile("s_nop 1\n\tv_permlane16_swap_b32 %0, %1" : "+v"(a), "+v"(b)); return a + b; }
__device__ __forceinline__ float xor16f(float x) { float a = x, b = x; asm volatile("s_nop 1\n\tv_permlane16_swap_b32 %0, %1" : "+v"(a), "+v"(b)); return ((threadIdx.x >> 4) & 1) ? a : b; }
__device__ __forceinline__ float xor32f(float x) { float a = x, b = x; asm volatile("s_nop 1\n\tv_permlane32_swap_b32 %0, %1" : "+v"(a), "+v"(b)); return (threadIdx.x & 32) ? a : b; }
__device__ __forceinline__ float wave_sum(float v) {
    v += xor1f(v); v += xor2f(v); v += xor4f(v); v += xor8f(v);
    v = swap16_add(v, v); v = swap32_add(v, v);
    return v;
}
__device__ __forceinline__ float wave_max(float v) {
    v = fmaxf(v, xor1f(v)); v = fmaxf(v, xor2f(v)); v = fmaxf(v, xor4f(v)); v = fmaxf(v, xor8f(v));
    v = fmaxf(v, xor16f(v)); v = fmaxf(v, xor32f(v));
    return v;
}

__device__ __forceinline__ void unpack8(const v4u w, float (&f)[8]) { f[0] = bflo(w.x); f[1] = bfhi(w.x); f[2] = bflo(w.y); f[3] = bfhi(w.y); f[4] = bflo(w.z); f[5] = bfhi(w.z); f[6] = bflo(w.w); f[7] = bfhi(w.w); }
__device__ __forceinline__ v4u pack8(const float (&f)[8]) { v4u w; w.x = pk2(f[0], f[1]); w.y = pk2(f[2], f[3]); w.z = pk2(f[4], f[5]); w.w = pk2(f[6], f[7]); return w; }

#define XB_TMO      128
#define XB_XCNT(j)  (256  + 64 * (j))
#define XB_XSUB(j)  (1280 + 64 * (j))
#define XB_XGEN(j)  (2304 + 64 * (j))
#define XB_TOP      3328
#define XB_TOPGEN   3392
#define XCD_BAR_WORDS 3456
#define XB_SPIN_CAP (1u << 18)
__device__ __forceinline__ unsigned xb_ld(unsigned* p)              { return __hip_atomic_load(p, __ATOMIC_RELAXED, __HIP_MEMORY_SCOPE_AGENT); }
__device__ __forceinline__ unsigned xb_add(unsigned* p, unsigned v) { return __hip_atomic_fetch_add(p, v, __ATOMIC_RELAXED, __HIP_MEMORY_SCOPE_AGENT); }
__device__ __forceinline__ unsigned xb_xcc_id() { return (unsigned)__builtin_amdgcn_s_getreg((3 << 11) | 20) & 0xFu; }
#define XB_SPIN(cond, bar) do { unsigned _sp = 0; while (cond) { __builtin_amdgcn_s_sleep(0); \
    if ((++_sp & 255u) == 0u) { if (xb_ld(&(bar)[XB_TMO])) break; if (_sp > XB_SPIN_CAP) { atomicAdd(&(bar)[XB_TMO], 1u); break; } } } } while (0)
struct XcdBarrier { unsigned* bar; unsigned x; volatile LAS unsigned* st; };
__device__ __forceinline__ XcdBarrier xcd_barrier_post(unsigned* bar, volatile LAS unsigned* st) {
    XcdBarrier b; b.bar = bar; b.x = xb_xcc_id(); b.st = st;
    if (threadIdx.x == 0) (void)xb_add(&bar[XB_XCNT(b.x)], 1u);
    return b;
}
__device__ __forceinline__ void xcd_barrier_complete(unsigned* bar, unsigned x, unsigned& nloc, unsigned& nx) {
    const unsigned G = gridDim.x * gridDim.y * gridDim.z;
    unsigned sum, cnt, mine, sp = 0u;
    for (;;) {
        sum = 0u; cnt = 0u; mine = 0u;
#pragma unroll
        for (unsigned j = 0; j < 16; ++j) { const unsigned c = xb_ld(&bar[XB_XCNT(j)]); sum += c; cnt += (c > 0u) ? 1u : 0u; mine = (j == x) ? c : mine; }
        if (sum == G) break;
        __builtin_amdgcn_s_sleep(1);
        if ((++sp & 255u) == 0u) { if (xb_ld(&bar[XB_TMO])) break; if (sp > XB_SPIN_CAP) { atomicAdd(&bar[XB_TMO], 1u); break; } }
    }
    nloc = mine > 0u ? mine : 1u; nx = cnt > 0u ? cnt : 1u;
}
__device__ __forceinline__ void xcd_barrier(const XcdBarrier& b) {
    asm volatile("s_waitcnt vmcnt(0)" ::: "memory");
    __syncthreads();
    if (threadIdx.x == 0) {
        unsigned* bar = b.bar;
        __builtin_amdgcn_s_waitcnt(0);
        unsigned nloc = b.st[0], nx = b.st[1];
        if (nloc == 0u) { xcd_barrier_complete(bar, b.x, nloc, nx); b.st[0] = nloc; b.st[1] = nx; }
        const unsigned old = xb_add(&bar[XB_XSUB(b.x)], 1u);
        const unsigned gen = old / nloc;
        if (old + 1u == (gen + 1u) * nloc) {
            __builtin_amdgcn_fence(__ATOMIC_RELEASE, "agent");
            asm volatile("s_waitcnt vmcnt(0)" ::: "memory");
            const unsigned og = xb_add(&bar[XB_TOP], 1u);
            const unsigned tg = og / nx;
            if (og + 1u == (tg + 1u) * nx) xb_add(&bar[XB_TOPGEN], 1u);
            else XB_SPIN(xb_ld(&bar[XB_TOPGEN]) == tg, bar);
            __builtin_amdgcn_fence(__ATOMIC_ACQUIRE, "agent");
            xb_add(&bar[XB_XGEN(b.x)], 1u);
            asm volatile("s_waitcnt vmcnt(0)" ::: "memory");
        } else {
            XB_SPIN(xb_ld(&bar[XB_XGEN(b.x)]) == gen, bar);
            __builtin_amdgcn_fence(__ATOMIC_ACQUIRE, "agent");
            asm volatile("s_waitcnt vmcnt(0)" ::: "memory");
        }
    }
    __syncthreads();
}

__device__ __forceinline__ void p0_transpose_item(const float* W, int K, int N, bf16* WT, LAS float* scr, int item, int lane, const unsigned* kmax = nullptr) {
    const int nblk = N / 32, kb = item / nblk, nb = item % nblk, k0 = 64 * kb, n0 = 32 * nb;
#pragma unroll 8
    for (int i = 0; i < 32; ++i) { const int kk = 2 * i + (lane >> 5); float ks = 1.f; if (kmax) { const float mxv = __builtin_bit_cast(float, kmax[k0 + kk]); ks = mxv > 0.f ? mxv * (1.f / 127.f) : 1.f; }
        scr[kk * 33 + (lane & 31)] = W[(size_t)(k0 + kk) * N + n0 + (lane & 31)] * ks; }
    LDS_WAIT(); asm volatile("" ::: "memory");
    const int c = lane & 7;
#pragma unroll
    for (int j = 0; j < 4; ++j) { const int n = (lane >> 3) + 8 * j; const LAS float* s = scr + (8 * c) * 33 + n;
        v4u o; o.x = pk2(s[0 * 33], s[1 * 33]); o.y = pk2(s[2 * 33], s[3 * 33]); o.z = pk2(s[4 * 33], s[5 * 33]); o.w = pk2(s[6 * 33], s[7 * 33]);
        *(v4u*)(WT + (size_t)(n0 + n) * K + k0 + 8 * c) = o; }
    LDS_WAIT(); asm volatile("" ::: "memory");
}
__device__ __forceinline__ void p0_wc_item(const float* gwt, const float* scale, const float* wbp, float* WcF, unsigned* cmaxc, LAS float* scr, int item, int lane) {
    const int nb = item & 15, cb = (item >> 4) & 7, g = item >> 7;
    const int n = nb * 64 + lane;
    const f32x4* gsrc = (const f32x4*)(gwt + (size_t)((g * 128 + cb * 16) * 128));
    LAS f32x4* gt = (LAS f32x4*)scr;
#pragma unroll
    for (int i = 0; i < 8; ++i) gt[i * 64 + lane] = gsrc[i * 64 + lane];
    float acc[16];
#pragma unroll
    for (int c = 0; c < 16; ++c) acc[c] = 0.f;
    LDS_WAIT(); asm volatile("" ::: "memory");
    const float* bp = wbp + (size_t)(g * 128) * 1024 + n;
#pragma unroll 2
    for (int d4 = 0; d4 < 32; ++d4) {
        const f32x4 sc = *(const f32x4*)(scale + g * 128 + 4 * d4);
        const float b0 = bp[(size_t)(4 * d4 + 0) * 1024] * sc.x, b1 = bp[(size_t)(4 * d4 + 1) * 1024] * sc.y, b2 = bp[(size_t)(4 * d4 + 2) * 1024] * sc.z, b3 = bp[(size_t)(4 * d4 + 3) * 1024] * sc.w;
#pragma unroll
        for (int c = 0; c < 16; ++c) { const f32x4 gq = gt[c * 32 + d4]; acc[c] += (gq.x * b0 + gq.y * b1) + (gq.z * b2 + gq.w * b3); }
    }
    float* dst = WcF + (size_t)n * 512 + g * 128 + cb * 16;
    float mx = 0.f;
#pragma unroll
    for (int q = 0; q < 4; ++q) { *(f32x4*)(dst + 4 * q) = (f32x4){acc[4 * q], acc[4 * q + 1], acc[4 * q + 2], acc[4 * q + 3]};
        mx = fmaxf(mx, fmaxf(fmaxf(fabsf(acc[4 * q]), fabsf(acc[4 * q + 1])), fmaxf(fabsf(acc[4 * q + 2]), fabsf(acc[4 * q + 3])))); }
    atomicMax(cmaxc + n, __builtin_bit_cast(unsigned, mx));
    LDS_WAIT(); asm volatile("" ::: "memory");
}
__device__ __forceinline__ void p0_wc_quant_row(const float* WcF, const unsigned* cmaxc, unsigned char* Wc8, int n, int lane) {
    const f32x4* p = (const f32x4*)(WcF + (size_t)n * 512 + 8 * lane);
    const float mxv = __builtin_bit_cast(float, cmaxc[n]); const float sc = mxv > 0.f ? mxv * (1.f / 127.f) : 1.f, inv = 1.f / sc;
    v2u w;
#pragma unroll
    for (int j = 0; j < 2; ++j) { const f32x4 v = p[j]; unsigned a = 0;
#pragma unroll
        for (int c = 0; c < 4; ++c) { int q = (int)rintf(v[c] * inv); q = q > 127 ? 127 : (q < -127 ? -127 : q); a |= ((unsigned)q & 0xffu) << (8 * c); }
        w[j] = a; }
    *(v2u*)(Wc8 + (size_t)n * 512 + 8 * lane) = w;
}
__device__ __forceinline__ void p0_wpp_item(const float* wq, const float* keys, const float* gffn, float* WppF, unsigned* cmaxp, LAS float* scr, int item, int lane) {
    const int kb = item & 3, db = (item >> 2) & 15, hp = item >> 6;
    const int d = db * 64 + lane;
    const f32x4* kbase = (const f32x4*)(keys + (size_t)(hp * 128 + kb * 32) * 128);
    LAS f32x4* kt = (LAS f32x4*)scr;
#pragma unroll
    for (int i = 0; i < 16; ++i) kt[i * 64 + lane] = kbase[i * 64 + lane];
    float acc[32];
#pragma unroll
    for (int k = 0; k < 32; ++k) acc[k] = 0.f;
    const float* arow = wq + (size_t)d * 2048 + hp * 128;
    LDS_WAIT(); asm volatile("" ::: "memory");
#pragma unroll 4
    for (int c4 = 0; c4 < 32; ++c4) {
        const f32x4 a = *(const f32x4*)(arow + 4 * c4);
#pragma unroll
        for (int k = 0; k < 32; ++k) { const f32x4 kr = kt[k * 32 + c4]; acc[k] += (a.x * kr.x + a.y * kr.y) + (a.z * kr.z + a.w * kr.w); }
    }
    const float gs = gffn[d];
#pragma unroll
    for (int k = 0; k < 32; ++k) { const float v = acc[k] * gs; WppF[(size_t)(hp * 128 + kb * 32 + k) * 1024 + d] = v;
        const float mx = wave_max(fabsf(v)); if (lane == 0) atomicMax(cmaxp + hp * 128 + kb * 32 + k, __builtin_bit_cast(unsigned, mx)); }
    LDS_WAIT(); asm volatile("" ::: "memory");
}
__device__ __forceinline__ void p0_wpp_quant_row(const float* WppF, const unsigned* cmaxp, unsigned char* Wq8, float* SBP, int n, int lane) {
    const f32x4* p = (const f32x4*)(WppF + (size_t)n * 1024 + 16 * lane);
    const float mxv = __builtin_bit_cast(float, cmaxp[n]); const float sc = mxv > 0.f ? mxv * (1.f / 127.f) : 1.f, inv = 1.f / sc;
    v4u w;
#pragma unroll
    for (int j = 0; j < 4; ++j) { const f32x4 v = p[j]; unsigned a = 0;
#pragma unroll
        for (int c = 0; c < 4; ++c) { int q = (int)rintf(v[c] * inv); q = q > 127 ? 127 : (q < -127 ? -127 : q); a |= ((unsigned)q & 0xffu) << (8 * c); }
        w[j] = a; }
    *(v4u*)(Wq8 + (size_t)n * 1024 + 16 * lane) = w;
    if (lane == 0) SBP[n] = sc;
}
struct XRows { v4u a0, a1, b0, b1; float sa, sb; };
__device__ __forceinline__ void p5_x1_load(XRows& r, const bf16* X1, const float* SSQ, int r0, int r1, int lane) {
    r.a0 = *(const v4u*)(X1 + (size_t)r0 * D + 16 * lane); r.a1 = *(const v4u*)(X1 + (size_t)r0 * D + 16 * lane + 8);
    r.b0 = *(const v4u*)(X1 + (size_t)r1 * D + 16 * lane); r.b1 = *(const v4u*)(X1 + (size_t)r1 * D + 16 * lane + 8);
    r.sa = lane < 16 ? SSQ[(size_t)r0 * 16 + lane] : 0.f; r.sb = lane < 16 ? SSQ[(size_t)r1 * 16 + lane] : 0.f;
}
__device__ __forceinline__ void p5_x1_quant_rows2(const XRows& in, unsigned char* X1q, float* SX, float* SXR, float* RSTD, int r0, int r1, int lane) {
    const v4u a0 = in.a0, a1 = in.a1, b0 = in.b0, b1 = in.b1; const float sa = in.sa, sb = in.sb;
    float xa[16], xb[16];
    { float f[8]; unpack8(a0, f);
#pragma unroll
      for (int i = 0; i < 8; ++i) xa[i] = f[i];
      unpack8(a1, f);
#pragma unroll
      for (int i = 0; i < 8; ++i) xa[8 + i] = f[i];
      unpack8(b0, f);
#pragma unroll
      for (int i = 0; i < 8; ++i) xb[i] = f[i];
      unpack8(b1, f);
#pragma unroll
      for (int i = 0; i < 8; ++i) xb[8 + i] = f[i]; }
    float ma = 0.f, mb = 0.f;
#pragma unroll
    for (int i = 0; i < 16; ++i) { ma = fmaxf(ma, fabsf(xa[i])); mb = fmaxf(mb, fabsf(xb[i])); }
    ma = wave_max(ma); mb = wave_max(mb);
    const float ra = rsqrtf(wave_sum(sa) * (1.f / D) + RMS_EPS), rb = rsqrtf(wave_sum(sb) * (1.f / D) + RMS_EPS);
    const float sca = ma > 0.f ? ma * (1.f / 127.f) : 1.f, scb = mb > 0.f ? mb * (1.f / 127.f) : 1.f, ia = 1.f / sca, ib = 1.f / scb;
    v4u wa, wb;
#pragma unroll
    for (int j = 0; j < 4; ++j) { unsigned a = 0, b = 0;
#pragma unroll
        for (int c = 0; c < 4; ++c) { int q = (int)rintf(xa[4 * j + c] * ia); q = q > 127 ? 127 : (q < -127 ? -127 : q); a |= ((unsigned)q & 0xffu) << (8 * c);
            int q1 = (int)rintf(xb[4 * j + c] * ib); q1 = q1 > 127 ? 127 : (q1 < -127 ? -127 : q1); b |= ((unsigned)q1 & 0xffu) << (8 * c); }
        wa[j] = a; wb[j] = b; }
    *(v4u*)(X1q + (size_t)r0 * D + 16 * lane) = wa; *(v4u*)(X1q + (size_t)r1 * D + 16 * lane) = wb;
    if (lane == 0) { SX[r0] = sca; SX[r1] = scb; SXR[r0] = sca * ra; SXR[r1] = scb * rb; RSTD[r0] = ra; RSTD[r1] = rb; }
}
__device__ __forceinline__ void p0_h_row(const float* xrow, const float* g, bf16* orow, int lane) {
    const f32x4* xr = (const f32x4*)xrow + lane; const f32x4* gr = (const f32x4*)g + lane;
    f32x4 v[4]; float s = 0.f;
#pragma unroll
    for (int j = 0; j < 4; ++j) { v[j] = xr[64 * j]; s += (v[j].x * v[j].x + v[j].y * v[j].y) + (v[j].z * v[j].z + v[j].w * v[j].w); }
    const float rstd = rsqrtf(wave_sum(s) * (1.f / D) + RMS_EPS);
    v2u* o8 = (v2u*)orow + lane;
#pragma unroll
    for (int j = 0; j < 4; ++j) { const f32x4 gg = gr[64 * j]; v2u o; o.x = pk2(v[j].x * rstd * gg.x, v[j].y * rstd * gg.y); o.y = pk2(v[j].z * rstd * gg.z, v[j].w * rstd * gg.w); o8[64 * j] = o; }
}
struct HRows { f32x4 v0[4], v1[4]; };
__device__ __forceinline__ void p0_h_load(HRows& r, const float* x, int m0, int m1, int lane) {
    const f32x4* xr0 = (const f32x4*)(x + (size_t)m0 * D) + lane; const f32x4* xr1 = (const f32x4*)(x + (size_t)m1 * D) + lane;
#pragma unroll
    for (int j = 0; j < 4; ++j) { r.v0[j] = xr0[64 * j]; r.v1[j] = xr1[64 * j]; }
}
__device__ __forceinline__ void p0_h_rows2(const HRows& in, const float* g, unsigned char* Hq, float* SA, int m0, int m1, int lane) {
    const f32x4* gr = (const f32x4*)g + lane;
    f32x4 v0[4], v1[4]; float s0 = 0.f, s1 = 0.f;
#pragma unroll
    for (int j = 0; j < 4; ++j) { v0[j] = in.v0[j]; v1[j] = in.v1[j]; }
#pragma unroll
    for (int j = 0; j < 4; ++j) { s0 += (v0[j].x * v0[j].x + v0[j].y * v0[j].y) + (v0[j].z * v0[j].z + v0[j].w * v0[j].w); s1 += (v1[j].x * v1[j].x + v1[j].y * v1[j].y) + (v1[j].z * v1[j].z + v1[j].w * v1[j].w); }
    const float r0 = rsqrtf(wave_sum(s0) * (1.f / D) + RMS_EPS), r1 = rsqrtf(wave_sum(s1) * (1.f / D) + RMS_EPS);
    float mx0 = 0.f, mx1 = 0.f;
#pragma unroll
    for (int j = 0; j < 4; ++j) { const f32x4 gg = gr[64 * j]; v0[j] = v0[j] * gg * r0; v1[j] = v1[j] * gg * r1;
        mx0 = fmaxf(mx0, fmaxf(fmaxf(fabsf(v0[j].x), fabsf(v0[j].y)), fmaxf(fabsf(v0[j].z), fabsf(v0[j].w))));
        mx1 = fmaxf(mx1, fmaxf(fmaxf(fabsf(v1[j].x), fabsf(v1[j].y)), fmaxf(fabsf(v1[j].z), fabsf(v1[j].w)))); }
    mx0 = wave_max(mx0); mx1 = wave_max(mx1);
    const float sc0 = mx0 > 0.f ? mx0 * (1.f / 127.f) : 1.f, sc1 = mx1 > 0.f ? mx1 * (1.f / 127.f) : 1.f, i0 = 1.f / sc0, i1 = 1.f / sc1;
    unsigned* o0 = (unsigned*)(Hq + (size_t)m0 * D) + lane; unsigned* o1 = (unsigned*)(Hq + (size_t)m1 * D) + lane;
#pragma unroll
    for (int j = 0; j < 4; ++j) { unsigned a = 0, b = 0;
#pragma unroll
        for (int c = 0; c < 4; ++c) { int q = (int)rintf(v0[j][c] * i0); q = q > 127 ? 127 : (q < -127 ? -127 : q); a |= ((unsigned)q & 0xffu) << (8 * c);
            int q1 = (int)rintf(v1[j][c] * i1); q1 = q1 > 127 ? 127 : (q1 < -127 ? -127 : q1); b |= ((unsigned)q1 & 0xffu) << (8 * c); }
        o0[64 * j] = a; o1[64 * j] = b; }
    if (lane == 0) { SA[m0] = sc0; SA[m1] = sc1; }
}
__device__ __forceinline__ void p0_colmax_item(const float* W, int N, unsigned* cmax, int item, int lane) {
    const int nblk = N / 256, kb = item / nblk, nb = item % nblk;
    const float* p = W + (size_t)(kb * 64) * N + nb * 256 + 4 * lane;
    f32x4 mx = {0.f, 0.f, 0.f, 0.f};
#pragma unroll 8
    for (int k = 0; k < 64; ++k) { const f32x4 v = *(const f32x4*)(p + (size_t)k * N); mx.x = fmaxf(mx.x, fabsf(v.x)); mx.y = fmaxf(mx.y, fabsf(v.y)); mx.z = fmaxf(mx.z, fabsf(v.z)); mx.w = fmaxf(mx.w, fabsf(v.w)); }
    unsigned* c = cmax + nb * 256 + 4 * lane;
    atomicMax(c + 0, __builtin_bit_cast(unsigned, mx.x)); atomicMax(c + 1, __builtin_bit_cast(unsigned, mx.y)); atomicMax(c + 2, __builtin_bit_cast(unsigned, mx.z)); atomicMax(c + 3, __builtin_bit_cast(unsigned, mx.w));
}
__device__ __forceinline__ void p0_transpose_i8_item(const float* W, int K, int N, unsigned char* WT, const unsigned* cmax, float* SB, LAS float* scr, int item, int lane) {
    const int nblk = N / 32, kb = item / nblk, nb = item % nblk, k0 = 64 * kb, n0 = 32 * nb;
#pragma unroll 8
    for (int i = 0; i < 32; ++i) { const int kk = 2 * i + (lane >> 5); scr[kk * 33 + (lane & 31)] = W[(size_t)(k0 + kk) * N + n0 + (lane & 31)]; }
    LDS_WAIT(); asm volatile("" ::: "memory");
    const int c = lane & 3;
#pragma unroll
    for (int j = 0; j < 2; ++j) { const int n = (lane >> 2) + 16 * j; const LAS float* s = scr + (16 * c) * 33 + n;
        const float mxv = __builtin_bit_cast(float, cmax[n0 + n]); const float sc = mxv > 0.f ? mxv * (1.f / 127.f) : 1.f, inv = 1.f / sc;
        if (kb == 0 && c == 0) SB[n0 + n] = sc;
        v4u o;
#pragma unroll
        for (int q4 = 0; q4 < 4; ++q4) { unsigned a = 0;
#pragma unroll
            for (int b = 0; b < 4; ++b) { int q = (int)rintf(s[(4 * q4 + b) * 33] * inv); q = q > 127 ? 127 : (q < -127 ? -127 : q); a |= ((unsigned)q & 0xffu) << (8 * b); }
            o[q4] = a; }
        *(v4u*)(WT + (size_t)(n0 + n) * K + k0 + 16 * c) = o; }
    LDS_WAIT(); asm volatile("" ::: "memory");
}
__device__ __forceinline__ void p0_q_load(HRows& r, const float* src, int e0, int e1, int lane) {
    const f32x4* p0 = (const f32x4*)(src + (size_t)e0 * 1024 + 16 * lane); const f32x4* p1 = (const f32x4*)(src + (size_t)e1 * 1024 + 16 * lane);
#pragma unroll
    for (int j = 0; j < 4; ++j) { r.v0[j] = p0[j]; r.v1[j] = p1[j]; }
}
template <bool FP8>
__device__ __forceinline__ void p0_quant_rows2(const HRows& in, const float* gmul, unsigned char* dst, float* scale_out, int e0, int e1, int lane) {
    f32x4 v[2][4];
#pragma unroll
    for (int j = 0; j < 4; ++j) { v[0][j] = in.v0[j]; v[1][j] = in.v1[j]; }
    if (gmul) { const f32x4* gp = (const f32x4*)(gmul + 16 * lane);
#pragma unroll
        for (int j = 0; j < 4; ++j) { const f32x4 gg = gp[j]; v[0][j] = v[0][j] * gg; v[1][j] = v[1][j] * gg; } }
#pragma unroll
    for (int r = 0; r < 2; ++r) {
        float mx = 0.f;
#pragma unroll
        for (int j = 0; j < 4; ++j) mx = fmaxf(mx, fmaxf(fmaxf(fabsf(v[r][j].x), fabsf(v[r][j].y)), fmaxf(fabsf(v[r][j].z), fabsf(v[r][j].w))));
        mx = wave_max(mx);
        const float sc = mx > 0.f ? mx * (FP8 ? (1.f / 448.f) : (1.f / 127.f)) : 1.f, inv = 1.f / sc;
        v4u w;
#pragma unroll
        for (int j = 0; j < 4; ++j) {
            if (FP8) { int pk = __builtin_amdgcn_cvt_pk_fp8_f32(v[r][j].x * inv, v[r][j].y * inv, 0, false); pk = __builtin_amdgcn_cvt_pk_fp8_f32(v[r][j].z * inv, v[r][j].w * inv, pk, true); w[j] = (unsigned)pk; }
            else { unsigned acc = 0;
#pragma unroll
                for (int c = 0; c < 4; ++c) { int q = (int)rintf(v[r][j][c] * inv); q = q > 127 ? 127 : (q < -127 ? -127 : q); acc |= ((unsigned)q & 0xffu) << (8 * c); }
                w[j] = acc; }
        }
        const int e = r ? e1 : e0;
        *(v4u*)(dst + ((size_t)(lane >> 3) * NE + e) * 128 + 16 * (lane & 7)) = w;
        if (lane == 0) scale_out[e] = sc;
    }
}

__device__ __forceinline__ float ubf(unsigned w, int b) { return (float)((w >> (8 * b)) & 0xffu); }
typedef pg8::f32x4 (&AccRef)[2][2][4][2];
struct EpiZ {
    static constexpr bool PERM = true;
    unsigned char* O8; float* ZS; unsigned char* G8; const float* SA; const float* SB;
    __device__ __forceinline__ bool operator()(AccRef acc, const pg8::Unit& u, int wr, int wc, int fr, int fq) const {
        if (PROBE_SKIP_EPI == 1 && u.dup) return false;
        const int row0 = u.pm * 256 + wr * 64 + fr, col0 = u.pn * 256 + wc * 32 + 8 * fq;
        pg8::f32x4 sb[2][2];
#pragma unroll
        for (int bj = 0; bj < 2; ++bj) { sb[bj][0] = *(const pg8::f32x4*)(SB + col0 + bj * 128); sb[bj][1] = *(const pg8::f32x4*)(SB + col0 + bj * 128 + 4); }
        float sav[2][4];
#pragma unroll
        for (int ai = 0; ai < 2; ++ai)
#pragma unroll
            for (int m = 0; m < 4; ++m) sav[ai][m] = SA[row0 + ai * 128 + m * 16];
        asm volatile("" ::: "memory");
        const bool gate = u.pn >= 8;
#pragma unroll
        for (int ai = 0; ai < 2; ++ai)
#pragma unroll
            for (int m = 0; m < 4; ++m) { const int r = row0 + ai * 128 + m * 16; const float sa = sav[ai][m];
#pragma unroll
                for (int bj = 0; bj < 2; ++bj) { const pg8::i32x4 i0 = __builtin_bit_cast(pg8::i32x4, acc[ai][bj][m][0]), i1 = __builtin_bit_cast(pg8::i32x4, acc[ai][bj][m][1]);
                    pg8::f32x4 v0 = {(float)i0[0], (float)i0[1], (float)i0[2], (float)i0[3]}, v1 = {(float)i1[0], (float)i1[1], (float)i1[2], (float)i1[3]};
                    v0 = v0 * sb[bj][0] * sa; v1 = v1 * sb[bj][1] * sa;
                    if (!gate) {
                        float am = fmaxf(fmaxf(fmaxf(fabsf(v0[0]), fabsf(v0[1])), fmaxf(fabsf(v0[2]), fabsf(v0[3]))), fmaxf(fmaxf(fabsf(v1[0]), fabsf(v1[1])), fmaxf(fabsf(v1[2]), fabsf(v1[3]))));
                        am = fmaxf(am, xor16f(am)); am = fmaxf(am, xor32f(am));
                        const float sc = am > 0.f ? am * (1.f / 127.f) : 1.f, inv = __builtin_amdgcn_rcpf(sc) * 0.99999f;
#define QZ(x) __builtin_bit_cast(unsigned, fmaf((x), inv, 12582912.f + 128.f))
#define PK4(a, b, c, d) (__builtin_amdgcn_perm(QZ(b), QZ(a), 0x0c0c0400u) | (__builtin_amdgcn_perm(QZ(d), QZ(c), 0x0c0c0400u) << 16))
                        v2u w;
                        w.x = PK4(v0[0], v0[1], v0[2], v0[3]); w.y = PK4(v1[0], v1[1], v1[2], v1[3]);
#undef PK4
#undef QZ
                        *(v2u*)(O8 + (size_t)r * 2048 + col0 + bj * 128) = w;
                        if (fq == 0) ZS[(size_t)r * 64 + ((col0 + bj * 128) >> 5)] = sc;
                    } else { v2u w;
#define SQ(x) __builtin_bit_cast(unsigned, fmaxf(255.f * __builtin_amdgcn_rcpf(1.f + __builtin_amdgcn_exp2f((x) * -1.44269504089f)), 1.f) + 12582912.f)
#define PK4(a, b, c, d) (__builtin_amdgcn_perm(SQ(b), SQ(a), 0x0c0c0400u) | (__builtin_amdgcn_perm(SQ(d), SQ(c), 0x0c0c0400u) << 16))
                        w.x = PK4(v0[0], v0[1], v0[2], v0[3]); w.y = PK4(v1[0], v1[1], v1[2], v1[3]);
#undef PK4
#undef SQ
                        *(v2u*)(G8 + (size_t)r * 2048 + (col0 - 2048) + bj * 128) = w; } } }
        return false;
    }
};
__device__ __forceinline__ float einv(float x) { return 1.f + __builtin_amdgcn_exp2f(x * -1.44269504089f); }
__device__ __forceinline__ float sigm_ratio(float ga, float gb) { return einv(gb) * __builtin_amdgcn_rcpf(einv(ga)); }
__device__ __forceinline__ float iscale(float accbits_as_f, float r) { const int v = __builtin_bit_cast(int, accbits_as_f); const float y = fminf(fmaxf((float)v * r, -2.0e9f), 2.0e9f); return __builtin_bit_cast(float, (int)rintf(y)); }
struct EpiGate {
    static constexpr bool PERM = true;
    const unsigned char* G8; bf16* Mo; const float* SPC;
    __device__ __forceinline__ bool operator()(AccRef acc, const pg8::Unit& u, int wr, int wc, int fr, int fq) const {
        const int row0 = u.pm * 256 + wr * 64 + fr, col0 = u.pn * 256 + wc * 32 + 8 * fq;
        const unsigned goff0 = (unsigned)row0 * 2048u + (unsigned)col0;
        if (u.seg == 0) {
#pragma unroll
            for (int ai = 0; ai < 2; ++ai)
#pragma unroll
            for (int mh = 0; mh < 2; ++mh) {
                v2u ga[2][2], gb[2][2];
#pragma unroll
                for (int mm = 0; mm < 2; ++mm) { const unsigned go = goff0 + (unsigned)((ai * 128 + (2 * mh + mm) * 16) * 2048);
#pragma unroll
                    for (int bj = 0; bj < 2; ++bj) { ga[mm][bj] = *(const v2u*)(G8 + go + bj * 128); gb[mm][bj] = *(const v2u*)(G8 + go + 1024 + bj * 128); } }
                asm volatile("" ::: "memory");
#pragma unroll
                for (int mm = 0; mm < 2; ++mm)
#pragma unroll
                    for (int bj = 0; bj < 2; ++bj) { const v2u a = ga[mm][bj], b = gb[mm][bj]; const int m = 2 * mh + mm;
                        pg8::f32x4& v0 = acc[ai][bj][m][0]; pg8::f32x4& v1 = acc[ai][bj][m][1];
#pragma unroll
                        for (int e = 0; e < 4; ++e) { v0[e] = iscale(v0[e], ubf(a.x, e) * __builtin_amdgcn_rcpf(ubf(b.x, e))); v1[e] = iscale(v1[e], ubf(a.y, e) * __builtin_amdgcn_rcpf(ubf(b.y, e))); } }
                asm volatile("" ::: "memory");
            }
            return true;
        }
#pragma unroll
        for (int ai = 0; ai < 2; ++ai)
#pragma unroll
        for (int mh = 0; mh < 2; ++mh) {
            v2u gb[2][2]; float sr[2];
#pragma unroll
            for (int mm = 0; mm < 2; ++mm) { const int ro = ai * 128 + (2 * mh + mm) * 16; const unsigned go = goff0 + (unsigned)(ro * 2048); sr[mm] = SPC[row0 + ro] * (1.f / 255.f);
#pragma unroll
                for (int bj = 0; bj < 2; ++bj) gb[mm][bj] = *(const v2u*)(G8 + go + 1024 + bj * 128); }
            asm volatile("" ::: "memory");
#pragma unroll
            for (int mm = 0; mm < 2; ++mm) { const int m = 2 * mh + mm; const size_t r = (size_t)(row0 + ai * 128 + m * 16); bf16* mo = Mo + r * D + col0; const float rs = sr[mm];
#pragma unroll
                for (int bj = 0; bj < 2; ++bj) { const v2u b = gb[mm][bj];
                    const pg8::i32x4 i0 = __builtin_bit_cast(pg8::i32x4, acc[ai][bj][m][0]), i1 = __builtin_bit_cast(pg8::i32x4, acc[ai][bj][m][1]);
                    const pg8::f32x4 v0 = (pg8::f32x4){(float)i0[0], (float)i0[1], (float)i0[2], (float)i0[3]} * rs, v1 = (pg8::f32x4){(float)i1[0], (float)i1[1], (float)i1[2], (float)i1[3]} * rs; v4u w;
                    w.x = pg8::cvt_pk_bf16(v0[0] * ubf(b.x, 0), v0[1] * ubf(b.x, 1)); w.y = pg8::cvt_pk_bf16(v0[2] * ubf(b.x, 2), v0[3] * ubf(b.x, 3));
                    w.z = pg8::cvt_pk_bf16(v1[0] * ubf(b.y, 0), v1[1] * ubf(b.y, 1)); w.w = pg8::cvt_pk_bf16(v1[2] * ubf(b.y, 2), v1[3] * ubf(b.y, 3));
                    *(v4u*)(mo + bj * 128) = w; } }
            asm volatile("" ::: "memory");
        }
        return false;
    }
};
struct EpiRes {
    static constexpr bool PERM = true;
    const float* X; bf16* X1; float* SSQ;
    __device__ __forceinline__ bool operator()(AccRef acc, const pg8::Unit& u, int wr, int wc, int fr, int fq) const {
        if (PROBE_SKIP_EPI && u.dup) return false;
        const int row0 = u.pm * 256 + wr * 64 + fr, col0 = u.pn * 256 + wc * 32 + 8 * fq;
#pragma unroll
        for (int ai = 0; ai < 2; ++ai) {
            pg8::f32x4 xr[4][2][2];
#pragma unroll
            for (int m = 0; m < 4; ++m) { const float* xp = X + (size_t)(row0 + ai * 128 + m * 16) * D + col0;
#pragma unroll
                for (int bj = 0; bj < 2; ++bj) { xr[m][bj][0] = *(const pg8::f32x4*)(xp + bj * 128); xr[m][bj][1] = *(const pg8::f32x4*)(xp + bj * 128 + 4); } }
            asm volatile("" ::: "memory");
#pragma unroll
            for (int m = 0; m < 4; ++m) { const size_t r = (size_t)(row0 + ai * 128 + m * 16); bf16* o = X1 + r * D + col0; float ss = 0.f;
#pragma unroll
                for (int bj = 0; bj < 2; ++bj) { const pg8::f32x4 v0 = acc[ai][bj][m][0] + xr[m][bj][0], v1 = acc[ai][bj][m][1] + xr[m][bj][1];
                    ss += (v0[0] * v0[0] + v0[1] * v0[1]) + (v0[2] * v0[2] + v0[3] * v0[3]) + (v1[0] * v1[0] + v1[1] * v1[1]) + (v1[2] * v1[2] + v1[3] * v1[3]);
                    v4u w; w.x = pg8::cvt_pk_bf16(v0[0], v0[1]); w.y = pg8::cvt_pk_bf16(v0[2], v0[3]); w.z = pg8::cvt_pk_bf16(v1[0], v1[1]); w.w = pg8::cvt_pk_bf16(v1[2], v1[3]);
                    *(v4u*)(o + bj * 128) = w; }
                ss += xor16f(ss); ss += xor32f(ss);
                if (fq == 0) SSQ[r * 16 + u.pn * 4 + wc] = ss; }
            asm volatile("" ::: "memory");
        }
        return false;
    }
};
struct EpiScore {
    static constexpr bool PERM = true;
    const float* SXR; const float* SBP; _Float16* S;
    __device__ __forceinline__ bool operator()(AccRef acc, const pg8::Unit& u, int wr, int wc, int fr, int fq) const {
        if (PROBE_SKIP_EPI && u.dup) return false;
        const int row0 = u.pm * 256 + wr * 64 + fr, col0 = u.pn * 256 + wc * 32 + 8 * fq;
        pg8::f32x4 sb[2][2]; float rs[2][4];
#pragma unroll
        for (int bj = 0; bj < 2; ++bj) { sb[bj][0] = *(const pg8::f32x4*)(SBP + col0 + bj * 128); sb[bj][1] = *(const pg8::f32x4*)(SBP + col0 + bj * 128 + 4); }
#pragma unroll
        for (int ai = 0; ai < 2; ++ai)
#pragma unroll
            for (int m = 0; m < 4; ++m) rs[ai][m] = SXR[row0 + ai * 128 + m * 16];
        asm volatile("" ::: "memory");
#pragma unroll
        for (int ai = 0; ai < 2; ++ai)
#pragma unroll
            for (int m = 0; m < 4; ++m) { const size_t r = (size_t)(row0 + ai * 128 + m * 16);
                const float rstd = rs[ai][m];
                _Float16* o = S + r * NSC + col0;
#pragma unroll
                for (int bj = 0; bj < 2; ++bj) { const pg8::i32x4 i0 = __builtin_bit_cast(pg8::i32x4, acc[ai][bj][m][0]), i1 = __builtin_bit_cast(pg8::i32x4, acc[ai][bj][m][1]);
                    pg8::f32x4 v0 = {(float)i0[0], (float)i0[1], (float)i0[2], (float)i0[3]}, v1 = {(float)i1[0], (float)i1[1], (float)i1[2], (float)i1[3]};
                    v0 = v0 * sb[bj][0] * rstd; v1 = v1 * sb[bj][1] * rstd;
                    typedef _Float16 h2 __attribute__((ext_vector_type(2)));
                    h2 p0 = {(_Float16)v0[0], (_Float16)v0[1]}, p1 = {(_Float16)v0[2], (_Float16)v0[3]}, p2 = {(_Float16)v1[0], (_Float16)v1[1]}, p3 = {(_Float16)v1[2], (_Float16)v1[3]};
                    v4u w; w.x = __builtin_bit_cast(unsigned, p0); w.y = __builtin_bit_cast(unsigned, p1); w.z = __builtin_bit_cast(unsigned, p2); w.w = __builtin_bit_cast(unsigned, p3);
                    *(v4u*)(o + bj * 128) = w; } }
        return false;
    }
};

__device__ __forceinline__ void unpack8q(v2u w, float sc, float (&f)[8]) {
    const float bias = -128.f * sc;
    f[0] = fmaf(ubf(w.x, 0), sc, bias); f[1] = fmaf(ubf(w.x, 1), sc, bias); f[2] = fmaf(ubf(w.x, 2), sc, bias); f[3] = fmaf(ubf(w.x, 3), sc, bias);
    f[4] = fmaf(ubf(w.y, 0), sc, bias); f[5] = fmaf(ubf(w.y, 1), sc, bias); f[6] = fmaf(ubf(w.y, 2), sc, bias); f[7] = fmaf(ubf(w.y, 3), sc, bias);
}
__device__ __forceinline__ void p2_timemix(const unsigned char* Z8, const float* ZS, const float* convw, unsigned char* PA, unsigned char* CA, float* SPC, int gw, int NGW, int lane) {
    const int w = 2 << (lane >> 4);
    const int ch = 8 * lane;
    const int sg = lane >> 2;
    float cw0[8], cw1[8], cw2[8];
#pragma unroll
    for (int i = 0; i < 8; ++i) { cw0[i] = convw[ch + i]; cw1[i] = convw[512 + ch + i]; cw2[i] = convw[1024 + ch + i]; }
    for (int chunk = gw; chunk < M / 32; chunk += NGW) {
        const int t0 = chunk * 32, s0 = t0 & (SEQ - 1);
        float sum[8], up1[8], up2[8];
#pragma unroll
        for (int i = 0; i < 8; ++i) { sum[i] = 0.f; up1[i] = 0.f; up2[i] = 0.f; }
        if (s0 > 0) {
            for (int j = 1; j < 16; ++j) {
                if (j < w) { float f[8]; unpack8q(*(const v2u*)(Z8 + (size_t)(t0 - j) * 2048 + ch), ZS[(size_t)(t0 - j) * 64 + sg], f);
#pragma unroll
                    for (int i = 0; i < 8; ++i) sum[i] += f[i]; }
            }
            float c[8], v[8];
            unpack8q(*(const v2u*)(Z8 + (size_t)(t0 - 2) * 2048 + 512 + ch), ZS[(size_t)(t0 - 2) * 64 + 16 + sg], c); unpack8q(*(const v2u*)(Z8 + (size_t)(t0 - 2) * 2048 + 1536 + ch), ZS[(size_t)(t0 - 2) * 64 + 48 + sg], v);
#pragma unroll
            for (int i = 0; i < 8; ++i) up2[i] = c[i] * v[i];
            unpack8q(*(const v2u*)(Z8 + (size_t)(t0 - 1) * 2048 + 512 + ch), ZS[(size_t)(t0 - 1) * 64 + 16 + sg], c); unpack8q(*(const v2u*)(Z8 + (size_t)(t0 - 1) * 2048 + 1536 + ch), ZS[(size_t)(t0 - 1) * 64 + 48 + sg], v);
#pragma unroll
            for (int i = 0; i < 8; ++i) up1[i] = c[i] * v[i];
        }
        v2u nz, nc, nb, nv, nold; float qz, qc, qb, qv, qold;
#define P2_LOAD(tt, ss) { const unsigned char* zr = Z8 + (size_t)(tt) * 2048 + ch; const float* sr = ZS + (size_t)(tt) * 64 + sg; \
          nz = *(const v2u*)zr; nc = *(const v2u*)(zr + 512); nb = *(const v2u*)(zr + 1024); nv = *(const v2u*)(zr + 1536); qz = sr[0]; qc = sr[16]; qb = sr[32]; qv = sr[48]; \
          const int to = ((ss) + 1 - w >= 0) ? ((tt) + 1 - w) : (tt); nold = *(const v2u*)(Z8 + (size_t)to * 2048 + ch); qold = ZS[(size_t)to * 64 + sg]; }
        P2_LOAD(t0, s0)
        float po[8], poc[8], pmx = 0.f; int pt = t0;
#pragma unroll
        for (int i = 0; i < 8; ++i) { po[i] = 0.f; poc[i] = 0.f; }
#define QP(x) __builtin_bit_cast(unsigned, fmaf((x), iq, 12582912.f))
#define PK4(a_, b_, c_, d_) (__builtin_amdgcn_perm(QP(b_), QP(a_), 0x0c0c0400u) | (__builtin_amdgcn_perm(QP(d_), QP(c_), 0x0c0c0400u) << 16))
#define P2_FLUSH() { const float mxw = wave_max(pmx); const float scq = mxw > 0.f ? mxw * (1.f / 127.f) : 1.f, iq = __builtin_amdgcn_rcpf(scq) * 0.99999f; \
            *(v2u*)(PA + (size_t)pt * DP + ch) = (v2u){PK4(po[0], po[1], po[2], po[3]), PK4(po[4], po[5], po[6], po[7])}; \
            *(v2u*)(CA + (size_t)pt * DP + ch) = (v2u){PK4(poc[0], poc[1], poc[2], poc[3]), PK4(poc[4], poc[5], poc[6], poc[7])}; \
            if (lane == 0) SPC[pt] = scq; }
        for (int i2 = 0; i2 < 32; ++i2) {
            const int t = t0 + i2, s = s0 + i2;
            float zt[8], c[8], b[8], v[8], o[8], fo[8];
            unpack8q(nz, qz, zt); unpack8q(nc, qc, c); unpack8q(nb, qb, b); unpack8q(nv, qv, v); unpack8q(nold, qold, fo);
            { const int d1 = (i2 < 31) ? 1 : 0; P2_LOAD(t + d1, s + d1) }
            P2_FLUSH()
            const int cnt = (s + 1) < w ? (s + 1) : w; const float rc = 1.f / (float)cnt;
#pragma unroll
            for (int i = 0; i < 8; ++i) { sum[i] += zt[i]; o[i] = sum[i] * rc - zt[i]; }
            if (s + 1 - w >= 0) {
#pragma unroll
                for (int i = 0; i < 8; ++i) sum[i] -= fo[i]; }
            float oc[8];
#pragma unroll
            for (int i = 0; i < 8; ++i) { const float uu = c[i] * v[i]; oc[i] = b[i] * (cw0[i] * up2[i] + cw1[i] * up1[i] + cw2[i] * uu); up2[i] = up1[i]; up1[i] = uu; }
            float mx = 0.f;
#pragma unroll
            for (int i = 0; i < 8; ++i) { mx = fmaxf(mx, fmaxf(fabsf(o[i]), fabsf(oc[i]))); po[i] = o[i]; poc[i] = oc[i]; }
            pmx = mx; pt = t;
        }
        P2_FLUSH()
#undef P2_FLUSH
#undef PK4
#undef QP
#undef P2_LOAD
    }
}

#define TK_NEG (-3.0e38f)
__device__ __forceinline__ void tk_ce(float& a, float& b) { const float hi = fmaxf(a, b), lo = fminf(a, b); a = hi; b = lo; }
__device__ __forceinline__ void tk_sort8(float (&v)[8]) {
    tk_ce(v[0], v[1]); tk_ce(v[2], v[3]); tk_ce(v[4], v[5]); tk_ce(v[6], v[7]);
    tk_ce(v[0], v[2]); tk_ce(v[1], v[3]); tk_ce(v[4], v[6]); tk_ce(v[5], v[7]);
    tk_ce(v[1], v[2]); tk_ce(v[5], v[6]);
    tk_ce(v[0], v[4]); tk_ce(v[1], v[5]); tk_ce(v[2], v[6]); tk_ce(v[3], v[7]);
    tk_ce(v[2], v[4]); tk_ce(v[3], v[5]);
    tk_ce(v[1], v[2]); tk_ce(v[3], v[4]); tk_ce(v[5], v[6]);
}
__device__ __forceinline__ void tk_bmerge16(float (&x)[16]) {
#pragma unroll
    for (int i = 0; i < 8; ++i) tk_ce(x[i], x[i + 8]);
#pragma unroll
    for (int b = 0; b < 16; b += 8)
#pragma unroll
        for (int i = 0; i < 4; ++i) tk_ce(x[b + i], x[b + i + 4]);
#pragma unroll
    for (int b = 0; b < 16; b += 4)
#pragma unroll
        for (int i = 0; i < 2; ++i) tk_ce(x[b + i], x[b + i + 2]);
#pragma unroll
    for (int b = 0; b < 16; b += 2) tk_ce(x[b], x[b + 1]);
}
__device__ __forceinline__ void tk_add16(float (&L)[16], float (&a)[8], float (&b)[8]) {
    tk_sort8(a); tk_sort8(b);
    float s[16];
#pragma unroll
    for (int i = 0; i < 8; ++i) { s[i] = a[i]; s[8 + i] = b[7 - i]; }
    tk_bmerge16(s);
#pragma unroll
    for (int i = 0; i < 16; ++i) L[i] = fmaxf(L[i], s[15 - i]);
    tk_bmerge16(L);
}
__device__ __forceinline__ void tk_final(const float (&A)[16], const float (&B)[16], float (&FV)[16]) {
    float av[16], bv[16];
#pragma unroll
    for (int i = 0; i < 16; ++i) { av[i] = __builtin_bit_cast(float, __builtin_bit_cast(unsigned, A[i]) & ~0x7fu); bv[i] = __builtin_bit_cast(float, __builtin_bit_cast(unsigned, B[i]) & ~0x7fu); }
#pragma unroll
    for (int j = 0; j < 16; ++j) FV[j] = __builtin_bit_cast(float, (__builtin_bit_cast(unsigned, av[0] + bv[j]) & ~0xffu) | (unsigned)j);
#pragma unroll
    for (int i = 1; i < 16; ++i)
#pragma unroll
        for (int j = 0; j < 16; ++j)
            if ((i + 1) * (j + 1) <= 16) {
                float x = __builtin_bit_cast(float, (__builtin_bit_cast(unsigned, av[i] + bv[j]) & ~0xffu) | (unsigned)(i * 16 + j));
#pragma unroll
                for (int s = (i + 1) * (j + 1) - 1; s < 16; ++s) { const float hi = fmaxf(FV[s], x); x = fminf(FV[s], x); FV[s] = hi; }
            }
}

__device__ __forceinline__ void tk_unpack_octets(const v4u d0, const v4u d1, unsigned kb0, float (&a)[8], float (&b)[8]) {
    const unsigned w0[4] = {d0.x, d0.y, d0.z, d0.w}, w1[4] = {d1.x, d1.y, d1.z, d1.w};
#pragma unroll
    for (int e = 0; e < 8; ++e) {
        const unsigned ha = (e & 1) ? (w0[e >> 1] >> 16) : (w0[e >> 1] & 0xffffu), hb = (e & 1) ? (w1[e >> 1] >> 16) : (w1[e >> 1] & 0xffffu);
        const float fa = (float)__builtin_bit_cast(_Float16, (unsigned short)ha), fb = (float)__builtin_bit_cast(_Float16, (unsigned short)hb);
        a[e] = __builtin_bit_cast(float, __builtin_bit_cast(unsigned, fa) | (kb0 - (unsigned)e));
        b[e] = __builtin_bit_cast(float, __builtin_bit_cast(unsigned, fb) | (kb0 - 8u - (unsigned)e));
    }
}
__device__ __forceinline__ void tk_emit(const float (&LA)[16], const float (&LB)[16], LAS unsigned char* kl, size_t r, unsigned short* IDX, float* EV, float* INV) {
    float FV[16];
    tk_final(LA, LB, FV);
#pragma unroll
    for (int q = 0; q < 4; ++q) { unsigned wa = 0, wb = 0;
#pragma unroll
        for (int e = 0; e < 4; ++e) { wa |= (127u - (__builtin_bit_cast(unsigned, LA[4 * q + e]) & 0x7fu)) << (8 * e); wb |= (127u - (__builtin_bit_cast(unsigned, LB[4 * q + e]) & 0x7fu)) << (8 * e); }
        *(LAS unsigned*)(kl + 4 * q) = wa; *(LAS unsigned*)(kl + 16 + 4 * q) = wb; }
    asm volatile("s_waitcnt lgkmcnt(0)" ::: "memory");
    int FI[16]; float ev[16]; float sum = 0.f;
    const float top = __builtin_bit_cast(float, __builtin_bit_cast(unsigned, FV[0]) & ~0xffu);
#pragma unroll
    for (int s = 0; s < 16; ++s) { const unsigned u = __builtin_bit_cast(unsigned, FV[s]); const unsigned ci = (u >> 4) & 15u, cj = u & 15u;
        const unsigned ka = *(const LAS unsigned char*)(kl + ci), kb = *(const LAS unsigned char*)(kl + 16 + cj);
        FI[s] = (int)(ka * 128u + kb);
        ev[s] = __expf(__builtin_bit_cast(float, u & ~0xffu) - top); sum += ev[s]; }
    v4u i0, i1;
    i0.x = (unsigned)FI[0] | ((unsigned)FI[1] << 16); i0.y = (unsigned)FI[2] | ((unsigned)FI[3] << 16); i0.z = (unsigned)FI[4] | ((unsigned)FI[5] << 16); i0.w = (unsigned)FI[6] | ((unsigned)FI[7] << 16);
    i1.x = (unsigned)FI[8] | ((unsigned)FI[9] << 16); i1.y = (unsigned)FI[10] | ((unsigned)FI[11] << 16); i1.z = (unsigned)FI[12] | ((unsigned)FI[13] << 16); i1.w = (unsigned)FI[14] | ((unsigned)FI[15] << 16);
    *(v4u*)(IDX + r * 16) = i0; *(v4u*)(IDX + r * 16 + 8) = i1;
#pragma unroll
    for (int q = 0; q < 4; ++q) *(f32x4*)(EV + r * 16 + 4 * q) = (f32x4){ev[4 * q], ev[4 * q + 1], ev[4 * q + 2], ev[4 * q + 3]};
    INV[r] = 1.f / sum;
}
__device__ __forceinline__ void p6_topk(const _Float16* S, unsigned short* IDX, float* EV, float* INV, LAS unsigned char* lds, int gw, int NGW, int wave, int lane) {
    LAS unsigned char* my = lds + wave * 10240;
    const int srow = lane >> 2, schn = lane & 3;
    v4u nx[8];
    { const char* b0 = (const char*)S + (size_t)GRP_QREV(gw) * 128 * 512;
#pragma unroll
      for (int q = 0; q < 8; ++q) nx[q] = *(const v4u*)(b0 + (size_t)(16 * q + srow) * 512 + 16 * schn); }
    for (int lg = gw; lg < M * NH / 128; lg += NGW) {
        const int grp = GRP_QREV(lg);
        const char* base = (const char*)S + (size_t)grp * 128 * 512;
        const char* nbase = (const char*)S + (size_t)GRP_QREV((lg + NGW) < M * NH / 128 ? (lg + NGW) : lg) * 128 * 512;
        float LA0[16], LB0[16], LA1[16], LB1[16];
#pragma unroll
        for (int half = 0; half < 2; ++half) {
            float L0[16], L1[16];
#pragma unroll
            for (int i = 0; i < 16; ++i) { L0[i] = TK_NEG; L1[i] = TK_NEG; }
#pragma unroll 1
            for (int step = 0; step < 4; ++step) {
                const int j = half * 4 + step;
#pragma unroll
                for (int q = 0; q < 8; ++q) *(LAS v4u*)(my + (16 * q + srow) * 80 + 16 * schn) = nx[q];
                asm volatile("s_waitcnt lgkmcnt(0)" ::: "memory");
                { const char* pb = (j < 7) ? base + 64 * (j + 1) : nbase;
#pragma unroll
                  for (int q = 0; q < 8; ++q) nx[q] = *(const v4u*)(pb + (size_t)(16 * q + srow) * 512 + 16 * schn); }
                const LAS unsigned char* r0p = my + lane * 80; const LAS unsigned char* r1p = my + (lane + 64) * 80;
                const v4u a0 = *(const LAS v4u*)(r0p), a1 = *(const LAS v4u*)(r0p + 16), a2 = *(const LAS v4u*)(r0p + 32), a3 = *(const LAS v4u*)(r0p + 48);
                const v4u c0 = *(const LAS v4u*)(r1p), c1 = *(const LAS v4u*)(r1p + 16), c2 = *(const LAS v4u*)(r1p + 32), c3 = *(const LAS v4u*)(r1p + 48);
                const unsigned kb0 = (unsigned)(127 - step * 32);
                float pa[8], pb2[8], qa[8], qb[8];
                tk_unpack_octets(a0, a1, kb0, pa, pb2); tk_unpack_octets(c0, c1, kb0, qa, qb);
                tk_add16(L0, pa, pb2); tk_add16(L1, qa, qb);
                tk_unpack_octets(a2, a3, kb0 - 16u, pa, pb2); tk_unpack_octets(c2, c3, kb0 - 16u, qa, qb);
                tk_add16(L0, pa, pb2); tk_add16(L1, qa, qb);
                asm volatile("s_waitcnt lgkmcnt(0)" ::: "memory");
            }
#pragma unroll
            for (int i = 0; i < 16; ++i) { if (half == 0) { LA0[i] = L0[i]; LA1[i] = L1[i]; } else { LB0[i] = L0[i]; LB1[i] = L1[i]; } }
        }
        tk_emit(LA0, LB0, my + lane * 80, (size_t)grp * 128 + lane, IDX, EV, INV);
        tk_emit(LA1, LB1, my + (lane + 64) * 80, (size_t)grp * 128 + 64 + lane, IDX, EV, INV);
        asm volatile("s_waitcnt lgkmcnt(0)" ::: "memory");
    }
}

typedef float v2f __attribute__((ext_vector_type(2)));
__device__ __forceinline__ int q_pull(unsigned* heads, int s, int lane) { int it = 0; if (lane == 0) it = (int)__hip_atomic_fetch_add(heads + 64 * s, 1u, __ATOMIC_RELAXED, __HIP_MEMORY_SCOPE_AGENT); return __builtin_amdgcn_readfirstlane(it); }

struct UIdx { v4u ia, ib; };
struct UBuf { v4u ur[16]; v4u xa, xb; };
__device__ __forceinline__ void u_idx(UIdx& p, int t, const unsigned short* IDX, int lane) { const unsigned short* ip = IDX + (size_t)t * 128 + (lane >> 3) * 16; p.ia = *(const v4u*)ip; p.ib = *(const v4u*)(ip + 8); }
__device__ __forceinline__ void u_gather(UBuf& b, const UIdx& p, int s, int t, const bf16* X1, const unsigned char* U8, int lane) {
    const int c = lane & 7;
    const unsigned iw[8] = {p.ia.x, p.ia.y, p.ia.z, p.ia.w, p.ib.x, p.ib.y, p.ib.z, p.ib.w};
    const unsigned char* ub = U8 + (size_t)s * NE * 128 + 16 * c;
#pragma unroll
    for (int i = 0; i < 16; ++i) { const unsigned e = (i & 1) ? (iw[i >> 1] >> 16) : (iw[i >> 1] & 0xffffu); b.ur[i] = *(const v4u*)(ub + (size_t)e * 128); }
    const bf16* xp = X1 + (size_t)t * D + 128 * s + 16 * c;
    b.xa = *(const v4u*)xp; b.xb = *(const v4u*)(xp + 8);
}
__device__ __forceinline__ void u_compute(const UBuf& bf, int s, int t, float* PART, int lane) {
    float xv[16];
    { float f[8]; unpack8(bf.xa, f);
#pragma unroll
      for (int i = 0; i < 8; ++i) xv[i] = f[i];
      unpack8(bf.xb, f);
#pragma unroll
      for (int i = 0; i < 8; ++i) xv[8 + i] = f[i]; }
    float mx = 0.f;
#pragma unroll
    for (int i = 0; i < 16; ++i) mx = fmaxf(mx, fabsf(xv[i]));
    mx = fmaxf(mx, __shfl_xor(mx, 1)); mx = fmaxf(mx, __shfl_xor(mx, 2)); mx = fmaxf(mx, __shfl_xor(mx, 4));
    const float sx = mx > 0.f ? mx * (1.f / 127.f) : 1.f, isx = 1.f / sx;
    int xq[4];
#pragma unroll
    for (int j = 0; j < 4; ++j) { unsigned a = 0;
#pragma unroll
        for (int b = 0; b < 4; ++b) { int q = (int)rintf(xv[4 * j + b] * isx); q = q > 127 ? 127 : (q < -127 ? -127 : q); a |= ((unsigned)q & 0xffu) << (8 * b); }
        xq[j] = (int)a; }
    int p[16];
#pragma unroll
    for (int i = 0; i < 16; ++i) { int a = __builtin_amdgcn_sdot4((int)bf.ur[i].x, xq[0], 0, false); a = __builtin_amdgcn_sdot4((int)bf.ur[i].y, xq[1], a, false);
        a = __builtin_amdgcn_sdot4((int)bf.ur[i].z, xq[2], a, false); a = __builtin_amdgcn_sdot4((int)bf.ur[i].w, xq[3], a, false); p[i] = a; }
    int r8[8], r4[4], r2[2];
    const bool b2 = lane & 4, b1 = lane & 2, b0 = lane & 1;
#pragma unroll
    for (int i = 0; i < 8; ++i) { const int snd = b2 ? p[i] : p[i + 8], kp = b2 ? p[i + 8] : p[i]; r8[i] = kp + __shfl_xor(snd, 4); }
#pragma unroll
    for (int i = 0; i < 4; ++i) { const int snd = b1 ? r8[i] : r8[i + 4], kp = b1 ? r8[i + 4] : r8[i]; r4[i] = kp + __shfl_xor(snd, 2); }
#pragma unroll
    for (int i = 0; i < 2; ++i) { const int snd = b0 ? r4[i] : r4[i + 2], kp = b0 ? r4[i + 2] : r4[i]; r2[i] = kp + __shfl_xor(snd, 1); }
    *(v2f*)(PART + ((size_t)s * M + t) * 128 + 2 * lane) = (v2f){(float)r2[0] * sx, (float)r2[1] * sx};
}
__device__ __forceinline__ void u_finish(const int (&p)[16], float sx, int s, int t, unsigned* PART, int lane) {
    int r8[8], r4[4], r2[2];
    const bool b2 = lane & 4, b1 = lane & 2, b0 = lane & 1;
#pragma unroll
    for (int i = 0; i < 8; ++i) { const int snd = b2 ? p[i] : p[i + 8], kp = b2 ? p[i + 8] : p[i]; r8[i] = kp + xor4i(snd); }
#pragma unroll
    for (int i = 0; i < 4; ++i) { const int snd = b1 ? r8[i] : r8[i + 4], kp = b1 ? r8[i + 4] : r8[i]; r4[i] = kp + xor2i(snd); }
#pragma unroll
    for (int i = 0; i < 2; ++i) { const int snd = b0 ? r4[i] : r4[i + 2], kp = b0 ? r4[i + 2] : r4[i]; r2[i] = kp + xor1i(snd); }
    typedef _Float16 h2 __attribute__((ext_vector_type(2)));
    const h2 pr = {(_Float16)((float)r2[0] * sx), (_Float16)((float)r2[1] * sx)};
    PART[((size_t)s * M + t) * 64 + lane] = __builtin_bit_cast(unsigned, pr);
}
#define IDX_E(iw, i) (((i) & 1) ? ((iw)[(i) >> 1] >> 16) : ((iw)[(i) >> 1] & 0xffffu))
struct QStream { unsigned* heads; int ps, tried; int cs, ct0, ns, nt0, pos; };
__device__ __forceinline__ bool qs_pull(QStream& q, int& os, int& ot0, int lane) {
    for (;;) { const int it = q_pull(q.heads, q.ps, lane); if (it < M / TPI) { os = q.ps; ot0 = it * TPI; return true; } if (++q.tried >= 8) return false; q.ps = (q.ps + 1) & 7; }
}
__device__ __forceinline__ bool qs_init(QStream& q, unsigned* heads, unsigned xcc, int lane) {
    q.heads = heads; q.ps = (int)(xcc & 7u); q.tried = 0; q.pos = 0; q.ns = 0; q.nt0 = -1;
    if (!qs_pull(q, q.cs, q.ct0, lane)) return false;
    if (!qs_pull(q, q.ns, q.nt0, lane)) q.nt0 = -1;
    return true;
}
__device__ __forceinline__ void qs_peek(const QStream& q, int k, int& s, int& t) {
    int p = q.pos + k;
    if (p < TPI) { s = q.cs; t = q.ct0 + p; }
    else if (q.nt0 >= 0) { s = q.ns; t = q.nt0 + (p - TPI); }
    else { s = q.cs; t = q.ct0 + TPI - 1; }
}
__device__ __forceinline__ bool qs_advance2(QStream& q, int lane) {
    q.pos += 2;
    if (q.pos >= TPI) { if (q.nt0 < 0) return false; q.pos = 0; q.cs = q.ns; q.ct0 = q.nt0; if (!qs_pull(q, q.ns, q.nt0, lane)) q.nt0 = -1; }
    return true;
}
__device__ __forceinline__ void p7_u_phase(unsigned* heads, unsigned xcc, const unsigned char* X1q, const float* SX, const unsigned short* IDX, const unsigned char* U8, unsigned* PART, int lane) {
    const int c = lane & 7;
    QStream q;
    if (!qs_init(q, heads, xcc, lane)) return;
    const unsigned char* ub0 = U8; const unsigned c16 = 16u * (unsigned)c; const unsigned char* xb0 = X1q + 16 * c;
    v4u ring[32]; v4u xA, xB; float sA, sB; UIdx iN, iM;
    { int s0, t0, s1, t1; qs_peek(q, 0, s0, t0); qs_peek(q, 1, s1, t1);
      UIdx iA, iB; u_idx(iA, t0, IDX, lane); u_idx(iB, t1, IDX, lane);
      const unsigned wa[8] = {iA.ia.x, iA.ia.y, iA.ia.z, iA.ia.w, iA.ib.x, iA.ib.y, iA.ib.z, iA.ib.w}, wb[8] = {iB.ia.x, iB.ia.y, iB.ia.z, iB.ia.w, iB.ib.x, iB.ib.y, iB.ib.z, iB.ib.w};
      const unsigned char* ua = ub0 + (size_t)s0 * NE * 128; const unsigned char* ubb = ub0 + (size_t)s1 * NE * 128;
#pragma unroll
      for (int r = 0; r < 16; ++r) ring[r] = *(const v4u*)(ua + (IDX_E(wa, r) * 128u + c16));
      xA = *(const v4u*)(xb0 + (size_t)t0 * D + 128 * s0); sA = SX[t0];
#pragma unroll
      for (int r = 0; r < 16; ++r) ring[16 + r] = *(const v4u*)(ubb + (IDX_E(wb, r) * 128u + c16));
      xB = *(const v4u*)(xb0 + (size_t)t1 * D + 128 * s1); sB = SX[t1];
      int s2, t2, s3, t3; qs_peek(q, 2, s2, t2); qs_peek(q, 3, s3, t3);
      u_idx(iN, t2, IDX, lane); u_idx(iM, t3, IDX, lane); }
    unsigned pfa = 0u, pfb = 0u, pf = 0u;
#pragma unroll 1
    for (;;) {
        if (q.pos == 0) { pf ^= pfa ^ pfb;
            if (q.nt0 >= 0) { pfa = *(const unsigned*)((const char*)IDX + (size_t)q.nt0 * 256 + lane * 128);
                pfb = *(const unsigned*)(lane < 32 ? (const char*)X1q + (size_t)(q.nt0 + lane) * D + 128 * q.ns : (const char*)SX + (size_t)q.nt0 * 4); } }
        int s0, t0, s1, t1, s2, t2, s3, t3, s4, t4, s5, t5;
        qs_peek(q, 0, s0, t0); qs_peek(q, 1, s1, t1); qs_peek(q, 2, s2, t2); qs_peek(q, 3, s3, t3); qs_peek(q, 4, s4, t4); qs_peek(q, 5, s5, t5);
        int p[16];
        {
            const int x0 = (int)xA.x, x1 = (int)xA.y, x2 = (int)xA.z, x3 = (int)xA.w; const float sx = sA;
            const unsigned wn[8] = {iN.ia.x, iN.ia.y, iN.ia.z, iN.ia.w, iN.ib.x, iN.ib.y, iN.ib.z, iN.ib.w};
            const unsigned char* un = ub0 + (size_t)s2 * NE * 128;
#pragma unroll
            for (int r = 0; r < 16; ++r) { int a = __builtin_amdgcn_sdot4((int)ring[r].x, x0, 0, false); a = __builtin_amdgcn_sdot4((int)ring[r].y, x1, a, false);
                a = __builtin_amdgcn_sdot4((int)ring[r].z, x2, a, false); a = __builtin_amdgcn_sdot4((int)ring[r].w, x3, a, false); p[r] = a;
                ring[r] = *(const v4u*)(un + (IDX_E(wn, r) * 128u + c16)); }
            xA = *(const v4u*)(xb0 + (size_t)t2 * D + 128 * s2); sA = SX[t2];
            u_idx(iN, t4, IDX, lane);
            u_finish(p, sx, s0, t0, PART, lane);
        }
        {
            const int x0 = (int)xB.x, x1 = (int)xB.y, x2 = (int)xB.z, x3 = (int)xB.w; const float sx = sB;
            const unsigned wn[8] = {iM.ia.x, iM.ia.y, iM.ia.z, iM.ia.w, iM.ib.x, iM.ib.y, iM.ib.z, iM.ib.w};
            const unsigned char* un = ub0 + (size_t)s3 * NE * 128;
#pragma unroll
            for (int r = 0; r < 16; ++r) { int a = __builtin_amdgcn_sdot4((int)ring[16 + r].x, x0, 0, false); a = __builtin_amdgcn_sdot4((int)ring[16 + r].y, x1, a, false);
                a = __builtin_amdgcn_sdot4((int)ring[16 + r].z, x2, a, false); a = __builtin_amdgcn_sdot4((int)ring[16 + r].w, x3, a, false); p[r] = a;
                ring[16 + r] = *(const v4u*)(un + (IDX_E(wn, r) * 128u + c16)); }
            xB = *(const v4u*)(xb0 + (size_t)t3 * D + 128 * s3); sB = SX[t3];
            u_idx(iM, t5, IDX, lane);
            u_finish(p, sx, s1, t1, PART, lane);
        }
        if (!qs_advance2(q, lane)) break;
    }
    asm volatile("" :: "v"(pf ^ pfa ^ pfb));
}
__device__ __forceinline__ void p8_w_phase(const unsigned* PART, const float* RSTD, const unsigned short* IDX, const float* EV, const float* INV, const float* SU, const float* SV, unsigned short* WQ, float* SWH, int gw, int NGW, int lane) {
    typedef _Float16 h2 __attribute__((ext_vector_type(2)));
    for (int tb = gw; tb < M; tb += 4 * NGW) {
        unsigned pp[4][8], ip[4]; v2f evp[4]; float iv[4], rs[4];
#pragma unroll
        for (int q = 0; q < 4; ++q) { const int t = ROW_REV(tb + q * NGW);
#pragma unroll
            for (int x = 0; x < 8; ++x) pp[q][x] = PART[((size_t)x * M + t) * 64 + lane];
            ip[q] = *(const unsigned*)(IDX + (size_t)t * 128 + 2 * lane); evp[q] = *(const v2f*)(EV + (size_t)t * 128 + 2 * lane); iv[q] = INV[(size_t)t * NH + (lane >> 3)]; rs[q] = RSTD[t]; }
        float su0[4], su1[4], sv0[4], sv1[4];
#pragma unroll
        for (int q = 0; q < 4; ++q) { const int e0 = (int)(ip[q] & 0xffffu), e1 = (int)(ip[q] >> 16); su0[q] = SU[e0]; su1[q] = SU[e1]; sv0[q] = SV[e0]; sv1[q] = SV[e1]; }
#pragma unroll
        for (int q = 0; q < 4; ++q) { const int t = ROW_REV(tb + q * NGW);
            float a0 = 0.f, a1 = 0.f;
#pragma unroll
            for (int x = 0; x < 8; ++x) { const h2 v = __builtin_bit_cast(h2, pp[q][x]); a0 += (float)v[0]; a1 += (float)v[1]; }
            const float act0 = a0 * su0[q] * rs[q], act1 = a1 * su1[q] * rs[q];
            const float w0 = evp[q].x * iv[q] * (0.5f * act0 * (1.f + erff(act0 * 0.70710678118654752f))) * sv0[q];
            const float w1 = evp[q].y * iv[q] * (0.5f * act1 * (1.f + erff(act1 * 0.70710678118654752f))) * sv1[q];
            const float mx = wave_max(fmaxf(fabsf(w0), fabsf(w1)));
            const float sw = mx > 0.f ? mx * (1.f / 127.f) : 1.f, isw = 1.f / sw;
            int q0 = (int)rintf(w0 * isw), q1 = (int)rintf(w1 * isw); q0 = q0 > 127 ? 127 : (q0 < -127 ? -127 : q0); q1 = q1 > 127 ? 127 : (q1 < -127 ? -127 : q1);
            WQ[(size_t)t * 64 + lane] = (unsigned short)(((unsigned)q0 & 0xffu) | (((unsigned)q1 & 0xffu) << 8));
            if ((lane & 7) == 0) SWH[(size_t)t * NH + (lane >> 3)] = sw; }
    }
}
struct VBuf { v4u vr[16]; v4u w4; float sw; unsigned xw; };
__device__ __forceinline__ void v_gather(VBuf& b, const UIdx& p, int s, int t, const bf16* X1, const unsigned short* WQ, const float* SWH, const unsigned char* V8, int lane) {
    const int c = lane & 7, g = lane >> 3;
    const unsigned iw[8] = {p.ia.x, p.ia.y, p.ia.z, p.ia.w, p.ib.x, p.ib.y, p.ib.z, p.ib.w};
    const unsigned char* vb = V8 + (size_t)s * NE * 128; const unsigned c16 = 16u * (unsigned)c;
#pragma unroll
    for (int i = 0; i < 16; ++i) { const unsigned e = (i & 1) ? (iw[i >> 1] >> 16) : (iw[i >> 1] & 0xffffu); b.vr[i] = *(const v4u*)(vb + (e * 128u + c16)); }
    b.w4 = *(const v4u*)((const unsigned char*)WQ + (size_t)t * 128 + 16 * g); b.sw = SWH[(size_t)t * NH + g];
    b.xw = *(const unsigned*)(X1 + (size_t)t * D + 128 * s + 2 * lane);
}
__device__ __forceinline__ void v_compute(VBuf& bf, int s, int t, bf16* out, float* SSQ2, int lane, const UIdx& nidx, int ns, int nt, const bf16* X1, const unsigned short* WQ, const float* SWH, const unsigned char* V8) {
    const int c = lane & 7, g = lane >> 3;
    const unsigned niw[8] = {nidx.ia.x, nidx.ia.y, nidx.ia.z, nidx.ia.w, nidx.ib.x, nidx.ib.y, nidx.ib.z, nidx.ib.w};
    const unsigned char* nvb = V8 + (size_t)ns * NE * 128; const unsigned c16 = 16u * (unsigned)c;
    int ai[16];
#pragma unroll
    for (int j = 0; j < 16; ++j) ai[j] = 0;
#pragma unroll
    for (int rg = 0; rg < 4; ++rg) { const int w4 = (int)bf.w4[rg];
#pragma unroll
        for (int j = 0; j < 4; ++j) { const unsigned r0 = bf.vr[4 * rg][j], r1 = bf.vr[4 * rg + 1][j], r2q = bf.vr[4 * rg + 2][j], r3 = bf.vr[4 * rg + 3][j];
            const unsigned t0 = __builtin_amdgcn_perm(r1, r0, 0x05010400u), t1 = __builtin_amdgcn_perm(r1, r0, 0x07030602u), t2 = __builtin_amdgcn_perm(r3, r2q, 0x05010400u), t3 = __builtin_amdgcn_perm(r3, r2q, 0x07030602u);
            ai[4 * j + 0] = __builtin_amdgcn_sdot4((int)__builtin_amdgcn_perm(t2, t0, 0x05040100u), w4, ai[4 * j + 0], false);
            ai[4 * j + 1] = __builtin_amdgcn_sdot4((int)__builtin_amdgcn_perm(t2, t0, 0x07060302u), w4, ai[4 * j + 1], false);
            ai[4 * j + 2] = __builtin_amdgcn_sdot4((int)__builtin_amdgcn_perm(t3, t1, 0x05040100u), w4, ai[4 * j + 2], false);
            ai[4 * j + 3] = __builtin_amdgcn_sdot4((int)__builtin_amdgcn_perm(t3, t1, 0x07060302u), w4, ai[4 * j + 3], false); }
#pragma unroll
        for (int i = 0; i < 4; ++i) { const int r = 4 * rg + i; const unsigned e = (r & 1) ? (niw[r >> 1] >> 16) : (niw[r >> 1] & 0xffffu); bf.vr[r] = *(const v4u*)(nvb + (e * 128u + c16)); } }
    const float sw_cur = bf.sw;
    const unsigned xw_cur = bf.xw;
    bf.w4 = *(const v4u*)((const unsigned char*)WQ + (size_t)nt * 128 + 16 * g); bf.sw = SWH[(size_t)nt * NH + g];
    bf.xw = *(const unsigned*)(X1 + (size_t)nt * D + 128 * ns + 2 * lane);
    int r8[8], r4[4], r2[2];
    const bool b3 = lane & 8;
#pragma unroll
    for (int i = 0; i < 8; ++i) r8[i] = swap32_addi(ai[i], ai[i + 8]);
#pragma unroll
    for (int i = 0; i < 4; ++i) r4[i] = swap16_addi(r8[i], r8[i + 4]);
#pragma unroll
    for (int i = 0; i < 2; ++i) { const int snd = b3 ? r4[i] : r4[i + 2], kp = b3 ? r4[i + 2] : r4[i]; r2[i] = kp + xor8i(snd); }
    const int srcl = 8 * (lane & 7) + (lane >> 3);
    const float p0 = (float)__shfl(r2[0], srcl) * sw_cur, p1 = (float)__shfl(r2[1], srcl) * sw_cur;
    const size_t col = (size_t)t * D + 128 * s + 2 * lane;
    const float y0 = bflo(xw_cur) + p0, y1 = bfhi(xw_cur) + p1;
    const float ss = wave_sum(y0 * y0 + y1 * y1);
    *(unsigned*)(out + col) = pk2(y0, y1);
    if (lane == 0) SSQ2[(size_t)t * 8 + s] = ss;
}
__device__ __forceinline__ void p9_v_phase(unsigned* heads, unsigned xcc, const bf16* X1, const unsigned short* IDX, const unsigned short* WQ, const float* SWH, const unsigned char* V8, bf16* out, float* SSQ2, int lane) {
    QStream q;
    if (!qs_init(q, heads, xcc, lane)) return;
    UIdx iN, iM; VBuf ga, gb;
    { int s0, t0, s1, t1, s2, t2, s3, t3; qs_peek(q, 0, s0, t0); qs_peek(q, 1, s1, t1); qs_peek(q, 2, s2, t2); qs_peek(q, 3, s3, t3);
      UIdx ia, ib; u_idx(ia, t0, IDX, lane); u_idx(ib, t1, IDX, lane);
      v_gather(ga, ia, s0, t0, X1, WQ, SWH, V8, lane); v_gather(gb, ib, s1, t1, X1, WQ, SWH, V8, lane);
      u_idx(iN, t2, IDX, lane); u_idx(iM, t3, IDX, lane); }
    unsigned pfa = 0u, pfb = 0u, pfc = 0u, pf = 0u;
#pragma unroll 1
    for (;;) {
        if (q.pos == 0) { pf ^= pfa ^ pfb ^ pfc;
            if (q.nt0 >= 0) { pfa = *(const unsigned*)((const char*)IDX + (size_t)q.nt0 * 256 + lane * 128);
                pfb = *(const unsigned*)(lane < 32 ? (const char*)WQ + (size_t)q.nt0 * 128 + lane * 128 : (const char*)SWH + (size_t)q.nt0 * 32 + (lane & 7) * 128);
                pfc = *(const unsigned*)((const char*)X1 + (size_t)(q.nt0 + (lane >> 1)) * (D * 2) + 256 * q.ns + (lane & 1) * 128); } }
        int s0, t0, s1, t1, s2, t2, s3, t3, s4, t4, s5, t5;
        qs_peek(q, 0, s0, t0); qs_peek(q, 1, s1, t1); qs_peek(q, 2, s2, t2); qs_peek(q, 3, s3, t3); qs_peek(q, 4, s4, t4); qs_peek(q, 5, s5, t5);
        v_compute(ga, s0, t0, out, SSQ2, lane, iN, s2, t2, X1, WQ, SWH, V8);
        u_idx(iN, t4, IDX, lane);
        v_compute(gb, s1, t1, out, SSQ2, lane, iM, s3, t3, X1, WQ, SWH, V8);
        u_idx(iM, t5, IDX, lane);
        if (!qs_advance2(q, lane)) break;
    }
    asm volatile("" :: "v"(pf ^ pfa ^ pfb ^ pfc));
}
__device__ __forceinline__ void p10_final(const bf16* X2, float* out, const float* SSQ2, const float* gfin, int gw, int NGW, int lane) {
    f32x4 gf[4];
#pragma unroll
    for (int j = 0; j < 4; ++j) gf[j] = ((const f32x4*)gfin)[lane + 64 * j];
    v2u nxa[4], nxb[4]; float nsa, nsb;
#pragma unroll
    for (int j = 0; j < 4; ++j) { nxa[j] = ((const v2u*)(X2 + (size_t)ROW_REV(gw) * D))[lane + 64 * j]; nxb[j] = ((const v2u*)(X2 + (size_t)ROW_REV(gw + NGW) * D))[lane + 64 * j]; }
    nsa = lane < 8 ? SSQ2[(size_t)ROW_REV(gw) * 8 + lane] : 0.f; nsb = lane < 8 ? SSQ2[(size_t)ROW_REV(gw + NGW) * 8 + lane] : 0.f;
    for (int t = gw; t < M; t += 2 * NGW) {
        const int t1 = t + NGW;
        v2u xa[4], xb[4];
#pragma unroll
        for (int j = 0; j < 4; ++j) { xa[j] = nxa[j]; xb[j] = nxb[j]; }
        const float sa = nsa, sb = nsb;
        { const int tn = (t + 2 * NGW) < M ? (t + 2 * NGW) : t, tn1 = tn + NGW;
#pragma unroll
          for (int j = 0; j < 4; ++j) { nxa[j] = ((const v2u*)(X2 + (size_t)ROW_REV(tn) * D))[lane + 64 * j]; nxb[j] = ((const v2u*)(X2 + (size_t)ROW_REV(tn1) * D))[lane + 64 * j]; }
          nsa = lane < 8 ? SSQ2[(size_t)ROW_REV(tn) * 8 + lane] : 0.f; nsb = lane < 8 ? SSQ2[(size_t)ROW_REV(tn1) * 8 + lane] : 0.f; }
        const float ra = rsqrtf(wave_sum(sa) * (1.f / D) + RMS_EPS), rb = rsqrtf(wave_sum(sb) * (1.f / D) + RMS_EPS);
        f32x4* oa = (f32x4*)(out + (size_t)ROW_REV(t) * D) + lane; f32x4* ob = (f32x4*)(out + (size_t)ROW_REV(t1) * D) + lane;
#pragma unroll
        for (int j = 0; j < 4; ++j) {
            oa[64 * j] = (f32x4){bflo(xa[j].x) * ra * gf[j].x, bfhi(xa[j].x) * ra * gf[j].y, bflo(xa[j].y) * ra * gf[j].z, bfhi(xa[j].y) * ra * gf[j].w};
            ob[64 * j] = (f32x4){bflo(xb[j].x) * rb * gf[j].x, bfhi(xb[j].x) * rb * gf[j].y, bflo(xb[j].y) * rb * gf[j].z, bfhi(xb[j].y) * rb * gf[j].w}; }
    }
}

struct Args { const float* in[15]; float* out; unsigned char* ws; int ph_lo, ph_hi, li, pad; };
__global__ void __launch_bounds__(NWAVES * 64, 2) fwd_kernel(Args args) {
    extern __shared__ __attribute__((aligned(16))) unsigned char lds_raw[];
    LAS unsigned char* lds = (LAS unsigned char*)lds_raw;
    volatile LAS unsigned* MISC = (volatile LAS unsigned*)(lds + MISC_OFF);
    const int tid = threadIdx.x, lane = tid & 63, wave = __builtin_amdgcn_readfirstlane(tid >> 6);
    const int G = gridDim.x; const int bx = blockIdx.x; const int vcu = (G % 8 == 0) ? (bx % 8) * (G / 8) + bx / 8 : bx;
    const int gw = vcu * NWAVES + wave, NGW = G * NWAVES;
    unsigned char* ws = args.ws;
    gu32* ctl = (gu32*)(ws + WS_CTL);
    const float* x = args.in[0]; const float* g_mix = args.in[1]; const float* w_in = args.in[2]; const float* pool_gw = args.in[3]; const float* pool_scale = args.in[4];
    const float* conv_w = args.in[5]; const float* w_bp = args.in[6]; const float* w_bc = args.in[7]; const float* w_out = args.in[8]; const float* g_ffn = args.in[9];
    const float* w_q = args.in[10]; const float* sub_keys = args.in[11]; const float* expert_u = args.in[12]; const float* expert_v = args.in[13]; const float* g_final = args.in[14];
    unsigned char* Wc8 = ws + WS_WC; unsigned char* Wbc8 = ws + WS_WBC; float* SBC = (float*)(ws + WS_SBC); float* SPC = (float*)(ws + WS_SPC); float* WcF = (float*)(ws + WS_WCF); unsigned* CMAXC = (unsigned*)(ctl + CW_CMAXC); bf16* Wout_t = (bf16*)(ws + WS_WOUT); unsigned char* Wpp8 = ws + WS_WPP; float* WppF = (float*)(ws + WS_WPPF); float* SBP = (float*)(ws + WS_SBP); float* SXR = (float*)(ws + WS_SXR); unsigned char* X1q = ws + WS_X1Q; unsigned* CMAXP = (unsigned*)(ctl + CW_CMAXP);
    float* SU = (float*)(ws + WS_SU); float* SV = (float*)(ws + WS_SV); float* SSQ = (float*)(ws + WS_SSQ);
    unsigned char* U8 = ws + WS_U8; unsigned char* V8 = ws + WS_V8; float* INV = (float*)(ws + WS_INV); float* SSQ2 = (float*)(ws + WS_SSQ2); unsigned* PART = (unsigned*)(ws + WS_PART); float* RSTD = (float*)(ws + WS_RSTD); unsigned short* WQ = (unsigned short*)(ws + WS_WV); float* SWH = (float*)(ws + WS_SWH);
    unsigned char* Hq = ws + WS_B; unsigned char* Winq = ws + WS_WIN; float* SA = (float*)(ws + WS_SA); float* SB = (float*)(ws + WS_SB); unsigned* CMAX = (unsigned*)(ctl + CW_CMAX); unsigned char* PA = ws + WS_B; unsigned char* CA = ws + WS_B + 64 * MiB; bf16* X1 = (bf16*)(ws + WS_B);
    bf16* Mb = (bf16*)(ws + WS_C); unsigned short* IDX = (unsigned short*)(ws + WS_C); float* EV = (float*)(ws + WS_C + 16 * MiB);
    unsigned char* Z8 = ws + WS_A; float* ZS = (float*)(ws + WS_A + 128 * MiB); unsigned char* G8 = ws + WS_A + 256 * MiB;
     _Float16* SC = (_Float16*)(ws + WS_A); bf16* X2 = (bf16*)(ws + WS_A);

    for (int u = tid; u < (LDS_BYTES - LDSCTL_OFF) / 4; u += NWAVES * 64) ((LAS unsigned*)(lds + LDSCTL_OFF))[u] = 0u;
    __syncthreads();
    XcdBarrier bar; bar.bar = (unsigned*)(ctl + CW_BAR); bar.x = 0; bar.st = nullptr;
    if (N_LAUNCHES != PER_PHASE) bar = xcd_barrier_post((unsigned*)(ctl + CW_BAR), MISC + 8);
#define GRID_BAR() do { if (N_LAUNCHES != PER_PHASE) xcd_barrier(bar); } while (0)
    const int lo = args.ph_lo, hi = args.ph_hi;
#define IN(k) (lo <= (k) && (k) < hi)
#define BOTH(k) (IN(k) && IN((k) + 1))

    if (IN(0)) for (int rep_ = 0; rep_ < ((PROBE_REPEAT >> 0) & 1) + 1; ++rep_) {
        LAS float* scr = (LAS float*)(lds + wave * 16384);
        constexpr int I_WPP = 1024, I_CMAX = 16 * 16, I_WOUT = (1024 / 64) * (1024 / 32), I_WBC = (512 / 64) * (1024 / 256), I_WC = 512;
        constexpr int NITEMS = I_WPP + I_CMAX + I_WBC + I_WC;
        for (int it = gw; it < NITEMS; it += NGW) {
            int r = it;
            if (r < I_WPP) { p0_wpp_item(w_q, sub_keys, g_ffn, WppF, CMAXP, scr, r, lane); continue; } r -= I_WPP;
            if (r < I_WC) { p0_wc_item(pool_gw, pool_scale, w_bp, WcF, CMAXC, scr, r, lane); continue; } r -= I_WC;
            if (r < I_CMAX) { p0_colmax_item(w_in, 4096, CMAX, r, lane); continue; } r -= I_CMAX;
            p0_colmax_item(w_bc, 1024, CMAXC, r, lane);
        }
        GRID_BAR();
        for (int it = gw; it < (1024 / 64) * (4096 / 32); it += NGW) p0_transpose_i8_item(w_in, 1024, 4096, Winq, CMAX, SB, scr, it, lane);
        for (int n = gw; n < NSC; n += NGW) p0_wpp_quant_row(WppF, CMAXP, Wpp8, SBP, n, lane);
        for (int n = gw; n < D; n += NGW) p0_wc_quant_row(WcF, CMAXC, Wc8, n, lane);
        for (int it = gw; it < (512 / 64) * (1024 / 32); it += NGW) p0_transpose_i8_item(w_bc, 512, 1024, Wbc8, CMAXC, SBC, scr, it, lane);
        for (int it = gw; it < I_WOUT; it += NGW) p0_transpose_item(w_out, 1024, 1024, Wout_t, scr, it, lane, CMAXC);
        {
            HRows ra, rb;
            p0_q_load(ra, expert_u, gw, gw + NGW, lane);
            for (int e = gw; e < NE; e += 2 * NGW) { const int en = e + 2 * NGW; if (en < NE) p0_q_load(rb, expert_u, en, en + NGW, lane); else p0_q_load(rb, expert_v, gw, gw + NGW, lane);
                p0_quant_rows2<false>(ra, g_ffn, U8, SU, e, e + NGW, lane); ra = rb; }
            for (int e = gw; e < NE; e += 2 * NGW) { const int en = e + 2 * NGW; if (en < NE) p0_q_load(rb, expert_v, en, en + NGW, lane); else p0_h_load(rb, x, gw, gw + NGW, lane);
                p0_quant_rows2<false>(ra, nullptr, V8, SV, e, e + NGW, lane); ra = rb; }
            for (int m = gw; m < M; m += 2 * NGW) { const int mn = (m + 2 * NGW) < M ? (m + 2 * NGW) : m; p0_h_load(rb, x, mn, mn + NGW, lane);
                p0_h_rows2(ra, g_mix, Hq, SA, m, m + NGW, lane); ra = rb; }
        }
        if (BOTH(0)) GRID_BAR();
    }
    if (IN(1)) for (int rep_ = 0; rep_ < ((PROBE_REPEAT >> 1) & 1) + 1; ++rep_) {
        pg8::Gemm g{(const bf16*)Hq, (const bf16*)Winq, (const bf16*)Hq, (const bf16*)Winq, M, DIN, D / 2}; pg8::StaticOrder S; S.init(M, DIN, G, bx, 1, 1 + ((PROBE_GEMM_REP >> 1) & 1));
        EpiZ E{Z8, ZS, G8, SA, SB};
        pg8::gemm_phase<EpiZ, pg8::StaticOrder, true, true, true>(lds, g, S, E, (unsigned)((bx >> 3) & 3) * STAGGER_P1);
        if (BOTH(1)) GRID_BAR();
    }
    if (IN(2)) for (int rep_ = 0; rep_ < ((PROBE_REPEAT >> 2) & 1) + 1; ++rep_) {
        p2_timemix(Z8, ZS, conv_w, PA, CA, SPC, gw, NGW, lane);
        if (BOTH(2)) GRID_BAR();
    }
    if (IN(3)) for (int rep_ = 0; rep_ < ((PROBE_REPEAT >> 3) & 1) + 1; ++rep_) {
        pg8::Gemm g{(const bf16*)PA, (const bf16*)Wc8, (const bf16*)CA, (const bf16*)Wbc8, M, D, DP / 2}; pg8::StaticOrder S; S.init(M, D, G, bx, 2, 1 + ((PROBE_GEMM_REP >> 3) & 1));
        EpiGate E{G8, Mb, SPC};
        pg8::gemm_phase<EpiGate, pg8::StaticOrder, true, true, true>(lds, g, S, E);
        if (BOTH(3)) GRID_BAR();
    }
    if (IN(4)) for (int rep_ = 0; rep_ < ((PROBE_REPEAT >> 4) & 1) + 1; ++rep_) {
        pg8::Gemm g{Mb, Wout_t, Mb, Wout_t, M, D, D}; pg8::StaticOrder S; S.init(M, D, G, bx, 1, 1 + ((PROBE_GEMM_REP >> 4) & 1));
        EpiRes E{x, X1, SSQ};
        pg8::gemm_phase<EpiRes, pg8::StaticOrder, true, true>(lds, g, S, E);
        if (BOTH(4)) GRID_BAR();
    }
    if (IN(5)) for (int rep_ = 0; rep_ < ((PROBE_REPEAT >> 5) & 1) + 1; ++rep_) {
        { XRows xa, xb; p5_x1_load(xa, X1, SSQ, ROW_QREV(gw), ROW_QREV(gw + NGW), lane);
          for (int r = gw; r < M; r += 2 * NGW) { const int rn = (r + 2 * NGW) < M ? (r + 2 * NGW) : r; p5_x1_load(xb, X1, SSQ, ROW_QREV(rn), ROW_QREV(rn + NGW), lane);
              p5_x1_quant_rows2(xa, X1q, SA, SXR, RSTD, ROW_QREV(r), ROW_QREV(r + NGW), lane); xa = xb; } }
        GRID_BAR();
        pg8::Gemm g{(const bf16*)X1q, (const bf16*)Wpp8, (const bf16*)X1q, (const bf16*)Wpp8, M, NSC, D / 2}; pg8::StaticOrder S; S.init(M, NSC, G, bx, 1, 1 + ((PROBE_GEMM_REP >> 5) & 1));
        EpiScore E{SXR, SBP, SC};
        pg8::gemm_phase<EpiScore, pg8::StaticOrder, true, true, true>(lds, g, S, E);
        if (BOTH(5)) GRID_BAR();
    }
    if (IN(6)) for (int rep_ = 0; rep_ < ((PROBE_REPEAT >> 6) & 1) + 1; ++rep_) {
        p6_topk(SC, IDX, EV, INV, lds, gw, NGW, wave, lane);
        if (BOTH(6)) GRID_BAR();
    }
    const unsigned xcc = xb_xcc_id();
    if (IN(7)) for (int rep_ = 0; rep_ < ((PROBE_REPEAT >> 7) & 1) + 1; ++rep_) {
        p7_u_phase((unsigned*)(ctl + CW_QU + 2048 * rep_), xcc, X1q, SA, IDX, U8, PART, lane);
        if (BOTH(7)) GRID_BAR();
    }
    if (IN(8)) for (int rep_ = 0; rep_ < ((PROBE_REPEAT >> 8) & 1) + 1; ++rep_) {
        p8_w_phase(PART, RSTD, IDX, EV, INV, SU, SV, WQ, SWH, gw, NGW, lane);
        if (BOTH(8)) GRID_BAR();
    }
    if (IN(9)) for (int rep_ = 0; rep_ < ((PROBE_REPEAT >> 9) & 1) + 1; ++rep_) {
        p9_v_phase((unsigned*)(ctl + CW_QV + 2048 * rep_), xcc, X1, IDX, WQ, SWH, V8, X2, SSQ2, lane);
        if (BOTH(9)) GRID_BAR();
    }
    if (IN(10)) {
        p10_final(X2, args.out, SSQ2, g_final, gw, NGW, lane);
    }
#undef IN
#undef BOTH
#undef GRID_BAR
}

extern "C" void kernel_launch(void* const* d_in, const int* in_sizes, int n_in, void* d_out, int out_size, void* d_ws, size_t ws_size, hipStream_t stream) {
    static int grid = 0;
    if (grid == 0) {
        if (n_in != 15 || in_sizes[0] != M * D || out_size != M * D || ws_size < WS_END) { fprintf(stderr, "kernel_launch: unexpected shapes (n_in %d, in0 %d, out %d, ws %zu); nothing launched\n", n_in, n_in > 0 ? in_sizes[0] : -1, out_size, ws_size); grid = -1; return; }
        int dev = 0, cus = 0, per_cu = 0;
        if (hipGetDevice(&dev) != hipSuccess || hipDeviceGetAttribute(&cus, hipDeviceAttributeMultiprocessorCount, dev) != hipSuccess) { grid = -1; return; }
        if (hipFuncSetAttribute((const void*)fwd_kernel, hipFuncAttributeMaxDynamicSharedMemorySize, LDS_BYTES) != hipSuccess) { fprintf(stderr, "kernel_launch: hipFuncSetAttribute failed\n"); grid = -1; return; }
        if (hipOccupancyMaxActiveBlocksPerMultiprocessor(&per_cu, (const void*)fwd_kernel, NWAVES * 64, LDS_BYTES) != hipSuccess || per_cu < 1)
            fprintf(stderr, "kernel_launch: note: occupancy query reports %d workgroups per CU\n", per_cu);
        (void)hipGetLastError();
        grid = cus;
    }
    if (grid < 0) return;
    if (hipMemsetAsync((char*)d_ws + WS_CTL, 0, CTL_ZERO_BYTES, stream) != hipSuccess) { fprintf(stderr, "kernel_launch: hipMemsetAsync failed\n"); return; }
    Args a{};
    for (int i = 0; i < 15; ++i) a.in[i] = (const float*)d_in[i];
    a.out = (float*)d_out; a.ws = (unsigned char*)d_ws;
    for (int li = 0; li < N_LAUNCHES; ++li) {
        a.ph_lo = (N_LAUNCHES == PER_PHASE) ? li : 0; a.ph_hi = (N_LAUNCHES == PER_PHASE) ? li + 1 : PER_PHASE; a.li = li;
        hipLaunchKernelGGL(fwd_kernel, dim3(grid), dim3(NWAVES * 64), LDS_BYTES, stream, a);
        const hipError_t le = hipPeekAtLastError();
        if (le != hipSuccess) { fprintf(stderr, "kernel_launch: launch %d failed: %s\n", li, hipGetErrorName(le)); break; }
    }
}
```

```cpp
#include <hip/hip_runtime.h>
#include <cstdio>
#include <cstdint>

#ifndef PROBE_REPEAT
#define PROBE_REPEAT 0
#endif
#ifndef PROBE_GEMM_REP
#define PROBE_GEMM_REP 0
#endif
#ifndef STAGGER_P1
#define STAGGER_P1 0u
#endif
#ifndef PROBE_SKIP_EPI
#define PROBE_SKIP_EPI 0
#endif
#ifndef MK_N_LAUNCHES
#define MK_N_LAUNCHES 1
#endif

namespace pg8 {
#define PG8_LAS __attribute__((address_space(3)))
typedef unsigned short bf16_t;
typedef short bf16x8 __attribute__((ext_vector_type(8)));
typedef float f32x4 __attribute__((ext_vector_type(4)));
typedef unsigned u32x4 __attribute__((ext_vector_type(4)));
constexpr int BM = 256, BK = 64, HALF = 128, HTB = HALF * BK * 2  , STAGE_BYTES = 8 * HTB, NXCD = 8, WGM = 8;

__host__ __device__ __forceinline__ int lds_byte(int r, int c) { const int st = (r >> 4) * 2 + (c >> 5), rr = r & 15, cc = c & 31, ob = rr * 64 + cc * 2; return st * 1024 + (ob ^ (((ob >> 9) & 1) << 5)); }
__host__ __device__ __forceinline__ void stage_rc(int b, int& R, int& C) { const int st = b / 1024, sb = b % 1024, swz = sb ^ (((sb >> 9) & 1) << 5); R = (st >> 1) * 16 + swz / 64; C = (st & 1) * 32 + (swz % 64) / 2; }
__host__ __device__ __forceinline__ int perm32(int rho) { const int n = rho >> 4, i = rho & 15; return 8 * (i >> 2) + 4 * n + (i & 3); }

struct Unit { int pm, pn, seg, dup; };
struct Gemm { const bf16_t* A; const bf16_t* Bt; const bf16_t* A2; const bf16_t* Bt2; int M, N, K; };

struct StaticOrder {
    int nM, nN, nwg, G, c, segs, rep;
    __host__ __device__ void init(int M, int N, int G_, int c_, int segs_, int rep_ = 1) { nM = M / BM; nN = N / BM; nwg = nM * nN; G = G_; c = c_; segs = segs_; rep = rep_; }
    __host__ __device__ bool next(int i, Unit& u) const {
        const int ti = (segs == 2) ? (i >> 1) : i; u.seg = (segs == 2) ? (i & 1) : 0;
        const long L = (long)ti * G + c; if (L >= (long)nwg * rep) return false;
        int wgid = (int)(L % nwg); u.dup = (L >= nwg) ? 1 : 0; { const int q = nwg / NXCD, r = nwg % NXCD, xcd = wgid % NXCD, off = wgid / NXCD; wgid = (xcd < r ? xcd * (q + 1) : r * (q + 1) + (xcd - r) * q) + off; }
        const int nig = WGM * nN, gid = wgid / nig, fm = gid * WGM, gsz = (nM - fm) < WGM ? (nM - fm) : WGM;
        u.pm = fm + ((wgid % nig) % gsz); u.pn = (wgid % nig) / gsz; return true;
    }
    __device__ __forceinline__ void a_ready(const Unit&) const {}
    __device__ __forceinline__ void done(const Unit&) const {}
};

__device__ __forceinline__ unsigned cvt_pk_bf16(float lo, float hi) { unsigned r; asm volatile("v_cvt_pk_bf16_f32 %0, %1, %2" : "=v"(r) : "v"(lo), "v"(hi)); return r; }

typedef int i32x4 __attribute__((ext_vector_type(4)));
template <class Epi, class Sched, bool ALIGN_EPI = false, bool SP2 = false, bool I8 = false>
__device__ __forceinline__ void gemm_phase(PG8_LAS unsigned char* lds, const Gemm g, const Sched& S, const Epi& E, unsigned stagger_ticks = 0) {
    if (stagger_ticks) { const unsigned long long t0_ = __builtin_amdgcn_s_memrealtime(); while (__builtin_amdgcn_s_memrealtime() - t0_ < (unsigned long long)stagger_ticks) __builtin_amdgcn_s_sleep(8); }
    const int tid = threadIdx.x, wid = __builtin_amdgcn_readfirstlane(tid >> 6), lane = tid & 63, wr = wid >> 2, wc = wid & 3, fr = lane & 15, fq = lane >> 4;
    const int K = g.K, nt = K / BK;
    unsigned voffA[2], voffB[2];
#pragma unroll
    for (int i = 0; i < 2; ++i) { int R, C; stage_rc(tid * 16 + i * 8192, R, C); const int Rb = Epi::PERM ? ((R & ~31) + perm32(R & 31)) : R;
        voffA[i] = (unsigned)(R * K + C) * 2u; voffB[i] = (unsigned)(Rb * K + C) * 2u; }
    const size_t kstep = (size_t)(BK * 2);
    const size_t hstep = (size_t)HALF * K * 2;
    const size_t tstep = 2 * hstep;
    const unsigned ldsw = (unsigned)wid * 1024u;
    const int aoff = lds_byte(wr * 64 + fr, fq * 8), boff = lds_byte(wc * 32 + fr, fq * 8);
#define PG8_SA(b, h) (((b) * 2 + (h)) * HTB)
#define PG8_SB(b, h) ((4 + (b) * 2 + (h)) * HTB)
#define PG8_STAGE(bufoff, gbase, voff) do { _Pragma("unroll") for (int _i = 0; _i < 2; ++_i) \
        __builtin_amdgcn_global_load_lds((const unsigned*)((const char*)(gbase) + (voff)[_i]), (PG8_LAS unsigned*)(lds + (bufoff) + ldsw + _i * 8192), 16, 0, 0); } while (0)
#define PG8_LDA(dst, b, h) do { _Pragma("unroll") for (int m = 0; m < 4; ++m) _Pragma("unroll") for (int k = 0; k < 2; ++k) dst[m][k] = *(const PG8_LAS bf16x8*)(lds + PG8_SA(b, h) + aoff + m * 2048 + k * 1024); } while (0)
#define PG8_LDB(dst, b, h) do { _Pragma("unroll") for (int n = 0; n < 2; ++n) _Pragma("unroll") for (int k = 0; k < 2; ++k) dst[n][k] = *(const PG8_LAS bf16x8*)(lds + PG8_SB(b, h) + boff + n * 2048 + k * 1024); } while (0)
#define PG8_MMA(ai, bj, At, Bt) do { __builtin_amdgcn_s_setprio(1); _Pragma("unroll") for (int m = 0; m < 4; ++m) _Pragma("unroll") for (int n = 0; n < 2; ++n) _Pragma("unroll") for (int k = 0; k < 2; ++k) { \
        if constexpr (I8) acc[ai][bj][m][n] = __builtin_bit_cast(f32x4, __builtin_amdgcn_mfma_i32_16x16x64_i8(__builtin_bit_cast(i32x4, Bt[n][k]), __builtin_bit_cast(i32x4, At[m][k]), __builtin_bit_cast(i32x4, acc[ai][bj][m][n]), 0, 0, 0)); \
        else acc[ai][bj][m][n] = __builtin_amdgcn_mfma_f32_16x16x32_bf16(Bt[n][k], At[m][k], acc[ai][bj][m][n], 0, 0, 0); } __builtin_amdgcn_s_setprio(0); } while (0)
#define PG8_WAIT_V(n) asm volatile("s_waitcnt vmcnt(" #n ")" ::: "memory")
#define PG8_WAIT_L(n) asm volatile("s_waitcnt lgkmcnt(" #n ")" ::: "memory")
#define PG8_BAR __builtin_amdgcn_s_barrier()
#define PG8_SCHED __builtin_amdgcn_sched_barrier(0)
    Unit cur, nxt; int ui = 0;
    if (!S.next(0, cur)) return;
    f32x4 acc[2][2][4][2];
#pragma unroll
    for (int a = 0; a < 2; ++a)
#pragma unroll
        for (int b = 0; b < 2; ++b)
#pragma unroll
            for (int m = 0; m < 4; ++m)
#pragma unroll
                for (int n = 0; n < 2; ++n) acc[a][b][m][n] = (f32x4){0.f, 0.f, 0.f, 0.f};
    bf16x8 At[4][2], B0[2][2], B1[2][2];
    const char* cA = (const char*)(cur.seg ? g.A2 : g.A) + (size_t)cur.pm * tstep; const char* cB = (const char*)(cur.seg ? g.Bt2 : g.Bt) + (size_t)cur.pn * tstep;
    S.a_ready(cur);
    if constexpr (SP2) {
        PG8_STAGE(PG8_SB(0, 0), cB, voffB); PG8_STAGE(PG8_SB(0, 1), cB + hstep, voffB); PG8_STAGE(PG8_SA(0, 0), cA, voffA); PG8_STAGE(PG8_SA(0, 1), cA + hstep, voffA);
        if (wr == 1) PG8_BAR;
        PG8_WAIT_V(2); PG8_BAR;
        PG8_STAGE(PG8_SB(1, 0), cB + kstep, voffB); PG8_STAGE(PG8_SA(1, 0), cA + kstep, voffA); PG8_STAGE(PG8_SB(1, 1), cB + hstep + kstep, voffB);
        PG8_WAIT_V(6); PG8_BAR;
    } else {
        PG8_STAGE(PG8_SB(0, 0), cB, voffB); PG8_STAGE(PG8_SA(0, 0), cA, voffA); PG8_STAGE(PG8_SB(0, 1), cB + hstep, voffB); PG8_STAGE(PG8_SA(0, 1), cA + hstep, voffA);
        if (wr == 1) PG8_BAR;
        PG8_WAIT_V(4); PG8_BAR;
        PG8_STAGE(PG8_SB(1, 0), cB + kstep, voffB); PG8_STAGE(PG8_SA(1, 0), cA + kstep, voffA); PG8_STAGE(PG8_SB(1, 1), cB + hstep + kstep, voffB);
        PG8_WAIT_V(6); PG8_BAR;
    }
    for (;;) {
        const bool has_next = S.next(ui + 1, nxt);
        const char* nA = has_next ? (const char*)(nxt.seg ? g.A2 : g.A) + (size_t)nxt.pm * tstep : cA; const char* nB = has_next ? (const char*)(nxt.seg ? g.Bt2 : g.Bt) + (size_t)nxt.pn * tstep : cB;
        for (int t = 0; t < nt; t += 2) {
            const bool last = (t == nt - 2);
            const char* a1 = cA + (size_t)(t + 1) * kstep;
            const char* a2 = last ? nA : cA + (size_t)(t + 2) * kstep; const char* b2 = last ? nB : cB + (size_t)(t + 2) * kstep;
            const char* a3 = a2 + kstep; const char* b3 = b2 + kstep;
            if (last && has_next) S.a_ready(nxt);
            if constexpr (SP2) {
            PG8_LDB(B0, 0, 0); PG8_LDB(B1, 0, 1); PG8_SCHED; PG8_LDA(At, 0, 0); PG8_STAGE(PG8_SA(1, 1), a1 + hstep, voffA);
            PG8_WAIT_V(8); PG8_WAIT_L(0); PG8_BAR; PG8_MMA(0, 0, At, B0); PG8_MMA(0, 1, At, B1); PG8_BAR; PG8_SCHED;
            PG8_LDA(At, 0, 1); PG8_STAGE(PG8_SB(0, 0), b2, voffB); PG8_STAGE(PG8_SB(0, 1), b2 + hstep, voffB); PG8_STAGE(PG8_SA(0, 0), a2, voffA);
            PG8_WAIT_V(8); PG8_WAIT_L(0); PG8_BAR; PG8_MMA(1, 0, At, B0); PG8_MMA(1, 1, At, B1); PG8_BAR; PG8_SCHED;
            PG8_LDB(B0, 1, 0); PG8_LDB(B1, 1, 1); PG8_SCHED; PG8_LDA(At, 1, 0); PG8_STAGE(PG8_SA(0, 1), a2 + hstep, voffA);
            PG8_WAIT_V(8); PG8_WAIT_L(0); PG8_BAR; PG8_MMA(0, 0, At, B0); PG8_MMA(0, 1, At, B1); PG8_BAR; PG8_SCHED;
            PG8_LDA(At, 1, 1); PG8_STAGE(PG8_SB(1, 0), b3, voffB); PG8_STAGE(PG8_SB(1, 1), b3 + hstep, voffB); PG8_STAGE(PG8_SA(1, 0), a3, voffA);
            PG8_WAIT_V(8); PG8_WAIT_L(0); PG8_BAR; PG8_MMA(1, 0, At, B0); PG8_MMA(1, 1, At, B1); PG8_BAR; PG8_SCHED;
            } else {
            PG8_LDB(B0, 0, 0); PG8_SCHED; PG8_LDA(At, 0, 0); PG8_STAGE(PG8_SA(1, 1), a1 + hstep, voffA);
            PG8_WAIT_L(8); PG8_BAR; PG8_WAIT_L(0); PG8_MMA(0, 0, At, B0); PG8_BAR; PG8_SCHED;
            PG8_LDB(B1, 0, 1); PG8_STAGE(PG8_SB(0, 0), b2, voffB);
            PG8_BAR; PG8_WAIT_L(0); PG8_MMA(0, 1, At, B1); PG8_BAR;
            PG8_LDA(At, 0, 1); PG8_STAGE(PG8_SA(0, 0), a2, voffA);
            PG8_BAR; PG8_WAIT_L(0); PG8_MMA(1, 0, At, B0); PG8_BAR; PG8_SCHED;
            PG8_STAGE(PG8_SB(0, 1), b2 + hstep, voffB);
            PG8_WAIT_V(6); PG8_BAR; PG8_MMA(1, 1, At, B1); PG8_BAR;
            PG8_LDB(B0, 1, 0); PG8_SCHED; PG8_LDA(At, 1, 0); PG8_STAGE(PG8_SA(0, 1), a2 + hstep, voffA);
            PG8_WAIT_L(8); PG8_BAR; PG8_WAIT_L(0); PG8_MMA(0, 0, At, B0); PG8_BAR; PG8_SCHED;
            PG8_LDB(B1, 1, 1); PG8_STAGE(PG8_SB(1, 0), b3, voffB);
            PG8_BAR; PG8_WAIT_L(0); PG8_MMA(0, 1, At, B1); PG8_BAR;
            PG8_LDA(At, 1, 1); PG8_STAGE(PG8_SA(1, 0), a3, voffA);
            PG8_BAR; PG8_WAIT_L(0); PG8_MMA(1, 0, At, B0); PG8_BAR; PG8_SCHED;
            PG8_STAGE(PG8_SB(1, 1), b3 + hstep, voffB);
            PG8_WAIT_V(6); PG8_BAR; PG8_MMA(1, 1, At, B1); PG8_BAR;
            }
        }
        if constexpr (ALIGN_EPI) { if (wr == 0) PG8_BAR; }
        const bool keep = E(acc, cur, wr, wc, fr, fq); S.done(cur);
        if (!has_next) break;
        if (!keep) {
#pragma unroll
        for (int a = 0; a < 2; ++a)
#pragma unroll
            for (int b = 0; b < 2; ++b)
#pragma unroll
                for (int m = 0; m < 4; ++m)
#pragma unroll
                    for (int n = 0; n < 2; ++n) acc[a][b][m][n] = (f32x4){0.f, 0.f, 0.f, 0.f};
        }
        cur = nxt; cA = nA; cB = nB; ++ui;
        if constexpr (ALIGN_EPI) { if (wr == 1) PG8_BAR; }
    }
    PG8_WAIT_V(0);
    if constexpr (!ALIGN_EPI) { if (wr == 0) PG8_BAR; }
    PG8_BAR;
#undef PG8_SA
#undef PG8_SB
#undef PG8_STAGE
#undef PG8_LDA
#undef PG8_LDB
#undef PG8_MMA
#undef PG8_WAIT_V
#undef PG8_WAIT_L
#undef PG8_BAR
#undef PG8_SCHED
}
}

constexpr int NWAVES = 8;
constexpr int M = 65536, D = 1024, SEQ = 4096, DIN = 4096, DP = 512, NSC = 2048, NE = 16384, NH = 8, TOPK = 16;
constexpr float RMS_EPS = 1e-6f;
constexpr int N_LAUNCHES = MK_N_LAUNCHES;
constexpr int PER_PHASE = 11;
constexpr int TPI = 32;
__device__ __forceinline__ int ROW_REV(int t) { return M - 1 - t; }
__device__ __forceinline__ int ROW_QREV(int L) { return ((L >> 11) & 7) * 8192 + (3 - (L >> 14)) * 2048 + (L & 2047); }
__device__ __forceinline__ int GRP_QREV(int L) { return ((L >> 7) & 7) * 512 + (3 - (L >> 10)) * 128 + (L & 127); }

constexpr size_t MiB = 1u << 20;
constexpr size_t WS_CTL = 0, CTL_ZERO_BYTES = 1 * MiB;
constexpr size_t WS_WIN = 1 * MiB;
constexpr size_t WS_WC = 9 * MiB;
constexpr size_t WS_WBC = 10 * MiB;
constexpr size_t WS_SBC = 10 * MiB + 512 * 1024;
constexpr size_t WS_SPC = 62 * MiB;
constexpr size_t WS_WCF = 200 * MiB;
constexpr int CW_CMAXC = 45056;
constexpr size_t WS_WOUT = 11 * MiB;
constexpr size_t WS_WPP = 13 * MiB;
constexpr size_t WS_SBP = 15 * MiB;
constexpr size_t WS_SXR = 15 * MiB + 65536;
constexpr size_t WS_WPPF = 192 * MiB;
constexpr size_t WS_X1Q = 704 * MiB;
constexpr int CW_CMAXP = 40960;
constexpr size_t WS_SU = 17 * MiB;
constexpr size_t WS_SV = 17 * MiB + 65536;
constexpr size_t WS_SSQ = 18 * MiB;
constexpr size_t WS_U8 = 22 * MiB;
constexpr size_t WS_V8 = 38 * MiB;
constexpr size_t WS_INV = 54 * MiB;
constexpr size_t WS_SSQ2 = 56 * MiB;
constexpr size_t WS_RSTD = 58 * MiB;
constexpr size_t WS_SWH = 60 * MiB;
constexpr size_t WS_SA = 59 * MiB;
constexpr size_t WS_SB = 59 * MiB + 512 * 1024;
constexpr int CW_CMAX = 32768;
constexpr size_t WS_WV = 192 * MiB + 48 * MiB;
constexpr size_t WS_PART = 576 * MiB;
constexpr size_t WS_B = 64 * MiB;
constexpr size_t WS_C = 192 * MiB;
constexpr size_t WS_A = 320 * MiB;
constexpr size_t WS_END = 832 * MiB;
constexpr int CW_BAR = 4096;
constexpr int CW_QU = 16384, CW_QV = 16384 + 1024;

constexpr int RING_BYTES = 131072;
constexpr int LDSCTL_OFF = RING_BYTES, MISC_OFF = LDSCTL_OFF + 320;
constexpr int LDS_BYTES = 147456;

#define GAS __attribute__((address_space(1)))
#define LAS __attribute__((address_space(3)))
typedef unsigned short bf16;
typedef unsigned v4u __attribute__((ext_vector_type(4)));
typedef unsigned v2u __attribute__((ext_vector_type(2)));
typedef float f32x4 __attribute__((ext_vector_type(4)));
typedef GAS unsigned gu32;
#define RLX_AGENT __ATOMIC_RELAXED, __HIP_MEMORY_SCOPE_AGENT
#define LDS_WAIT() asm volatile("s_waitcnt lgkmcnt(0)" ::: "memory")
#define VM_WAIT() asm volatile("s_waitcnt vmcnt(0)" ::: "memory")
__device__ __forceinline__ unsigned f2bf(float f) { unsigned u = __builtin_bit_cast(unsigned, f); return (u + 0x7fffu + ((u >> 16) & 1u)) >> 16; }
__device__ __forceinline__ unsigned pk2(float lo, float hi) { return f2bf(lo) | (f2bf(hi) << 16); }
__device__ __forceinline__ float bflo(unsigned w) { return __builtin_bit_cast(float, w << 16); }
__device__ __forceinline__ float bfhi(unsigned w) { return __builtin_bit_cast(float, w & 0xffff0000u); }
template <int CTRL> __device__ __forceinline__ int dppi(int x) { return __builtin_amdgcn_mov_dpp(x, CTRL, 0xf, 0xf, true); }
__device__ __forceinline__ int xor1i(int x) { return dppi<0xB1>(x); }
__device__ __forceinline__ int xor2i(int x) { return dppi<0x4E>(x); }
__device__ __forceinline__ int xor4i(int x) { return dppi<0x1B>(dppi<0x141>(x)); }
__device__ __forceinline__ int xor8i(int x) { return dppi<0x128>(x); }
__device__ __forceinline__ float xor1f(float x) { return __builtin_bit_cast(float, xor1i(__builtin_bit_cast(int, x))); }
__device__ __forceinline__ float xor2f(float x) { return __builtin_bit_cast(float, xor2i(__builtin_bit_cast(int, x))); }
__device__ __forceinline__ float xor4f(float x) { return __builtin_bit_cast(float, xor4i(__builtin_bit_cast(int, x))); }
__device__ __forceinline__ float xor8f(float x) { return __builtin_bit_cast(float, xor8i(__builtin_bit_cast(int, x))); }
__device__ __forceinline__ float swap32_add(float a, float b) { asm volatile("s_nop 1\n\tv_permlane32_swap_b32 %0, %1" : "+v"(a), "+v"(b)); return a + b; }
__device__ __forceinline__ int swap32_addi(int a, int b) { asm volatile("s_nop 1\n\tv_permlane32_swap_b32 %0, %1" : "+v"(a), "+v"(b)); return a + b; }
__device__ __forceinline__ int swap16_addi(int a, int b) { asm volatile("s_nop 1\n\tv_permlane16_swap_b32 %0, %1" : "+v"(a), "+v"(b)); return a + b; }
__device__ __forceinline__ float swap16_add(float a, float b) { asm volatile("s_nop 1\n\tv_permlane16_swap_b32 %0, %1" : "+v"(a), "+v"(b)); return a + b; }
__device__ __forceinline__ float xor16f(float x) { float a = x, b = x; asm volatile("s_nop 1\n\tv_permlane16_swap_b32 %0, %1" : "+v"(a), "+v"(b)); return ((threadIdx.x >> 4) & 1) ? a : b; }
__device__ __forceinline__ float xor32f(float x) { float a = x, b = x; asm volatile("s_nop 1\n\tv_permlane32_swap_b32 %0, %1" : "+v"(a), "+v"(b)); return (threadIdx.x & 32) ? a : b; }
__device__ __forceinline__ float wave_sum(float v) {
    v += xor1f(v); v += xor2f(v); v += xor4f(v); v += xor8f(v);
    v = swap16_add(v, v); v = swap32_add(v, v);
    return v;
}
__device__ __forceinline__ float wave_max(float v) {
    v = fmaxf(v, xor1f(v)); v = fmaxf(v, xor2f(v)); v = fmaxf(v, xor4f(v)); v = fmaxf(v, xor8f(v));
    v = fmaxf(v, xor16f(v)); v = fmaxf(v, xor32f(v));
    return v;
}

__device__ __forceinline__ void unpack8(const v4u w, float (&f)[8]) { f[0] = bflo(w.x); f[1] = bfhi(w.x); f[2] = bflo(w.y); f[3] = bfhi(w.y); f[4] = bflo(w.z); f[5] = bfhi(w.z); f[6] = bflo(w.w); f[7] = bfhi(w.w); }
__device__ __forceinline__ v4u pack8(const float (&f)[8]) { v4u w; w.x = pk2(f[0], f[1]); w.y = pk2(f[2], f[3]); w.z = pk2(f[4], f[5]); w.w = pk2(f[6], f[7]); return w; }

#define XB_TMO      128
#define XB_XCNT(j)  (256  + 64 * (j))
#define XB_XSUB(j)  (1280 + 64 * (j))
#define XB_XGEN(j)  (2304 + 64 * (j))
#define XB_TOP      3328
#define XB_TOPGEN   3392
#define XCD_BAR_WORDS 3456
#define XB_SPIN_CAP (1u << 18)
__device__ __forceinline__ unsigned xb_ld(unsigned* p)              { return __hip_atomic_load(p, __ATOMIC_RELAXED, __HIP_MEMORY_SCOPE_AGENT); }
__device__ __forceinline__ unsigned xb_add(unsigned* p, unsigned v) { return __hip_atomic_fetch_add(p, v, __ATOMIC_RELAXED, __HIP_MEMORY_SCOPE_AGENT); }
__device__ __forceinline__ unsigned xb_xcc_id() { return (unsigned)__builtin_amdgcn_s_getreg((3 << 11) | 20) & 0xFu; }
#define XB_SPIN(cond, bar) do { unsigned _sp = 0; while (cond) { __builtin_amdgcn_s_sleep(0); \
    if ((++_sp & 255u) == 0u) { if (xb_ld(&(bar)[XB_TMO])) break; if (_sp > XB_SPIN_CAP) { atomicAdd(&(bar)[XB_TMO], 1u); break; } } } } while (0)
struct XcdBarrier { unsigned* bar; unsigned x; volatile LAS unsigned* st; };
__device__ __forceinline__ XcdBarrier xcd_barrier_post(unsigned* bar, volatile LAS unsigned* st) {
    XcdBarrier b; b.bar = bar; b.x = xb_xcc_id(); b.st = st;
    if (threadIdx.x == 0) (void)xb_add(&bar[XB_XCNT(b.x)], 1u);
    return b;
}
__device__ __forceinline__ void xcd_barrier_complete(unsigned* bar, unsigned x, unsigned& nloc, unsigned& nx) {
    const unsigned G = gridDim.x * gridDim.y * gridDim.z;
    unsigned sum, cnt, mine, sp = 0u;
    for (;;) {
        sum = 0u; cnt = 0u; mine = 0u;
#pragma unroll
        for (unsigned j = 0; j < 16; ++j) { const unsigned c = xb_ld(&bar[XB_XCNT(j)]); sum += c; cnt += (c > 0u) ? 1u : 0u; mine = (j == x) ? c : mine; }
        if (sum == G) break;
        __builtin_amdgcn_s_sleep(1);
        if ((++sp & 255u) == 0u) { if (xb_ld(&bar[XB_TMO])) break; if (sp > XB_SPIN_CAP) { atomicAdd(&bar[XB_TMO], 1u); break; } }
    }
    nloc = mine > 0u ? mine : 1u; nx = cnt > 0u ? cnt : 1u;
}
__device__ __forceinline__ void xcd_barrier(const XcdBarrier& b) {
    asm volatile("s_waitcnt vmcnt(0)" ::: "memory");
    __syncthreads();
    if (threadIdx.x == 0) {
        unsigned* bar = b.bar;
        __builtin_amdgcn_s_waitcnt(0);
        unsigned nloc = b.st[0], nx = b.st[1];
        if (nloc == 0u) { xcd_barrier_complete(bar, b.x, nloc, nx); b.st[0] = nloc; b.st[1] = nx; }
        const unsigned old = xb_add(&bar[XB_XSUB(b.x)], 1u);
        const unsigned gen = old / nloc;
        if (old + 1u == (gen + 1u) * nloc) {
            __builtin_amdgcn_fence(__ATOMIC_RELEASE, "agent");
            asm volatile("s_waitcnt vmcnt(0)" ::: "memory");
            const unsigned og = xb_add(&bar[XB_TOP], 1u);
            const unsigned tg = og / nx;
            if (og + 1u == (tg + 1u) * nx) xb_add(&bar[XB_TOPGEN], 1u);
            else XB_SPIN(xb_ld(&bar[XB_TOPGEN]) == tg, bar);
            __builtin_amdgcn_fence(__ATOMIC_ACQUIRE, "agent");
            xb_add(&bar[XB_XGEN(b.x)], 1u);
            asm volatile("s_waitcnt vmcnt(0)" ::: "memory");
        } else {
            XB_SPIN(xb_ld(&bar[XB_XGEN(b.x)]) == gen, bar);
            __builtin_amdgcn_fence(__ATOMIC_ACQUIRE, "agent");
            asm volatile("s_waitcnt vmcnt(0)" ::: "memory");
        }
    }
    __syncthreads();
}

__device__ __forceinline__ void p0_transpose_item(const float* W, int K, int N, bf16* WT, LAS float* scr, int item, int lane, const unsigned* kmax = nullptr) {
    const int nblk = N / 32, kb = item / nblk, nb = item % nblk, k0 = 64 * kb, n0 = 32 * nb;
#pragma unroll 8
    for (int i = 0; i < 32; ++i) { const int kk = 2 * i + (lane >> 5); float ks = 1.f; if (kmax) { const float mxv = __builtin_bit_cast(float, kmax[k0 + kk]); ks = mxv > 0.f ? mxv * (1.f / 127.f) : 1.f; }
        scr[kk * 33 + (lane & 31)] = W[(size_t)(k0 + kk) * N + n0 + (lane & 31)] * ks; }
    LDS_WAIT(); asm volatile("" ::: "memory");
    const int c = lane & 7;
#pragma unroll
    for (int j = 0; j < 4; ++j) { const int n = (lane >> 3) + 8 * j; const LAS float* s = scr + (8 * c) * 33 + n;
        v4u o; o.x = pk2(s[0 * 33], s[1 * 33]); o.y = pk2(s[2 * 33], s[3 * 33]); o.z = pk2(s[4 * 33], s[5 * 33]); o.w = pk2(s[6 * 33], s[7 * 33]);
        *(v4u*)(WT + (size_t)(n0 + n) * K + k0 + 8 * c) = o; }
    LDS_WAIT(); asm volatile("" ::: "memory");
}
__device__ __forceinline__ void p0_wc_item(const float* gwt, const float* scale, const float* wbp, float* WcF, unsigned* cmaxc, LAS float* scr, int item, int lane) {
    const int nb = item & 15, cb = (item >> 4) & 7, g = item >> 7;
    const int n = nb * 64 + lane;
    const f32x4* gsrc = (const f32x4*)(gwt + (size_t)((g * 128 + cb * 16) * 128));
    LAS f32x4* gt = (LAS f32x4*)scr;
#pragma unroll
    for (int i = 0; i < 8; ++i) gt[i * 64 + lane] = gsrc[i * 64 + lane];
    float acc[16];
#pragma unroll
    for (int c = 0; c < 16; ++c) acc[c] = 0.f;
    LDS_WAIT(); asm volatile("" ::: "memory");
    const float* bp = wbp + (size_t)(g * 128) * 1024 + n;
#pragma unroll 2
    for (int d4 = 0; d4 < 32; ++d4) {
        const f32x4 sc = *(const f32x4*)(scale + g * 128 + 4 * d4);
        const float b0 = bp[(size_t)(4 * d4 + 0) * 1024] * sc.x, b1 = bp[(size_t)(4 * d4 + 1) * 1024] * sc.y, b2 = bp[(size_t)(4 * d4 + 2) * 1024] * sc.z, b3 = bp[(size_t)(4 * d4 + 3) * 1024] * sc.w;
#pragma unroll
        for (int c = 0; c < 16; ++c) { const f32x4 gq = gt[c * 32 + d4]; acc[c] += (gq.x * b0 + gq.y * b1) + (gq.z * b2 + gq.w * b3); }
    }
    float* dst = WcF + (size_t)n * 512 + g * 128 + cb * 16;
    float mx = 0.f;
#pragma unroll
    for (int q = 0; q < 4; ++q) { *(f32x4*)(dst + 4 * q) = (f32x4){acc[4 * q], acc[4 * q + 1], acc[4 * q + 2], acc[4 * q + 3]};
        mx = fmaxf(mx, fmaxf(fmaxf(fabsf(acc[4 * q]), fabsf(acc[4 * q + 1])), fmaxf(fabsf(acc[4 * q + 2]), fabsf(acc[4 * q + 3])))); }
    atomicMax(cmaxc + n, __builtin_bit_cast(unsigned, mx));
    LDS_WAIT(); asm volatile("" ::: "memory");
}
__device__ __forceinline__ void p0_wc_quant_row(const float* WcF, const unsigned* cmaxc, unsigned char* Wc8, int n, int lane) {
    const f32x4* p = (const f32x4*)(WcF + (size_t)n * 512 + 8 * lane);
    const float mxv = __builtin_bit_cast(float, cmaxc[n]); const float sc = mxv > 0.f ? mxv * (1.f / 127.f) : 1.f, inv = 1.f / sc;
    v2u w;
#pragma unroll
    for (int j = 0; j < 2; ++j) { const f32x4 v = p[j]; unsigned a = 0;
#pragma unroll
        for (int c = 0; c < 4; ++c) { int q = (int)rintf(v[c] * inv); q = q > 127 ? 127 : (q < -127 ? -127 : q); a |= ((unsigned)q & 0xffu) << (8 * c); }
        w[j] = a; }
    *(v2u*)(Wc8 + (size_t)n * 512 + 8 * lane) = w;
}
__device__ __forceinline__ void p0_wpp_item(const float* wq, const float* keys, const float* gffn, float* WppF, unsigned* cmaxp, LAS float* scr, int item, int lane) {
    const int kb = item & 3, db = (item >> 2) & 15, hp = item >> 6;
    const int d = db * 64 + lane;
    const f32x4* kbase = (const f32x4*)(keys + (size_t)(hp * 128 + kb * 32) * 128);
    LAS f32x4* kt = (LAS f32x4*)scr;
#pragma unroll
    for (int i = 0; i < 16; ++i) kt[i * 64 + lane] = kbase[i * 64 + lane];
    float acc[32];
#pragma unroll
    for (int k = 0; k < 32; ++k) acc[k] = 0.f;
    const float* arow = wq + (size_t)d * 2048 + hp * 128;
    LDS_WAIT(); asm volatile("" ::: "memory");
#pragma unroll 4
    for (int c4 = 0; c4 < 32; ++c4) {
        const f32x4 a = *(const f32x4*)(arow + 4 * c4);
#pragma unroll
        for (int k = 0; k < 32; ++k) { const f32x4 kr = kt[k * 32 + c4]; acc[k] += (a.x * kr.x + a.y * kr.y) + (a.z * kr.z + a.w * kr.w); }
    }
    const float gs = gffn[d];
#pragma unroll
    for (int k = 0; k < 32; ++k) { const float v = acc[k] * gs; WppF[(size_t)(hp * 128 + kb * 32 + k) * 1024 + d] = v;
        const float mx = wave_max(fabsf(v)); if (lane == 0) atomicMax(cmaxp + hp * 128 + kb * 32 + k, __builtin_bit_cast(unsigned, mx)); }
    LDS_WAIT(); asm volatile("" ::: "memory");
}
__device__ __forceinline__ void p0_wpp_quant_row(const float* WppF, const unsigned* cmaxp, unsigned char* Wq8, float* SBP, int n, int lane) {
    const f32x4* p = (const f32x4*)(WppF + (size_t)n * 1024 + 16 * lane);
    const float mxv = __builtin_bit_cast(float, cmaxp[n]); const float sc = mxv > 0.f ? mxv * (1.f / 127.f) : 1.f, inv = 1.f / sc;
    v4u w;
#pragma unroll
    for (int j = 0; j < 4; ++j) { const f32x4 v = p[j]; unsigned a = 0;
#pragma unroll
        for (int c = 0; c < 4; ++c) { int q = (int)rintf(v[c] * inv); q = q > 127 ? 127 : (q < -127 ? -127 : q); a |= ((unsigned)q & 0xffu) << (8 * c); }
        w[j] = a; }
    *(v4u*)(Wq8 + (size_t)n * 1024 + 16 * lane) = w;
    if (lane == 0) SBP[n] = sc;
}
struct XRows { v4u a0, a1, b0, b1; float sa, sb; };
__device__ __forceinline__ void p5_x1_load(XRows& r, const bf16* X1, const float* SSQ, int r0, int r1, int lane) {
    r.a0 = *(const v4u*)(X1 + (size_t)r0 * D + 16 * lane); r.a1 = *(const v4u*)(X1 + (size_t)r0 * D + 16 * lane + 8);
    r.b0 = *(const v4u*)(X1 + (size_t)r1 * D + 16 * lane); r.b1 = *(const v4u*)(X1 + (size_t)r1 * D + 16 * lane + 8);
    r.sa = lane < 16 ? SSQ[(size_t)r0 * 16 + lane] : 0.f; r.sb = lane < 16 ? SSQ[(size_t)r1 * 16 + lane] : 0.f;
}
__device__ __forceinline__ void p5_x1_quant_rows2(const XRows& in, unsigned char* X1q, float* SX, float* SXR, float* RSTD, int r0, int r1, int lane) {
    const v4u a0 = in.a0, a1 = in.a1, b0 = in.b0, b1 = in.b1; const float sa = in.sa, sb = in.sb;
    float xa[16], xb[16];
    { float f[8]; unpack8(a0, f);
#pragma unroll
      for (int i = 0; i < 8; ++i) xa[i] = f[i];
      unpack8(a1, f);
#pragma unroll
      for (int i = 0; i < 8; ++i) xa[8 + i] = f[i];
      unpack8(b0, f);
#pragma unroll
      for (int i = 0; i < 8; ++i) xb[i] = f[i];
      unpack8(b1, f);
#pragma unroll
      for (int i = 0; i < 8; ++i) xb[8 + i] = f[i]; }
    float ma = 0.f, mb = 0.f;
#pragma unroll
    for (int i = 0; i < 16; ++i) { ma = fmaxf(ma, fabsf(xa[i])); mb = fmaxf(mb, fabsf(xb[i])); }
    ma = wave_max(ma); mb = wave_max(mb);
    const float ra = rsqrtf(wave_sum(sa) * (1.f / D) + RMS_EPS), rb = rsqrtf(wave_sum(sb) * (1.f / D) + RMS_EPS);
    const float sca = ma > 0.f ? ma * (1.f / 127.f) : 1.f, scb = mb > 0.f ? mb * (1.f / 127.f) : 1.f, ia = 1.f / sca, ib = 1.f / scb;
    v4u wa, wb;
#pragma unroll
    for (int j = 0; j < 4; ++j) { unsigned a = 0, b = 0;
#pragma unroll
        for (int c = 0; c < 4; ++c) { int q = (int)rintf(xa[4 * j + c] * ia); q = q > 127 ? 127 : (q < -127 ? -127 : q); a |= ((unsigned)q & 0xffu) << (8 * c);
            int q1 = (int)rintf(xb[4 * j + c] * ib); q1 = q1 > 127 ? 127 : (q1 < -127 ? -127 : q1); b |= ((unsigned)q1 & 0xffu) << (8 * c); }
        wa[j] = a; wb[j] = b; }
    *(v4u*)(X1q + (size_t)r0 * D + 16 * lane) = wa; *(v4u*)(X1q + (size_t)r1 * D + 16 * lane) = wb;
    if (lane == 0) { SX[r0] = sca; SX[r1] = scb; SXR[r0] = sca * ra; SXR[r1] = scb * rb; RSTD[r0] = ra; RSTD[r1] = rb; }
}
__device__ __forceinline__ void p0_h_row(const float* xrow, const float* g, bf16* orow, int lane) {
    const f32x4* xr = (const f32x4*)xrow + lane; const f32x4* gr = (const f32x4*)g + lane;
    f32x4 v[4]; float s = 0.f;
#pragma unroll
    for (int j = 0; j < 4; ++j) { v[j] = xr[64 * j]; s += (v[j].x * v[j].x + v[j].y * v[j].y) + (v[j].z * v[j].z + v[j].w * v[j].w); }
    const float rstd = rsqrtf(wave_sum(s) * (1.f / D) + RMS_EPS);
    v2u* o8 = (v2u*)orow + lane;
#pragma unroll
    for (int j = 0; j < 4; ++j) { const f32x4 gg = gr[64 * j]; v2u o; o.x = pk2(v[j].x * rstd * gg.x, v[j].y * rstd * gg.y); o.y = pk2(v[j].z * rstd * gg.z, v[j].w * rstd * gg.w); o8[64 * j] = o; }
}
struct HRows { f32x4 v0[4], v1[4]; };
__device__ __forceinline__ void p0_h_load(HRows& r, const float* x, int m0, int m1, int lane) {
    const f32x4* xr0 = (const f32x4*)(x + (size_t)m0 * D) + lane; const f32x4* xr1 = (const f32x4*)(x + (size_t)m1 * D) + lane;
#pragma unroll
    for (int j = 0; j < 4; ++j) { r.v0[j] = xr0[64 * j]; r.v1[j] = xr1[64 * j]; }
}
__device__ __forceinline__ void p0_h_rows2(const HRows& in, const float* g, unsigned char* Hq, float* SA, int m0, int m1, int lane) {
    const f32x4* gr = (const f32x4*)g + lane;
    f32x4 v0[4], v1[4]; float s0 = 0.f, s1 = 0.f;
#pragma unroll
    for (int j = 0; j < 4; ++j) { v0[j] = in.v0[j]; v1[j] = in.v1[j]; }
#pragma unroll
    for (int j = 0; j < 4; ++j) { s0 += (v0[j].x * v0[j].x + v0[j].y * v0[j].y) + (v0[j].z * v0[j].z + v0[j].w * v0[j].w); s1 += (v1[j].x * v1[j].x + v1[j].y * v1[j].y) + (v1[j].z * v1[j].z + v1[j].w * v1[j].w); }
    const float r0 = rsqrtf(wave_sum(s0) * (1.f / D) + RMS_EPS), r1 = rsqrtf(wave_sum(s1) * (1.f / D) + RMS_EPS);
    float mx0 = 0.f, mx1 = 0.f;
#pragma unroll
    for (int j = 0; j < 4; ++j) { const f32x4 gg = gr[64 * j]; v0[j] = v0[j] * gg * r0; v1[j] = v1[j] * gg * r1;
        mx0 = fmaxf(mx0, fmaxf(fmaxf(fabsf(v0[j].x), fabsf(v0[j].y)), fmaxf(fabsf(v0[j].z), fabsf(v0[j].w))));
        mx1 = fmaxf(mx1, fmaxf(fmaxf(fabsf(v1[j].x), fabsf(v1[j].y)), fmaxf(fabsf(v1[j].z), fabsf(v1[j].w)))); }
    mx0 = wave_max(mx0); mx1 = wave_max(mx1);
    const float sc0 = mx0 > 0.f ? mx0 * (1.f / 127.f) : 1.f, sc1 = mx1 > 0.f ? mx1 * (1.f / 127.f) : 1.f, i0 = 1.f / sc0, i1 = 1.f / sc1;
    unsigned* o0 = (unsigned*)(Hq + (size_t)m0 * D) + lane; unsigned* o1 = (unsigned*)(Hq + (size_t)m1 * D) + lane;
#pragma unroll
    for (int j = 0; j < 4; ++j) { unsigned a = 0, b = 0;
#pragma unroll
        for (int c = 0; c < 4; ++c) { int q = (int)rintf(v0[j][c] * i0); q = q > 127 ? 127 : (q < -127 ? -127 : q); a |= ((unsigned)q & 0xffu) << (8 * c);
            int q1 = (int)rintf(v1[j][c] * i1); q1 = q1 > 127 ? 127 : (q1 < -127 ? -127 : q1); b |= ((unsigned)q1 & 0xffu) << (8 * c); }
        o0[64 * j] = a; o1[64 * j] = b; }
    if (lane == 0) { SA[m0] = sc0; SA[m1] = sc1; }
}
__device__ __forceinline__ void p0_colmax_item(const float* W, int N, unsigned* cmax, int item, int lane) {
    const int nblk = N / 256, kb = item / nblk, nb = item % nblk;
    const float* p = W + (size_t)(kb * 64) * N + nb * 256 + 4 * lane;
    f32x4 mx = {0.f, 0.f, 0.f, 0.f};
#pragma unroll 8
    for (int k = 0; k < 64; ++k) { const f32x4 v = *(const f32x4*)(p + (size_t)k * N); mx.x = fmaxf(mx.x, fabsf(v.x)); mx.y = fmaxf(mx.y, fabsf(v.y)); mx.z = fmaxf(mx.z, fabsf(v.z)); mx.w = fmaxf(mx.w, fabsf(v.w)); }
    unsigned* c = cmax + nb * 256 + 4 * lane;
    atomicMax(c + 0, __builtin_bit_cast(unsigned, mx.x)); atomicMax(c + 1, __builtin_bit_cast(unsigned, mx.y)); atomicMax(c + 2, __builtin_bit_cast(unsigned, mx.z)); atomicMax(c + 3, __builtin_bit_cast(unsigned, mx.w));
}
__device__ __forceinline__ void p0_transpose_i8_item(const float* W, int K, int N, unsigned char* WT, const unsigned* cmax, float* SB, LAS float* scr, int item, int lane) {
    const int nblk = N / 32, kb = item / nblk, nb = item % nblk, k0 = 64 * kb, n0 = 32 * nb;
#pragma unroll 8
    for (int i = 0; i < 32; ++i) { const int kk = 2 * i + (lane >> 5); scr[kk * 33 + (lane & 31)] = W[(size_t)(k0 + kk) * N + n0 + (lane & 31)]; }
    LDS_WAIT(); asm volatile("" ::: "memory");
    const int c = lane & 3;
#pragma unroll
    for (int j = 0; j < 2; ++j) { const int n = (lane >> 2) + 16 * j; const LAS float* s = scr + (16 * c) * 33 + n;
        const float mxv = __builtin_bit_cast(float, cmax[n0 + n]); const float sc = mxv > 0.f ? mxv * (1.f / 127.f) : 1.f, inv = 1.f / sc;
        if (kb == 0 && c == 0) SB[n0 + n] = sc;
        v4u o;
#pragma unroll
        for (int q4 = 0; q4 < 4; ++q4) { unsigned a = 0;
#pragma unroll
            for (int b = 0; b < 4; ++b) { int q = (int)rintf(s[(4 * q4 + b) * 33] * inv); q = q > 127 ? 127 : (q < -127 ? -127 : q); a |= ((unsigned)q & 0xffu) << (8 * b); }
            o[q4] = a; }
        *(v4u*)(WT + (size_t)(n0 + n) * K + k0 + 16 * c) = o; }
    LDS_WAIT(); asm volatile("" ::: "memory");
}
__device__ __forceinline__ void p0_q_load(HRows& r, const float* src, int e0, int e1, int lane) {
    const f32x4* p0 = (const f32x4*)(src + (size_t)e0 * 1024 + 16 * lane); const f32x4* p1 = (const f32x4*)(src + (size_t)e1 * 1024 + 16 * lane);
#pragma unroll
    for (int j = 0; j < 4; ++j) { r.v0[j] = p0[j]; r.v1[j] = p1[j]; }
}
template <bool FP8>
__device__ __forceinline__ void p0_quant_rows2(const HRows& in, const float* gmul, unsigned char* dst, float* scale_out, int e0, int e1, int lane) {
    f32x4 v[2][4];
#pragma unroll
    for (int j = 0; j < 4; ++j) { v[0][j] = in.v0[j]; v[1][j] = in.v1[j]; }
    if (gmul) { const f32x4* gp = (const f32x4*)(gmul + 16 * lane);
#pragma unroll
        for (int j = 0; j < 4; ++j) { const f32x4 gg = gp[j]; v[0][j] = v[0][j] * gg; v[1][j] = v[1][j] * gg; } }
#pragma unroll
    for (int r = 0; r < 2; ++r) {
        float mx = 0.f;
#pragma unroll
        for (int j = 0; j < 4; ++j) mx = fmaxf(mx, fmaxf(fmaxf(fabsf(v[r][j].x), fabsf(v[r][j].y)), fmaxf(fabsf(v[r][j].z), fabsf(v[r][j].w))));
        mx = wave_max(mx);
        const float sc = mx > 0.f ? mx * (FP8 ? (1.f / 448.f) : (1.f / 127.f)) : 1.f, inv = 1.f / sc;
        v4u w;
#pragma unroll
        for (int j = 0; j < 4; ++j) {
            if (FP8) { int pk = __builtin_amdgcn_cvt_pk_fp8_f32(v[r][j].x * inv, v[r][j].y * inv, 0, false); pk = __builtin_amdgcn_cvt_pk_fp8_f32(v[r][j].z * inv, v[r][j].w * inv, pk, true); w[j] = (unsigned)pk; }
            else { unsigned acc = 0;
#pragma unroll
                for (int c = 0; c < 4; ++c) { int q = (int)rintf(v[r][j][c] * inv); q = q > 127 ? 127 : (q < -127 ? -127 : q); acc |= ((unsigned)q & 0xffu) << (8 * c); }
                w[j] = acc; }
        }
        const int e = r ? e1 : e0;
        *(v4u*)(dst + ((size_t)(lane >> 3) * NE + e) * 128 + 16 * (lane & 7)) = w;
        if (lane == 0) scale_out[e] = sc;
    }
}

__device__ __forceinline__ float ubf(unsigned w, int b) { return (float)((w >> (8 * b)) & 0xffu); }
typedef pg8::f32x4 (&AccRef)[2][2][4][2];
struct EpiZ {
    static constexpr bool PERM = true;
    unsigned char* O8; float* ZS; unsigned char* G8; const float* SA; const float* SB;
    __device__ __forceinline__ bool operator()(AccRef acc, const pg8::Unit& u, int wr, int wc, int fr, int fq) const {
        if (PROBE_SKIP_EPI == 1 && u.dup) return false;
        const int row0 = u.pm * 256 + wr * 64 + fr, col0 = u.pn * 256 + wc * 32 + 8 * fq;
        pg8::f32x4 sb[2][2];
#pragma unroll
        for (int bj = 0; bj < 2; ++bj) { sb[bj][0] = *(const pg8::f32x4*)(SB + col0 + bj * 128); sb[bj][1] = *(const pg8::f32x4*)(SB + col0 + bj * 128 + 4); }
        float sav[2][4];
#pragma unroll
        for (int ai = 0; ai < 2; ++ai)
#pragma unroll
            for (int m = 0; m < 4; ++m) sav[ai][m] = SA[row0 + ai * 128 + m * 16];
        asm volatile("" ::: "memory");
        const bool gate = u.pn >= 8;
#pragma unroll
        for (int ai = 0; ai < 2; ++ai)
#pragma unroll
            for (int m = 0; m < 4; ++m) { const int r = row0 + ai * 128 + m * 16; const float sa = sav[ai][m];
#pragma unroll
                for (int bj = 0; bj < 2; ++bj) { const pg8::i32x4 i0 = __builtin_bit_cast(pg8::i32x4, acc[ai][bj][m][0]), i1 = __builtin_bit_cast(pg8::i32x4, acc[ai][bj][m][1]);
                    pg8::f32x4 v0 = {(float)i0[0], (float)i0[1], (float)i0[2], (float)i0[3]}, v1 = {(float)i1[0], (float)i1[1], (float)i1[2], (float)i1[3]};
                    v0 = v0 * sb[bj][0] * sa; v1 = v1 * sb[bj][1] * sa;
                    if (!gate) {
                        float am = fmaxf(fmaxf(fmaxf(fabsf(v0[0]), fabsf(v0[1])), fmaxf(fabsf(v0[2]), fabsf(v0[3]))), fmaxf(fmaxf(fabsf(v1[0]), fabsf(v1[1])), fmaxf(fabsf(v1[2]), fabsf(v1[3]))));
                        am = fmaxf(am, xor16f(am)); am = fmaxf(am, xor32f(am));
                        const float sc = am > 0.f ? am * (1.f / 127.f) : 1.f, inv = __builtin_amdgcn_rcpf(sc) * 0.99999f;
#define QZ(x) __builtin_bit_cast(unsigned, fmaf((x), inv, 12582912.f + 128.f))
#define PK4(a, b, c, d) (__builtin_amdgcn_perm(QZ(b), QZ(a), 0x0c0c0400u) | (__builtin_amdgcn_perm(QZ(d), QZ(c), 0x0c0c0400u) << 16))
                        v2u w;
                        w.x = PK4(v0[0], v0[1], v0[2], v0[3]); w.y = PK4(v1[0], v1[1], v1[2], v1[3]);
#undef PK4
#undef QZ
                        *(v2u*)(O8 + (size_t)r * 2048 + col0 + bj * 128) = w;
                        if (fq == 0) ZS[(size_t)r * 64 + ((col0 + bj * 128) >> 5)] = sc;
                    } else { v2u w;
#define SQ(x) __builtin_bit_cast(unsigned, fmaxf(255.f * __builtin_amdgcn_rcpf(1.f + __builtin_amdgcn_exp2f((x) * -1.44269504089f)), 1.f) + 12582912.f)
#define PK4(a, b, c, d) (__builtin_amdgcn_perm(SQ(b), SQ(a), 0x0c0c0400u) | (__builtin_amdgcn_perm(SQ(d), SQ(c), 0x0c0c0400u) << 16))
                        w.x = PK4(v0[0], v0[1], v0[2], v0[3]); w.y = PK4(v1[0], v1[1], v1[2], v1[3]);
#undef PK4
#undef SQ
                        *(v2u*)(G8 + (size_t)r * 2048 + (col0 - 2048) + bj * 128) = w; } } }
        return false;
    }
};
__device__ __forceinline__ float einv(float x) { return 1.f + __builtin_amdgcn_exp2f(x * -1.44269504089f); }
__device__ __forceinline__ float sigm_ratio(float ga, float gb) { return einv(gb) * __builtin_amdgcn_rcpf(einv(ga)); }
__device__ __forceinline__ float iscale(float accbits_as_f, float r) { const int v = __builtin_bit_cast(int, accbits_as_f); const float y = fminf(fmaxf((float)v * r, -2.0e9f), 2.0e9f); return __builtin_bit_cast(float, (int)rintf(y)); }
struct EpiGate {
    static constexpr bool PERM = true;
    const unsigned char* G8; bf16* Mo; const float* SPC;
    __device__ __forceinline__ bool operator()(AccRef acc, const pg8::Unit& u, int wr, int wc, int fr, int fq) const {
        const int row0 = u.pm * 256 + wr * 64 + fr, col0 = u.pn * 256 + wc * 32 + 8 * fq;
        const unsigned goff0 = (unsigned)row0 * 2048u + (unsigned)col0;
        if (u.seg == 0) {
#pragma unroll
            for (int ai = 0; ai < 2; ++ai)
#pragma unroll
            for (int mh = 0; mh < 2; ++mh) {
                v2u ga[2][2], gb[2][2];
#pragma unroll
                for (int mm = 0; mm < 2; ++mm) { const unsigned go = goff0 + (unsigned)((ai * 128 + (2 * mh + mm) * 16) * 2048);
#pragma unroll
                    for (int bj = 0; bj < 2; ++bj) { ga[mm][bj] = *(const v2u*)(G8 + go + bj * 128); gb[mm][bj] = *(const v2u*)(G8 + go + 1024 + bj * 128); } }
                asm volatile("" ::: "memory");
#pragma unroll
                for (int mm = 0; mm < 2; ++mm)
#pragma unroll
                    for (int bj = 0; bj < 2; ++bj) { const v2u a = ga[mm][bj], b = gb[mm][bj]; const int m = 2 * mh + mm;
                        pg8::f32x4& v0 = acc[ai][bj][m][0]; pg8::f32x4& v1 = acc[ai][bj][m][1];
#pragma unroll
                        for (int e = 0; e < 4; ++e) { v0[e] = iscale(v0[e], ubf(a.x, e) * __builtin_amdgcn_rcpf(ubf(b.x, e))); v1[e] = iscale(v1[e], ubf(a.y, e) * __builtin_amdgcn_rcpf(ubf(b.y, e))); } }
                asm volatile("" ::: "memory");
            }
            return true;
        }
#pragma unroll
        for (int ai = 0; ai < 2; ++ai)
#pragma unroll
        for (int mh = 0; mh < 2; ++mh) {
            v2u gb[2][2]; float sr[2];
#pragma unroll
            for (int mm = 0; mm < 2; ++mm) { const int ro = ai * 128 + (2 * mh + mm) * 16; const unsigned go = goff0 + (unsigned)(ro * 2048); sr[mm] = SPC[row0 + ro] * (1.f / 255.f);
#pragma unroll
                for (int bj = 0; bj < 2; ++bj) gb[mm][bj] = *(const v2u*)(G8 + go + 1024 + bj * 128); }
            asm volatile("" ::: "memory");
#pragma unroll
            for (int mm = 0; mm < 2; ++mm) { const int m = 2 * mh + mm; const size_t r = (size_t)(row0 + ai * 128 + m * 16); bf16* mo = Mo + r * D + col0; const float rs = sr[mm];
#pragma unroll
                for (int bj = 0; bj < 2; ++bj) { const v2u b = gb[mm][bj];
                    const pg8::i32x4 i0 = __builtin_bit_cast(pg8::i32x4, acc[ai][bj][m][0]), i1 = __builtin_bit_cast(pg8::i32x4, acc[ai][bj][m][1]);
                    const pg8::f32x4 v0 = (pg8::f32x4){(float)i0[0], (float)i0[1], (float)i0[2], (float)i0[3]} * rs, v1 = (pg8::f32x4){(float)i1[0], (float)i1[1], (float)i1[2], (float)i1[3]} * rs; v4u w;
                    w.x = pg8::cvt_pk_bf16(v0[0] * ubf(b.x, 0), v0[1] * ubf(b.x, 1)); w.y = pg8::cvt_pk_bf16(v0[2] * ubf(b.x, 2), v0[3] * ubf(b.x, 3));
                    w.z = pg8::cvt_pk_bf16(v1[0] * ubf(b.y, 0), v1[1] * ubf(b.y, 1)); w.w = pg8::cvt_pk_bf16(v1[2] * ubf(b.y, 2), v1[3] * ubf(b.y, 3));
                    *(v4u*)(mo + bj * 128) = w; } }
            asm volatile("" ::: "memory");
        }
        return false;
    }
};
struct EpiRes {
    static constexpr bool PERM = true;
    const float* X; bf16* X1; float* SSQ;
    __device__ __forceinline__ bool operator()(AccRef acc, const pg8::Unit& u, int wr, int wc, int fr, int fq) const {
        if (PROBE_SKIP_EPI && u.dup) return false;
        const int row0 = u.pm * 256 + wr * 64 + fr, col0 = u.pn * 256 + wc * 32 + 8 * fq;
#pragma unroll
        for (int ai = 0; ai < 2; ++ai) {
            pg8::f32x4 xr[4][2][2];
#pragma unroll
            for (int m = 0; m < 4; ++m) { const float* xp = X + (size_t)(row0 + ai * 128 + m * 16) * D + col0;
#pragma unroll
                for (int bj = 0; bj < 2; ++bj) { xr[m][bj][0] = *(const pg8::f32x4*)(xp + bj * 128); xr[m][bj][1] = *(const pg8::f32x4*)(xp + bj * 128 + 4); } }
            asm volatile("" ::: "memory");
#pragma unroll
            for (int m = 0; m < 4; ++m) { const size_t r = (size_t)(row0 + ai * 128 + m * 16); bf16* o = X1 + r * D + col0; float ss = 0.f;
#pragma unroll
                for (int bj = 0; bj < 2; ++bj) { const pg8::f32x4 v0 = acc[ai][bj][m][0] + xr[m][bj][0], v1 = acc[ai][bj][m][1] + xr[m][bj][1];
                    ss += (v0[0] * v0[0] + v0[1] * v0[1]) + (v0[2] * v0[2] + v0[3] * v0[3]) + (v1[0] * v1[0] + v1[1] * v1[1]) + (v1[2] * v1[2] + v1[3] * v1[3]);
                    v4u w; w.x = pg8::cvt_pk_bf16(v0[0], v0[1]); w.y = pg8::cvt_pk_bf16(v0[2], v0[3]); w.z = pg8::cvt_pk_bf16(v1[0], v1[1]); w.w = pg8::cvt_pk_bf16(v1[2], v1[3]);
                    *(v4u*)(o + bj * 128) = w; }
                ss += xor16f(ss); ss += xor32f(ss);
                if (fq == 0) SSQ[r * 16 + u.pn * 4 + wc] = ss; }
            asm volatile("" ::: "memory");
        }
        return false;
    }
};
struct EpiScore {
    static constexpr bool PERM = true;
    const float* SXR; const float* SBP; _Float16* S;
    __device__ __forceinline__ bool operator()(AccRef acc, const pg8::Unit& u, int wr, int wc, int fr, int fq) const {
        if (PROBE_SKIP_EPI && u.dup) return false;
        const int row0 = u.pm * 256 + wr * 64 + fr, col0 = u.pn * 256 + wc * 32 + 8 * fq;
        pg8::f32x4 sb[2][2]; float rs[2][4];
#pragma unroll
        for (int bj = 0; bj < 2; ++bj) { sb[bj][0] = *(const pg8::f32x4*)(SBP + col0 + bj * 128); sb[bj][1] = *(const pg8::f32x4*)(SBP + col0 + bj * 128 + 4); }
#pragma unroll
        for (int ai = 0; ai < 2; ++ai)
#pragma unroll
            for (int m = 0; m < 4; ++m) rs[ai][m] = SXR[row0 + ai * 128 + m * 16];
        asm volatile("" ::: "memory");
#pragma unroll
        for (int ai = 0; ai < 2; ++ai)
#pragma unroll
            for (int m = 0; m < 4; ++m) { const size_t r = (size_t)(row0 + ai * 128 + m * 16);
                const float rstd = rs[ai][m];
                _Float16* o = S + r * NSC + col0;
#pragma unroll
                for (int bj = 0; bj < 2; ++bj) { const pg8::i32x4 i0 = __builtin_bit_cast(pg8::i32x4, acc[ai][bj][m][0]), i1 = __builtin_bit_cast(pg8::i32x4, acc[ai][bj][m][1]);
                    pg8::f32x4 v0 = {(float)i0[0], (float)i0[1], (float)i0[2], (float)i0[3]}, v1 = {(float)i1[0], (float)i1[1], (float)i1[2], (float)i1[3]};
                    v0 = v0 * sb[bj][0] * rstd; v1 = v1 * sb[bj][1] * rstd;
                    typedef _Float16 h2 __attribute__((ext_vector_type(2)));
                    h2 p0 = {(_Float16)v0[0], (_Float16)v0[1]}, p1 = {(_Float16)v0[2], (_Float16)v0[3]}, p2 = {(_Float16)v1[0], (_Float16)v1[1]}, p3 = {(_Float16)v1[2], (_Float16)v1[3]};
                    v4u w; w.x = __builtin_bit_cast(unsigned, p0); w.y = __builtin_bit_cast(unsigned, p1); w.z = __builtin_bit_cast(unsigned, p2); w.w = __builtin_bit_cast(unsigned, p3);
                    *(v4u*)(o + bj * 128) = w; } }
        return false;
    }
};

__device__ __forceinline__ void unpack8q(v2u w, float sc, float (&f)[8]) {
    const float bias = -128.f * sc;
    f[0] = fmaf(ubf(w.x, 0), sc, bias); f[1] = fmaf(ubf(w.x, 1), sc, bias); f[2] = fmaf(ubf(w.x, 2), sc, bias); f[3] = fmaf(ubf(w.x, 3), sc, bias);
    f[4] = fmaf(ubf(w.y, 0), sc, bias); f[5] = fmaf(ubf(w.y, 1), sc, bias); f[6] = fmaf(ubf(w.y, 2), sc, bias); f[7] = fmaf(ubf(w.y, 3), sc, bias);
}
__device__ __forceinline__ void p2_timemix(const unsigned char* Z8, const float* ZS, const float* convw, unsigned char* PA, unsigned char* CA, float* SPC, int gw, int NGW, int lane) {
    const int w = 2 << (lane >> 4);
    const int ch = 8 * lane;
    const int sg = lane >> 2;
    float cw0[8], cw1[8], cw2[8];
#pragma unroll
    for (int i = 0; i < 8; ++i) { cw0[i] = convw[ch + i]; cw1[i] = convw[512 + ch + i]; cw2[i] = convw[1024 + ch + i]; }
    for (int chunk = gw; chunk < M / 32; chunk += NGW) {
        const int t0 = chunk * 32, s0 = t0 & (SEQ - 1);
        float sum[8], up1[8], up2[8];
#pragma unroll
        for (int i = 0; i < 8; ++i) { sum[i] = 0.f; up1[i] = 0.f; up2[i] = 0.f; }
        if (s0 > 0) {
            for (int j = 1; j < 16; ++j) {
                if (j < w) { float f[8]; unpack8q(*(const v2u*)(Z8 + (size_t)(t0 - j) * 2048 + ch), ZS[(size_t)(t0 - j) * 64 + sg], f);
#pragma unroll
                    for (int i = 0; i < 8; ++i) sum[i] += f[i]; }
            }
            float c[8], v[8];
            unpack8q(*(const v2u*)(Z8 + (size_t)(t0 - 2) * 2048 + 512 + ch), ZS[(size_t)(t0 - 2) * 64 + 16 + sg], c); unpack8q(*(const v2u*)(Z8 + (size_t)(t0 - 2) * 2048 + 1536 + ch), ZS[(size_t)(t0 - 2) * 64 + 48 + sg], v);
#pragma unroll
            for (int i = 0; i < 8; ++i) up2[i] = c[i] * v[i];
            unpack8q(*(const v2u*)(Z8 + (size_t)(t0 - 1) * 2048 + 512 + ch), ZS[(size_t)(t0 - 1) * 64 + 16 + sg], c); unpack8q(*(const v2u*)(Z8 + (size_t)(t0 - 1) * 2048 + 1536 + ch), ZS[(size_t)(t0 - 1) * 64 + 48 + sg], v);
#pragma unroll
            for (int i = 0; i < 8; ++i) up1[i] = c[i] * v[i];
        }
        v2u nz, nc, nb, nv, nold; float qz, qc, qb, qv, qold;
#define P2_LOAD(tt, ss) { const unsigned char* zr = Z8 + (size_t)(tt) * 2048 + ch; const float* sr = ZS + (size_t)(tt) * 64 + sg; \
          nz = *(const v2u*)zr; nc = *(const v2u*)(zr + 512); nb = *(const v2u*)(zr + 1024); nv = *(const v2u*)(zr + 1536); qz = sr[0]; qc = sr[16]; qb = sr[32]; qv = sr[48]; \
          const int to = ((ss) + 1 - w >= 0) ? ((tt) + 1 - w) : (tt); nold = *(const v2u*)(Z8 + (size_t)to * 2048 + ch); qold = ZS[(size_t)to * 64 + sg]; }
        P2_LOAD(t0, s0)
        float po[8], poc[8], pmx = 0.f; int pt = t0;
#pragma unroll
        for (int i = 0; i < 8; ++i) { po[i] = 0.f; poc[i] = 0.f; }
#define QP(x) __builtin_bit_cast(unsigned, fmaf((x), iq, 12582912.f))
#define PK4(a_, b_, c_, d_) (__builtin_amdgcn_perm(QP(b_), QP(a_), 0x0c0c0400u) | (__builtin_amdgcn_perm(QP(d_), QP(c_), 0x0c0c0400u) << 16))
#define P2_FLUSH() { const float mxw = wave_max(pmx); const float scq = mxw > 0.f ? mxw * (1.f / 127.f) : 1.f, iq = __builtin_amdgcn_rcpf(scq) * 0.99999f; \
            *(v2u*)(PA + (size_t)pt * DP + ch) = (v2u){PK4(po[0], po[1], po[2], po[3]), PK4(po[4], po[5], po[6], po[7])}; \
            *(v2u*)(CA + (size_t)pt * DP + ch) = (v2u){PK4(poc[0], poc[1], poc[2], poc[3]), PK4(poc[4], poc[5], poc[6], poc[7])}; \
            if (lane == 0) SPC[pt] = scq; }
        for (int i2 = 0; i2 < 32; ++i2) {
            const int t = t0 + i2, s = s0 + i2;
            float zt[8], c[8], b[8], v[8], o[8], fo[8];
            unpack8q(nz, qz, zt); unpack8q(nc, qc, c); unpack8q(nb, qb, b); unpack8q(nv, qv, v); unpack8q(nold, qold, fo);
            { const int d1 = (i2 < 31) ? 1 : 0; P2_LOAD(t + d1, s + d1) }
            P2_FLUSH()
            const int cnt = (s + 1) < w ? (s + 1) : w; const float rc = 1.f / (float)cnt;
#pragma unroll
            for (int i = 0; i < 8; ++i) { sum[i] += zt[i]; o[i] = sum[i] * rc - zt[i]; }
            if (s + 1 - w >= 0) {
#pragma unroll
                for (int i = 0; i < 8; ++i) sum[i] -= fo[i]; }
            float oc[8];
#pragma unroll
            for (int i = 0; i < 8; ++i) { const float uu = c[i] * v[i]; oc[i] = b[i] * (cw0[i] * up2[i] + cw1[i] * up1[i] + cw2[i] * uu); up2[i] = up1[i]; up1[i] = uu; }
            float mx = 0.f;
#pragma unroll
            for (int i = 0; i < 8; ++i) { mx = fmaxf(mx, fmaxf(fabsf(o[i]), fabsf(oc[i]))); po[i] = o[i]; poc[i] = oc[i]; }
            pmx = mx; pt = t;
        }
        P2_FLUSH()
#undef P2_FLUSH
#undef PK4
#undef QP
#undef P2_LOAD
    }
}

#define TK_NEG (-3.0e38f)
__device__ __forceinline__ void tk_ce(float& a, float& b) { const float hi = fmaxf(a, b), lo = fminf(a, b); a = hi; b = lo; }
__device__ __forceinline__ void tk_sort8(float (&v)[8]) {
    tk_ce(v[0], v[1]); tk_ce(v[2], v[3]); tk_ce(v[4], v[5]); tk_ce(v[6], v[7]);
    tk_ce(v[0], v[2]); tk_ce(v[1], v[3]); tk_ce(v[4], v[6]); tk_ce(v[5], v[7]);
    tk_ce(v[1], v[2]); tk_ce(v[5], v[6]);
    tk_ce(v[0], v[4]); tk_ce(v[1], v[5]); tk_ce(v[2], v[6]); tk_ce(v[3], v[7]);
    tk_ce(v[2], v[4]); tk_ce(v[3], v[5]);
    tk_ce(v[1], v[2]); tk_ce(v[3], v[4]); tk_ce(v[5], v[6]);
}
__device__ __forceinline__ void tk_bmerge16(float (&x)[16]) {
#pragma unroll
    for (int i = 0; i < 8; ++i) tk_ce(x[i], x[i + 8]);
#pragma unroll
    for (int b = 0; b < 16; b += 8)
#pragma unroll
        for (int i = 0; i < 4; ++i) tk_ce(x[b + i], x[b + i + 4]);
#pragma unroll
    for (int b = 0; b < 16; b += 4)
#pragma unroll
        for (int i = 0; i < 2; ++i) tk_ce(x[b + i], x[b + i + 2]);
#pragma unroll
    for (int b = 0; b < 16; b += 2) tk_ce(x[b], x[b + 1]);
}
__device__ __forceinline__ void tk_add16(float (&L)[16], float (&a)[8], float (&b)[8]) {
    tk_sort8(a); tk_sort8(b);
    float s[16];
#pragma unroll
    for (int i = 0; i < 8; ++i) { s[i] = a[i]; s[8 + i] = b[7 - i]; }
    tk_bmerge16(s);
#pragma unroll
    for (int i = 0; i < 16; ++i) L[i] = fmaxf(L[i], s[15 - i]);
    tk_bmerge16(L);
}
__device__ __forceinline__ void tk_final(const float (&A)[16], const float (&B)[16], float (&FV)[16]) {
    float av[16], bv[16];
#pragma unroll
    for (int i = 0; i < 16; ++i) { av[i] = __builtin_bit_cast(float, __builtin_bit_cast(unsigned, A[i]) & ~0x7fu); bv[i] = __builtin_bit_cast(float, __builtin_bit_cast(unsigned, B[i]) & ~0x7fu); }
#pragma unroll
    for (int j = 0; j < 16; ++j) FV[j] = __builtin_bit_cast(float, (__builtin_bit_cast(unsigned, av[0] + bv[j]) & ~0xffu) | (unsigned)j);
#pragma unroll
    for (int i = 1; i < 16; ++i)
#pragma unroll
        for (int j = 0; j < 16; ++j)
            if ((i + 1) * (j + 1) <= 16) {
                float x = __builtin_bit_cast(float, (__builtin_bit_cast(unsigned, av[i] + bv[j]) & ~0xffu) | (unsigned)(i * 16 + j));
#pragma unroll
                for (int s = (i + 1) * (j + 1) - 1; s < 16; ++s) { const float hi = fmaxf(FV[s], x); x = fminf(FV[s], x); FV[s] = hi; }
            }
}

__device__ __forceinline__ void tk_unpack_octets(const v4u d0, const v4u d1, unsigned kb0, float (&a)[8], float (&b)[8]) {
    const unsigned w0[4] = {d0.x, d0.y, d0.z, d0.w}, w1[4] = {d1.x, d1.y, d1.z, d1.w};
#pragma unroll
    for (int e = 0; e < 8; ++e) {
        const unsigned ha = (e & 1) ? (w0[e >> 1] >> 16) : (w0[e >> 1] & 0xffffu), hb = (e & 1) ? (w1[e >> 1] >> 16) : (w1[e >> 1] & 0xffffu);
        const float fa = (float)__builtin_bit_cast(_Float16, (unsigned short)ha), fb = (float)__builtin_bit_cast(_Float16, (unsigned short)hb);
        a[e] = __builtin_bit_cast(float, __builtin_bit_cast(unsigned, fa) | (kb0 - (unsigned)e));
        b[e] = __builtin_bit_cast(float, __builtin_bit_cast(unsigned, fb) | (kb0 - 8u - (unsigned)e));
    }
}
__device__ __forceinline__ void tk_emit(const float (&LA)[16], const float (&LB)[16], LAS unsigned char* kl, size_t r, unsigned short* IDX, float* EV, float* INV) {
    float FV[16];
    tk_final(LA, LB, FV);
#pragma unroll
    for (int q = 0; q < 4; ++q) { unsigned wa = 0, wb = 0;
#pragma unroll
        for (int e = 0; e < 4; ++e) { wa |= (127u - (__builtin_bit_cast(unsigned, LA[4 * q + e]) & 0x7fu)) << (8 * e); wb |= (127u - (__builtin_bit_cast(unsigned, LB[4 * q + e]) & 0x7fu)) << (8 * e); }
        *(LAS unsigned*)(kl + 4 * q) = wa; *(LAS unsigned*)(kl + 16 + 4 * q) = wb; }
    asm volatile("s_waitcnt lgkmcnt(0)" ::: "memory");
    int FI[16]; float ev[16]; float sum = 0.f;
    const float top = __builtin_bit_cast(float, __builtin_bit_cast(unsigned, FV[0]) & ~0xffu);
#pragma unroll
    for (int s = 0; s < 16; ++s) { const unsigned u = __builtin_bit_cast(unsigned, FV[s]); const unsigned ci = (u >> 4) & 15u, cj = u & 15u;
        const unsigned ka = *(const LAS unsigned char*)(kl + ci), kb = *(const LAS unsigned char*)(kl + 16 + cj);
        FI[s] = (int)(ka * 128u + kb);
        ev[s] = __expf(__builtin_bit_cast(float, u & ~0xffu) - top); sum += ev[s]; }
    v4u i0, i1;
    i0.x = (unsigned)FI[0] | ((unsigned)FI[1] << 16); i0.y = (unsigned)FI[2] | ((unsigned)FI[3] << 16); i0.z = (unsigned)FI[4] | ((unsigned)FI[5] << 16); i0.w = (unsigned)FI[6] | ((unsigned)FI[7] << 16);
    i1.x = (unsigned)FI[8] | ((unsigned)FI[9] << 16); i1.y = (unsigned)FI[10] | ((unsigned)FI[11] << 16); i1.z = (unsigned)FI[12] | ((unsigned)FI[13] << 16); i1.w = (unsigned)FI[14] | ((unsigned)FI[15] << 16);
    *(v4u*)(IDX + r * 16) = i0; *(v4u*)(IDX + r * 16 + 8) = i1;
#pragma unroll
    for (int q = 0; q < 4; ++q) *(f32x4*)(EV + r * 16 + 4 * q) = (f32x4){ev[4 * q], ev[4 * q + 1], ev[4 * q + 2], ev[4 * q + 3]};
    INV[r] = 1.f / sum;
}
__device__ __forceinline__ void p6_topk(const _Float16* S, unsigned short* IDX, float* EV, float* INV, LAS unsigned char* lds, int gw, int NGW, int wave, int lane) {
    LAS unsigned char* my = lds + wave * 10240;
    const int srow = lane >> 2, schn = lane & 3;
    v4u nx[8];
    { const char* b0 = (const char*)S + (size_t)GRP_QREV(gw) * 128 * 512;
#pragma unroll
      for (int q = 0; q < 8; ++q) nx[q] = *(const v4u*)(b0 + (size_t)(16 * q + srow) * 512 + 16 * schn); }
    for (int lg = gw; lg < M * NH / 128; lg += NGW) {
        const int grp = GRP_QREV(lg);
        const char* base = (const char*)S + (size_t)grp * 128 * 512;
        const char* nbase = (const char*)S + (size_t)GRP_QREV((lg + NGW) < M * NH / 128 ? (lg + NGW) : lg) * 128 * 512;
        float LA0[16], LB0[16], LA1[16], LB1[16];
#pragma unroll
        for (int half = 0; half < 2; ++half) {
            float L0[16], L1[16];
#pragma unroll
            for (int i = 0; i < 16; ++i) { L0[i] = TK_NEG; L1[i] = TK_NEG; }
#pragma unroll 1
            for (int step = 0; step < 4; ++step) {
                const int j = half * 4 + step;
#pragma unroll
                for (int q = 0; q < 8; ++q) *(LAS v4u*)(my + (16 * q + srow) * 80 + 16 * schn) = nx[q];
                asm volatile("s_waitcnt lgkmcnt(0)" ::: "memory");
                { const char* pb = (j < 7) ? base + 64 * (j + 1) : nbase;
#pragma unroll
                  for (int q = 0; q < 8; ++q) nx[q] = *(const v4u*)(pb + (size_t)(16 * q + srow) * 512 + 16 * schn); }
                const LAS unsigned char* r0p = my + lane * 80; const LAS unsigned char* r1p = my + (lane + 64) * 80;
                const v4u a0 = *(const LAS v4u*)(r0p), a1 = *(const LAS v4u*)(r0p + 16), a2 = *(const LAS v4u*)(r0p + 32), a3 = *(const LAS v4u*)(r0p + 48);
                const v4u c0 = *(const LAS v4u*)(r1p), c1 = *(const LAS v4u*)(r1p + 16), c2 = *(const LAS v4u*)(r1p + 32), c3 = *(const LAS v4u*)(r1p + 48);
                const unsigned kb0 = (unsigned)(127 - step * 32);
                float pa[8], pb2[8], qa[8], qb[8];
                tk_unpack_octets(a0, a1, kb0, pa, pb2); tk_unpack_octets(c0, c1, kb0, qa, qb);
                tk_add16(L0, pa, pb2); tk_add16(L1, qa, qb);
                tk_unpack_octets(a2, a3, kb0 - 16u, pa, pb2); tk_unpack_octets(c2, c3, kb0 - 16u, qa, qb);
                tk_add16(L0, pa, pb2); tk_add16(L1, qa, qb);
                asm volatile("s_waitcnt lgkmcnt(0)" ::: "memory");
            }
#pragma unroll
            for (int i = 0; i < 16; ++i) { if (half == 0) { LA0[i] = L0[i]; LA1[i] = L1[i]; } else { LB0[i] = L0[i]; LB1[i] = L1[i]; } }
        }
        tk_emit(LA0, LB0, my + lane * 80, (size_t)grp * 128 + lane, IDX, EV, INV);
        tk_emit(LA1, LB1, my + (lane + 64) * 80, (size_t)grp * 128 + 64 + lane, IDX, EV, INV);
        asm volatile("s_waitcnt lgkmcnt(0)" ::: "memory");
    }
}

typedef float v2f __attribute__((ext_vector_type(2)));
__device__ __forceinline__ int q_pull(unsigned* heads, int s, int lane) { int it = 0; if (lane == 0) it = (int)__hip_atomic_fetch_add(heads + 64 * s, 1u, __ATOMIC_RELAXED, __HIP_MEMORY_SCOPE_AGENT); return __builtin_amdgcn_readfirstlane(it); }

struct UIdx { v4u ia, ib; };
struct UBuf { v4u ur[16]; v4u xa, xb; };
__device__ __forceinline__ void u_idx(UIdx& p, int t, const unsigned short* IDX, int lane) { const unsigned short* ip = IDX + (size_t)t * 128 + (lane >> 3) * 16; p.ia = *(const v4u*)ip; p.ib = *(const v4u*)(ip + 8); }
__device__ __forceinline__ void u_gather(UBuf& b, const UIdx& p, int s, int t, const bf16* X1, const unsigned char* U8, int lane) {
    const int c = lane & 7;
    const unsigned iw[8] = {p.ia.x, p.ia.y, p.ia.z, p.ia.w, p.ib.x, p.ib.y, p.ib.z, p.ib.w};
    const unsigned char* ub = U8 + (size_t)s * NE * 128 + 16 * c;
#pragma unroll
    for (int i = 0; i < 16; ++i) { const unsigned e = (i & 1) ? (iw[i >> 1] >> 16) : (iw[i >> 1] & 0xffffu); b.ur[i] = *(const v4u*)(ub + (size_t)e * 128); }
    const bf16* xp = X1 + (size_t)t * D + 128 * s + 16 * c;
    b.xa = *(const v4u*)xp; b.xb = *(const v4u*)(xp + 8);
}
__device__ __forceinline__ void u_compute(const UBuf& bf, int s, int t, float* PART, int lane) {
    float xv[16];
    { float f[8]; unpack8(bf.xa, f);
#pragma unroll
      for (int i = 0; i < 8; ++i) xv[i] = f[i];
      unpack8(bf.xb, f);
#pragma unroll
      for (int i = 0; i < 8; ++i) xv[8 + i] = f[i]; }
    float mx = 0.f;
#pragma unroll
    for (int i = 0; i < 16; ++i) mx = fmaxf(mx, fabsf(xv[i]));
    mx = fmaxf(mx, __shfl_xor(mx, 1)); mx = fmaxf(mx, __shfl_xor(mx, 2)); mx = fmaxf(mx, __shfl_xor(mx, 4));
    const float sx = mx > 0.f ? mx * (1.f / 127.f) : 1.f, isx = 1.f / sx;
    int xq[4];
#pragma unroll
    for (int j = 0; j < 4; ++j) { unsigned a = 0;
#pragma unroll
        for (int b = 0; b < 4; ++b) { int q = (int)rintf(xv[4 * j + b] * isx); q = q > 127 ? 127 : (q < -127 ? -127 : q); a |= ((unsigned)q & 0xffu) << (8 * b); }
        xq[j] = (int)a; }
    int p[16];
#pragma unroll
    for (int i = 0; i < 16; ++i) { int a = __builtin_amdgcn_sdot4((int)bf.ur[i].x, xq[0], 0, false); a = __builtin_amdgcn_sdot4((int)bf.ur[i].y, xq[1], a, false);
        a = __builtin_amdgcn_sdot4((int)bf.ur[i].z, xq[2], a, false); a = __builtin_amdgcn_sdot4((int)bf.ur[i].w, xq[3], a, false); p[i] = a; }
    int r8[8], r4[4], r2[2];
    const bool b2 = lane & 4, b1 = lane & 2, b0 = lane & 1;
#pragma unroll
    for (int i = 0; i < 8; ++i) { const int snd = b2 ? p[i] : p[i + 8], kp = b2 ? p[i + 8] : p[i]; r8[i] = kp + __shfl_xor(snd, 4); }
#pragma unroll
    for (int i = 0; i < 4; ++i) { const int snd = b1 ? r8[i] : r8[i + 4], kp = b1 ? r8[i + 4] : r8[i]; r4[i] = kp + __shfl_xor(snd, 2); }
#pragma unroll
    for (int i = 0; i < 2; ++i) { const int snd = b0 ? r4[i] : r4[i + 2], kp = b0 ? r4[i + 2] : r4[i]; r2[i] = kp + __shfl_xor(snd, 1); }
    *(v2f*)(PART + ((size_t)s * M + t) * 128 + 2 * lane) = (v2f){(float)r2[0] * sx, (float)r2[1] * sx};
}
__device__ __forceinline__ void u_finish(const int (&p)[16], float sx, int s, int t, unsigned* PART, int lane) {
    int r8[8], r4[4], r2[2];
    const bool b2 = lane & 4, b1 = lane & 2, b0 = lane & 1;
#pragma unroll
    for (int i = 0; i < 8; ++i) { const int snd = b2 ? p[i] : p[i + 8], kp = b2 ? p[i + 8] : p[i]; r8[i] = kp + xor4i(snd); }
#pragma unroll
    for (int i = 0; i < 4; ++i) { const int snd = b1 ? r8[i] : r8[i + 4], kp = b1 ? r8[i + 4] : r8[i]; r4[i] = kp + xor2i(snd); }
#pragma unroll
    for (int i = 0; i < 2; ++i) { const int snd = b0 ? r4[i] : r4[i + 2], kp = b0 ? r4[i + 2] : r4[i]; r2[i] = kp + xor1i(snd); }
    typedef _Float16 h2 __attribute__((ext_vector_type(2)));
    const h2 pr = {(_Float16)((float)r2[0] * sx), (_Float16)((float)r2[1] * sx)};
    PART[((size_t)s * M + t) * 64 + lane] = __builtin_bit_cast(unsigned, pr);
}
#define IDX_E(iw, i) (((i) & 1) ? ((iw)[(i) >> 1] >> 16) : ((iw)[(i) >> 1] & 0xffffu))
struct QStream { unsigned* heads; int ps, tried; int cs, ct0, ns, nt0, pos; };
__device__ __forceinline__ bool qs_pull(QStream& q, int& os, int& ot0, int lane) {
    for (;;) { const int it = q_pull(q.heads, q.ps, lane); if (it < M / TPI) { os = q.ps; ot0 = it * TPI; return true; } if (++q.tried >= 8) return false; q.ps = (q.ps + 1) & 7; }
}
__device__ __forceinline__ bool qs_init(QStream& q, unsigned* heads, unsigned xcc, int lane) {
    q.heads = heads; q.ps = (int)(xcc & 7u); q.tried = 0; q.pos = 0; q.ns = 0; q.nt0 = -1;
    if (!qs_pull(q, q.cs, q.ct0, lane)) return false;
    if (!qs_pull(q, q.ns, q.nt0, lane)) q.nt0 = -1;
    return true;
}
__device__ __forceinline__ void qs_peek(const QStream& q, int k, int& s, int& t) {
    int p = q.pos + k;
    if (p < TPI) { s = q.cs; t = q.ct0 + p; }
    else if (q.nt0 >= 0) { s = q.ns; t = q.nt0 + (p - TPI); }
    else { s = q.cs; t = q.ct0 + TPI - 1; }
}
__device__ __forceinline__ bool qs_advance2(QStream& q, int lane) {
    q.pos += 2;
    if (q.pos >= TPI) { if (q.nt0 < 0) return false; q.pos = 0; q.cs = q.ns; q.ct0 = q.nt0; if (!qs_pull(q, q.ns, q.nt0, lane)) q.nt0 = -1; }
    return true;
}
__device__ __forceinline__ void p7_u_phase(unsigned* heads, unsigned xcc, const unsigned char* X1q, const float* SX, const unsigned short* IDX, const unsigned char* U8, unsigned* PART, int lane) {
    const int c = lane & 7;
    QStream q;
    if (!qs_init(q, heads, xcc, lane)) return;
    const unsigned char* ub0 = U8; const unsigned c16 = 16u * (unsigned)c; const unsigned char* xb0 = X1q + 16 * c;
    v4u ring[32]; v4u xA, xB; float sA, sB; UIdx iN, iM;
    { int s0, t0, s1, t1; qs_peek(q, 0, s0, t0); qs_peek(q, 1, s1, t1);
      UIdx iA, iB; u_idx(iA, t0, IDX, lane); u_idx(iB, t1, IDX, lane);
      const unsigned wa[8] = {iA.ia.x, iA.ia.y, iA.ia.z, iA.ia.w, iA.ib.x, iA.ib.y, iA.ib.z, iA.ib.w}, wb[8] = {iB.ia.x, iB.ia.y, iB.ia.z, iB.ia.w, iB.ib.x, iB.ib.y, iB.ib.z, iB.ib.w};
      const unsigned char* ua = ub0 + (size_t)s0 * NE * 128; const unsigned char* ubb = ub0 + (size_t)s1 * NE * 128;
#pragma unroll
      for (int r = 0; r < 16; ++r) ring[r] = *(const v4u*)(ua + (IDX_E(wa, r) * 128u + c16));
      xA = *(const v4u*)(xb0 + (size_t)t0 * D + 128 * s0); sA = SX[t0];
#pragma unroll
      for (int r = 0; r < 16; ++r) ring[16 + r] = *(const v4u*)(ubb + (IDX_E(wb, r) * 128u + c16));
      xB = *(const v4u*)(xb0 + (size_t)t1 * D + 128 * s1); sB = SX[t1];
      int s2, t2, s3, t3; qs_peek(q, 2, s2, t2); qs_peek(q, 3, s3, t3);
      u_idx(iN, t2, IDX, lane); u_idx(iM, t3, IDX, lane); }
    unsigned pfa = 0u, pfb = 0u, pf = 0u;
#pragma unroll 1
    for (;;) {
        if ((q.pos & 15) == 0) {
            const bool nx = q.pos != 0; const int hs = nx ? q.ns : q.cs, ht = nx ? q.nt0 : q.ct0 + 16;
            pf ^= pfa;
            if (ht >= 0) pfa = *(const unsigned*)(lane < 32 ? (const char*)IDX + (size_t)ht * 256 + lane * 128
                                                : lane < 48 ? (const char*)X1q + (size_t)(ht + (lane - 32)) * D + 128 * hs : (const char*)SX + (size_t)ht * 4); }
        int s0, t0, s1, t1, s2, t2, s3, t3, s4, t4, s5, t5;
        qs_peek(q, 0, s0, t0); qs_peek(q, 1, s1, t1); qs_peek(q, 2, s2, t2); qs_peek(q, 3, s3, t3); qs_peek(q, 4, s4, t4); qs_peek(q, 5, s5, t5);
        int p[16];
        {
            const int x0 = (int)xA.x, x1 = (int)xA.y, x2 = (int)xA.z, x3 = (int)xA.w; const float sx = sA;
            const unsigned wn[8] = {iN.ia.x, iN.ia.y, iN.ia.z, iN.ia.w, iN.ib.x, iN.ib.y, iN.ib.z, iN.ib.w};
            const unsigned char* un = ub0 + (size_t)s2 * NE * 128;
#pragma unroll
            for (int r = 0; r < 16; ++r) { int a = __builtin_amdgcn_sdot4((int)ring[r].x, x0, 0, false); a = __builtin_amdgcn_sdot4((int)ring[r].y, x1, a, false);
                a = __builtin_amdgcn_sdot4((int)ring[r].z, x2, a, false); a = __builtin_amdgcn_sdot4((int)ring[r].w, x3, a, false); p[r] = a;
                ring[r] = *(const v4u*)(un + (IDX_E(wn, r) * 128u + c16)); }
            xA = *(const v4u*)(xb0 + (size_t)t2 * D + 128 * s2); sA = SX[t2];
            u_idx(iN, t4, IDX, lane);
            u_finish(p, sx, s0, t0, PART, lane);
        }
        {
            const int x0 = (int)xB.x, x1 = (int)xB.y, x2 = (int)xB.z, x3 = (int)xB.w; const float sx = sB;
            const unsigned wn[8] = {iM.ia.x, iM.ia.y, iM.ia.z, iM.ia.w, iM.ib.x, iM.ib.y, iM.ib.z, iM.ib.w};
            const unsigned char* un = ub0 + (size_t)s3 * NE * 128;
#pragma unroll
            for (int r = 0; r < 16; ++r) { int a = __builtin_amdgcn_sdot4((int)ring[16 + r].x, x0, 0, false); a = __builtin_amdgcn_sdot4((int)ring[16 + r].y, x1, a, false);
                a = __builtin_amdgcn_sdot4((int)ring[16 + r].z, x2, a, false); a = __builtin_amdgcn_sdot4((int)ring[16 + r].w, x3, a, false); p[r] = a;
                ring[16 + r] = *(const v4u*)(un + (IDX_E(wn, r) * 128u + c16)); }
            xB = *(const v4u*)(xb0 + (size_t)t3 * D + 128 * s3); sB = SX[t3];
            u_idx(iM, t5, IDX, lane);
            u_finish(p, sx, s1, t1, PART, lane);
        }
        if (!qs_advance2(q, lane)) break;
    }
    asm volatile("" :: "v"(pf ^ pfa ^ pfb));
}
__device__ __forceinline__ void p8_w_phase(const unsigned* PART, const float* RSTD, const unsigned short* IDX, const float* EV, const float* INV, const float* SU, const float* SV, unsigned short* WQ, float* SWH, int gw, int NGW, int lane) {
    typedef _Float16 h2 __attribute__((ext_vector_type(2)));
    for (int tb = gw; tb < M; tb += 4 * NGW) {
        unsigned pp[4][8], ip[4]; v2f evp[4]; float iv[4], rs[4];
#pragma unroll
        for (int q = 0; q < 4; ++q) { const int t = ROW_REV(tb + q * NGW);
#pragma unroll
            for (int x = 0; x < 8; ++x) pp[q][x] = PART[((size_t)x * M + t) * 64 + lane];
            ip[q] = *(const unsigned*)(IDX + (size_t)t * 128 + 2 * lane); evp[q] = *(const v2f*)(EV + (size_t)t * 128 + 2 * lane); iv[q] = INV[(size_t)t * NH + (lane >> 3)]; rs[q] = RSTD[t]; }
        float su0[4], su1[4], sv0[4], sv1[4];
#pragma unroll
        for (int q = 0; q < 4; ++q) { const int e0 = (int)(ip[q] & 0xffffu), e1 = (int)(ip[q] >> 16); su0[q] = SU[e0]; su1[q] = SU[e1]; sv0[q] = SV[e0]; sv1[q] = SV[e1]; }
#pragma unroll
        for (int q = 0; q < 4; ++q) { const int t = ROW_REV(tb + q * NGW);
            float a0 = 0.f, a1 = 0.f;
#pragma unroll
            for (int x = 0; x < 8; ++x) { const h2 v = __builtin_bit_cast(h2, pp[q][x]); a0 += (float)v[0]; a1 += (float)v[1]; }
            const float act0 = a0 * su0[q] * rs[q], act1 = a1 * su1[q] * rs[q];
            const float w0 = evp[q].x * iv[q] * (0.5f * act0 * (1.f + erff(act0 * 0.70710678118654752f))) * sv0[q];
            const float w1 = evp[q].y * iv[q] * (0.5f * act1 * (1.f + erff(act1 * 0.70710678118654752f))) * sv1[q];
            const float mx = wave_max(fmaxf(fabsf(w0), fabsf(w1)));
            const float sw = mx > 0.f ? mx * (1.f / 127.f) : 1.f, isw = 1.f / sw;
            int q0 = (int)rintf(w0 * isw), q1 = (int)rintf(w1 * isw); q0 = q0 > 127 ? 127 : (q0 < -127 ? -127 : q0); q1 = q1 > 127 ? 127 : (q1 < -127 ? -127 : q1);
            WQ[(size_t)t * 64 + lane] = (unsigned short)(((unsigned)q0 & 0xffu) | (((unsigned)q1 & 0xffu) << 8));
            if ((lane & 7) == 0) SWH[(size_t)t * NH + (lane >> 3)] = sw; }
    }
}
struct VBuf { v4u vr[16]; v4u w4; float sw; unsigned xw; };
__device__ __forceinline__ void v_gather(VBuf& b, const UIdx& p, int s, int t, const bf16* X1, const unsigned short* WQ, const float* SWH, const unsigned char* V8, int lane) {
    const int c = lane & 7, g = lane >> 3;
    const unsigned iw[8] = {p.ia.x, p.ia.y, p.ia.z, p.ia.w, p.ib.x, p.ib.y, p.ib.z, p.ib.w};
    const unsigned char* vb = V8 + (size_t)s * NE * 128; const unsigned c16 = 16u * (unsigned)c;
#pragma unroll
    for (int i = 0; i < 16; ++i) { const unsigned e = (i & 1) ? (iw[i >> 1] >> 16) : (iw[i >> 1] & 0xffffu); b.vr[i] = *(const v4u*)(vb + (e * 128u + c16)); }
    b.w4 = *(const v4u*)((const unsigned char*)WQ + (size_t)t * 128 + 16 * g); b.sw = SWH[(size_t)t * NH + g];
    b.xw = *(const unsigned*)(X1 + (size_t)t * D + 128 * s + 2 * lane);
}
__device__ __forceinline__ void v_compute(VBuf& bf, int s, int t, bf16* out, float* SSQ2, int lane, const UIdx& nidx, int ns, int nt, const bf16* X1, const unsigned short* WQ, const float* SWH, const unsigned char* V8) {
    const int c = lane & 7, g = lane >> 3;
    const unsigned niw[8] = {nidx.ia.x, nidx.ia.y, nidx.ia.z, nidx.ia.w, nidx.ib.x, nidx.ib.y, nidx.ib.z, nidx.ib.w};
    const unsigned char* nvb = V8 + (size_t)ns * NE * 128; const unsigned c16 = 16u * (unsigned)c;
    int ai[16];
#pragma unroll
    for (int j = 0; j < 16; ++j) ai[j] = 0;
#pragma unroll
    for (int rg = 0; rg < 4; ++rg) { const int w4 = (int)bf.w4[rg];
#pragma unroll
        for (int j = 0; j < 4; ++j) { const unsigned r0 = bf.vr[4 * rg][j], r1 = bf.vr[4 * rg + 1][j], r2q = bf.vr[4 * rg + 2][j], r3 = bf.vr[4 * rg + 3][j];
            const unsigned t0 = __builtin_amdgcn_perm(r1, r0, 0x05010400u), t1 = __builtin_amdgcn_perm(r1, r0, 0x07030602u), t2 = __builtin_amdgcn_perm(r3, r2q, 0x05010400u), t3 = __builtin_amdgcn_perm(r3, r2q, 0x07030602u);
            ai[4 * j + 0] = __builtin_amdgcn_sdot4((int)__builtin_amdgcn_perm(t2, t0, 0x05040100u), w4, ai[4 * j + 0], false);
            ai[4 * j + 1] = __builtin_amdgcn_sdot4((int)__builtin_amdgcn_perm(t2, t0, 0x07060302u), w4, ai[4 * j + 1], false);
            ai[4 * j + 2] = __builtin_amdgcn_sdot4((int)__builtin_amdgcn_perm(t3, t1, 0x05040100u), w4, ai[4 * j + 2], false);
            ai[4 * j + 3] = __builtin_amdgcn_sdot4((int)__builtin_amdgcn_perm(t3, t1, 0x07060302u), w4, ai[4 * j + 3], false); }
#pragma unroll
        for (int i = 0; i < 4; ++i) { const int r = 4 * rg + i; const unsigned e = (r & 1) ? (niw[r >> 1] >> 16) : (niw[r >> 1] & 0xffffu); bf.vr[r] = *(const v4u*)(nvb + (e * 128u + c16)); } }
    const float sw_cur = bf.sw;
    const unsigned xw_cur = bf.xw;
    bf.w4 = *(const v4u*)((const unsigned char*)WQ + (size_t)nt * 128 + 16 * g); bf.sw = SWH[(size_t)nt * NH + g];
    bf.xw = *(const unsigned*)(X1 + (size_t)nt * D + 128 * ns + 2 * lane);
    int r8[8], r4[4], r2[2];
    const bool b3 = lane & 8;
#pragma unroll
    for (int i = 0; i < 8; ++i) r8[i] = swap32_addi(ai[i], ai[i + 8]);
#pragma unroll
    for (int i = 0; i < 4; ++i) r4[i] = swap16_addi(r8[i], r8[i + 4]);
#pragma unroll
    for (int i = 0; i < 2; ++i) { const int snd = b3 ? r4[i] : r4[i + 2], kp = b3 ? r4[i + 2] : r4[i]; r2[i] = kp + xor8i(snd); }
    const int srcl = 8 * (lane & 7) + (lane >> 3);
    const float p0 = (float)__shfl(r2[0], srcl) * sw_cur, p1 = (float)__shfl(r2[1], srcl) * sw_cur;
    const size_t col = (size_t)t * D + 128 * s + 2 * lane;
    const float y0 = bflo(xw_cur) + p0, y1 = bfhi(xw_cur) + p1;
    const float ss = wave_sum(y0 * y0 + y1 * y1);
    *(unsigned*)(out + col) = pk2(y0, y1);
    if (lane == 0) SSQ2[(size_t)t * 8 + s] = ss;
}
__device__ __forceinline__ void p9_v_phase(unsigned* heads, unsigned xcc, const bf16* X1, const unsigned short* IDX, const unsigned short* WQ, const float* SWH, const unsigned char* V8, bf16* out, float* SSQ2, int lane) {
    QStream q;
    if (!qs_init(q, heads, xcc, lane)) return;
    UIdx iN, iM; VBuf ga, gb;
    { int s0, t0, s1, t1, s2, t2, s3, t3; qs_peek(q, 0, s0, t0); qs_peek(q, 1, s1, t1); qs_peek(q, 2, s2, t2); qs_peek(q, 3, s3, t3);
      UIdx ia, ib; u_idx(ia, t0, IDX, lane); u_idx(ib, t1, IDX, lane);
      v_gather(ga, ia, s0, t0, X1, WQ, SWH, V8, lane); v_gather(gb, ib, s1, t1, X1, WQ, SWH, V8, lane);
      u_idx(iN, t2, IDX, lane); u_idx(iM, t3, IDX, lane); }
    unsigned pfa = 0u, pfb = 0u, pf = 0u;
#pragma unroll 1
    for (;;) {
        if ((q.pos & 15) == 0) {
            const bool nx = q.pos != 0; const int hs = nx ? q.ns : q.cs, ht = nx ? q.nt0 : q.ct0 + 16;
            pf ^= pfa ^ pfb;
            if (ht >= 0) { pfa = *(const unsigned*)(lane < 32 ? (const char*)IDX + (size_t)ht * 256 + lane * 128
                                                  : lane < 48 ? (const char*)WQ + (size_t)ht * 128 + (lane - 32) * 128 : (const char*)SWH + (size_t)ht * 32 + (lane & 3) * 128);
                pfb = *(const unsigned*)(lane < 32 ? (const char*)X1 + (size_t)(ht + (lane >> 1)) * (D * 2) + 256 * hs + (lane & 1) * 128 : (const char*)IDX + (size_t)ht * 256); } }
        int s0, t0, s1, t1, s2, t2, s3, t3, s4, t4, s5, t5;
        qs_peek(q, 0, s0, t0); qs_peek(q, 1, s1, t1); qs_peek(q, 2, s2, t2); qs_peek(q, 3, s3, t3); qs_peek(q, 4, s4, t4); qs_peek(q, 5, s5, t5);
        v_compute(ga, s0, t0, out, SSQ2, lane, iN, s2, t2, X1, WQ, SWH, V8);
        u_idx(iN, t4, IDX, lane);
        v_compute(gb, s1, t1, out, SSQ2, lane, iM, s3, t3, X1, WQ, SWH, V8);
        u_idx(iM, t5, IDX, lane);
        if (!qs_advance2(q, lane)) break;
    }
    asm volatile("" :: "v"(pf ^ pfa ^ pfb));
}
__device__ __forceinline__ void p10_final(const bf16* X2, float* out, const float* SSQ2, const float* gfin, int gw, int NGW, int lane) {
    f32x4 gf[4];
#pragma unroll
    for (int j = 0; j < 4; ++j) gf[j] = ((const f32x4*)gfin)[lane + 64 * j];
    v2u nxa[4], nxb[4]; float nsa, nsb;
#pragma unroll
    for (int j = 0; j < 4; ++j) { nxa[j] = ((const v2u*)(X2 + (size_t)ROW_REV(gw) * D))[lane + 64 * j]; nxb[j] = ((const v2u*)(X2 + (size_t)ROW_REV(gw + NGW) * D))[lane + 64 * j]; }
    nsa = lane < 8 ? SSQ2[(size_t)ROW_REV(gw) * 8 + lane] : 0.f; nsb = lane < 8 ? SSQ2[(size_t)ROW_REV(gw + NGW) * 8 + lane] : 0.f;
    for (int t = gw; t < M; t += 2 * NGW) {
        const int t1 = t + NGW;
        v2u xa[4], xb[4];
#pragma unroll
        for (int j = 0; j < 4; ++j) { xa[j] = nxa[j]; xb[j] = nxb[j]; }
        const float sa = nsa, sb = nsb;
        { const int tn = (t + 2 * NGW) < M ? (t + 2 * NGW) : t, tn1 = tn + NGW;
#pragma unroll
          for (int j = 0; j < 4; ++j) { nxa[j] = ((const v2u*)(X2 + (size_t)ROW_REV(tn) * D))[lane + 64 * j]; nxb[j] = ((const v2u*)(X2 + (size_t)ROW_REV(tn1) * D))[lane + 64 * j]; }
          nsa = lane < 8 ? SSQ2[(size_t)ROW_REV(tn) * 8 + lane] : 0.f; nsb = lane < 8 ? SSQ2[(size_t)ROW_REV(tn1) * 8 + lane] : 0.f; }
        const float ra = rsqrtf(wave_sum(sa) * (1.f / D) + RMS_EPS), rb = rsqrtf(wave_sum(sb) * (1.f / D) + RMS_EPS);
        f32x4* oa = (f32x4*)(out + (size_t)ROW_REV(t) * D) + lane; f32x4* ob = (f32x4*)(out + (size_t)ROW_REV(t1) * D) + lane;
#pragma unroll
        for (int j = 0; j < 4; ++j) {
            oa[64 * j] = (f32x4){bflo(xa[j].x) * ra * gf[j].x, bfhi(xa[j].x) * ra * gf[j].y, bflo(xa[j].y) * ra * gf[j].z, bfhi(xa[j].y) * ra * gf[j].w};
            ob[64 * j] = (f32x4){bflo(xb[j].x) * rb * gf[j].x, bfhi(xb[j].x) * rb * gf[j].y, bflo(xb[j].y) * rb * gf[j].z, bfhi(xb[j].y) * rb * gf[j].w}; }
    }
}

struct Args { const float* in[15]; float* out; unsigned char* ws; int ph_lo, ph_hi, li, pad; };
__global__ void __launch_bounds__(NWAVES * 64, 2) fwd_kernel(Args args) {
    extern __shared__ __attribute__((aligned(16))) unsigned char lds_raw[];
    LAS unsigned char* lds = (LAS unsigned char*)lds_raw;
    volatile LAS unsigned* MISC = (volatile LAS unsigned*)(lds + MISC_OFF);
    const int tid = threadIdx.x, lane = tid & 63, wave = __builtin_amdgcn_readfirstlane(tid >> 6);
    const int G = gridDim.x; const int bx = blockIdx.x; const int vcu = (G % 8 == 0) ? (bx % 8) * (G / 8) + bx / 8 : bx;
    const int gw = vcu * NWAVES + wave, NGW = G * NWAVES;
    unsigned char* ws = args.ws;
    gu32* ctl = (gu32*)(ws + WS_CTL);
    const float* x = args.in[0]; const float* g_mix = args.in[1]; const float* w_in = args.in[2]; const float* pool_gw = args.in[3]; const float* pool_scale = args.in[4];
    const float* conv_w = args.in[5]; const float* w_bp = args.in[6]; const float* w_bc = args.in[7]; const float* w_out = args.in[8]; const float* g_ffn = args.in[9];
    const float* w_q = args.in[10]; const float* sub_keys = args.in[11]; const float* expert_u = args.in[12]; const float* expert_v = args.in[13]; const float* g_final = args.in[14];
    unsigned char* Wc8 = ws + WS_WC; unsigned char* Wbc8 = ws + WS_WBC; float* SBC = (float*)(ws + WS_SBC); float* SPC = (float*)(ws + WS_SPC); float* WcF = (float*)(ws + WS_WCF); unsigned* CMAXC = (unsigned*)(ctl + CW_CMAXC); bf16* Wout_t = (bf16*)(ws + WS_WOUT); unsigned char* Wpp8 = ws + WS_WPP; float* WppF = (float*)(ws + WS_WPPF); float* SBP = (float*)(ws + WS_SBP); float* SXR = (float*)(ws + WS_SXR); unsigned char* X1q = ws + WS_X1Q; unsigned* CMAXP = (unsigned*)(ctl + CW_CMAXP);
    float* SU = (float*)(ws + WS_SU); float* SV = (float*)(ws + WS_SV); float* SSQ = (float*)(ws + WS_SSQ);
    unsigned char* U8 = ws + WS_U8; unsigned char* V8 = ws + WS_V8; float* INV = (float*)(ws + WS_INV); float* SSQ2 = (float*)(ws + WS_SSQ2); unsigned* PART = (unsigned*)(ws + WS_PART); float* RSTD = (float*)(ws + WS_RSTD); unsigned short* WQ = (unsigned short*)(ws + WS_WV); float* SWH = (float*)(ws + WS_SWH);
    unsigned char* Hq = ws + WS_B; unsigned char* Winq = ws + WS_WIN; float* SA = (float*)(ws + WS_SA); float* SB = (float*)(ws + WS_SB); unsigned* CMAX = (unsigned*)(ctl + CW_CMAX); unsigned char* PA = ws + WS_B; unsigned char* CA = ws + WS_B + 64 * MiB; bf16* X1 = (bf16*)(ws + WS_B);
    bf16* Mb = (bf16*)(ws + WS_C); unsigned short* IDX = (unsigned short*)(ws + WS_C); float* EV = (float*)(ws + WS_C + 16 * MiB);
    unsigned char* Z8 = ws + WS_A; float* ZS = (float*)(ws + WS_A + 128 * MiB); unsigned char* G8 = ws + WS_A + 256 * MiB;
     _Float16* SC = (_Float16*)(ws + WS_A); bf16* X2 = (bf16*)(ws + WS_A);

    for (int u = tid; u < (LDS_BYTES - LDSCTL_OFF) / 4; u += NWAVES * 64) ((LAS unsigned*)(lds + LDSCTL_OFF))[u] = 0u;
    __syncthreads();
    XcdBarrier bar; bar.bar = (unsigned*)(ctl + CW_BAR); bar.x = 0; bar.st = nullptr;
    if (N_LAUNCHES != PER_PHASE) bar = xcd_barrier_post((unsigned*)(ctl + CW_BAR), MISC + 8);
#define GRID_BAR() do { if (N_LAUNCHES != PER_PHASE) xcd_barrier(bar); } while (0)
    const int lo = args.ph_lo, hi = args.ph_hi;
#define IN(k) (lo <= (k) && (k) < hi)
#define BOTH(k) (IN(k) && IN((k) + 1))

    if (IN(0)) for (int rep_ = 0; rep_ < ((PROBE_REPEAT >> 0) & 1) + 1; ++rep_) {
        LAS float* scr = (LAS float*)(lds + wave * 16384);
        constexpr int I_WPP = 1024, I_CMAX = 16 * 16, I_WOUT = (1024 / 64) * (1024 / 32), I_WBC = (512 / 64) * (1024 / 256), I_WC = 512;
        constexpr int NITEMS = I_WPP + I_CMAX + I_WBC + I_WC;
        for (int it = gw; it < NITEMS; it += NGW) {
            int r = it;
            if (r < I_WPP) { p0_wpp_item(w_q, sub_keys, g_ffn, WppF, CMAXP, scr, r, lane); continue; } r -= I_WPP;
            if (r < I_WC) { p0_wc_item(pool_gw, pool_scale, w_bp, WcF, CMAXC, scr, r, lane); continue; } r -= I_WC;
            if (r < I_CMAX) { p0_colmax_item(w_in, 4096, CMAX, r, lane); continue; } r -= I_CMAX;
            p0_colmax_item(w_bc, 1024, CMAXC, r, lane);
        }
        GRID_BAR();
        for (int it = gw; it < (1024 / 64) * (4096 / 32); it += NGW) p0_transpose_i8_item(w_in, 1024, 4096, Winq, CMAX, SB, scr, it, lane);
        for (int n = gw; n < NSC; n += NGW) p0_wpp_quant_row(WppF, CMAXP, Wpp8, SBP, n, lane);
        for (int n = gw; n < D; n += NGW) p0_wc_quant_row(WcF, CMAXC, Wc8, n, lane);
        for (int it = gw; it < (512 / 64) * (1024 / 32); it += NGW) p0_transpose_i8_item(w_bc, 512, 1024, Wbc8, CMAXC, SBC, scr, it, lane);
        for (int it = gw; it < I_WOUT; it += NGW) p0_transpose_item(w_out, 1024, 1024, Wout_t, scr, it, lane, CMAXC);
        {
            HRows ra, rb;
            p0_q_load(ra, expert_u, gw, gw + NGW, lane);
            for (int e = gw; e < NE; e += 2 * NGW) { const int en = e + 2 * NGW; if (en < NE) p0_q_load(rb, expert_u, en, en + NGW, lane); else p0_q_load(rb, expert_v, gw, gw + NGW, lane);
                p0_quant_rows2<false>(ra, g_ffn, U8, SU, e, e + NGW, lane); ra = rb; }
            for (int e = gw; e < NE; e += 2 * NGW) { const int en = e + 2 * NGW; if (en < NE) p0_q_load(rb, expert_v, en, en + NGW, lane); else p0_h_load(rb, x, gw, gw + NGW, lane);
                p0_quant_rows2<false>(ra, nullptr, V8, SV, e, e + NGW, lane); ra = rb; }
            for (int m = gw; m < M; m += 2 * NGW) { const int mn = (m + 2 * NGW) < M ? (m + 2 * NGW) : m; p0_h_load(rb, x, mn, mn + NGW, lane);
                p0_h_rows2(ra, g_mix, Hq, SA, m, m + NGW, lane); ra = rb; }
        }
        if (BOTH(0)) GRID_BAR();
    }
    if (IN(1)) for (int rep_ = 0; rep_ < ((PROBE_REPEAT >> 1) & 1) + 1; ++rep_) {
        pg8::Gemm g{(const bf16*)Hq, (const bf16*)Winq, (const bf16*)Hq, (const bf16*)Winq, M, DIN, D / 2}; pg8::StaticOrder S; S.init(M, DIN, G, bx, 1, 1 + ((PROBE_GEMM_REP >> 1) & 1));
        EpiZ E{Z8, ZS, G8, SA, SB};
        pg8::gemm_phase<EpiZ, pg8::StaticOrder, true, true, true>(lds, g, S, E, (unsigned)((bx >> 3) & 3) * STAGGER_P1);
        if (BOTH(1)) GRID_BAR();
    }
    if (IN(2)) for (int rep_ = 0; rep_ < ((PROBE_REPEAT >> 2) & 1) + 1; ++rep_) {
        p2_timemix(Z8, ZS, conv_w, PA, CA, SPC, gw, NGW, lane);
        if (BOTH(2)) GRID_BAR();
    }
    if (IN(3)) for (int rep_ = 0; rep_ < ((PROBE_REPEAT >> 3) & 1) + 1; ++rep_) {
        pg8::Gemm g{(const bf16*)PA, (const bf16*)Wc8, (const bf16*)CA, (const bf16*)Wbc8, M, D, DP / 2}; pg8::StaticOrder S; S.init(M, D, G, bx, 2, 1 + ((PROBE_GEMM_REP >> 3) & 1));
        EpiGate E{G8, Mb, SPC};
        pg8::gemm_phase<EpiGate, pg8::StaticOrder, true, true, true>(lds, g, S, E);
        if (BOTH(3)) GRID_BAR();
    }
    if (IN(4)) for (int rep_ = 0; rep_ < ((PROBE_REPEAT >> 4) & 1) + 1; ++rep_) {
        pg8::Gemm g{Mb, Wout_t, Mb, Wout_t, M, D, D}; pg8::StaticOrder S; S.init(M, D, G, bx, 1, 1 + ((PROBE_GEMM_REP >> 4) & 1));
        EpiRes E{x, X1, SSQ};
        pg8::gemm_phase<EpiRes, pg8::StaticOrder, true, true>(lds, g, S, E);
        if (BOTH(4)) GRID_BAR();
    }
    if (IN(5)) for (int rep_ = 0; rep_ < ((PROBE_REPEAT >> 5) & 1) + 1; ++rep_) {
        { XRows xa, xb; p5_x1_load(xa, X1, SSQ, ROW_QREV(gw), ROW_QREV(gw + NGW), lane);
          for (int r = gw; r < M; r += 2 * NGW) { const int rn = (r + 2 * NGW) < M ? (r + 2 * NGW) : r; p5_x1_load(xb, X1, SSQ, ROW_QREV(rn), ROW_QREV(rn + NGW), lane);
              p5_x1_quant_rows2(xa, X1q, SA, SXR, RSTD, ROW_QREV(r), ROW_QREV(r + NGW), lane); xa = xb; } }
        GRID_BAR();
        pg8::Gemm g{(const bf16*)X1q, (const bf16*)Wpp8, (const bf16*)X1q, (const bf16*)Wpp8, M, NSC, D / 2}; pg8::StaticOrder S; S.init(M, NSC, G, bx, 1, 1 + ((PROBE_GEMM_REP >> 5) & 1));
        EpiScore E{SXR, SBP, SC};
        pg8::gemm_phase<EpiScore, pg8::StaticOrder, true, true, true>(lds, g, S, E);
        if (BOTH(5)) GRID_BAR();
    }
    if (IN(6)) for (int rep_ = 0; rep_ < ((PROBE_REPEAT >> 6) & 1) + 1; ++rep_) {
        p6_topk(SC, IDX, EV, INV, lds, gw, NGW, wave, lane);
        if (BOTH(6)) GRID_BAR();
    }
    const unsigned xcc = xb_xcc_id();
    if (IN(7)) for (int rep_ = 0; rep_ < ((PROBE_REPEAT >> 7) & 1) + 1; ++rep_) {
        p7_u_phase((unsigned*)(ctl + CW_QU + 2048 * rep_), xcc, X1q, SA, IDX, U8, PART, lane);
        if (BOTH(7)) GRID_BAR();
    }
    if (IN(8)) for (int rep_ = 0; rep_ < ((PROBE_REPEAT >> 8) & 1) + 1; ++rep_) {
        p8_w_phase(PART, RSTD, IDX, EV, INV, SU, SV, WQ, SWH, gw, NGW, lane);
        if (BOTH(8)) GRID_BAR();
    }
    if (IN(9)) for (int rep_ = 0; rep_ < ((PROBE_REPEAT >> 9) & 1) + 1; ++rep_) {
        p9_v_phase((unsigned*)(ctl + CW_QV + 2048 * rep_), xcc, X1, IDX, WQ, SWH, V8, X2, SSQ2, lane);
        if (BOTH(9)) GRID_BAR();
    }
    if (IN(10)) {
        p10_final(X2, args.out, SSQ2, g_final, gw, NGW, lane);
    }
#undef IN
#undef BOTH
#undef GRID_BAR
}

extern "C" void kernel_launch(void* const* d_in, const int* in_sizes, int n_in, void* d_out, int out_size, void* d_ws, size_t ws_size, hipStream_t stream) {
    static int grid = 0;
    if (grid == 0) {
        if (n_in != 15 || in_sizes[0] != M * D || out_size != M * D || ws_size < WS_END) { fprintf(stderr, "kernel_launch: unexpected shapes (n_in %d, in0 %d, out %d, ws %zu); nothing launched\n", n_in, n_in > 0 ? in_sizes[0] : -1, out_size, ws_size); grid = -1; return; }
        int dev = 0, cus = 0, per_cu = 0;
        if (hipGetDevice(&dev) != hipSuccess || hipDeviceGetAttribute(&cus, hipDeviceAttributeMultiprocessorCount, dev) != hipSuccess) { grid = -1; return; }
        if (hipFuncSetAttribute((const void*)fwd_kernel, hipFuncAttributeMaxDynamicSharedMemorySize, LDS_BYTES) != hipSuccess) { fprintf(stderr, "kernel_launch: hipFuncSetAttribute failed\n"); grid = -1; return; }
        if (hipOccupancyMaxActiveBlocksPerMultiprocessor(&per_cu, (const void*)fwd_kernel, NWAVES * 64, LDS_BYTES) != hipSuccess || per_cu < 1)
            fprintf(stderr, "kernel_launch: note: occupancy query reports %d workgroups per CU\n", per_cu);
        (void)hipGetLastError();
        grid = cus;
    }
    if (grid < 0) return;
    if (hipMemsetAsync((char*)d_ws + WS_CTL, 0, CTL_ZERO_BYTES, stream) != hipSuccess) { fprintf(stderr, "kernel_launch: hipMemsetAsync failed\n"); return; }
    Args a{};
    for (int i = 0; i < 15; ++i) a.in[i] = (const float*)d_in[i];
    a.out = (float*)d_out; a.ws = (unsigned char*)d_ws;
    for (int li = 0; li < N_LAUNCHES; ++li) {
        a.ph_lo = (N_LAUNCHES == PER_PHASE) ? li : 0; a.ph_hi = (N_LAUNCHES == PER_PHASE) ? li + 1 : PER_PHASE; a.li = li;
        hipLaunchKernelGGL(fwd_kernel, dim3(grid), dim3(NWAVES * 64), LDS_BYTES, stream, a);
        const hipError_t le = hipPeekAtLastError();
        if (le != hipSuccess) { fprintf(stderr, "kernel_launch: launch %d failed: %s\n", li, hipGetErrorName(le)); break; }
    }
}
```
